# Optimizing an MI355X kernel written in HIP

```python
import math
import jax, jax.numpy as jnp
from jax import lax
import numpy as np

D_MODEL = 1024
BATCH = 1
SEQ = 16384
DEPTH = 4

MIX_WIDTH = D_MODEL
ATTN_WIDTH = MIX_WIDTH // 2
POOL_WIDTH = MIX_WIDTH - ATTN_WIDTH
DIFF_HEAD_DIM = 64
N_DIFF_HEADS = ATTN_WIDTH // (2 * DIFF_HEAD_DIM)
N_POOL_GROUPS = 4
POOL_GROUP_WIDTH = POOL_WIDTH // N_POOL_GROUPS
POOL_WINDOWS = (2, 4, 8, 16)
D_FF = ((8 * D_MODEL // 3 + 255) // 256) * 256
IN_WIDTH = 3 * ATTN_WIDTH + POOL_WIDTH
ROPE_THETA = 10000.0
Q_BLOCK = 128
NORM_EPS = 1e-6

kernel_name = "hymba_diffattn_pool_macaron"


def rms_norm(x, g):
    xf = x.astype(jnp.float32)
    y = xf * lax.rsqrt(jnp.mean(xf * xf, axis=-1, keepdims=True) + NORM_EPS)
    return (y * g.astype(jnp.float32)).astype(x.dtype)


def swiglu(h, w_gate, w_up, w_down):
    return (jax.nn.silu(h @ w_gate) * (h @ w_up)) @ w_down


def rope_tables(seq, dim):
    inv_freq = ROPE_THETA ** (-jnp.arange(0, dim, 2, dtype=jnp.float32) / dim)
    ang = jnp.arange(seq, dtype=jnp.float32)[:, None] * inv_freq[None, :]
    ang = jnp.concatenate([ang, ang], axis=-1)
    return jnp.cos(ang), jnp.sin(ang)


def apply_rope(t, cos, sin):
    half = t.shape[-1] // 2
    t1, t2 = t[..., :half], t[..., half:]
    rot = jnp.concatenate([-t2, t1], axis=-1)
    c = cos[None, :, None, None, :]
    s = sin[None, :, None, None, :]
    return (t.astype(jnp.float32) * c + rot.astype(jnp.float32) * s).astype(t.dtype)


def diff_attention(q, k, v, lam):
    B, S, H, _, d = q.shape
    nb = S // Q_BLOCK
    scale = d ** -0.5
    kt = jnp.transpose(k, (0, 2, 3, 1, 4))
    vt = jnp.transpose(v, (0, 2, 1, 3))
    qb = (q * scale).reshape(B, nb, Q_BLOCK, H, 2, d).transpose(1, 0, 3, 4, 2, 5)
    key_pos = jnp.arange(S, dtype=jnp.int32)
    starts = jnp.arange(nb, dtype=jnp.int32) * Q_BLOCK

    def block(args):
        q_blk, start = args
        s = jnp.einsum('bhcqd,bhckd->bhcqk', q_blk, kt).astype(jnp.float32)
        q_pos = start + jnp.arange(Q_BLOCK, dtype=jnp.int32)
        mask = key_pos[None, :] <= q_pos[:, None]
        s = jnp.where(mask, s, -jnp.inf)
        p = jax.nn.softmax(s, axis=-1)
        a = p[:, :, 0] - lam * p[:, :, 1]
        return jnp.einsum('bhqk,bhke->bhqe', a.astype(v.dtype), vt)

    out = lax.map(block, (qb, starts))
    return out.transpose(1, 0, 3, 2, 4).reshape(B, S, H, 2 * d)


def pool_mixer(u, w, scale):
    B, S, _ = u.shape
    ug = u.reshape(B, S, N_POOL_GROUPS, POOL_GROUP_WIDTH).astype(jnp.float32)
    cs = jnp.cumsum(ug, axis=1)
    cs = jnp.concatenate([jnp.zeros_like(cs[:, :1]), cs], axis=1)
    pos = jnp.arange(S, dtype=jnp.int32)[:, None]
    win = jnp.array(POOL_WINDOWS, dtype=jnp.int32)[None, :]
    lo = jnp.maximum(pos + 1 - win, 0)
    grp = jnp.arange(N_POOL_GROUPS, dtype=jnp.int32)[None, :]
    window_sum = cs[:, 1:] - cs[:, lo, grp]
    count = jnp.minimum(pos + 1, win).astype(jnp.float32)
    diff = (window_sum / count[None, :, :, None] - ug).astype(u.dtype)
    y = jnp.einsum('bsgc,gce->bsge', diff, w).reshape(B, S, POOL_WIDTH)
    return y * scale


def setup_inputs(seed: int = 0) -> dict:
    key = jax.random.key(seed)
    ks = jax.random.split(key, 24)
    f32 = jnp.float32

    def normal(k, shape, s):
        return jax.random.normal(k, shape, dtype=f32) * s

    def gain(k, shape):
        return 1.0 + normal(k, shape, 0.02)

    return {
        "x": normal(ks[0], (BATCH, SEQ, D_MODEL), 1.0),
        "ffn1_norm": gain(ks[1], (DEPTH, D_MODEL)),
        "ffn1_w_gate": normal(ks[2], (DEPTH, D_MODEL, D_FF), D_MODEL ** -0.5),
        "ffn1_w_up": normal(ks[3], (DEPTH, D_MODEL, D_FF), D_MODEL ** -0.5),
        "ffn1_w_down": normal(ks[4], (DEPTH, D_FF, D_MODEL), D_FF ** -0.5),
        "mix_norm": gain(ks[5], (DEPTH, D_MODEL)),
        "w_in": normal(ks[6], (DEPTH, D_MODEL, IN_WIDTH), D_MODEL ** -0.5),
        "lambda_q1": normal(ks[7], (DEPTH, DIFF_HEAD_DIM), 0.1),
        "lambda_k1": normal(ks[8], (DEPTH, DIFF_HEAD_DIM), 0.1),
        "lambda_q2": normal(ks[9], (DEPTH, DIFF_HEAD_DIM), 0.1),
        "lambda_k2": normal(ks[10], (DEPTH, DIFF_HEAD_DIM), 0.1),
        "subln_gain": gain(ks[11], (DEPTH, 2 * DIFF_HEAD_DIM)),
        "pool_w": normal(ks[12], (DEPTH, N_POOL_GROUPS, POOL_GROUP_WIDTH, POOL_GROUP_WIDTH), POOL_GROUP_WIDTH ** -0.5),
        "pool_scale": gain(ks[13], (DEPTH, POOL_WIDTH)),
        "w_out": normal(ks[14], (DEPTH, MIX_WIDTH, D_MODEL), MIX_WIDTH ** -0.5),
        "ffn2_norm": gain(ks[15], (DEPTH, D_MODEL)),
        "ffn2_w_gate": normal(ks[16], (DEPTH, D_MODEL, D_FF), D_MODEL ** -0.5),
        "ffn2_w_up": normal(ks[17], (DEPTH, D_MODEL, D_FF), D_MODEL ** -0.5),
        "ffn2_w_down": normal(ks[18], (DEPTH, D_FF, D_MODEL), D_FF ** -0.5),
        "final_norm": gain(ks[19], (D_MODEL,)),
    }


def reference(x, ffn1_norm, ffn1_w_gate, ffn1_w_up, ffn1_w_down, mix_norm, w_in,
              lambda_q1, lambda_k1, lambda_q2, lambda_k2, subln_gain, pool_w, pool_scale,
              w_out, ffn2_norm, ffn2_w_gate, ffn2_w_up, ffn2_w_down, final_norm):
    B, S, _ = x.shape
    H, d = N_DIFF_HEADS, DIFF_HEAD_DIM
    cos, sin = rope_tables(S, d)

    for l in range(DEPTH):
        h = rms_norm(x, ffn1_norm[l])
        x = x + 0.5 * swiglu(h, ffn1_w_gate[l], ffn1_w_up[l], ffn1_w_down[l])

        h = rms_norm(x, mix_norm[l])
        proj = h @ w_in[l]
        q = proj[..., :ATTN_WIDTH].reshape(B, S, H, 2, d)
        k = proj[..., ATTN_WIDTH:2 * ATTN_WIDTH].reshape(B, S, H, 2, d)
        v = proj[..., 2 * ATTN_WIDTH:3 * ATTN_WIDTH].reshape(B, S, H, 2 * d)
        u = proj[..., 3 * ATTN_WIDTH:]

        q = apply_rope(q, cos, sin)
        k = apply_rope(k, cos, sin)
        lam_init = 0.8 - 0.6 * math.exp(-0.3 * l)
        lam = (jnp.exp(jnp.sum(lambda_q1[l].astype(jnp.float32) * lambda_k1[l].astype(jnp.float32)))
               - jnp.exp(jnp.sum(lambda_q2[l].astype(jnp.float32) * lambda_k2[l].astype(jnp.float32)))
               + lam_init)
        o = diff_attention(q, k, v, lam)
        o = rms_norm(o, subln_gain[l]) * (1.0 - lam_init)
        o = o.reshape(B, S, ATTN_WIDTH)

        p = pool_mixer(u, pool_w[l], pool_scale[l])

        x = x + jnp.concatenate([o, p], axis=-1) @ w_out[l]

        h = rms_norm(x, ffn2_norm[l])
        x = x + 0.5 * swiglu(h, ffn2_w_gate[l], ffn2_w_up[l], ffn2_w_down[l])

    return rms_norm(x, final_norm)
```

```cpp
#include <hip/hip_runtime.h>
#include <hip/hip_cooperative_groups.h>
#include <cstdio>
#include <cstdint>
namespace cg = cooperative_groups;
namespace pg8 {
#define PG8_LAS __attribute__((address_space(3)))
typedef unsigned short bf16_t;
typedef short bf16x8 __attribute__((ext_vector_type(8)));
typedef float f32x4 __attribute__((ext_vector_type(4)));
typedef unsigned u32x4 __attribute__((ext_vector_type(4)));
constexpr int BM = 256, BK = 64, HALF = 128, HTB = HALF * BK * 2  , STAGE_BYTES = 8 * HTB, NXCD = 8, WGM = 8;

__host__ __device__ __forceinline__ int lds_byte(int r, int c) { const int st = (r >> 4) * 2 + (c >> 5), rr = r & 15, cc = c & 31, ob = rr * 64 + cc * 2; return st * 1024 + (ob ^ (((ob >> 9) & 1) << 5)); }
__host__ __device__ __forceinline__ void stage_rc(int b, int& R, int& C) { const int st = b / 1024, sb = b % 1024, swz = sb ^ (((sb >> 9) & 1) << 5); R = (st >> 1) * 16 + swz / 64; C = (st & 1) * 32 + (swz % 64) / 2; }
__host__ __device__ __forceinline__ int perm32(int rho) { const int n = rho >> 4, i = rho & 15; return 8 * (i >> 2) + 4 * n + (i & 3); }

struct Unit { int pm, pn; };
struct Gemm { const bf16_t* A; const bf16_t* Bt; int M, N, K; };

struct StaticOrder {
    int nM, nN, nwg, G, c;
    __host__ __device__ void init(int M, int N, int G_, int c_) { nM = M / BM; nN = N / BM; nwg = nM * nN; G = G_; c = c_; }
    __host__ __device__ bool next(int i, Unit& u) const {
        const long L = (long)i * G + c; if (L >= nwg) return false;
        int wgid = (int)L; { const int q = nwg / NXCD, r = nwg % NXCD, xcd = wgid % NXCD, off = wgid / NXCD; wgid = (xcd < r ? xcd * (q + 1) : r * (q + 1) + (xcd - r) * q) + off; }
        const int nig = WGM * nN, gid = wgid / nig, fm = gid * WGM, gsz = (nM - fm) < WGM ? (nM - fm) : WGM;
        u.pm = fm + ((wgid % nig) % gsz); u.pn = (wgid % nig) / gsz; return true;
    }
    __device__ __forceinline__ void a_ready(const Unit&) const {}
    __device__ __forceinline__ void done(const Unit&) const {}
};

__device__ __forceinline__ unsigned cvt_pk_bf16(float lo, float hi) { unsigned r; asm volatile("v_cvt_pk_bf16_f32 %0, %1, %2" : "=v"(r) : "v"(lo), "v"(hi)); return r; }
typedef float f32x2 __attribute__((ext_vector_type(2)));
__device__ __forceinline__ f32x2 gelu_pk(f32x2 v) {
    const f32x2 av = __builtin_elementwise_abs(v), d = av * 0.2316418882f + 1.0f;
    f32x2 t; t.x = __builtin_amdgcn_rcpf(d.x); t.y = __builtin_amdgcn_rcpf(d.y);
    f32x2 q = t * 0.5307027145f + (-0.7265760135f); q = q * t + 0.7107068705f; q = q * t + (-0.142248368f); q = q * t + 0.127414796f; q = q * t;
    const f32x2 s = (v * v) * (-0.72134752044f);
    f32x2 e; e.x = __builtin_amdgcn_exp2f(s.x); e.y = __builtin_amdgcn_exp2f(s.y);
    const f32x2 m = v * (q * e), r = v - m;
    f32x2 o; o.x = v.x < 0.f ? m.x : r.x; o.y = v.y < 0.f ? m.y : r.y; return o;
}

template <int ACT  > struct EpiBf16 {
    static constexpr bool PERM = true, AFTER_DRAIN = false; static_assert(ACT == 0 || ACT == 1, "EpiBf16: ACT is 0 (none) or 1 (gelu_pk)");
    bf16_t* O; int ldc; const float* bias; int split_cols; size_t split_stride; float scale0;
    __device__ __forceinline__ void operator()(const f32x4 (&acc)[2][2][4][2], const Unit& u, int wr, int wc, int fr, int fq) const {
        const int row0 = u.pm * BM + wr * 64 + fr; int colt = u.pn * BM; bf16_t* base = O;
        float sc = 1.f; if (split_cols) { const int t = colt / split_cols; base += (size_t)t * split_stride; colt -= t * split_cols; if (t == 0) sc = scale0; }
        const int col0 = colt + wc * 32 + 8 * fq, bcol0 = u.pn * BM + wc * 32 + 8 * fq;
        f32x4 bv[2][2];
#pragma unroll
        for (int bj = 0; bj < 2; ++bj)
#pragma unroll
            for (int n = 0; n < 2; ++n) bv[bj][n] = bias ? *(const f32x4*)(bias + bcol0 + bj * HALF + 4 * n) : (f32x4){0.f, 0.f, 0.f, 0.f};
#pragma unroll
        for (int ai = 0; ai < 2; ++ai)
#pragma unroll
            for (int m = 0; m < 4; ++m) { bf16_t* rowp = base + (size_t)(row0 + ai * HALF + m * 16) * ldc + col0;
#pragma unroll
                for (int bj = 0; bj < 2; ++bj) { f32x4 v0 = acc[ai][bj][m][0] + bv[bj][0], v1 = acc[ai][bj][m][1] + bv[bj][1];
                    if (ACT == 1) { f32x2 a = gelu_pk((f32x2){v0[0], v0[1]}), b = gelu_pk((f32x2){v0[2], v0[3]}), c = gelu_pk((f32x2){v1[0], v1[1]}), d = gelu_pk((f32x2){v1[2], v1[3]});
                        v0 = (f32x4){a.x, a.y, b.x, b.y}; v1 = (f32x4){c.x, c.y, d.x, d.y}; }
                    v0 = v0 * sc; v1 = v1 * sc; u32x4 w; w.x = cvt_pk_bf16(v0[0], v0[1]); w.y = cvt_pk_bf16(v0[2], v0[3]); w.z = cvt_pk_bf16(v1[0], v1[1]); w.w = cvt_pk_bf16(v1[2], v1[3]);
                    *(u32x4*)(rowp + bj * HALF) = w; } }
    }
};
__device__ __forceinline__ float rs_from_ss(const float* p) { const f32x4 a = ((const f32x4*)p)[0], b = ((const f32x4*)p)[1], c = ((const f32x4*)p)[2], d = ((const f32x4*)p)[3];
    const float ss = (((a[0] + a[1]) + (a[2] + a[3])) + ((b[0] + b[1]) + (b[2] + b[3]))) + (((c[0] + c[1]) + (c[2] + c[3])) + ((d[0] + d[1]) + (d[2] + d[3])));
    return __builtin_amdgcn_rsqf(ss * (1.0f / 1024.0f) + 1e-6f); }
struct EpiGateUp {
    static constexpr bool PERM = true, AFTER_DRAIN = false;
    bf16_t* H; const float* rowss;
    __device__ __forceinline__ void operator()(const f32x4 (&acc)[2][2][4][2], const Unit& u, int wr, int wc, int fr, int fq) const {
        const int row0 = u.pm * BM + wr * 64 + fr; const int col0 = u.pn * HALF + wc * 32 + 8 * fq;
#pragma unroll
        for (int ai = 0; ai < 2; ++ai)
#pragma unroll
            for (int m = 0; m < 4; ++m) { const int row = row0 + ai * HALF + m * 16; const float r = rs_from_ss(rowss + (size_t)row * 16);
                float hv[8];
#pragma unroll
                for (int n = 0; n < 2; ++n)
#pragma unroll
                    for (int e = 0; e < 4; ++e) { const float g = acc[ai][0][m][n][e] * r, up = acc[ai][1][m][n][e] * r;
                        const float sg = g * __builtin_amdgcn_rcpf(1.0f + __builtin_amdgcn_exp2f(g * -1.4426950408889634f)); hv[n * 4 + e] = sg * up; }
                u32x4 w; w.x = cvt_pk_bf16(hv[0], hv[1]); w.y = cvt_pk_bf16(hv[2], hv[3]); w.z = cvt_pk_bf16(hv[4], hv[5]); w.w = cvt_pk_bf16(hv[6], hv[7]);
                *(u32x4*)(H + (size_t)row * 2816 + col0) = w; }
    }
};
struct EpiResid {
    static constexpr bool PERM = true, AFTER_DRAIN = false;
    const float* xin; float* xout; bf16_t* xb; float* rowss_next; float alpha;
    __device__ __forceinline__ void operator()(const f32x4 (&acc)[2][2][4][2], const Unit& u, int wr, int wc, int fr, int fq) const {
        const int row0 = u.pm * BM + wr * 64 + fr; const int col0 = u.pn * BM + wc * 32 + 8 * fq;
#pragma unroll
        for (int ai = 0; ai < 2; ++ai)
#pragma unroll
            for (int m = 0; m < 4; ++m) { const int row = row0 + ai * HALF + m * 16; float ss = 0.f;
#pragma unroll
                for (int bj = 0; bj < 2; ++bj) { const size_t off = (size_t)row * 1024 + col0 + bj * HALF;
                    const f32x4 a0 = *(const f32x4*)(xin + off), a1 = *(const f32x4*)(xin + off + 4);
                    const f32x4 v0 = a0 + acc[ai][bj][m][0] * alpha, v1 = a1 + acc[ai][bj][m][1] * alpha;
                    *(f32x4*)(xout + off) = v0; *(f32x4*)(xout + off + 4) = v1;
                    ss += (v0[0] * v0[0] + v0[1] * v0[1]) + (v0[2] * v0[2] + v0[3] * v0[3]) + (v1[0] * v1[0] + v1[1] * v1[1]) + (v1[2] * v1[2] + v1[3] * v1[3]);
                    u32x4 w; w.x = cvt_pk_bf16(v0[0], v0[1]); w.y = cvt_pk_bf16(v0[2], v0[3]); w.z = cvt_pk_bf16(v1[0], v1[1]); w.w = cvt_pk_bf16(v1[2], v1[3]);
                    *(u32x4*)(xb + off) = w; }
                ss += __shfl_xor(ss, 16); ss += __shfl_xor(ss, 32);
                if (fq == 0) rowss_next[(size_t)row * 16 + u.pn * 4 + wc] = ss; }
    }
};
struct EpiQKVU {
    static constexpr bool PERM = true, AFTER_DRAIN = false;
    bf16_t* O; const float* rowss; const float* rope;
    __device__ __forceinline__ void operator()(const f32x4 (&acc)[2][2][4][2], const Unit& u, int wr, int wc, int fr, int fq) const {
        const int row0 = u.pm * BM + wr * 64 + fr; const int col0 = u.pn * BM + wc * 32 + 8 * fq; const int sec = u.pn >> 1;
        const int j0 = 16 * (wc & 1) + 4 * fq;
#pragma unroll
        for (int ai = 0; ai < 2; ++ai)
#pragma unroll
            for (int m = 0; m < 4; ++m) { const int row = row0 + ai * HALF + m * 16; float r = rs_from_ss(rowss + (size_t)row * 16); if (sec == 0) r *= 0.125f * 1.4426950408889634f;
                f32x4 cs0 = (f32x4){1.f, 0.f, 1.f, 0.f}, cs1 = cs0;
                if (sec < 2) { const f32x4* rp = (const f32x4*)(rope + ((size_t)row * 32 + j0) * 2); cs0 = rp[0]; cs1 = rp[1]; }
#pragma unroll
                for (int bj = 0; bj < 2; ++bj) { const f32x4 v0 = acc[ai][bj][m][0] * r, v1 = acc[ai][bj][m][1] * r;
                    const float o0 = v0[0] * cs0[0] - v0[1] * cs0[1], o1 = v0[1] * cs0[0] + v0[0] * cs0[1];
                    const float o2 = v0[2] * cs0[2] - v0[3] * cs0[3], o3 = v0[3] * cs0[2] + v0[2] * cs0[3];
                    const float o4 = v1[0] * cs1[0] - v1[1] * cs1[1], o5 = v1[1] * cs1[0] + v1[0] * cs1[1];
                    const float o6 = v1[2] * cs1[2] - v1[3] * cs1[3], o7 = v1[3] * cs1[2] + v1[2] * cs1[3];
                    u32x4 w; w.x = cvt_pk_bf16(o0, o1); w.y = cvt_pk_bf16(o2, o3); w.z = cvt_pk_bf16(o4, o5); w.w = cvt_pk_bf16(o6, o7);
                    *(u32x4*)(O + (size_t)row * 2048 + col0 + bj * HALF) = w; } }
    }
};

template <class Epi, class Sched, bool ALIGN_EPI = false, bool SP2 = false>
__device__ __forceinline__ void gemm_phase(PG8_LAS unsigned char* lds, const Gemm g, const Sched& S, const Epi& E) {
    int tid_ = threadIdx.x; asm volatile("" : "+v"(tid_));
    const int tid = tid_, wid = __builtin_amdgcn_readfirstlane(tid >> 6), lane = tid & 63, wr = wid >> 2, wc = wid & 3, fr = lane & 15, fq = lane >> 4;
    const int K = g.K, nt = K / BK;
    unsigned voffA[2], voffB[2];
#pragma unroll
    for (int i = 0; i < 2; ++i) { int R, C; stage_rc(tid * 16 + i * 8192, R, C); const int Rb = Epi::PERM ? ((R & ~31) + perm32(R & 31)) : R;
        voffA[i] = (unsigned)(R * K + C) * 2u; voffB[i] = (unsigned)(Rb * K + C) * 2u; }
    const size_t kstep = (size_t)(BK * 2);
    const size_t hstep = (size_t)HALF * K * 2;
    const size_t tstep = 2 * hstep;
    const unsigned ldsw = (unsigned)wid * 1024u;
    const int aoff = lds_byte(wr * 64 + fr, fq * 8), boff = lds_byte(wc * 32 + fr, fq * 8);
#define PG8_SA(b, h) (((b) * 2 + (h)) * HTB)
#define PG8_SB(b, h) ((4 + (b) * 2 + (h)) * HTB)
#define PG8_STAGE(bufoff, gbase, voff) do { _Pragma("unroll") for (int _i = 0; _i < 2; ++_i) \
        __builtin_amdgcn_global_load_lds((const unsigned*)((const char*)(gbase) + (voff)[_i]), (PG8_LAS unsigned*)(lds + (bufoff) + ldsw + _i * 8192), 16, 0, 0); } while (0)
#define PG8_LDA(dst, b, h) do { _Pragma("unroll") for (int m = 0; m < 4; ++m) _Pragma("unroll") for (int k = 0; k < 2; ++k) dst[m][k] = *(const PG8_LAS bf16x8*)(lds + PG8_SA(b, h) + aoff + m * 2048 + k * 1024); } while (0)
#define PG8_LDB(dst, b, h) do { _Pragma("unroll") for (int n = 0; n < 2; ++n) _Pragma("unroll") for (int k = 0; k < 2; ++k) dst[n][k] = *(const PG8_LAS bf16x8*)(lds + PG8_SB(b, h) + boff + n * 2048 + k * 1024); } while (0)
#define PG8_MMA(ai, bj, At, Bt) do { __builtin_amdgcn_s_setprio(1); _Pragma("unroll") for (int m = 0; m < 4; ++m) _Pragma("unroll") for (int n = 0; n < 2; ++n) _Pragma("unroll") for (int k = 0; k < 2; ++k) \
        acc[ai][bj][m][n] = __builtin_amdgcn_mfma_f32_16x16x32_bf16(Bt[n][k], At[m][k], acc[ai][bj][m][n], 0, 0, 0); __builtin_amdgcn_s_setprio(0); } while (0)
#define PG8_WAIT_V(n) asm volatile("s_waitcnt vmcnt(" #n ")" ::: "memory")
#define PG8_WAIT_L(n) asm volatile("s_waitcnt lgkmcnt(" #n ")" ::: "memory")
#define PG8_BAR __builtin_amdgcn_s_barrier()
#define PG8_SCHED __builtin_amdgcn_sched_barrier(0)
    Unit cur, nxt; int ui = 0;
    if (!S.next(0, cur)) return;
    f32x4 acc[2][2][4][2];
#pragma unroll
    for (int a = 0; a < 2; ++a)
#pragma unroll
        for (int b = 0; b < 2; ++b)
#pragma unroll
            for (int m = 0; m < 4; ++m)
#pragma unroll
                for (int n = 0; n < 2; ++n) acc[a][b][m][n] = (f32x4){0.f, 0.f, 0.f, 0.f};
    bf16x8 At[4][2], B0[2][2], B1[2][2];
    const char* cA = (const char*)g.A + (size_t)cur.pm * tstep; const char* cB = (const char*)g.Bt + (size_t)cur.pn * tstep;
    S.a_ready(cur);
    if constexpr (SP2) {
        PG8_STAGE(PG8_SB(0, 0), cB, voffB); PG8_STAGE(PG8_SB(0, 1), cB + hstep, voffB); PG8_STAGE(PG8_SA(0, 0), cA, voffA); PG8_STAGE(PG8_SA(0, 1), cA + hstep, voffA);
        if (wr == 1) PG8_BAR;
        PG8_WAIT_V(2); PG8_BAR;
        PG8_STAGE(PG8_SB(1, 0), cB + kstep, voffB); PG8_STAGE(PG8_SA(1, 0), cA + kstep, voffA); PG8_STAGE(PG8_SB(1, 1), cB + hstep + kstep, voffB);
        PG8_WAIT_V(6); PG8_BAR;
    } else {
        PG8_STAGE(PG8_SB(0, 0), cB, voffB); PG8_STAGE(PG8_SA(0, 0), cA, voffA); PG8_STAGE(PG8_SB(0, 1), cB + hstep, voffB); PG8_STAGE(PG8_SA(0, 1), cA + hstep, voffA);
        if (wr == 1) PG8_BAR;
        PG8_WAIT_V(4); PG8_BAR;
        PG8_STAGE(PG8_SB(1, 0), cB + kstep, voffB); PG8_STAGE(PG8_SA(1, 0), cA + kstep, voffA); PG8_STAGE(PG8_SB(1, 1), cB + hstep + kstep, voffB);
        PG8_WAIT_V(6); PG8_BAR;
    }
    for (;;) {
        const bool has_next = S.next(ui + 1, nxt);
        const char* nA = has_next ? (const char*)g.A + (size_t)nxt.pm * tstep : cA; const char* nB = has_next ? (const char*)g.Bt + (size_t)nxt.pn * tstep : cB;
        for (int t = 0; t < nt; t += 2) {
            const bool last = (t == nt - 2);
            const char* a1 = cA + (size_t)(t + 1) * kstep;
            const char* a2 = last ? nA : cA + (size_t)(t + 2) * kstep; const char* b2 = last ? nB : cB + (size_t)(t + 2) * kstep;
            const char* a3 = a2 + kstep; const char* b3 = b2 + kstep;
            if (last && has_next) S.a_ready(nxt);
            if constexpr (SP2) {
            PG8_LDB(B0, 0, 0); PG8_LDB(B1, 0, 1); PG8_SCHED; PG8_LDA(At, 0, 0); PG8_STAGE(PG8_SA(1, 1), a1 + hstep, voffA);
            PG8_WAIT_V(8); PG8_WAIT_L(0); PG8_BAR; PG8_MMA(0, 0, At, B0); PG8_MMA(0, 1, At, B1); PG8_BAR; PG8_SCHED;
            PG8_LDA(At, 0, 1); PG8_STAGE(PG8_SB(0, 0), b2, voffB); PG8_STAGE(PG8_SB(0, 1), b2 + hstep, voffB); PG8_STAGE(PG8_SA(0, 0), a2, voffA);
            PG8_WAIT_V(8); PG8_WAIT_L(0); PG8_BAR; PG8_MMA(1, 0, At, B0); PG8_MMA(1, 1, At, B1); PG8_BAR; PG8_SCHED;
            PG8_LDB(B0, 1, 0); PG8_LDB(B1, 1, 1); PG8_SCHED; PG8_LDA(At, 1, 0); PG8_STAGE(PG8_SA(0, 1), a2 + hstep, voffA);
            PG8_WAIT_V(8); PG8_WAIT_L(0); PG8_BAR; PG8_MMA(0, 0, At, B0); PG8_MMA(0, 1, At, B1); PG8_BAR; PG8_SCHED;
            PG8_LDA(At, 1, 1); PG8_STAGE(PG8_SB(1, 0), b3, voffB); PG8_STAGE(PG8_SB(1, 1), b3 + hstep, voffB); PG8_STAGE(PG8_SA(1, 0), a3, voffA);
            PG8_WAIT_V(8); PG8_WAIT_L(0); PG8_BAR; PG8_MMA(1, 0, At, B0); PG8_MMA(1, 1, At, B1); PG8_BAR; PG8_SCHED;
            } else {
            PG8_LDB(B0, 0, 0); PG8_SCHED; PG8_LDA(At, 0, 0); PG8_STAGE(PG8_SA(1, 1), a1 + hstep, voffA);
            PG8_WAIT_L(8); PG8_BAR; PG8_WAIT_L(0); PG8_MMA(0, 0, At, B0); PG8_BAR; PG8_SCHED;
            PG8_LDB(B1, 0, 1); PG8_STAGE(PG8_SB(0, 0), b2, voffB);
            PG8_BAR; PG8_WAIT_L(0); PG8_MMA(0, 1, At, B1); PG8_BAR;
            PG8_LDA(At, 0, 1); PG8_STAGE(PG8_SA(0, 0), a2, voffA);
            PG8_BAR; PG8_WAIT_L(0); PG8_MMA(1, 0, At, B0); PG8_BAR; PG8_SCHED;
            PG8_STAGE(PG8_SB(0, 1), b2 + hstep, voffB);
            PG8_WAIT_V(6); PG8_BAR; PG8_MMA(1, 1, At, B1); PG8_BAR;
            PG8_LDB(B0, 1, 0); PG8_SCHED; PG8_LDA(At, 1, 0); PG8_STAGE(PG8_SA(0, 1), a2 + hstep, voffA);
            PG8_WAIT_L(8); PG8_BAR; PG8_WAIT_L(0); PG8_MMA(0, 0, At, B0); PG8_BAR; PG8_SCHED;
            PG8_LDB(B1, 1, 1); PG8_STAGE(PG8_SB(1, 0), b3, voffB);
            PG8_BAR; PG8_WAIT_L(0); PG8_MMA(0, 1, At, B1); PG8_BAR;
            PG8_LDA(At, 1, 1); PG8_STAGE(PG8_SA(1, 0), a3, voffA);
            PG8_BAR; PG8_WAIT_L(0); PG8_MMA(1, 0, At, B0); PG8_BAR; PG8_SCHED;
            PG8_STAGE(PG8_SB(1, 1), b3 + hstep, voffB);
            PG8_WAIT_V(6); PG8_BAR; PG8_MMA(1, 1, At, B1); PG8_BAR;
            }
        }
        if constexpr (ALIGN_EPI) { if (wr == 0) PG8_BAR; }
        if constexpr (!Epi::AFTER_DRAIN) { E(acc, cur, wr, wc, fr, fq); S.done(cur); }
        if (!has_next) break;
#pragma unroll
        for (int a = 0; a < 2; ++a)
#pragma unroll
            for (int b = 0; b < 2; ++b)
#pragma unroll
                for (int m = 0; m < 4; ++m)
#pragma unroll
                    for (int n = 0; n < 2; ++n) acc[a][b][m][n] = (f32x4){0.f, 0.f, 0.f, 0.f};
        cur = nxt; cA = nA; cB = nB; ++ui;
        if constexpr (ALIGN_EPI) { if (wr == 1) PG8_BAR; }
    }
    PG8_WAIT_V(0);
    if constexpr (!ALIGN_EPI) { if (wr == 0) PG8_BAR; }
    PG8_BAR;
    if constexpr (Epi::AFTER_DRAIN) { E.fused(acc, cur, wr, wc, fr, fq, lds, wid, lane); S.done(cur); }
#undef PG8_SA
#undef PG8_SB
#undef PG8_STAGE
#undef PG8_LDA
#undef PG8_LDB
#undef PG8_MMA
#undef PG8_WAIT_V
#undef PG8_WAIT_L
#undef PG8_BAR
#undef PG8_SCHED
}
}

#ifndef PG8_SP2
#define PG8_SP2 true
#endif
#ifndef PG8_ALIGN
#define PG8_ALIGN true
#endif
#include <hip/hip_bf16.h>
#include <cmath>
namespace attn_body {
using bf16=__hip_bfloat16;
using bf16x8=__attribute__((ext_vector_type(8)))short;
using s16x4=__attribute__((ext_vector_type(4)))short;
using f32x16=__attribute__((ext_vector_type(16)))float;
using u32x4=__attribute__((ext_vector_type(4)))unsigned;
constexpr int BATCH=1,NHEAD=16,SEQ=16384,D=64,DM=2048,DMO=1024;
constexpr int NW=8,QBLK=32,QB=QBLK*NW,KVBLK=64,NQB=SEQ/QB;
constexpr int ATTN_PITCH=DM, ATTN_UNIT_ROWS=QB;
__device__ __forceinline__ int crow(int r,int hi){return (r&3)+8*(r>>2)+4*hi;}
#define SBAR() __builtin_amdgcn_sched_barrier(0)
__device__ __forceinline__ void cmask(f32x16&p0,f32x16&p1,int jb,int qrel,int hi){
  const float NEG=-INFINITY; int kb=64*jb+4*hi;
  #pragma unroll
  for(int r=0;r<16;++r){int kv=kb+(r&3)+8*(r>>2); if(kv>qrel)p0[r]=NEG; if(kv+32>qrel)p1[r]=NEG;}
}

constexpr int NSLOT=3, SLOTB=8192;
constexpr int LDS_K=0, LDS_V=NSLOT*SLOTB, LDS_WS=2*NSLOT*SLOTB, LDS_OST=LDS_WS+NW*64*4, LDS_BYTES=LDS_OST+NW*4096;
constexpr float C2=0.125f*1.4426950408889634f;
__device__ __forceinline__ void glds16(const void*gsrc,unsigned lds_dst){unsigned keep;
  asm volatile("s_mov_b32 %0, m0\n\ts_mov_b32 m0, %2\n\ts_nop 0\n\tglobal_load_lds_dwordx4 %1, off\n\ts_mov_b32 m0, %0":"=&s"(keep):"v"(gsrc),"s"(lds_dst):"memory");}
__device__ __forceinline__ float max3f(float a,float b,float c){float r;asm("v_max3_f32 %0, %1, %2, %3":"=v"(r):"v"(a),"v"(b),"v"(c));return r;}
__device__ __forceinline__ float max2f(float a,float b){float r;asm("v_max_f32_e32 %0, %1, %2":"=v"(r):"v"(a),"v"(b));return r;}
__device__ __forceinline__ float fadd_s(float a,float b){float r;asm("v_add_f32_e32 %0, %1, %2":"=v"(r):"v"(a),"v"(b));return r;}
__device__ __forceinline__ float fsub_s(float a,float b){float r;asm("v_sub_f32_e32 %0, %1, %2":"=v"(r):"v"(a),"v"(b));return r;}
typedef float f32x2_t __attribute__((ext_vector_type(2))); typedef __bf16 bf16x2_t __attribute__((ext_vector_type(2)));
__device__ __forceinline__ unsigned cvtpk_s(float lo,float hi){f32x2_t v={lo,hi};bf16x2_t b=__builtin_convertvector(v,bf16x2_t);return __builtin_bit_cast(unsigned,b);}
#define WAIT_BAR(N) asm volatile("s_waitcnt vmcnt(" #N ") lgkmcnt(0)\n\ts_barrier":::"memory")

__device__ __forceinline__ void qkt(f32x16&p0,f32x16&p1,const char*Kslot,const bf16x8*qr,const f32x16&negm,int r32,int hi){
  const char*kb=Kslot+hi*1024+r32*16;
  #pragma unroll
  for(int d0=0;d0<4;++d0){
    const bf16x8 b0=*reinterpret_cast<const bf16x8*>(kb+d0*2048);
    const bf16x8 b1=*reinterpret_cast<const bf16x8*>(kb+d0*2048+512);
    if(d0==0){p0=__builtin_amdgcn_mfma_f32_32x32x16_bf16(b0,qr[0],negm,0,0,0);p1=__builtin_amdgcn_mfma_f32_32x32x16_bf16(b1,qr[0],negm,0,0,0);}
    else{p0=__builtin_amdgcn_mfma_f32_32x32x16_bf16(b0,qr[d0],p0,0,0,0);p1=__builtin_amdgcn_mfma_f32_32x32x16_bf16(b1,qr[d0],p1,0,0,0);}}
}
typedef __attribute__((address_space(3))) const char* lds_cptr;
typedef short v4i16_t __attribute__((ext_vector_type(4)));
__device__ __forceinline__ void kload8(bf16x8*kf,lds_cptr kp){
  kf[0]=*(const __attribute__((address_space(3))) bf16x8*)(kp);      kf[1]=*(const __attribute__((address_space(3))) bf16x8*)(kp+512);
  kf[2]=*(const __attribute__((address_space(3))) bf16x8*)(kp+2048); kf[3]=*(const __attribute__((address_space(3))) bf16x8*)(kp+2560);
  kf[4]=*(const __attribute__((address_space(3))) bf16x8*)(kp+4096); kf[5]=*(const __attribute__((address_space(3))) bf16x8*)(kp+4608);
  kf[6]=*(const __attribute__((address_space(3))) bf16x8*)(kp+6144); kf[7]=*(const __attribute__((address_space(3))) bf16x8*)(kp+6656);
}
__device__ __forceinline__ void kload2(bf16x8*kf,lds_cptr kp,int j){ kf[2*j]=*(const __attribute__((address_space(3))) bf16x8*)(kp+j*2048); kf[2*j+1]=*(const __attribute__((address_space(3))) bf16x8*)(kp+j*2048+512); }
__device__ __forceinline__ s16x4 vtr(lds_cptr p){ return __builtin_bit_cast(s16x4,__builtin_amdgcn_ds_read_tr16_b64_v4i16((__attribute__((address_space(3))) v4i16_t*)p)); }
__device__ __forceinline__ float rowmax(const f32x16&p0,const f32x16&p1){
  float a=max3f(p0[0],p0[1],p1[0]),b=max3f(p0[2],p0[3],p1[1]);a=max3f(a,p1[2],p1[3]);
  #pragma unroll
  for(int r=4;r<16;r+=4){a=max3f(a,p0[r],p0[r+1]);b=max3f(b,p0[r+2],p0[r+3]);a=max3f(a,p1[r],p1[r+1]);b=max3f(b,p1[r+2],p1[r+3]);}
  const float m=max2f(a,b);
  auto rr=__builtin_amdgcn_permlane32_swap(__float_as_uint(m),__float_as_uint(m),false,false);
  return max2f(__uint_as_float(rr[0]),__uint_as_float(rr[1]));
}
__device__ __forceinline__ void pv(f32x16*o,int vb,bf16x8 pa0,bf16x8 pa1,bf16x8 pa2,bf16x8 pa3){
  #pragma unroll
  for(int d0=0;d0<2;++d0){s16x4 lo[4],hi[4];
    #pragma unroll
    for(int ks=0;ks<4;++ks){
      asm volatile("ds_read_b64_tr_b16 %0,%1 offset:%c2":"=&v"(lo[ks]):"v"(vb),"i"(d0*4096+ks*1024):"memory");
      asm volatile("ds_read_b64_tr_b16 %0,%1 offset:%c2":"=&v"(hi[ks]):"v"(vb),"i"(d0*4096+ks*1024+512):"memory");}
    asm volatile("s_waitcnt lgkmcnt(0)":::"memory");SBAR();
    #define PK(k) (bf16x8){lo[k][0],lo[k][1],lo[k][2],lo[k][3],hi[k][0],hi[k][1],hi[k][2],hi[k][3]}
    o[d0]=__builtin_amdgcn_mfma_f32_32x32x16_bf16(pa0,PK(0),o[d0],0,0,0);
    o[d0]=__builtin_amdgcn_mfma_f32_32x32x16_bf16(pa1,PK(1),o[d0],0,0,0);
    o[d0]=__builtin_amdgcn_mfma_f32_32x32x16_bf16(pa2,PK(2),o[d0],0,0,0);
    o[d0]=__builtin_amdgcn_mfma_f32_32x32x16_bf16(pa3,PK(3),o[d0],0,0,0);
    #undef PK
  }
}

#ifndef ATTN_STORE16
#define ATTN_STORE16(p,v) (*(u32x4*)(p)=(v))
#endif
template<int THRL> __device__ __forceinline__ void attn_unit(int b,int h,int qb,const bf16*Q,const bf16*__restrict__ K,const bf16*__restrict__ V,bf16*O,char*shm){
  int tid_=threadIdx.x; asm volatile("":"+v"(tid_)); const int tid=tid_,lane=tid&63,r32=lane&31,hi=lane>>5; const int wid=__builtin_amdgcn_readfirstlane(tid>>6);
  const long rowbase=(long)b*SEQ; const int q0=qb*QB;
  const bf16*Qw=Q+(rowbase+q0+wid*QBLK)*DM+h*D;
  const bf16*Kh=K+rowbase*DM+h*D,*Vh=V+rowbase*DM+h*D;
  const unsigned lds0=(unsigned)(uintptr_t)shm;
  float*wsf=(float*)(shm+LDS_WS)+wid*64;
  const bf16*ksrc=Kh+(long)lane*DM+wid*8;
  const bf16*vsrc=Vh+(long)(16*(wid&3)+(lane>>2))*DM+(wid>>2)*32+(lane&3)*8;
  const unsigned kdst=lds0+LDS_K+wid*1024, vdst=lds0+LDS_V+wid*1024;
  #define DMA_K(t,slot) glds16(ksrc+(long)(t)*KVBLK*DM,(unsigned)__builtin_amdgcn_readfirstlane(kdst+(slot)))
  #define DMA_V(t,slot) glds16(vsrc+(long)(t)*KVBLK*DM,(unsigned)__builtin_amdgcn_readfirstlane(vdst+(slot)))
  const int vb0=(int)(lds0+LDS_V)+((lane>>4)&1)*32+(lane&3)*8+(4*hi+((lane&15)>>2))*64;
  const char*Kbase=shm+LDS_K; bf16x8 kf[8];
  const lds_cptr shm3=(lds_cptr)shm; const lds_cptr kp0=shm3+LDS_K+hi*1024+r32*16; const lds_cptr vp0=shm3+LDS_V+((lane>>4)&1)*32+(lane&3)*8+(4*hi+((lane&15)>>2))*64;
  const int NT=(q0+QB)/KVBLK;
  DMA_K(0,0);DMA_V(0,0);DMA_K(1,SLOTB);
  bf16x8 qr[4];
  #pragma unroll
  for(int d0=0;d0<4;++d0)qr[d0]=*reinterpret_cast<const bf16x8*>(&Qw[(long)r32*DM+d0*16+hi*8]);
  float mhat=0.f,l_reg=0.f;f32x16 o[2];o[0]=f32x16{};o[1]=f32x16{};f32x16 negm=f32x16{};asm volatile("":"+v"(negm));
  const int qrel=wid*QBLK+r32;
  #define CMASK(P0,P1,t) do{int jb_=(t)-(NT-4); if(jb_>=0)cmask(P0,P1,jb_,qrel,hi);}while(0)
  bool resc=false;
  #define START(P0,P1) do{ const float rm=rowmax(P0,P1); resc=false; \
    { const float dl=rm; mhat=fadd_s(mhat,dl); \
      _Pragma("unroll") for(int r=0;r<16;++r){P0[r]=fsub_s(P0[r],dl);P1[r]=fsub_s(P1[r],dl);} \
      _Pragma("unroll") for(int r=0;r<16;++r)negm[r]=-mhat; asm volatile("":"+v"(negm)); } \
    _Pragma("unroll") for(int r=0;r<16;++r)P0[r]=__builtin_amdgcn_exp2f(P0[r]); }while(0)
  #define RESC() do{ if(resc){ asm volatile("s_waitcnt lgkmcnt(0)":::"memory"); \
      _Pragma("unroll") for(int d_=0;d_<2;++d_) _Pragma("unroll") for(int r=0;r<16;++r)o[d_][r]*=wsf[crow(r,hi)]; } }while(0)
  f32x16 pA0,pA1,pB0,pB1;
  int sl_prev=0,sl_cur=0,sl_next=SLOTB;
  #define ROT() do{sl_prev=sl_cur;sl_cur=sl_next;sl_next=(sl_next==(NSLOT-1)*SLOTB)?0:sl_next+SLOTB;}while(0)
  DMA_K(2,2*SLOTB);
  WAIT_BAR(3);
  qkt(pA0,pA1,Kbase,qr,negm,r32,hi);asm volatile("s_nop 15\n\ts_nop 7":"+v"(pA0),"+v"(pA1));CMASK(pA0,pA1,0);
  START(pA0,pA1);
  _Pragma("unroll") for(int r=0;r<16;++r)pA1[r]=__builtin_amdgcn_exp2f(pA1[r]);
  WAIT_BAR(0);
  DMA_K(3,0);DMA_V(1,SLOTB);
  ROT();
  kload8(kf,kp0+sl_cur);
  WAIT_BAR(2);
  s16x4 vlo[8],vhi[8]; u32x4 pw0,pw1,pw2,pw3;
  #define PKW(P,B) cvtpk_s(P[B],P[B+1])
  #define PAF(k) __builtin_bit_cast(bf16x8,pw##k)
  #define VFR(i) (bf16x8){vlo[i][0],vlo[i][1],vlo[i][2],vlo[i][3],vhi[i][0],vhi[i][1],vhi[i][2],vhi[i][3]}
  #define PIN(x) asm volatile("":"+v"(x))
  #define MX3(a,b,c) __builtin_fmaxf(__builtin_fmaxf((a),(b)),(c))
  #define GAPA(MF,A0,A1,A2,A3,W0,W1,PW) do{ MF; sacc+=A0; sacc+=A1; sacc+=A2; sacc+=A3; PIN(sacc); W0; W1; PIN(PW); SBAR(); }while(0)
  #define EX(v) __builtin_amdgcn_exp2f(v)
  #define GAPB(MF,X,B) do{ MF; X[B]=EX(X[B]); X[B+1]=EX(X[B+1]); X[B+2]=EX(X[B+2]); X[B+3]=EX(X[B+3]); PIN(X); SBAR(); }while(0)
  #define VRD(i) do{ vlo[i]=vtr(vp_+(((i)>>2)*4096+((i)&3)*1024)); vhi[i]=vtr(vp_+(((i)>>2)*4096+((i)&3)*1024+512)); }while(0)
  #define KRD(G,j) do{ if(G){ kload2(kf,kp0+sl_next,j); SBAR(); } }while(0)
  #define STEP(C0,C1,P0,P1,t,GK,GV,GL) do{ SBAR(); \
    const lds_cptr vp_=vp0+sl_prev; \
    VRD(0); SBAR(); float sacc=(P0[0]+P0[1]); \
    GAPA(C0=__builtin_amdgcn_mfma_f32_32x32x16_bf16(kf[0],qr[0],negm,0,0,0), P0[2],P0[3],P0[4],P0[5],     pw0[0]=PKW(P0,0), pw0[1]=PKW(P0,2), pw0); \
    VRD(4); SBAR(); GAPA(C1=__builtin_amdgcn_mfma_f32_32x32x16_bf16(kf[1],qr[0],negm,0,0,0), P0[6],P0[7],P0[8],P0[9],     pw0[2]=PKW(P0,4), pw0[3]=PKW(P0,6), pw0); \
    VRD(1); SBAR(); GAPA(C0=__builtin_amdgcn_mfma_f32_32x32x16_bf16(kf[2],qr[1],C0,0,0,0),   P0[10],P0[11],P0[12],P0[13], pw1[0]=PKW(P0,8), pw1[1]=PKW(P0,10), pw1); \
    VRD(5); SBAR(); GAPA(C1=__builtin_amdgcn_mfma_f32_32x32x16_bf16(kf[3],qr[1],C1,0,0,0),   P0[14],P0[15],P1[0],P1[1],   pw1[2]=PKW(P0,12),pw1[3]=PKW(P0,14), pw1); \
    VRD(2); SBAR(); GAPA(C0=__builtin_amdgcn_mfma_f32_32x32x16_bf16(kf[4],qr[2],C0,0,0,0),   P1[2],P1[3],P1[4],P1[5],     pw2[0]=PKW(P1,0), pw2[1]=PKW(P1,2), pw2); \
    VRD(6); SBAR(); GAPA(C1=__builtin_amdgcn_mfma_f32_32x32x16_bf16(kf[5],qr[2],C1,0,0,0),   P1[6],P1[7],P1[8],P1[9],     pw2[2]=PKW(P1,4), pw2[3]=PKW(P1,6), pw2); \
    VRD(3); SBAR(); GAPA(C0=__builtin_amdgcn_mfma_f32_32x32x16_bf16(kf[6],qr[3],C0,0,0,0),   P1[10],P1[11],P1[12],P1[13], pw3[0]=PKW(P1,8), pw3[1]=PKW(P1,10), pw3); \
    VRD(7); SBAR(); GAPA(C1=__builtin_amdgcn_mfma_f32_32x32x16_bf16(kf[7],qr[3],C1,0,0,0),   P1[14],P1[15],0.f,0.f,       pw3[2]=PKW(P1,12),pw3[3]=PKW(P1,14), pw3); \
    l_reg+=sacc; \
    if(GK){DMA_K((t)+3,sl_cur);} if(GV){DMA_V((t)+1,sl_next);} \
    CMASK(C0,C1,t); \
    { float a=MX3(C0[0],C0[1],C1[0]),b=MX3(C0[2],C0[3],C1[1]); a=MX3(a,C1[2],C1[3]); \
      _Pragma("unroll") for(int r=4;r<16;r+=4){a=MX3(a,C0[r],C0[r+1]);b=MX3(b,C0[r+2],C0[r+3]);a=MX3(a,C1[r],C1[r+1]);b=MX3(b,C1[r+2],C1[r+3]);} \
      float rm=__builtin_fmaxf(a,b); { auto rr=__builtin_amdgcn_permlane32_swap(__float_as_uint(rm),__float_as_uint(rm),false,false); rm=__builtin_fmaxf(__uint_as_float(rr[0]),__uint_as_float(rr[1])); } \
      resc=false; \
      if(__builtin_expect(__any(rm>(float)THRL),0)){ const float dl=__builtin_fmaxf(rm,0.f); mhat+=dl; \
        _Pragma("unroll") for(int r=0;r<16;++r){C0[r]-=dl;C1[r]-=dl;} \
        _Pragma("unroll") for(int r=0;r<16;++r)negm[r]=-mhat; asm volatile("":"+v"(negm)); \
        const float f=__builtin_amdgcn_exp2f(-dl); l_reg*=f; if(hi==0)wsf[r32]=f; resc=true; } } \
    SBAR(); \
    GAPB(o[0]=__builtin_amdgcn_mfma_f32_32x32x16_bf16(PAF(0),VFR(0),o[0],0,0,0), C0,0); \
    GAPB(o[1]=__builtin_amdgcn_mfma_f32_32x32x16_bf16(PAF(0),VFR(4),o[1],0,0,0), C0,4); \
    KRD(GL,0); GAPB(o[0]=__builtin_amdgcn_mfma_f32_32x32x16_bf16(PAF(1),VFR(1),o[0],0,0,0), C0,8); \
    KRD(GL,1); GAPB(o[1]=__builtin_amdgcn_mfma_f32_32x32x16_bf16(PAF(1),VFR(5),o[1],0,0,0), C0,12); \
    KRD(GL,2); GAPB(o[0]=__builtin_amdgcn_mfma_f32_32x32x16_bf16(PAF(2),VFR(2),o[0],0,0,0), C1,0); \
    KRD(GL,3); GAPB(o[1]=__builtin_amdgcn_mfma_f32_32x32x16_bf16(PAF(2),VFR(6),o[1],0,0,0), C1,4); \
    GAPB(o[0]=__builtin_amdgcn_mfma_f32_32x32x16_bf16(PAF(3),VFR(3),o[0],0,0,0), C1,8); \
    GAPB(o[1]=__builtin_amdgcn_mfma_f32_32x32x16_bf16(PAF(3),VFR(7),o[1],0,0,0), C1,12); \
    }while(0)
  int t=1;
  #undef CMASK
  #define CMASK(P0,P1,t) do{}while(0)
  for(;t+5<NT;t+=2){
    STEP(pB0,pB1,pA0,pA1,t,true,true,true);     WAIT_BAR(2); RESC(); ROT();
    STEP(pA0,pA1,pB0,pB1,t+1,true,true,true);   WAIT_BAR(2); RESC(); ROT();
  }
  #undef CMASK
  #define CMASK(P0,P1,t) do{int jb_=(t)-(NT-4); if(jb_>=0)cmask(P0,P1,jb_,qrel,hi);}while(0)
  #define ENDW(tt) do{ if((tt)+3<NT){WAIT_BAR(2);} else if((tt)+2<NT){WAIT_BAR(1);} else {WAIT_BAR(0);} }while(0)
  for(;t+1<NT;t+=2){
    STEP(pB0,pB1,pA0,pA1,t,(t+3<NT),(t+1<NT),(t+1<NT));       ENDW(t);   RESC(); ROT();
    STEP(pA0,pA1,pB0,pB1,t+1,(t+4<NT),(t+2<NT),(t+2<NT));     ENDW(t+1); RESC(); ROT();
  }
  STEP(pB0,pB1,pA0,pA1,NT-1,false,false,false); RESC();
  { float sacc=pB0[0]+pB0[1]; _Pragma("unroll") for(int r=2;r<16;++r)sacc+=pB0[r]; _Pragma("unroll") for(int r=0;r<16;++r)sacc+=pB1[r]; l_reg+=sacc;
    pw0=(u32x4){PKW(pB0,0),PKW(pB0,2),PKW(pB0,4),PKW(pB0,6)};pw1=(u32x4){PKW(pB0,8),PKW(pB0,10),PKW(pB0,12),PKW(pB0,14)};pw2=(u32x4){PKW(pB1,0),PKW(pB1,2),PKW(pB1,4),PKW(pB1,6)};pw3=(u32x4){PKW(pB1,8),PKW(pB1,10),PKW(pB1,12),PKW(pB1,14)};
    SBAR(); pv(o,vb0+sl_cur,PAF(0),PAF(1),PAF(2),PAF(3)); }
  #undef PKW
  #undef PAF
  #undef VFR
  #undef PIN
  #undef MX3
  #undef GAPA
  #undef GAPB
  #undef EX
  #undef VRD
  #undef KRD
  #undef STEP
  #undef ENDW
  {auto rr=__builtin_amdgcn_permlane32_swap(__float_as_uint(l_reg),__float_as_uint(l_reg),false,false);l_reg=__uint_as_float(rr[0])+__uint_as_float(rr[1]);}
  if(hi==0)wsf[32+r32]=l_reg;asm volatile("s_waitcnt lgkmcnt(0)":::"memory");
  float rli[16];
  #pragma unroll
  for(int r=0;r<16;++r)rli[r]=__builtin_amdgcn_rcpf(wsf[32+crow(r,hi)]);
  bf16*Ow=O+(rowbase+q0+wid*QBLK)*DMO+h*D;
  { bf16*stg=(bf16*)(shm+LDS_OST)+wid*2048;
    #pragma unroll
    for(int r=0;r<16;++r){const int orow=crow(r,hi);
      #pragma unroll
      for(int d0=0;d0<2;++d0)stg[orow*64+d0*32+r32]=__float2bfloat16(o[d0][r]*rli[r]);}
    asm volatile("s_waitcnt lgkmcnt(0)":::"memory");
    #pragma unroll
    for(int i=0;i<4;++i){const int row=i*8+(lane>>3),ch=lane&7; const u32x4 v=*(const u32x4*)(stg+row*64+ch*8); ATTN_STORE16(Ow+(long)row*DMO+ch*8,v);} }
  asm volatile("s_waitcnt lgkmcnt(0)\n\ts_barrier":::"memory");
  #undef DMA_K
  #undef DMA_V
  #undef CMASK
  #undef START
  #undef RESC
  #undef ROT
}
constexpr int ATTN_LDS_BYTES=LDS_BYTES;
struct AttnTensors { const bf16* Q; const bf16* K; const bf16* V; bf16* O; };
struct AttnUnit { int vh; int qb; };
struct StaticOrder {
  int vcu, G, bx;
  __device__ __forceinline__ StaticOrder(int grid,int block):vcu((grid%8==0)?(block%8)*(grid/8)+block/8:block),G(grid),bx(block){}
  __device__ __forceinline__ bool next(int i,AttnUnit&u)const{
    if(G==256){ if(i>=4)return false; const int s=vcu&15; u.vh=vcu>>4; u.qb=(i==0)?63-s:(i==1)?32+s:(i==2)?31-s:s; return true; }
    const int idx=i*G+bx; if(idx>=16*NQB)return false; u.vh=idx&15; u.qb=NQB-1-(idx>>4); return true; }
};
template<class Sched,int THRL=8> __device__ __forceinline__ void attn_phase(char*lds,const AttnTensors&T,const Sched&S){
  AttnUnit u;
  for(int i=0;S.next(i,u);++i){ const int h=u.vh>>2,c=(u.vh>>1)&1,e=u.vh&1;
    attn_unit<THRL>(0,0,u.qb,T.Q+h*128+c*64,T.K+h*128+c*64,T.V+h*128+e*64,T.O+u.vh*64,lds); }
}
#undef SBAR
#undef WAIT_BAR
}
constexpr int NWAVES = 8;
constexpr int M = 16384, D = 1024, FF = 2816, NGU = 2 * FF, NIN = 2048, DEPTH = 4;
constexpr size_t MiB = 1u << 20;
constexpr size_t WS_ROWSS = 1 * MiB;
constexpr size_t WS_ROPE = 2 * MiB;
constexpr size_t WS_XB = 8 * MiB;
constexpr size_t WS_H = 40 * MiB;
constexpr size_t WS_QKVU = 40 * MiB;
constexpr size_t WS_OBUF = 104 * MiB;
constexpr size_t WS_CAT = 136 * MiB;
constexpr size_t WS_W = 168 * MiB;
constexpr size_t OFF_GU1 = 0, OFF_DN1 = 11 * MiB, OFF_IN = 16 * MiB + 512 * 1024, OFF_OUT = 20 * MiB + 512 * 1024, OFF_GU2 = 22 * MiB + 512 * 1024, OFF_DN2 = 33 * MiB + 512 * 1024, W_LAYER = 39 * MiB;
constexpr size_t WS_END = WS_W + DEPTH * W_LAYER;
static_assert((size_t)NGU * D * 2 == 11 * MiB && (size_t)D * FF * 2 == 5 * MiB + 512 * 1024 && WS_H + (size_t)M * FF * 2 <= WS_CAT && WS_ROWSS + 16 * (size_t)M * 4 <= WS_ROPE && WS_ROPE + (size_t)M * 64 * 4 <= WS_XB, "ws map");
constexpr int LDS_BYTES = 147456;

#define LAS __attribute__((address_space(3)))
typedef unsigned short bf16;
typedef unsigned v4u __attribute__((ext_vector_type(4)));
typedef unsigned v2u __attribute__((ext_vector_type(2)));
typedef float f32x4 __attribute__((ext_vector_type(4)));
#define LDS_WAIT() asm volatile("s_waitcnt lgkmcnt(0)" ::: "memory")
__device__ __forceinline__ unsigned f2bf(float f) { unsigned u = __builtin_bit_cast(unsigned, f); return (u + 0x7fffu + ((u >> 16) & 1u)) >> 16; }
__device__ __forceinline__ unsigned pk2(float lo, float hi) { return f2bf(lo) | (f2bf(hi) << 16); }
__device__ __forceinline__ float bflo(unsigned w) { return __builtin_bit_cast(float, w << 16); }
__device__ __forceinline__ float bfhi(unsigned w) { return __builtin_bit_cast(float, w & 0xffff0000u); }
__device__ __forceinline__ float wave_sum(float v) {
#pragma unroll
    for (int o = 1; o < 64; o <<= 1) v += __shfl_xor(v, o);
    return v;
}
__device__ __forceinline__ void tr_item(const float* W, int N, int k0, int n0, const float* gk, bf16* WT, int Kd, int rbase, int rstride, LAS float* scr, int lane) {
#pragma unroll 8
    for (int i = 0; i < 32; ++i) { const int kk = 2 * i + (lane >> 5); float w = W[(size_t)(k0 + kk) * N + n0 + (lane & 31)]; if (gk) w *= gk[k0 + kk]; scr[kk * 33 + (lane & 31)] = w; }
    LDS_WAIT(); asm volatile("" ::: "memory");
    const int c = lane & 7;
#pragma unroll
    for (int j = 0; j < 4; ++j) { const int n = (lane >> 3) + 8 * j; const LAS float* s = scr + (8 * c) * 33 + n;
        v4u o; o.x = pk2(s[0 * 33], s[1 * 33]); o.y = pk2(s[2 * 33], s[3 * 33]); o.z = pk2(s[4 * 33], s[5 * 33]); o.w = pk2(s[6 * 33], s[7 * 33]);
        *(v4u*)(WT + (size_t)(rbase + n * rstride) * Kd + k0 + 8 * c) = o; }
    LDS_WAIT(); asm volatile("" ::: "memory");
}

struct Args { const float* in[20]; float* out; unsigned char* ws; };

__global__ void __launch_bounds__(NWAVES * 64, 2) hymba_fwd(Args args) {
    extern __shared__ __attribute__((aligned(16))) unsigned char lds[];
    cg::grid_group grid = cg::this_grid();
    LAS unsigned char* L = (LAS unsigned char*)lds;
    const int tid = threadIdx.x, lane = tid & 63, wave = __builtin_amdgcn_readfirstlane(tid >> 6);
    const int G = gridDim.x, bx = blockIdx.x;
    const int gw = bx * NWAVES + wave, NGW = G * NWAVES;
    const int gtid = bx * (NWAVES * 64) + tid, NT = G * NWAVES * 64;
    unsigned char* ws = args.ws;
    float* rowss = (float*)(ws + WS_ROWSS); float* rope = (float*)(ws + WS_ROPE);
    bf16* XB = (bf16*)(ws + WS_XB); bf16* HB = (bf16*)(ws + WS_H); bf16* QKVU = (bf16*)(ws + WS_QKVU); bf16* OBUF = (bf16*)(ws + WS_OBUF); bf16* CAT = (bf16*)(ws + WS_CAT);
    float* xout = args.out;

    {
        LAS float* scr = (LAS float*)(L + wave * 16384);
        constexpr int IT_G = 16 * 88, IT_D = 44 * 32, IT_IN = 16 * 64, IT_OUT = 8 * 32, IT_LAYER = 4 * IT_G + 2 * IT_D + IT_IN + IT_OUT;
        static_assert(IT_G == IT_D, "item decode");
        for (int it = gw; it < DEPTH * IT_LAYER; it += NGW) {
            const int l = it / IT_LAYER; int r = it % IT_LAYER; unsigned char* wl = ws + WS_W + (size_t)l * W_LAYER;
            if (r < 6 * IT_G) {
                const int f = r / (3 * IT_G), q = r % (3 * IT_G), kind = q / IT_G, i = q % IT_G;
                if (kind < 2) { const float* W = args.in[(f ? 16 : 2) + kind] + (size_t)l * D * FF; const int kb = i / 88, nb = i % 88, n0 = 32 * nb;
                    tr_item(W, FF, 64 * kb, n0, args.in[f ? 15 : 1] + l * D, (bf16*)(wl + (f ? OFF_GU2 : OFF_GU1)), D, (n0 >> 7) * 256 + kind * 128 + (n0 & 127), 1, scr, lane); }
                else { const float* W = args.in[f ? 18 : 4] + (size_t)l * FF * D; const int kb = i / 32, nb = i % 32;
                    tr_item(W, D, 64 * kb, 32 * nb, nullptr, (bf16*)(wl + (f ? OFF_DN2 : OFF_DN1)), FF, 32 * nb, 1, scr, lane); }
            } else { r -= 6 * IT_G;
                if (r < IT_IN) { const float* W = args.in[6] + (size_t)l * D * NIN; const int kb = r / 64, nb = r % 64, n0 = 32 * nb; int rbase = n0, rstride = 1;
                    if (n0 < 1024) { const int d0 = n0 & 63; rbase = (n0 - d0) + (d0 ? 1 : 0); rstride = 2; }
                    tr_item(W, NIN, 64 * kb, n0, args.in[5] + l * D, (bf16*)(wl + OFF_IN), D, rbase, rstride, scr, lane); }
                else { r -= IT_IN; const float* W = args.in[14] + (size_t)l * D * D; const int kb = r / 32, nb = r % 32;
                    tr_item(W, D, 64 * kb, 32 * nb, nullptr, (bf16*)(wl + OFF_OUT), D, 32 * nb, 1, scr, lane); }
            }
        }
        for (int it = gw; it < DEPTH * 1024; it += NGW) {
            const int l = it >> 10, r = it & 1023, g = r >> 8, cb = (r >> 4) & 15, nb = r & 15, c0 = cb * 8, n = nb * 64 + lane;
            const float* pw = args.in[12] + ((size_t)(l * 4 + g) * 128 + c0) * 128; const float* ps = args.in[13] + l * 512 + g * 128;
            const float* wo = args.in[14] + (size_t)l * D * D + (size_t)(512 + g * 128) * D + n;
            float a[8];
#pragma unroll
            for (int j = 0; j < 8; ++j) a[j] = 0.f;
            for (int e = 0; e < 128; ++e) { const float w = wo[(size_t)e * D] * ps[e];
#pragma unroll
                for (int j = 0; j < 8; ++j) a[j] += pw[j * 128 + e] * w; }
            v4u o; o.x = pk2(a[0], a[1]); o.y = pk2(a[2], a[3]); o.z = pk2(a[4], a[5]); o.w = pk2(a[6], a[7]);
            *(v4u*)((bf16*)(ws + WS_W + (size_t)l * W_LAYER + OFF_OUT) + (size_t)n * D + 512 + g * 128 + c0) = o;
        }
        for (int i = gtid; i < M * 32; i += NT) { const int s = i >> 5, j = i & 31; const float inv = (float)pow(10000.0, -(double)j / 32.0); const float ang = (float)s * inv;
            const double a = (double)ang; rope[2 * i] = (float)cos(a); rope[2 * i + 1] = (float)sin(a); }
        for (int m = gw; m < M; m += NGW) { const f32x4* xr = (const f32x4*)(args.in[0] + (size_t)m * D) + lane; f32x4 v[4]; float s = 0.f;
#pragma unroll
            for (int j = 0; j < 4; ++j) { v[j] = xr[64 * j]; s += (v[j].x * v[j].x + v[j].y * v[j].y) + (v[j].z * v[j].z + v[j].w * v[j].w); }
            s = wave_sum(s); if (lane < 16) rowss[(size_t)m * 16 + lane] = (lane == 0) ? s : 0.f;
            v2u* o8 = (v2u*)(XB + (size_t)m * D) + lane;
#pragma unroll
            for (int j = 0; j < 4; ++j) { v2u w; w.x = pk2(v[j].x, v[j].y); w.y = pk2(v[j].z, v[j].w); o8[64 * j] = w; } }
    }
    grid.sync();

    for (int step = 0; step < 3 * DEPTH; ++step) {
        const int l = step / 3, kind = step % 3; unsigned char* wl = ws + WS_W + (size_t)l * W_LAYER;
        if (kind != 1) {
            const int f = kind >> 1;
            { pg8::Gemm g{XB, (const bf16*)(wl + (f ? OFF_GU2 : OFF_GU1)), M, NGU, D}; pg8::StaticOrder S; S.init(M, NGU, G, bx);
              pg8::EpiGateUp E{HB, rowss};
              pg8::gemm_phase<pg8::EpiGateUp, pg8::StaticOrder, PG8_ALIGN, PG8_SP2>(L, g, S, E); }
            grid.sync();
            { pg8::Gemm g{HB, (const bf16*)(wl + (f ? OFF_DN2 : OFF_DN1)), M, D, FF}; pg8::StaticOrder S; S.init(M, D, G, bx);
              pg8::EpiResid E{(step == 0) ? args.in[0] : xout, xout, XB, rowss, 0.5f};
              pg8::gemm_phase<pg8::EpiResid, pg8::StaticOrder, PG8_ALIGN, PG8_SP2>(L, g, S, E); }
            grid.sync();
        } else {
            { pg8::Gemm g{XB, (const bf16*)(wl + OFF_IN), M, NIN, D}; pg8::StaticOrder S; S.init(M, NIN, G, bx);
              pg8::EpiQKVU E{QKVU, rowss, rope};
              pg8::gemm_phase<pg8::EpiQKVU, pg8::StaticOrder, PG8_ALIGN, PG8_SP2>(L, g, S, E); }
            grid.sync();
            { const attn_body::AttnTensors AT{(const attn_body::bf16*)QKVU, (const attn_body::bf16*)(QKVU + 512), (const attn_body::bf16*)(QKVU + 1024), (attn_body::bf16*)OBUF};
              const attn_body::StaticOrder S(G, bx);
              attn_body::attn_phase<attn_body::StaticOrder>((char*)lds, AT, S); }
            grid.sync();
            {
                const float li = 0.8f - 0.6f * expf(-0.3f * (float)l);
                const float s1 = wave_sum(args.in[7][l * 64 + lane] * args.in[8][l * 64 + lane]), s2 = wave_sum(args.in[9][l * 64 + lane] * args.in[10][l * 64 + lane]);
                const float lam = expf(s1) - expf(s2) + li;
                const int hd = lane >> 4, j0 = (lane & 15) * 8;
                float gn[8];
#pragma unroll
                for (int j = 0; j < 8; ++j) gn[j] = args.in[11][l * 128 + j0 + j] * (1.0f - li);
                const int win = 2 << hd;
                for (int m = gw; m < M; m += NGW) {
                    const v4u a = *(const v4u*)(OBUF + (size_t)m * 1024 + hd * 256 + j0), b = *(const v4u*)(OBUF + (size_t)m * 1024 + hd * 256 + 128 + j0);
                    float o[8];
                    o[0] = bflo(a.x) - lam * bflo(b.x); o[1] = bfhi(a.x) - lam * bfhi(b.x); o[2] = bflo(a.y) - lam * bflo(b.y); o[3] = bfhi(a.y) - lam * bfhi(b.y);
                    o[4] = bflo(a.z) - lam * bflo(b.z); o[5] = bfhi(a.z) - lam * bfhi(b.z); o[6] = bflo(a.w) - lam * bflo(b.w); o[7] = bfhi(a.w) - lam * bfhi(b.w);
                    float ss = 0.f;
#pragma unroll
                    for (int j = 0; j < 8; ++j) ss += o[j] * o[j];
                    ss += __shfl_xor(ss, 1); ss += __shfl_xor(ss, 2); ss += __shfl_xor(ss, 4); ss += __shfl_xor(ss, 8);
                    const float rr = __builtin_amdgcn_rsqf(ss * (1.0f / 128.0f) + 1e-6f);
                    v4u w; w.x = pk2(o[0] * rr * gn[0], o[1] * rr * gn[1]); w.y = pk2(o[2] * rr * gn[2], o[3] * rr * gn[3]); w.z = pk2(o[4] * rr * gn[4], o[5] * rr * gn[5]); w.w = pk2(o[6] * rr * gn[6], o[7] * rr * gn[7]);
                    *(v4u*)(CAT + (size_t)m * 1024 + hd * 128 + j0) = w;
                    const bf16* up = QKVU + (size_t)m * 2048 + 1536 + hd * 128 + j0;
                    const v4u u0 = *(const v4u*)up;
                    float sm[8] = {bflo(u0.x), bfhi(u0.x), bflo(u0.y), bfhi(u0.y), bflo(u0.z), bfhi(u0.z), bflo(u0.w), bfhi(u0.w)};
                    float us[8];
#pragma unroll
                    for (int j = 0; j < 8; ++j) us[j] = sm[j];
                    for (int t = 1; t < win; ++t) { if (m - t >= 0) { const v4u ut = *(const v4u*)(up - (size_t)t * 2048);
                        sm[0] += bflo(ut.x); sm[1] += bfhi(ut.x); sm[2] += bflo(ut.y); sm[3] += bfhi(ut.y); sm[4] += bflo(ut.z); sm[5] += bfhi(ut.z); sm[6] += bflo(ut.w); sm[7] += bfhi(ut.w); } }
                    const float ic = 1.0f / (float)((m + 1 < win) ? (m + 1) : win);
                    v4u d; d.x = pk2(sm[0] * ic - us[0], sm[1] * ic - us[1]); d.y = pk2(sm[2] * ic - us[2], sm[3] * ic - us[3]); d.z = pk2(sm[4] * ic - us[4], sm[5] * ic - us[5]); d.w = pk2(sm[6] * ic - us[6], sm[7] * ic - us[7]);
                    *(v4u*)(CAT + (size_t)m * 1024 + 512 + hd * 128 + j0) = d;
                }
            }
            grid.sync();
            { pg8::Gemm g{CAT, (const bf16*)(wl + OFF_OUT), M, D, D}; pg8::StaticOrder S; S.init(M, D, G, bx);
              pg8::EpiResid E{xout, xout, XB, rowss, 1.0f};
              pg8::gemm_phase<pg8::EpiResid, pg8::StaticOrder, PG8_ALIGN, PG8_SP2>(L, g, S, E); }
            grid.sync();
        }
    }
    for (int m = gw; m < M; m += NGW) { f32x4* xr = (f32x4*)(xout + (size_t)m * D) + lane; const f32x4* gr = (const f32x4*)args.in[19] + lane;
        const float r = pg8::rs_from_ss(rowss + (size_t)m * 16);
#pragma unroll
        for (int j = 0; j < 4; ++j) { const f32x4 v = xr[64 * j], gg = gr[64 * j]; xr[64 * j] = v * r * gg; } }
}

extern "C" void kernel_launch(void* const* d_in, const int* in_sizes, int n_in, void* d_out, int out_size, void* d_ws, size_t ws_size, hipStream_t stream) {
    static int grid_blocks = 0;
    if (grid_blocks == 0) {
        if (n_in != 20 || out_size != M * D || ws_size < WS_END) { fprintf(stderr, "kernel_launch: unexpected shapes (n_in %d out %d ws %zu, need %zu)\n", n_in, out_size, ws_size, (size_t)WS_END); grid_blocks = -1; return; }
        int dev = 0, cus = 0, per_cu = 0;
        (void)hipGetDevice(&dev); (void)hipDeviceGetAttribute(&cus, hipDeviceAttributeMultiprocessorCount, dev);
        if (hipFuncSetAttribute((const void*)hymba_fwd, hipFuncAttributeMaxDynamicSharedMemorySize, LDS_BYTES) != hipSuccess) { fprintf(stderr, "kernel_launch: hipFuncSetAttribute failed\n"); grid_blocks = -1; return; }
        if (hipOccupancyMaxActiveBlocksPerMultiprocessor(&per_cu, (const void*)hymba_fwd, NWAVES * 64, LDS_BYTES) != hipSuccess || per_cu < 1) { fprintf(stderr, "kernel_launch: occupancy query says %d\n", per_cu); per_cu = 1; }
        (void)hipGetLastError();
        grid_blocks = cus * per_cu;
    }
    if (grid_blocks < 0) return;
    Args a{};
    for (int i = 0; i < 20; ++i) a.in[i] = (const float*)d_in[i];
    a.out = (float*)d_out; a.ws = (unsigned char*)d_ws;
    void* kargs[] = {&a};
    hipError_t e = hipLaunchCooperativeKernel((const void*)hymba_fwd, dim3(grid_blocks), dim3(NWAVES * 64), kargs, LDS_BYTES, stream);
    if (e != hipSuccess) fprintf(stderr, "cooperative launch failed: %s (grid %d)\n", hipGetErrorString(e), grid_blocks);
}
```

```cpp
#include <hip/hip_runtime.h>
#include <hip/hip_cooperative_groups.h>
#include <cstdio>
#include <cstdint>
namespace cg = cooperative_groups;
namespace pg8 {
#define PG8_LAS __attribute__((address_space(3)))
typedef unsigned short bf16_t;
typedef short bf16x8 __attribute__((ext_vector_type(8)));
typedef float f32x4 __attribute__((ext_vector_type(4)));
typedef unsigned u32x4 __attribute__((ext_vector_type(4)));
constexpr int BM = 256, BK = 64, HALF = 128, HTB = HALF * BK * 2  , STAGE_BYTES = 8 * HTB, NXCD = 8, WGM = 8;

__host__ __device__ __forceinline__ int lds_byte(int r, int c) { const int st = (r >> 4) * 2 + (c >> 5), rr = r & 15, cc = c & 31, ob = rr * 64 + cc * 2; return st * 1024 + (ob ^ (((ob >> 9) & 1) << 5)); }
__host__ __device__ __forceinline__ void stage_rc(int b, int& R, int& C) { const int st = b / 1024, sb = b % 1024, swz = sb ^ (((sb >> 9) & 1) << 5); R = (st >> 1) * 16 + swz / 64; C = (st & 1) * 32 + (swz % 64) / 2; }
__host__ __device__ __forceinline__ int perm32(int rho) { const int n = rho >> 4, i = rho & 15; return 8 * (i >> 2) + 4 * n + (i & 3); }

struct Unit { int pm, pn; };
struct Gemm { const bf16_t* A; const bf16_t* Bt; int M, N, K; };

struct StaticOrder {
    int nM, nN, nwg, G, c;
    __host__ __device__ void init(int M, int N, int G_, int c_) { nM = M / BM; nN = N / BM; nwg = nM * nN; G = G_; c = c_; }
    __host__ __device__ bool next(int i, Unit& u) const {
        const long L = (long)i * G + c; if (L >= nwg) return false;
        int wgid = (int)L; { const int q = nwg / NXCD, r = nwg % NXCD, xcd = wgid % NXCD, off = wgid / NXCD; wgid = (xcd < r ? xcd * (q + 1) : r * (q + 1) + (xcd - r) * q) + off; }
        const int nig = WGM * nN, gid = wgid / nig, fm = gid * WGM, gsz = (nM - fm) < WGM ? (nM - fm) : WGM;
        u.pm = fm + ((wgid % nig) % gsz); u.pn = (wgid % nig) / gsz; return true;
    }
    __device__ __forceinline__ void a_ready(const Unit&) const {}
    __device__ __forceinline__ void done(const Unit&) const {}
};

__device__ __forceinline__ unsigned cvt_pk_bf16(float lo, float hi) { unsigned r; asm volatile("v_cvt_pk_bf16_f32 %0, %1, %2" : "=v"(r) : "v"(lo), "v"(hi)); return r; }
typedef float f32x2 __attribute__((ext_vector_type(2)));
__device__ __forceinline__ f32x2 gelu_pk(f32x2 v) {
    const f32x2 av = __builtin_elementwise_abs(v), d = av * 0.2316418882f + 1.0f;
    f32x2 t; t.x = __builtin_amdgcn_rcpf(d.x); t.y = __builtin_amdgcn_rcpf(d.y);
    f32x2 q = t * 0.5307027145f + (-0.7265760135f); q = q * t + 0.7107068705f; q = q * t + (-0.142248368f); q = q * t + 0.127414796f; q = q * t;
    const f32x2 s = (v * v) * (-0.72134752044f);
    f32x2 e; e.x = __builtin_amdgcn_exp2f(s.x); e.y = __builtin_amdgcn_exp2f(s.y);
    const f32x2 m = v * (q * e), r = v - m;
    f32x2 o; o.x = v.x < 0.f ? m.x : r.x; o.y = v.y < 0.f ? m.y : r.y; return o;
}

template <int ACT  > struct EpiBf16 {
    static constexpr bool PERM = true, AFTER_DRAIN = false; static_assert(ACT == 0 || ACT == 1, "EpiBf16: ACT is 0 (none) or 1 (gelu_pk)");
    bf16_t* O; int ldc; const float* bias; int split_cols; size_t split_stride; float scale0;
    __device__ __forceinline__ void operator()(const f32x4 (&acc)[2][2][4][2], const Unit& u, int wr, int wc, int fr, int fq) const {
        const int row0 = u.pm * BM + wr * 64 + fr; int colt = u.pn * BM; bf16_t* base = O;
        float sc = 1.f; if (split_cols) { const int t = colt / split_cols; base += (size_t)t * split_stride; colt -= t * split_cols; if (t == 0) sc = scale0; }
        const int col0 = colt + wc * 32 + 8 * fq, bcol0 = u.pn * BM + wc * 32 + 8 * fq;
        f32x4 bv[2][2];
#pragma unroll
        for (int bj = 0; bj < 2; ++bj)
#pragma unroll
            for (int n = 0; n < 2; ++n) bv[bj][n] = bias ? *(const f32x4*)(bias + bcol0 + bj * HALF + 4 * n) : (f32x4){0.f, 0.f, 0.f, 0.f};
#pragma unroll
        for (int ai = 0; ai < 2; ++ai)
#pragma unroll
            for (int m = 0; m < 4; ++m) { bf16_t* rowp = base + (size_t)(row0 + ai * HALF + m * 16) * ldc + col0;
#pragma unroll
                for (int bj = 0; bj < 2; ++bj) { f32x4 v0 = acc[ai][bj][m][0] + bv[bj][0], v1 = acc[ai][bj][m][1] + bv[bj][1];
                    if (ACT == 1) { f32x2 a = gelu_pk((f32x2){v0[0], v0[1]}), b = gelu_pk((f32x2){v0[2], v0[3]}), c = gelu_pk((f32x2){v1[0], v1[1]}), d = gelu_pk((f32x2){v1[2], v1[3]});
                        v0 = (f32x4){a.x, a.y, b.x, b.y}; v1 = (f32x4){c.x, c.y, d.x, d.y}; }
                    v0 = v0 * sc; v1 = v1 * sc; u32x4 w; w.x = cvt_pk_bf16(v0[0], v0[1]); w.y = cvt_pk_bf16(v0[2], v0[3]); w.z = cvt_pk_bf16(v1[0], v1[1]); w.w = cvt_pk_bf16(v1[2], v1[3]);
                    *(u32x4*)(rowp + bj * HALF) = w; } }
    }
};
__device__ __forceinline__ float rs_from_ss(const float* p) { const f32x4 a = ((const f32x4*)p)[0], b = ((const f32x4*)p)[1], c = ((const f32x4*)p)[2], d = ((const f32x4*)p)[3];
    const float ss = (((a[0] + a[1]) + (a[2] + a[3])) + ((b[0] + b[1]) + (b[2] + b[3]))) + (((c[0] + c[1]) + (c[2] + c[3])) + ((d[0] + d[1]) + (d[2] + d[3])));
    return __builtin_amdgcn_rsqf(ss * (1.0f / 1024.0f) + 1e-6f); }
struct EpiGateUp {
    static constexpr bool PERM = true, AFTER_DRAIN = false;
    bf16_t* H; const float* rowss;
    __device__ __forceinline__ void operator()(const f32x4 (&acc)[2][2][4][2], const Unit& u, int wr, int wc, int fr, int fq) const {
        const int row0 = u.pm * BM + wr * 64 + fr; const int col0 = u.pn * HALF + wc * 32 + 8 * fq;
#pragma unroll
        for (int ai = 0; ai < 2; ++ai)
#pragma unroll
            for (int m = 0; m < 4; ++m) { const int row = row0 + ai * HALF + m * 16; const float r = rs_from_ss(rowss + (size_t)row * 16);
                float hv[8];
#pragma unroll
                for (int n = 0; n < 2; ++n)
#pragma unroll
                    for (int e = 0; e < 4; ++e) { const float g = acc[ai][0][m][n][e] * r, up = acc[ai][1][m][n][e] * r;
                        const float sg = g * __builtin_amdgcn_rcpf(1.0f + __builtin_amdgcn_exp2f(g * -1.4426950408889634f)); hv[n * 4 + e] = sg * up; }
                u32x4 w; w.x = cvt_pk_bf16(hv[0], hv[1]); w.y = cvt_pk_bf16(hv[2], hv[3]); w.z = cvt_pk_bf16(hv[4], hv[5]); w.w = cvt_pk_bf16(hv[6], hv[7]);
                *(u32x4*)(H + (size_t)row * 2816 + col0) = w; }
    }
};
struct EpiResid {
    static constexpr bool PERM = true, AFTER_DRAIN = false;
    const float* xin; float* xout; bf16_t* xb; float* rowss_next; float alpha;
    __device__ __forceinline__ void operator()(const f32x4 (&acc)[2][2][4][2], const Unit& u, int wr, int wc, int fr, int fq) const {
        const int row0 = u.pm * BM + wr * 64 + fr; const int col0 = u.pn * BM + wc * 32 + 8 * fq;
#pragma unroll
        for (int ai = 0; ai < 2; ++ai)
#pragma unroll
            for (int m = 0; m < 4; ++m) { const int row = row0 + ai * HALF + m * 16; float ss = 0.f;
#pragma unroll
                for (int bj = 0; bj < 2; ++bj) { const size_t off = (size_t)row * 1024 + col0 + bj * HALF;
                    const f32x4 a0 = *(const f32x4*)(xin + off), a1 = *(const f32x4*)(xin + off + 4);
                    const f32x4 v0 = a0 + acc[ai][bj][m][0] * alpha, v1 = a1 + acc[ai][bj][m][1] * alpha;
                    *(f32x4*)(xout + off) = v0; *(f32x4*)(xout + off + 4) = v1;
                    ss += (v0[0] * v0[0] + v0[1] * v0[1]) + (v0[2] * v0[2] + v0[3] * v0[3]) + (v1[0] * v1[0] + v1[1] * v1[1]) + (v1[2] * v1[2] + v1[3] * v1[3]);
                    u32x4 w; w.x = cvt_pk_bf16(v0[0], v0[1]); w.y = cvt_pk_bf16(v0[2], v0[3]); w.z = cvt_pk_bf16(v1[0], v1[1]); w.w = cvt_pk_bf16(v1[2], v1[3]);
                    *(u32x4*)(xb + off) = w; }
                ss += __shfl_xor(ss, 16); ss += __shfl_xor(ss, 32);
                if (fq == 0) rowss_next[(size_t)row * 16 + u.pn * 4 + wc] = ss; }
    }
};
struct EpiQKVU {
    static constexpr bool PERM = true, AFTER_DRAIN = false;
    bf16_t* O; const float* rowss; const float* rope;
    __device__ __forceinline__ void operator()(const f32x4 (&acc)[2][2][4][2], const Unit& u, int wr, int wc, int fr, int fq) const {
        const int row0 = u.pm * BM + wr * 64 + fr; const int col0 = u.pn * BM + wc * 32 + 8 * fq; const int sec = u.pn >> 1;
        const int j0 = 16 * (wc & 1) + 4 * fq;
#pragma unroll
        for (int ai = 0; ai < 2; ++ai)
#pragma unroll
            for (int m = 0; m < 4; ++m) { const int row = row0 + ai * HALF + m * 16; float r = rs_from_ss(rowss + (size_t)row * 16); if (sec == 0) r *= 0.125f * 1.4426950408889634f;
                f32x4 cs0 = (f32x4){1.f, 0.f, 1.f, 0.f}, cs1 = cs0;
                if (sec < 2) { const f32x4* rp = (const f32x4*)(rope + ((size_t)row * 32 + j0) * 2); cs0 = rp[0]; cs1 = rp[1]; }
#pragma unroll
                for (int bj = 0; bj < 2; ++bj) { const f32x4 v0 = acc[ai][bj][m][0] * r, v1 = acc[ai][bj][m][1] * r;
                    const float o0 = v0[0] * cs0[0] - v0[1] * cs0[1], o1 = v0[1] * cs0[0] + v0[0] * cs0[1];
                    const float o2 = v0[2] * cs0[2] - v0[3] * cs0[3], o3 = v0[3] * cs0[2] + v0[2] * cs0[3];
                    const float o4 = v1[0] * cs1[0] - v1[1] * cs1[1], o5 = v1[1] * cs1[0] + v1[0] * cs1[1];
                    const float o6 = v1[2] * cs1[2] - v1[3] * cs1[3], o7 = v1[3] * cs1[2] + v1[2] * cs1[3];
                    u32x4 w; w.x = cvt_pk_bf16(o0, o1); w.y = cvt_pk_bf16(o2, o3); w.z = cvt_pk_bf16(o4, o5); w.w = cvt_pk_bf16(o6, o7);
                    *(u32x4*)(O + (size_t)row * 2048 + col0 + bj * HALF) = w; } }
    }
};

template <class Epi, class Sched, bool ALIGN_EPI = false, bool SP2 = false>
__device__ __forceinline__ void gemm_phase(PG8_LAS unsigned char* lds, const Gemm g, const Sched& S, const Epi& E) {
    int tid_ = threadIdx.x; asm volatile("" : "+v"(tid_));
    const int tid = tid_, wid = __builtin_amdgcn_readfirstlane(tid >> 6), lane = tid & 63, wr = wid >> 2, wc = wid & 3, fr = lane & 15, fq = lane >> 4;
    const int K = g.K, nt = K / BK;
    unsigned voffA[2], voffB[2];
#pragma unroll
    for (int i = 0; i < 2; ++i) { int R, C; stage_rc(tid * 16 + i * 8192, R, C); const int Rb = Epi::PERM ? ((R & ~31) + perm32(R & 31)) : R;
        voffA[i] = (unsigned)(R * K + C) * 2u; voffB[i] = (unsigned)(Rb * K + C) * 2u; }
    const size_t kstep = (size_t)(BK * 2);
    const size_t hstep = (size_t)HALF * K * 2;
    const size_t tstep = 2 * hstep;
    const unsigned ldsw = (unsigned)wid * 1024u;
    const int aoff = lds_byte(wr * 64 + fr, fq * 8), boff = lds_byte(wc * 32 + fr, fq * 8);
#define PG8_SA(b, h) (((b) * 2 + (h)) * HTB)
#define PG8_SB(b, h) ((4 + (b) * 2 + (h)) * HTB)
#define PG8_STAGE(bufoff, gbase, voff) do { _Pragma("unroll") for (int _i = 0; _i < 2; ++_i) \
        __builtin_amdgcn_global_load_lds((const unsigned*)((const char*)(gbase) + (voff)[_i]), (PG8_LAS unsigned*)(lds + (bufoff) + ldsw + _i * 8192), 16, 0, 0); } while (0)
#define PG8_LDA(dst, b, h) do { _Pragma("unroll") for (int m = 0; m < 4; ++m) _Pragma("unroll") for (int k = 0; k < 2; ++k) dst[m][k] = *(const PG8_LAS bf16x8*)(lds + PG8_SA(b, h) + aoff + m * 2048 + k * 1024); } while (0)
#define PG8_LDB(dst, b, h) do { _Pragma("unroll") for (int n = 0; n < 2; ++n) _Pragma("unroll") for (int k = 0; k < 2; ++k) dst[n][k] = *(const PG8_LAS bf16x8*)(lds + PG8_SB(b, h) + boff + n * 2048 + k * 1024); } while (0)
#define PG8_MMA(ai, bj, At, Bt) do { __builtin_amdgcn_s_setprio(1); _Pragma("unroll") for (int m = 0; m < 4; ++m) _Pragma("unroll") for (int n = 0; n < 2; ++n) _Pragma("unroll") for (int k = 0; k < 2; ++k) \
        acc[ai][bj][m][n] = __builtin_amdgcn_mfma_f32_16x16x32_bf16(Bt[n][k], At[m][k], acc[ai][bj][m][n], 0, 0, 0); __builtin_amdgcn_s_setprio(0); } while (0)
#define PG8_WAIT_V(n) asm volatile("s_waitcnt vmcnt(" #n ")" ::: "memory")
#define PG8_WAIT_L(n) asm volatile("s_waitcnt lgkmcnt(" #n ")" ::: "memory")
#define PG8_BAR __builtin_amdgcn_s_barrier()
#define PG8_SCHED __builtin_amdgcn_sched_barrier(0)
    Unit cur, nxt; int ui = 0;
    if (!S.next(0, cur)) return;
    f32x4 acc[2][2][4][2];
#pragma unroll
    for (int a = 0; a < 2; ++a)
#pragma unroll
        for (int b = 0; b < 2; ++b)
#pragma unroll
            for (int m = 0; m < 4; ++m)
#pragma unroll
                for (int n = 0; n < 2; ++n) acc[a][b][m][n] = (f32x4){0.f, 0.f, 0.f, 0.f};
    bf16x8 At[4][2], B0[2][2], B1[2][2];
    const char* cA = (const char*)g.A + (size_t)cur.pm * tstep; const char* cB = (const char*)g.Bt + (size_t)cur.pn * tstep;
    S.a_ready(cur);
    if constexpr (SP2) {
        PG8_STAGE(PG8_SB(0, 0), cB, voffB); PG8_STAGE(PG8_SB(0, 1), cB + hstep, voffB); PG8_STAGE(PG8_SA(0, 0), cA, voffA); PG8_STAGE(PG8_SA(0, 1), cA + hstep, voffA);
        if (wr == 1) PG8_BAR;
        PG8_WAIT_V(2); PG8_BAR;
        PG8_STAGE(PG8_SB(1, 0), cB + kstep, voffB); PG8_STAGE(PG8_SA(1, 0), cA + kstep, voffA); PG8_STAGE(PG8_SB(1, 1), cB + hstep + kstep, voffB);
        PG8_WAIT_V(6); PG8_BAR;
    } else {
        PG8_STAGE(PG8_SB(0, 0), cB, voffB); PG8_STAGE(PG8_SA(0, 0), cA, voffA); PG8_STAGE(PG8_SB(0, 1), cB + hstep, voffB); PG8_STAGE(PG8_SA(0, 1), cA + hstep, voffA);
        if (wr == 1) PG8_BAR;
        PG8_WAIT_V(4); PG8_BAR;
        PG8_STAGE(PG8_SB(1, 0), cB + kstep, voffB); PG8_STAGE(PG8_SA(1, 0), cA + kstep, voffA); PG8_STAGE(PG8_SB(1, 1), cB + hstep + kstep, voffB);
        PG8_WAIT_V(6); PG8_BAR;
    }
    for (;;) {
        const bool has_next = S.next(ui + 1, nxt);
        const char* nA = has_next ? (const char*)g.A + (size_t)nxt.pm * tstep : cA; const char* nB = has_next ? (const char*)g.Bt + (size_t)nxt.pn * tstep : cB;
        for (int t = 0; t < nt; t += 2) {
            const bool last = (t == nt - 2);
            const char* a1 = cA + (size_t)(t + 1) * kstep;
            const char* a2 = last ? nA : cA + (size_t)(t + 2) * kstep; const char* b2 = last ? nB : cB + (size_t)(t + 2) * kstep;
            const char* a3 = a2 + kstep; const char* b3 = b2 + kstep;
            if (last && has_next) S.a_ready(nxt);
            if constexpr (SP2) {
            PG8_LDB(B0, 0, 0); PG8_LDB(B1, 0, 1); PG8_SCHED; PG8_LDA(At, 0, 0); PG8_STAGE(PG8_SA(1, 1), a1 + hstep, voffA);
            PG8_WAIT_V(8); PG8_WAIT_L(0); PG8_BAR; PG8_MMA(0, 0, At, B0); PG8_MMA(0, 1, At, B1); PG8_BAR; PG8_SCHED;
            PG8_LDA(At, 0, 1); PG8_STAGE(PG8_SB(0, 0), b2, voffB); PG8_STAGE(PG8_SB(0, 1), b2 + hstep, voffB); PG8_STAGE(PG8_SA(0, 0), a2, voffA);
            PG8_WAIT_V(8); PG8_WAIT_L(0); PG8_BAR; PG8_MMA(1, 0, At, B0); PG8_MMA(1, 1, At, B1); PG8_BAR; PG8_SCHED;
            PG8_LDB(B0, 1, 0); PG8_LDB(B1, 1, 1); PG8_SCHED; PG8_LDA(At, 1, 0); PG8_STAGE(PG8_SA(0, 1), a2 + hstep, voffA);
            PG8_WAIT_V(8); PG8_WAIT_L(0); PG8_BAR; PG8_MMA(0, 0, At, B0); PG8_MMA(0, 1, At, B1); PG8_BAR; PG8_SCHED;
            PG8_LDA(At, 1, 1); PG8_STAGE(PG8_SB(1, 0), b3, voffB); PG8_STAGE(PG8_SB(1, 1), b3 + hstep, voffB); PG8_STAGE(PG8_SA(1, 0), a3, voffA);
            PG8_WAIT_V(8); PG8_WAIT_L(0); PG8_BAR; PG8_MMA(1, 0, At, B0); PG8_MMA(1, 1, At, B1); PG8_BAR; PG8_SCHED;
            } else {
            PG8_LDB(B0, 0, 0); PG8_SCHED; PG8_LDA(At, 0, 0); PG8_STAGE(PG8_SA(1, 1), a1 + hstep, voffA);
            PG8_WAIT_L(8); PG8_BAR; PG8_WAIT_L(0); PG8_MMA(0, 0, At, B0); PG8_BAR; PG8_SCHED;
            PG8_LDB(B1, 0, 1); PG8_STAGE(PG8_SB(0, 0), b2, voffB);
            PG8_BAR; PG8_WAIT_L(0); PG8_MMA(0, 1, At, B1); PG8_BAR;
            PG8_LDA(At, 0, 1); PG8_STAGE(PG8_SA(0, 0), a2, voffA);
            PG8_BAR; PG8_WAIT_L(0); PG8_MMA(1, 0, At, B0); PG8_BAR; PG8_SCHED;
            PG8_STAGE(PG8_SB(0, 1), b2 + hstep, voffB);
            PG8_WAIT_V(6); PG8_BAR; PG8_MMA(1, 1, At, B1); PG8_BAR;
            PG8_LDB(B0, 1, 0); PG8_SCHED; PG8_LDA(At, 1, 0); PG8_STAGE(PG8_SA(0, 1), a2 + hstep, voffA);
            PG8_WAIT_L(8); PG8_BAR; PG8_WAIT_L(0); PG8_MMA(0, 0, At, B0); PG8_BAR; PG8_SCHED;
            PG8_LDB(B1, 1, 1); PG8_STAGE(PG8_SB(1, 0), b3, voffB);
            PG8_BAR; PG8_WAIT_L(0); PG8_MMA(0, 1, At, B1); PG8_BAR;
            PG8_LDA(At, 1, 1); PG8_STAGE(PG8_SA(1, 0), a3, voffA);
            PG8_BAR; PG8_WAIT_L(0); PG8_MMA(1, 0, At, B0); PG8_BAR; PG8_SCHED;
            PG8_STAGE(PG8_SB(1, 1), b3 + hstep, voffB);
            PG8_WAIT_V(6); PG8_BAR; PG8_MMA(1, 1, At, B1); PG8_BAR;
            }
        }
        if constexpr (ALIGN_EPI) { if (wr == 0) PG8_BAR; }
        if constexpr (!Epi::AFTER_DRAIN) { E(acc, cur, wr, wc, fr, fq); S.done(cur); }
        if (!has_next) break;
#pragma unroll
        for (int a = 0; a < 2; ++a)
#pragma unroll
            for (int b = 0; b < 2; ++b)
#pragma unroll
                for (int m = 0; m < 4; ++m)
#pragma unroll
                    for (int n = 0; n < 2; ++n) acc[a][b][m][n] = (f32x4){0.f, 0.f, 0.f, 0.f};
        cur = nxt; cA = nA; cB = nB; ++ui;
        if constexpr (ALIGN_EPI) { if (wr == 1) PG8_BAR; }
    }
    PG8_WAIT_V(0);
    if constexpr (!ALIGN_EPI) { if (wr == 0) PG8_BAR; }
    PG8_BAR;
    if constexpr (Epi::AFTER_DRAIN) { E.fused(acc, cur, wr, wc, fr, fq, lds, wid, lane); S.done(cur); }
#undef PG8_SA
#undef PG8_SB
#undef PG8_STAGE
#undef PG8_LDA
#undef PG8_LDB
#undef PG8_MMA
#undef PG8_WAIT_V
#undef PG8_WAIT_L
#undef PG8_BAR
#undef PG8_SCHED
}
}

#ifndef PG8_SP2
#define PG8_SP2 true
#endif
#ifndef PG8_ALIGN
#define PG8_ALIGN true
#endif
#include <hip/hip_bf16.h>
#include <cmath>
namespace attn_body {
using bf16=__hip_bfloat16;
using bf16x8=__attribute__((ext_vector_type(8)))short;
using s16x4=__attribute__((ext_vector_type(4)))short;
using f32x16=__attribute__((ext_vector_type(16)))float;
using u32x4=__attribute__((ext_vector_type(4)))unsigned;
constexpr int BATCH=1,NHEAD=16,SEQ=16384,D=64,DM=2048,DMO=1024;
constexpr int NW=8,QBLK=32,QB=QBLK*NW,KVBLK=64,NQB=SEQ/QB;
constexpr int ATTN_PITCH=DM, ATTN_UNIT_ROWS=QB;
__device__ __forceinline__ int crow(int r,int hi){return (r&3)+8*(r>>2)+4*hi;}
#define SBAR() __builtin_amdgcn_sched_barrier(0)
__device__ __forceinline__ void cmask(f32x16&p0,f32x16&p1,int jb,int qrel,int hi){
  const float NEG=-INFINITY; int kb=64*jb+4*hi;
  #pragma unroll
  for(int r=0;r<16;++r){int kv=kb+(r&3)+8*(r>>2); if(kv>qrel)p0[r]=NEG; if(kv+32>qrel)p1[r]=NEG;}
}

constexpr int NSLOT=3, SLOTB=8192;
constexpr int LDS_K=0, LDS_V=NSLOT*SLOTB, LDS_WS=2*NSLOT*SLOTB, LDS_OST=LDS_WS+NW*64*4, LDS_BYTES=LDS_OST+NW*4096;
constexpr float C2=0.125f*1.4426950408889634f;
__device__ __forceinline__ void glds16(const void*gsrc,unsigned lds_dst){unsigned keep;
  asm volatile("s_mov_b32 %0, m0\n\ts_mov_b32 m0, %2\n\ts_nop 0\n\tglobal_load_lds_dwordx4 %1, off\n\ts_mov_b32 m0, %0":"=&s"(keep):"v"(gsrc),"s"(lds_dst):"memory");}
__device__ __forceinline__ float max3f(float a,float b,float c){float r;asm("v_max3_f32 %0, %1, %2, %3":"=v"(r):"v"(a),"v"(b),"v"(c));return r;}
__device__ __forceinline__ float max2f(float a,float b){float r;asm("v_max_f32_e32 %0, %1, %2":"=v"(r):"v"(a),"v"(b));return r;}
__device__ __forceinline__ float fadd_s(float a,float b){float r;asm("v_add_f32_e32 %0, %1, %2":"=v"(r):"v"(a),"v"(b));return r;}
__device__ __forceinline__ float fsub_s(float a,float b){float r;asm("v_sub_f32_e32 %0, %1, %2":"=v"(r):"v"(a),"v"(b));return r;}
typedef float f32x2_t __attribute__((ext_vector_type(2))); typedef __bf16 bf16x2_t __attribute__((ext_vector_type(2)));
__device__ __forceinline__ unsigned cvtpk_s(float lo,float hi){f32x2_t v={lo,hi};bf16x2_t b=__builtin_convertvector(v,bf16x2_t);return __builtin_bit_cast(unsigned,b);}
#define WAIT_BAR(N) asm volatile("s_waitcnt vmcnt(" #N ") lgkmcnt(0)\n\ts_barrier":::"memory")

__device__ __forceinline__ void qkt(f32x16&p0,f32x16&p1,const char*Kslot,const bf16x8*qr,const f32x16&negm,int r32,int hi){
  const char*kb=Kslot+hi*1024+r32*16;
  #pragma unroll
  for(int d0=0;d0<4;++d0){
    const bf16x8 b0=*reinterpret_cast<const bf16x8*>(kb+d0*2048);
    const bf16x8 b1=*reinterpret_cast<const bf16x8*>(kb+d0*2048+512);
    if(d0==0){p0=__builtin_amdgcn_mfma_f32_32x32x16_bf16(b0,qr[0],negm,0,0,0);p1=__builtin_amdgcn_mfma_f32_32x32x16_bf16(b1,qr[0],negm,0,0,0);}
    else{p0=__builtin_amdgcn_mfma_f32_32x32x16_bf16(b0,qr[d0],p0,0,0,0);p1=__builtin_amdgcn_mfma_f32_32x32x16_bf16(b1,qr[d0],p1,0,0,0);}}
}
typedef __attribute__((address_space(3))) const char* lds_cptr;
typedef short v4i16_t __attribute__((ext_vector_type(4)));
__device__ __forceinline__ void kload8(bf16x8*kf,lds_cptr kp){
  kf[0]=*(const __attribute__((address_space(3))) bf16x8*)(kp);      kf[1]=*(const __attribute__((address_space(3))) bf16x8*)(kp+512);
  kf[2]=*(const __attribute__((address_space(3))) bf16x8*)(kp+2048); kf[3]=*(const __attribute__((address_space(3))) bf16x8*)(kp+2560);
  kf[4]=*(const __attribute__((address_space(3))) bf16x8*)(kp+4096); kf[5]=*(const __attribute__((address_space(3))) bf16x8*)(kp+4608);
  kf[6]=*(const __attribute__((address_space(3))) bf16x8*)(kp+6144); kf[7]=*(const __attribute__((address_space(3))) bf16x8*)(kp+6656);
}
__device__ __forceinline__ void kload2(bf16x8*kf,lds_cptr kp,int j){ kf[2*j]=*(const __attribute__((address_space(3))) bf16x8*)(kp+j*2048); kf[2*j+1]=*(const __attribute__((address_space(3))) bf16x8*)(kp+j*2048+512); }
__device__ __forceinline__ s16x4 vtr(lds_cptr p){ return __builtin_bit_cast(s16x4,__builtin_amdgcn_ds_read_tr16_b64_v4i16((__attribute__((address_space(3))) v4i16_t*)p)); }
__device__ __forceinline__ float rowmax(const f32x16&p0,const f32x16&p1){
  float a=max3f(p0[0],p0[1],p1[0]),b=max3f(p0[2],p0[3],p1[1]);a=max3f(a,p1[2],p1[3]);
  #pragma unroll
  for(int r=4;r<16;r+=4){a=max3f(a,p0[r],p0[r+1]);b=max3f(b,p0[r+2],p0[r+3]);a=max3f(a,p1[r],p1[r+1]);b=max3f(b,p1[r+2],p1[r+3]);}
  const float m=max2f(a,b);
  auto rr=__builtin_amdgcn_permlane32_swap(__float_as_uint(m),__float_as_uint(m),false,false);
  return max2f(__uint_as_float(rr[0]),__uint_as_float(rr[1]));
}
__device__ __forceinline__ void pv(f32x16*o,int vb,bf16x8 pa0,bf16x8 pa1,bf16x8 pa2,bf16x8 pa3){
  #pragma unroll
  for(int d0=0;d0<2;++d0){s16x4 lo[4],hi[4];
    #pragma unroll
    for(int ks=0;ks<4;++ks){
      asm volatile("ds_read_b64_tr_b16 %0,%1 offset:%c2":"=&v"(lo[ks]):"v"(vb),"i"(d0*4096+ks*1024):"memory");
      asm volatile("ds_read_b64_tr_b16 %0,%1 offset:%c2":"=&v"(hi[ks]):"v"(vb),"i"(d0*4096+ks*1024+512):"memory");}
    asm volatile("s_waitcnt lgkmcnt(0)":::"memory");SBAR();
    #define PK(k) (bf16x8){lo[k][0],lo[k][1],lo[k][2],lo[k][3],hi[k][0],hi[k][1],hi[k][2],hi[k][3]}
    o[d0]=__builtin_amdgcn_mfma_f32_32x32x16_bf16(pa0,PK(0),o[d0],0,0,0);
    o[d0]=__builtin_amdgcn_mfma_f32_32x32x16_bf16(pa1,PK(1),o[d0],0,0,0);
    o[d0]=__builtin_amdgcn_mfma_f32_32x32x16_bf16(pa2,PK(2),o[d0],0,0,0);
    o[d0]=__builtin_amdgcn_mfma_f32_32x32x16_bf16(pa3,PK(3),o[d0],0,0,0);
    #undef PK
  }
}

#ifndef ATTN_STORE16
#define ATTN_STORE16(p,v) (*(u32x4*)(p)=(v))
#endif
template<int THRL> __device__ __forceinline__ void attn_unit(int b,int h,int qb,const bf16*Q,const bf16*__restrict__ K,const bf16*__restrict__ V,bf16*O,char*shm){
  int tid_=threadIdx.x; asm volatile("":"+v"(tid_)); const int tid=tid_,lane=tid&63,r32=lane&31,hi=lane>>5; const int wid=__builtin_amdgcn_readfirstlane(tid>>6);
  const long rowbase=(long)b*SEQ; const int q0=qb*QB;
  const bf16*Qw=Q+(rowbase+q0+wid*QBLK)*DM+h*D;
  const bf16*Kh=K+rowbase*DM+h*D,*Vh=V+rowbase*DM+h*D;
  const unsigned lds0=(unsigned)(uintptr_t)shm;
  float*wsf=(float*)(shm+LDS_WS)+wid*64;
  const bf16*ksrc=Kh+(long)lane*DM+wid*8;
  const bf16*vsrc=Vh+(long)(16*(wid&3)+(lane>>2))*DM+(wid>>2)*32+(lane&3)*8;
  const unsigned kdst=lds0+LDS_K+wid*1024, vdst=lds0+LDS_V+wid*1024;
  #define DMA_K(t,slot) glds16(ksrc+(long)(t)*KVBLK*DM,(unsigned)__builtin_amdgcn_readfirstlane(kdst+(slot)))
  #define DMA_V(t,slot) glds16(vsrc+(long)(t)*KVBLK*DM,(unsigned)__builtin_amdgcn_readfirstlane(vdst+(slot)))
  const int vb0=(int)(lds0+LDS_V)+((lane>>4)&1)*32+(lane&3)*8+(4*hi+((lane&15)>>2))*64;
  const char*Kbase=shm+LDS_K; bf16x8 kf[8];
  const lds_cptr shm3=(lds_cptr)shm; const lds_cptr kp0=shm3+LDS_K+hi*1024+r32*16; const lds_cptr vp0=shm3+LDS_V+((lane>>4)&1)*32+(lane&3)*8+(4*hi+((lane&15)>>2))*64;
  const int NT=(q0+QB)/KVBLK;
  DMA_K(0,0);DMA_V(0,0);DMA_K(1,SLOTB);
  bf16x8 qr[4];
  #pragma unroll
  for(int d0=0;d0<4;++d0)qr[d0]=*reinterpret_cast<const bf16x8*>(&Qw[(long)r32*DM+d0*16+hi*8]);
  float mhat=0.f,l_reg=0.f;f32x16 o[2];o[0]=f32x16{};o[1]=f32x16{};f32x16 negm=f32x16{};asm volatile("":"+v"(negm));
  const int qrel=wid*QBLK+r32;
  #define CMASK(P0,P1,t) do{int jb_=(t)-(NT-4); if(jb_>=0)cmask(P0,P1,jb_,qrel,hi);}while(0)
  bool resc=false;
  #define START(P0,P1) do{ const float rm=rowmax(P0,P1); resc=false; \
    { const float dl=rm; mhat=fadd_s(mhat,dl); \
      _Pragma("unroll") for(int r=0;r<16;++r){P0[r]=fsub_s(P0[r],dl);P1[r]=fsub_s(P1[r],dl);} \
      _Pragma("unroll") for(int r=0;r<16;++r)negm[r]=-mhat; asm volatile("":"+v"(negm)); } \
    _Pragma("unroll") for(int r=0;r<16;++r)P0[r]=__builtin_amdgcn_exp2f(P0[r]); }while(0)
  #define RESC() do{ if(resc){ asm volatile("s_waitcnt lgkmcnt(0)":::"memory"); \
      _Pragma("unroll") for(int d_=0;d_<2;++d_) _Pragma("unroll") for(int r=0;r<16;++r)o[d_][r]*=wsf[crow(r,hi)]; } }while(0)
  f32x16 pA0,pA1,pB0,pB1;
  int sl_prev=0,sl_cur=0,sl_next=SLOTB;
  #define ROT() do{sl_prev=sl_cur;sl_cur=sl_next;sl_next=(sl_next==(NSLOT-1)*SLOTB)?0:sl_next+SLOTB;}while(0)
  DMA_K(2,2*SLOTB);
  WAIT_BAR(3);
  qkt(pA0,pA1,Kbase,qr,negm,r32,hi);asm volatile("s_nop 15\n\ts_nop 7":"+v"(pA0),"+v"(pA1));CMASK(pA0,pA1,0);
  START(pA0,pA1);
  _Pragma("unroll") for(int r=0;r<16;++r)pA1[r]=__builtin_amdgcn_exp2f(pA1[r]);
  WAIT_BAR(0);
  DMA_K(3,0);DMA_V(1,SLOTB);
  ROT();
  kload8(kf,kp0+sl_cur);
  WAIT_BAR(2);
  s16x4 vlo[8],vhi[8]; u32x4 pw0,pw1,pw2,pw3;
  #define PKW(P,B) cvtpk_s(P[B],P[B+1])
  #define PAF(k) __builtin_bit_cast(bf16x8,pw##k)
  #define VFR(i) (bf16x8){vlo[i][0],vlo[i][1],vlo[i][2],vlo[i][3],vhi[i][0],vhi[i][1],vhi[i][2],vhi[i][3]}
  #define PIN(x) asm volatile("":"+v"(x))
  #define MX3(a,b,c) __builtin_fmaxf(__builtin_fmaxf((a),(b)),(c))
  #define GAPA(MF,A0,A1,A2,A3,W0,W1,PW) do{ MF; sacc+=A0; sacc+=A1; sacc+=A2; sacc+=A3; PIN(sacc); W0; W1; PIN(PW); SBAR(); }while(0)
  #define EX(v) __builtin_amdgcn_exp2f(v)
  #define GAPB(MF,X,B) do{ MF; X[B]=EX(X[B]); X[B+1]=EX(X[B+1]); X[B+2]=EX(X[B+2]); X[B+3]=EX(X[B+3]); PIN(X); SBAR(); }while(0)
  #define VRD(i) do{ vlo[i]=vtr(vp_+(((i)>>2)*4096+((i)&3)*1024)); vhi[i]=vtr(vp_+(((i)>>2)*4096+((i)&3)*1024+512)); }while(0)
  #define KRD(G,j) do{ if(G){ kload2(kf,kp0+sl_next,j); SBAR(); } }while(0)
  #define STEP(C0,C1,P0,P1,t,GK,GV,GL) do{ SBAR(); \
    const lds_cptr vp_=vp0+sl_prev; \
    VRD(0); SBAR(); float sacc=(P0[0]+P0[1]); \
    GAPA(C0=__builtin_amdgcn_mfma_f32_32x32x16_bf16(kf[0],qr[0],negm,0,0,0), P0[2],P0[3],P0[4],P0[5],     pw0[0]=PKW(P0,0), pw0[1]=PKW(P0,2), pw0); \
    VRD(4); SBAR(); GAPA(C1=__builtin_amdgcn_mfma_f32_32x32x16_bf16(kf[1],qr[0],negm,0,0,0), P0[6],P0[7],P0[8],P0[9],     pw0[2]=PKW(P0,4), pw0[3]=PKW(P0,6), pw0); \
    VRD(1); SBAR(); GAPA(C0=__builtin_amdgcn_mfma_f32_32x32x16_bf16(kf[2],qr[1],C0,0,0,0),   P0[10],P0[11],P0[12],P0[13], pw1[0]=PKW(P0,8), pw1[1]=PKW(P0,10), pw1); \
    VRD(5); SBAR(); GAPA(C1=__builtin_amdgcn_mfma_f32_32x32x16_bf16(kf[3],qr[1],C1,0,0,0),   P0[14],P0[15],P1[0],P1[1],   pw1[2]=PKW(P0,12),pw1[3]=PKW(P0,14), pw1); \
    VRD(2); SBAR(); GAPA(C0=__builtin_amdgcn_mfma_f32_32x32x16_bf16(kf[4],qr[2],C0,0,0,0),   P1[2],P1[3],P1[4],P1[5],     pw2[0]=PKW(P1,0), pw2[1]=PKW(P1,2), pw2); \
    VRD(6); SBAR(); GAPA(C1=__builtin_amdgcn_mfma_f32_32x32x16_bf16(kf[5],qr[2],C1,0,0,0),   P1[6],P1[7],P1[8],P1[9],     pw2[2]=PKW(P1,4), pw2[3]=PKW(P1,6), pw2); \
    VRD(3); SBAR(); GAPA(C0=__builtin_amdgcn_mfma_f32_32x32x16_bf16(kf[6],qr[3],C0,0,0,0),   P1[10],P1[11],P1[12],P1[13], pw3[0]=PKW(P1,8), pw3[1]=PKW(P1,10), pw3); \
    VRD(7); SBAR(); GAPA(C1=__builtin_amdgcn_mfma_f32_32x32x16_bf16(kf[7],qr[3],C1,0,0,0),   P1[14],P1[15],0.f,0.f,       pw3[2]=PKW(P1,12),pw3[3]=PKW(P1,14), pw3); \
    l_reg+=sacc; \
    if(GK){DMA_K((t)+3,sl_cur);} if(GV){DMA_V((t)+1,sl_next);} \
    CMASK(C0,C1,t); \
    { float a=MX3(C0[0],C0[1],C1[0]),b=MX3(C0[2],C0[3],C1[1]); a=MX3(a,C1[2],C1[3]); \
      _Pragma("unroll") for(int r=4;r<16;r+=4){a=MX3(a,C0[r],C0[r+1]);b=MX3(b,C0[r+2],C0[r+3]);a=MX3(a,C1[r],C1[r+1]);b=MX3(b,C1[r+2],C1[r+3]);} \
      float rm=__builtin_fmaxf(a,b); { auto rr=__builtin_amdgcn_permlane32_swap(__float_as_uint(rm),__float_as_uint(rm),false,false); rm=__builtin_fmaxf(__uint_as_float(rr[0]),__uint_as_float(rr[1])); } \
      resc=false; \
      if(__builtin_expect(__any(rm>(float)THRL),0)){ const float dl=__builtin_fmaxf(rm,0.f); mhat+=dl; \
        _Pragma("unroll") for(int r=0;r<16;++r){C0[r]-=dl;C1[r]-=dl;} \
        _Pragma("unroll") for(int r=0;r<16;++r)negm[r]=-mhat; asm volatile("":"+v"(negm)); \
        const float f=__builtin_amdgcn_exp2f(-dl); l_reg*=f; if(hi==0)wsf[r32]=f; resc=true; } } \
    SBAR(); \
    GAPB(o[0]=__builtin_amdgcn_mfma_f32_32x32x16_bf16(PAF(0),VFR(0),o[0],0,0,0), C0,0); \
    GAPB(o[1]=__builtin_amdgcn_mfma_f32_32x32x16_bf16(PAF(0),VFR(4),o[1],0,0,0), C0,4); \
    KRD(GL,0); GAPB(o[0]=__builtin_amdgcn_mfma_f32_32x32x16_bf16(PAF(1),VFR(1),o[0],0,0,0), C0,8); \
    KRD(GL,1); GAPB(o[1]=__builtin_amdgcn_mfma_f32_32x32x16_bf16(PAF(1),VFR(5),o[1],0,0,0), C0,12); \
    KRD(GL,2); GAPB(o[0]=__builtin_amdgcn_mfma_f32_32x32x16_bf16(PAF(2),VFR(2),o[0],0,0,0), C1,0); \
    KRD(GL,3); GAPB(o[1]=__builtin_amdgcn_mfma_f32_32x32x16_bf16(PAF(2),VFR(6),o[1],0,0,0), C1,4); \
    GAPB(o[0]=__builtin_amdgcn_mfma_f32_32x32x16_bf16(PAF(3),VFR(3),o[0],0,0,0), C1,8); \
    GAPB(o[1]=__builtin_amdgcn_mfma_f32_32x32x16_bf16(PAF(3),VFR(7),o[1],0,0,0), C1,12); \
    }while(0)
  int t=1;
  #undef CMASK
  #define CMASK(P0,P1,t) do{}while(0)
  for(;t+5<NT;t+=2){
    STEP(pB0,pB1,pA0,pA1,t,true,true,true);     WAIT_BAR(2); RESC(); ROT();
    STEP(pA0,pA1,pB0,pB1,t+1,true,true,true);   WAIT_BAR(2); RESC(); ROT();
  }
  #undef CMASK
  #define CMASK(P0,P1,t) do{int jb_=(t)-(NT-4); if(jb_>=0)cmask(P0,P1,jb_,qrel,hi);}while(0)
  #define ENDW(tt) do{ if((tt)+3<NT){WAIT_BAR(2);} else if((tt)+2<NT){WAIT_BAR(1);} else {WAIT_BAR(0);} }while(0)
  for(;t+1<NT;t+=2){
    STEP(pB0,pB1,pA0,pA1,t,(t+3<NT),(t+1<NT),(t+1<NT));       ENDW(t);   RESC(); ROT();
    STEP(pA0,pA1,pB0,pB1,t+1,(t+4<NT),(t+2<NT),(t+2<NT));     ENDW(t+1); RESC(); ROT();
  }
  STEP(pB0,pB1,pA0,pA1,NT-1,false,false,false); RESC();
  { float sacc=pB0[0]+pB0[1]; _Pragma("unroll") for(int r=2;r<16;++r)sacc+=pB0[r]; _Pragma("unroll") for(int r=0;r<16;++r)sacc+=pB1[r]; l_reg+=sacc;
    pw0=(u32x4){PKW(pB0,0),PKW(pB0,2),PKW(pB0,4),PKW(pB0,6)};pw1=(u32x4){PKW(pB0,8),PKW(pB0,10),PKW(pB0,12),PKW(pB0,14)};pw2=(u32x4){PKW(pB1,0),PKW(pB1,2),PKW(pB1,4),PKW(pB1,6)};pw3=(u32x4){PKW(pB1,8),PKW(pB1,10),PKW(pB1,12),PKW(pB1,14)};
    SBAR(); pv(o,vb0+sl_cur,PAF(0),PAF(1),PAF(2),PAF(3)); }
  #undef PKW
  #undef PAF
  #undef VFR
  #undef PIN
  #undef MX3
  #undef GAPA
  #undef GAPB
  #undef EX
  #undef VRD
  #undef KRD
  #undef STEP
  #undef ENDW
  {auto rr=__builtin_amdgcn_permlane32_swap(__float_as_uint(l_reg),__float_as_uint(l_reg),false,false);l_reg=__uint_as_float(rr[0])+__uint_as_float(rr[1]);}
  if(hi==0)wsf[32+r32]=l_reg;asm volatile("s_waitcnt lgkmcnt(0)":::"memory");
  float rli[16];
  #pragma unroll
  for(int r=0;r<16;++r)rli[r]=__builtin_amdgcn_rcpf(wsf[32+crow(r,hi)]);
  bf16*Ow=O+(rowbase+q0+wid*QBLK)*DMO+h*D;
  { bf16*stg=(bf16*)(shm+LDS_OST)+wid*2048;
    #pragma unroll
    for(int r=0;r<16;++r){const int orow=crow(r,hi);
      #pragma unroll
      for(int d0=0;d0<2;++d0)stg[orow*64+d0*32+r32]=__float2bfloat16(o[d0][r]*rli[r]);}
    asm volatile("s_waitcnt lgkmcnt(0)":::"memory");
    #pragma unroll
    for(int i=0;i<4;++i){const int row=i*8+(lane>>3),ch=lane&7; const u32x4 v=*(const u32x4*)(stg+row*64+ch*8); ATTN_STORE16(Ow+(long)row*DMO+ch*8,v);} }
  asm volatile("s_waitcnt lgkmcnt(0)\n\ts_barrier":::"memory");
  #undef DMA_K
  #undef DMA_V
  #undef CMASK
  #undef START
  #undef RESC
  #undef ROT
}
constexpr int ATTN_LDS_BYTES=LDS_BYTES;
struct AttnTensors { const bf16* Q; const bf16* K; const bf16* V; bf16* O; };
struct AttnUnit { int vh; int qb; };
struct StaticOrder {
  int vcu, G, bx;
  __device__ __forceinline__ StaticOrder(int grid,int block):vcu((grid%8==0)?(block%8)*(grid/8)+block/8:block),G(grid),bx(block){}
  __device__ __forceinline__ bool next(int i,AttnUnit&u)const{
    if(G==256){ if(i>=4)return false; const int s=vcu&15; u.vh=vcu>>4; u.qb=(i==0)?63-s:(i==1)?32+s:(i==2)?31-s:s; return true; }
    const int idx=i*G+bx; if(idx>=16*NQB)return false; u.vh=idx&15; u.qb=NQB-1-(idx>>4); return true; }
};
template<class Sched,int THRL=8> __device__ __forceinline__ void attn_phase(char*lds,const AttnTensors&T,const Sched&S){
  AttnUnit u;
  for(int i=0;S.next(i,u);++i){ const int h=u.vh>>2,c=(u.vh>>1)&1,e=u.vh&1;
    attn_unit<THRL>(0,0,u.qb,T.Q+h*128+c*64,T.K+h*128+c*64,T.V+h*128+e*64,T.O+u.vh*64,lds); }
}
#undef SBAR
#undef WAIT_BAR
}
constexpr int NWAVES = 8;
constexpr int M = 16384, D = 1024, FF = 2816, NGU = 2 * FF, NIN = 2048, DEPTH = 4;
constexpr size_t MiB = 1u << 20;
constexpr size_t WS_ROWSS = 1 * MiB;
constexpr size_t WS_ROPE = 2 * MiB;
constexpr size_t WS_XB = 8 * MiB;
constexpr size_t WS_H = 40 * MiB;
constexpr size_t WS_QKVU = 40 * MiB;
constexpr size_t WS_OBUF = 104 * MiB;
constexpr size_t WS_CAT = 136 * MiB;
constexpr size_t WS_W = 168 * MiB;
constexpr size_t OFF_GU1 = 0, OFF_DN1 = 11 * MiB, OFF_IN = 16 * MiB + 512 * 1024, OFF_OUT = 20 * MiB + 512 * 1024, OFF_GU2 = 22 * MiB + 512 * 1024, OFF_DN2 = 33 * MiB + 512 * 1024, W_LAYER = 39 * MiB;
constexpr size_t WS_END = WS_W + DEPTH * W_LAYER;
static_assert((size_t)NGU * D * 2 == 11 * MiB && (size_t)D * FF * 2 == 5 * MiB + 512 * 1024 && WS_H + (size_t)M * FF * 2 <= WS_CAT && WS_ROWSS + 16 * (size_t)M * 4 <= WS_ROPE && WS_ROPE + (size_t)M * 64 * 4 <= WS_XB, "ws map");
constexpr int LDS_BYTES = 147456;

#define LAS __attribute__((address_space(3)))
typedef unsigned short bf16;
typedef unsigned v4u __attribute__((ext_vector_type(4)));
typedef unsigned v2u __attribute__((ext_vector_type(2)));
typedef float f32x4 __attribute__((ext_vector_type(4)));
#define LDS_WAIT() asm volatile("s_waitcnt lgkmcnt(0)" ::: "memory")
__device__ __forceinline__ unsigned f2bf(float f) { unsigned u = __builtin_bit_cast(unsigned, f); return (u + 0x7fffu + ((u >> 16) & 1u)) >> 16; }
__device__ __forceinline__ unsigned pk2(float lo, float hi) { return f2bf(lo) | (f2bf(hi) << 16); }
__device__ __forceinline__ float bflo(unsigned w) { return __builtin_bit_cast(float, w << 16); }
__device__ __forceinline__ float bfhi(unsigned w) { return __builtin_bit_cast(float, w & 0xffff0000u); }
__device__ __forceinline__ float wave_sum(float v) {
#pragma unroll
    for (int o = 1; o < 64; o <<= 1) v += __shfl_xor(v, o);
    return v;
}
__device__ __forceinline__ void tr_item(const float* W, int N, int k0, int n0, const float* gk, bf16* WT, int Kd, int rbase, int rstride, LAS float* scr, int lane) {
#pragma unroll 8
    for (int i = 0; i < 32; ++i) { const int kk = 2 * i + (lane >> 5); float w = W[(size_t)(k0 + kk) * N + n0 + (lane & 31)]; if (gk) w *= gk[k0 + kk]; scr[kk * 33 + (lane & 31)] = w; }
    LDS_WAIT(); asm volatile("" ::: "memory");
    const int c = lane & 7;
#pragma unroll
    for (int j = 0; j < 4; ++j) { const int n = (lane >> 3) + 8 * j; const LAS float* s = scr + (8 * c) * 33 + n;
        v4u o; o.x = pk2(s[0 * 33], s[1 * 33]); o.y = pk2(s[2 * 33], s[3 * 33]); o.z = pk2(s[4 * 33], s[5 * 33]); o.w = pk2(s[6 * 33], s[7 * 33]);
        *(v4u*)(WT + (size_t)(rbase + n * rstride) * Kd + k0 + 8 * c) = o; }
    LDS_WAIT(); asm volatile("" ::: "memory");
}

#define XB_TMO      128
#define XB_XCNT(j)  (256  + 64 * (j))
#define XB_XSUB(j)  (1280 + 64 * (j))
#define XB_XGEN(j)  (2304 + 64 * (j))
#define XB_TOP      3328
#define XB_TOPGEN   3392
#define XCD_BAR_WORDS 3456
#define XB_SPIN_CAP (1u << 18)

__device__ __forceinline__ unsigned xb_ld(unsigned* p)              { return __hip_atomic_load(p, __ATOMIC_RELAXED, __HIP_MEMORY_SCOPE_AGENT); }
__device__ __forceinline__ unsigned xb_add(unsigned* p, unsigned v) { return __hip_atomic_fetch_add(p, v, __ATOMIC_RELAXED, __HIP_MEMORY_SCOPE_AGENT); }
__device__ __forceinline__ unsigned xb_xcc_id() { return (unsigned)__builtin_amdgcn_s_getreg((3 << 11) | 20) & 0xFu; }
#define XB_SPIN(cond, bar) do { unsigned _sp = 0; while (cond) { __builtin_amdgcn_s_sleep(1); \
    if ((++_sp & 255u) == 0u) { if (xb_ld(&(bar)[XB_TMO])) break; if (_sp > XB_SPIN_CAP) { atomicAdd(&(bar)[XB_TMO], 1u); break; } } } } while (0)

struct XcdBarrier {
    unsigned* bar; unsigned x;
    volatile LAS unsigned* st;
};

__device__ __forceinline__ XcdBarrier xcd_barrier_post(unsigned* bar, volatile LAS unsigned* st) {
    XcdBarrier b; b.bar = bar; b.x = xb_xcc_id(); b.st = st;
    if (threadIdx.x == 0) (void)xb_add(&bar[XB_XCNT(b.x)], 1u);
    return b;
}
__device__ __forceinline__ void xcd_barrier_complete(unsigned* bar, unsigned x, unsigned& nloc, unsigned& nx) {
    const unsigned G = gridDim.x * gridDim.y * gridDim.z;
    unsigned sum, cnt, mine, sp = 0u;
    for (;;) {
        sum = 0u; cnt = 0u; mine = 0u;
#pragma unroll
        for (unsigned j = 0; j < 16; ++j) { const unsigned c = xb_ld(&bar[XB_XCNT(j)]); sum += c; cnt += (c > 0u) ? 1u : 0u; mine = (j == x) ? c : mine; }
        if (sum == G) break;
        __builtin_amdgcn_s_sleep(1);
        if ((++sp & 255u) == 0u) { if (xb_ld(&bar[XB_TMO])) break; if (sp > XB_SPIN_CAP) { atomicAdd(&bar[XB_TMO], 1u); break; } }
    }
    nloc = mine > 0u ? mine : 1u; nx = cnt > 0u ? cnt : 1u;
}

__device__ __forceinline__ void xcd_barrier(const XcdBarrier& b) {
    asm volatile("s_waitcnt vmcnt(0)" ::: "memory");
    __syncthreads();
    if (threadIdx.x == 0) {
        unsigned* bar = b.bar;
        __builtin_amdgcn_s_waitcnt(0);
        unsigned nloc = b.st[0], nx = b.st[1];
        if (nloc == 0u) { xcd_barrier_complete(bar, b.x, nloc, nx); b.st[0] = nloc; b.st[1] = nx; }
        const unsigned old = xb_add(&bar[XB_XSUB(b.x)], 1u);
        const unsigned gen = old / nloc;
        if (old + 1u == (gen + 1u) * nloc) {
            __builtin_amdgcn_fence(__ATOMIC_RELEASE, "agent");
            asm volatile("s_waitcnt vmcnt(0)" ::: "memory");
            const unsigned og = xb_add(&bar[XB_TOP], 1u);
            const unsigned tg = og / nx;
            if (og + 1u == (tg + 1u) * nx) xb_add(&bar[XB_TOPGEN], 1u);
            else XB_SPIN(xb_ld(&bar[XB_TOPGEN]) == tg, bar);
            __builtin_amdgcn_fence(__ATOMIC_ACQUIRE, "agent");
            xb_add(&bar[XB_XGEN(b.x)], 1u);
            asm volatile("s_waitcnt vmcnt(0)" ::: "memory");
        } else {
            XB_SPIN(xb_ld(&bar[XB_XGEN(b.x)]) == gen, bar);
            __builtin_amdgcn_fence(__ATOMIC_ACQUIRE, "agent");
            asm volatile("s_waitcnt vmcnt(0)" ::: "memory");
        }
    }
    __syncthreads();
}

struct Args { const float* in[20]; float* out; unsigned char* ws; };

__global__ void __launch_bounds__(NWAVES * 64, 2) hymba_fwd(Args args) {
    extern __shared__ __attribute__((aligned(16))) unsigned char lds[];
    LAS unsigned char* L = (LAS unsigned char*)lds;
    const int tid = threadIdx.x, lane = tid & 63, wave = __builtin_amdgcn_readfirstlane(tid >> 6);
    const int G = gridDim.x, bx = blockIdx.x;
    const int gw = bx * NWAVES + wave, NGW = G * NWAVES;
    const int gtid = bx * (NWAVES * 64) + tid, NT = G * NWAVES * 64;
    unsigned char* ws = args.ws;
    float* rowss = (float*)(ws + WS_ROWSS); float* rope = (float*)(ws + WS_ROPE);
    bf16* XB = (bf16*)(ws + WS_XB); bf16* HB = (bf16*)(ws + WS_H); bf16* QKVU = (bf16*)(ws + WS_QKVU); bf16* OBUF = (bf16*)(ws + WS_OBUF); bf16* CAT = (bf16*)(ws + WS_CAT);
    float* xout = args.out;
    { volatile LAS unsigned* st0 = (volatile LAS unsigned*)(L + 131072); if (tid < 2) st0[tid] = 0u; }
    __syncthreads();
    const XcdBarrier gbar = xcd_barrier_post((unsigned*)ws, (volatile LAS unsigned*)(L + 131072));

    {
        LAS float* scr = (LAS float*)(L + wave * 16384);
        constexpr int IT_G = 16 * 88, IT_D = 44 * 32, IT_IN = 16 * 64, IT_OUT = 8 * 32, IT_LAYER = 4 * IT_G + 2 * IT_D + IT_IN + IT_OUT;
        static_assert(IT_G == IT_D, "item decode");
        for (int it = gw; it < DEPTH * IT_LAYER; it += NGW) {
            const int l = it / IT_LAYER; int r = it % IT_LAYER; unsigned char* wl = ws + WS_W + (size_t)l * W_LAYER;
            if (r < 6 * IT_G) {
                const int f = r / (3 * IT_G), q = r % (3 * IT_G), kind = q / IT_G, i = q % IT_G;
                if (kind < 2) { const float* W = args.in[(f ? 16 : 2) + kind] + (size_t)l * D * FF; const int kb = i / 88, nb = i % 88, n0 = 32 * nb;
                    tr_item(W, FF, 64 * kb, n0, args.in[f ? 15 : 1] + l * D, (bf16*)(wl + (f ? OFF_GU2 : OFF_GU1)), D, (n0 >> 7) * 256 + kind * 128 + (n0 & 127), 1, scr, lane); }
                else { const float* W = args.in[f ? 18 : 4] + (size_t)l * FF * D; const int kb = i / 32, nb = i % 32;
                    tr_item(W, D, 64 * kb, 32 * nb, nullptr, (bf16*)(wl + (f ? OFF_DN2 : OFF_DN1)), FF, 32 * nb, 1, scr, lane); }
            } else { r -= 6 * IT_G;
                if (r < IT_IN) { const float* W = args.in[6] + (size_t)l * D * NIN; const int kb = r / 64, nb = r % 64, n0 = 32 * nb; int rbase = n0, rstride = 1;
                    if (n0 < 1024) { const int d0 = n0 & 63; rbase = (n0 - d0) + (d0 ? 1 : 0); rstride = 2; }
                    tr_item(W, NIN, 64 * kb, n0, args.in[5] + l * D, (bf16*)(wl + OFF_IN), D, rbase, rstride, scr, lane); }
                else { r -= IT_IN; const float* W = args.in[14] + (size_t)l * D * D; const int kb = r / 32, nb = r % 32;
                    tr_item(W, D, 64 * kb, 32 * nb, nullptr, (bf16*)(wl + OFF_OUT), D, 32 * nb, 1, scr, lane); }
            }
        }
        for (int it = gw; it < DEPTH * 1024; it += NGW) {
            const int l = it >> 10, r = it & 1023, g = r >> 8, cb = (r >> 4) & 15, nb = r & 15, c0 = cb * 8, n = nb * 64 + lane;
            const float* pw = args.in[12] + ((size_t)(l * 4 + g) * 128 + c0) * 128; const float* ps = args.in[13] + l * 512 + g * 128;
            const float* wo = args.in[14] + (size_t)l * D * D + (size_t)(512 + g * 128) * D + n;
            float a[8];
#pragma unroll
            for (int j = 0; j < 8; ++j) a[j] = 0.f;
            for (int e = 0; e < 128; ++e) { const float w = wo[(size_t)e * D] * ps[e];
#pragma unroll
                for (int j = 0; j < 8; ++j) a[j] += pw[j * 128 + e] * w; }
            v4u o; o.x = pk2(a[0], a[1]); o.y = pk2(a[2], a[3]); o.z = pk2(a[4], a[5]); o.w = pk2(a[6], a[7]);
            *(v4u*)((bf16*)(ws + WS_W + (size_t)l * W_LAYER + OFF_OUT) + (size_t)n * D + 512 + g * 128 + c0) = o;
        }
        for (int i = gtid; i < M * 32; i += NT) { const int s = i >> 5, j = i & 31; const float inv = (float)pow(10000.0, -(double)j / 32.0); const float ang = (float)s * inv;
            const double a = (double)ang; rope[2 * i] = (float)cos(a); rope[2 * i + 1] = (float)sin(a); }
        for (int m = gw; m < M; m += NGW) { const f32x4* xr = (const f32x4*)(args.in[0] + (size_t)m * D) + lane; f32x4 v[4]; float s = 0.f;
#pragma unroll
            for (int j = 0; j < 4; ++j) { v[j] = xr[64 * j]; s += (v[j].x * v[j].x + v[j].y * v[j].y) + (v[j].z * v[j].z + v[j].w * v[j].w); }
            s = wave_sum(s); if (lane < 16) rowss[(size_t)m * 16 + lane] = (lane == 0) ? s : 0.f;
            v2u* o8 = (v2u*)(XB + (size_t)m * D) + lane;
#pragma unroll
            for (int j = 0; j < 4; ++j) { v2u w; w.x = pk2(v[j].x, v[j].y); w.y = pk2(v[j].z, v[j].w); o8[64 * j] = w; } }
    }
    cg::this_grid().sync();


    for (int step = 0; step < 3 * DEPTH; ++step) {
        const int l = step / 3, kind = step % 3; unsigned char* wl = ws + WS_W + (size_t)l * W_LAYER;
        if (kind != 1) {
            const int f = kind >> 1;
            { pg8::Gemm g{XB, (const bf16*)(wl + (f ? OFF_GU2 : OFF_GU1)), M, NGU, D}; pg8::StaticOrder S; S.init(M, NGU, G, bx);
              pg8::EpiGateUp E{HB, rowss};
              pg8::gemm_phase<pg8::EpiGateUp, pg8::StaticOrder, PG8_ALIGN, PG8_SP2>(L, g, S, E); }
            xcd_barrier(gbar);
            { pg8::Gemm g{HB, (const bf16*)(wl + (f ? OFF_DN2 : OFF_DN1)), M, D, FF}; pg8::StaticOrder S; S.init(M, D, G, bx);
              pg8::EpiResid E{(step == 0) ? args.in[0] : xout, xout, XB, rowss, 0.5f};
              pg8::gemm_phase<pg8::EpiResid, pg8::StaticOrder, PG8_ALIGN, PG8_SP2>(L, g, S, E); }
            xcd_barrier(gbar);
        } else {
            { pg8::Gemm g{XB, (const bf16*)(wl + OFF_IN), M, NIN, D}; pg8::StaticOrder S; S.init(M, NIN, G, bx);
              pg8::EpiQKVU E{QKVU, rowss, rope};
              pg8::gemm_phase<pg8::EpiQKVU, pg8::StaticOrder, PG8_ALIGN, PG8_SP2>(L, g, S, E); }
            xcd_barrier(gbar);
            { const attn_body::AttnTensors AT{(const attn_body::bf16*)QKVU, (const attn_body::bf16*)(QKVU + 512), (const attn_body::bf16*)(QKVU + 1024), (attn_body::bf16*)OBUF};
              const attn_body::StaticOrder S(G, bx);
              attn_body::attn_phase<attn_body::StaticOrder>((char*)lds, AT, S); }
            xcd_barrier(gbar);
            {
                const float li = 0.8f - 0.6f * expf(-0.3f * (float)l);
                const float s1 = wave_sum(args.in[7][l * 64 + lane] * args.in[8][l * 64 + lane]), s2 = wave_sum(args.in[9][l * 64 + lane] * args.in[10][l * 64 + lane]);
                const float lam = expf(s1) - expf(s2) + li;
                const int hd = lane >> 4, j0 = (lane & 15) * 8;
                float gn[8];
#pragma unroll
                for (int j = 0; j < 8; ++j) gn[j] = args.in[11][l * 128 + j0 + j] * (1.0f - li);
                const int win = 2 << hd;
                for (int m = gw; m < M; m += NGW) {
                    const v4u a = *(const v4u*)(OBUF + (size_t)m * 1024 + hd * 256 + j0), b = *(const v4u*)(OBUF + (size_t)m * 1024 + hd * 256 + 128 + j0);
                    float o[8];
                    o[0] = bflo(a.x) - lam * bflo(b.x); o[1] = bfhi(a.x) - lam * bfhi(b.x); o[2] = bflo(a.y) - lam * bflo(b.y); o[3] = bfhi(a.y) - lam * bfhi(b.y);
                    o[4] = bflo(a.z) - lam * bflo(b.z); o[5] = bfhi(a.z) - lam * bfhi(b.z); o[6] = bflo(a.w) - lam * bflo(b.w); o[7] = bfhi(a.w) - lam * bfhi(b.w);
                    float ss = 0.f;
#pragma unroll
                    for (int j = 0; j < 8; ++j) ss += o[j] * o[j];
                    ss += __shfl_xor(ss, 1); ss += __shfl_xor(ss, 2); ss += __shfl_xor(ss, 4); ss += __shfl_xor(ss, 8);
                    const float rr = __builtin_amdgcn_rsqf(ss * (1.0f / 128.0f) + 1e-6f);
                    v4u w; w.x = pk2(o[0] * rr * gn[0], o[1] * rr * gn[1]); w.y = pk2(o[2] * rr * gn[2], o[3] * rr * gn[3]); w.z = pk2(o[4] * rr * gn[4], o[5] * rr * gn[5]); w.w = pk2(o[6] * rr * gn[6], o[7] * rr * gn[7]);
                    *(v4u*)(CAT + (size_t)m * 1024 + hd * 128 + j0) = w;
                    const bf16* up = QKVU + (size_t)m * 2048 + 1536 + hd * 128 + j0;
                    const v4u u0 = *(const v4u*)up;
                    float sm[8] = {bflo(u0.x), bfhi(u0.x), bflo(u0.y), bfhi(u0.y), bflo(u0.z), bfhi(u0.z), bflo(u0.w), bfhi(u0.w)};
                    float us[8];
#pragma unroll
                    for (int j = 0; j < 8; ++j) us[j] = sm[j];
                    for (int t = 1; t < win; ++t) { if (m - t >= 0) { const v4u ut = *(const v4u*)(up - (size_t)t * 2048);
                        sm[0] += bflo(ut.x); sm[1] += bfhi(ut.x); sm[2] += bflo(ut.y); sm[3] += bfhi(ut.y); sm[4] += bflo(ut.z); sm[5] += bfhi(ut.z); sm[6] += bflo(ut.w); sm[7] += bfhi(ut.w); } }
                    const float ic = 1.0f / (float)((m + 1 < win) ? (m + 1) : win);
                    v4u d; d.x = pk2(sm[0] * ic - us[0], sm[1] * ic - us[1]); d.y = pk2(sm[2] * ic - us[2], sm[3] * ic - us[3]); d.z = pk2(sm[4] * ic - us[4], sm[5] * ic - us[5]); d.w = pk2(sm[6] * ic - us[6], sm[7] * ic - us[7]);
                    *(v4u*)(CAT + (size_t)m * 1024 + 512 + hd * 128 + j0) = d;
                }
            }
            xcd_barrier(gbar);
            { pg8::Gemm g{CAT, (const bf16*)(wl + OFF_OUT), M, D, D}; pg8::StaticOrder S; S.init(M, D, G, bx);
              pg8::EpiResid E{xout, xout, XB, rowss, 1.0f};
              pg8::gemm_phase<pg8::EpiResid, pg8::StaticOrder, PG8_ALIGN, PG8_SP2>(L, g, S, E); }
            xcd_barrier(gbar);
        }
    }
    for (int m = gw; m < M; m += NGW) { f32x4* xr = (f32x4*)(xout + (size_t)m * D) + lane; const f32x4* gr = (const f32x4*)args.in[19] + lane;
        const float r = pg8::rs_from_ss(rowss + (size_t)m * 16);
#pragma unroll
        for (int j = 0; j < 4; ++j) { const f32x4 v = xr[64 * j], gg = gr[64 * j]; xr[64 * j] = v * r * gg; } }
}

extern "C" void kernel_launch(void* const* d_in, const int* in_sizes, int n_in, void* d_out, int out_size, void* d_ws, size_t ws_size, hipStream_t stream) {
    static int grid_blocks = 0;
    if (grid_blocks == 0) {
        if (n_in != 20 || out_size != M * D || ws_size < WS_END) { fprintf(stderr, "kernel_launch: unexpected shapes (n_in %d out %d ws %zu, need %zu)\n", n_in, out_size, ws_size, (size_t)WS_END); grid_blocks = -1; return; }
        int dev = 0, cus = 0, per_cu = 0;
        (void)hipGetDevice(&dev); (void)hipDeviceGetAttribute(&cus, hipDeviceAttributeMultiprocessorCount, dev);
        if (hipFuncSetAttribute((const void*)hymba_fwd, hipFuncAttributeMaxDynamicSharedMemorySize, LDS_BYTES) != hipSuccess) { fprintf(stderr, "kernel_launch: hipFuncSetAttribute failed\n"); grid_blocks = -1; return; }
        if (hipOccupancyMaxActiveBlocksPerMultiprocessor(&per_cu, (const void*)hymba_fwd, NWAVES * 64, LDS_BYTES) != hipSuccess || per_cu < 1) { fprintf(stderr, "kernel_launch: occupancy query says %d\n", per_cu); per_cu = 1; }
        (void)hipGetLastError();
        grid_blocks = cus * per_cu;
    }
    if (grid_blocks < 0) return;
    if (hipMemsetAsync(d_ws, 0, 65536, stream) != hipSuccess) { fprintf(stderr, "kernel_launch: memset failed\n"); return; }
    Args a{};
    for (int i = 0; i < 20; ++i) a.in[i] = (const float*)d_in[i];
    a.out = (float*)d_out; a.ws = (unsigned char*)d_ws;
    void* kargs[] = {&a};
    hipError_t e = hipLaunchCooperativeKernel((const void*)hymba_fwd, dim3(grid_blocks), dim3(NWAVES * 64), kargs, LDS_BYTES, stream);
    if (e != hipSuccess) fprintf(stderr, "cooperative launch failed: %s (grid %d)\n", hipGetErrorString(e), grid_blocks);
}
```

```cpp
#include <hip/hip_runtime.h>
#include <hip/hip_cooperative_groups.h>
#include <cstdio>
#include <cstdint>
namespace cg = cooperative_groups;
namespace pg8 {
#define PG8_LAS __attribute__((address_space(3)))
typedef unsigned short bf16_t;
typedef short bf16x8 __attribute__((ext_vector_type(8)));
typedef float f32x4 __attribute__((ext_vector_type(4)));
typedef unsigned u32x4 __attribute__((ext_vector_type(4)));
constexpr int BM = 256, BK = 64, HALF = 128, HTB = HALF * BK * 2  , STAGE_BYTES = 8 * HTB, NXCD = 8, WGM = 8;

__host__ __device__ __forceinline__ int lds_byte(int r, int c) { const int st = (r >> 4) * 2 + (c >> 5), rr = r & 15, cc = c & 31, ob = rr * 64 + cc * 2; return st * 1024 + (ob ^ (((ob >> 9) & 1) << 5)); }
__host__ __device__ __forceinline__ void stage_rc(int b, int& R, int& C) { const int st = b / 1024, sb = b % 1024, swz = sb ^ (((sb >> 9) & 1) << 5); R = (st >> 1) * 16 + swz / 64; C = (st & 1) * 32 + (swz % 64) / 2; }
__host__ __device__ __forceinline__ int perm32(int rho) { const int n = rho >> 4, i = rho & 15; return 8 * (i >> 2) + 4 * n + (i & 3); }

struct Unit { int pm, pn; };
struct Gemm { const bf16_t* A; const bf16_t* Bt; int M, N, K; };

struct StaticOrder {
    int nM, nN, nwg, G, c;
    __host__ __device__ void init(int M, int N, int G_, int c_) { nM = M / BM; nN = N / BM; nwg = nM * nN; G = G_; c = c_; }
    __host__ __device__ bool next(int i, Unit& u) const {
        const long L = (long)i * G + c; if (L >= nwg) return false;
        int wgid = (int)L; { const int q = nwg / NXCD, r = nwg % NXCD, xcd = wgid % NXCD, off = wgid / NXCD; wgid = (xcd < r ? xcd * (q + 1) : r * (q + 1) + (xcd - r) * q) + off; }
        const int nig = WGM * nN, gid = wgid / nig, fm = gid * WGM, gsz = (nM - fm) < WGM ? (nM - fm) : WGM;
        u.pm = fm + ((wgid % nig) % gsz); u.pn = (wgid % nig) / gsz; return true;
    }
    __device__ __forceinline__ void a_ready(const Unit&) const {}
    __device__ __forceinline__ void done(const Unit&) const {}
};

__device__ __forceinline__ unsigned cvt_pk_bf16(float lo, float hi) { unsigned r; asm volatile("v_cvt_pk_bf16_f32 %0, %1, %2" : "=v"(r) : "v"(lo), "v"(hi)); return r; }
typedef float f32x2 __attribute__((ext_vector_type(2)));
__device__ __forceinline__ f32x2 gelu_pk(f32x2 v) {
    const f32x2 av = __builtin_elementwise_abs(v), d = av * 0.2316418882f + 1.0f;
    f32x2 t; t.x = __builtin_amdgcn_rcpf(d.x); t.y = __builtin_amdgcn_rcpf(d.y);
    f32x2 q = t * 0.5307027145f + (-0.7265760135f); q = q * t + 0.7107068705f; q = q * t + (-0.142248368f); q = q * t + 0.127414796f; q = q * t;
    const f32x2 s = (v * v) * (-0.72134752044f);
    f32x2 e; e.x = __builtin_amdgcn_exp2f(s.x); e.y = __builtin_amdgcn_exp2f(s.y);
    const f32x2 m = v * (q * e), r = v - m;
    f32x2 o; o.x = v.x < 0.f ? m.x : r.x; o.y = v.y < 0.f ? m.y : r.y; return o;
}

template <int ACT  > struct EpiBf16 {
    static constexpr bool PERM = true, AFTER_DRAIN = false; static_assert(ACT == 0 || ACT == 1, "EpiBf16: ACT is 0 (none) or 1 (gelu_pk)");
    bf16_t* O; int ldc; const float* bias; int split_cols; size_t split_stride; float scale0;
    __device__ __forceinline__ void operator()(const f32x4 (&acc)[2][2][4][2], const Unit& u, int wr, int wc, int fr, int fq) const {
        const int row0 = u.pm * BM + wr * 64 + fr; int colt = u.pn * BM; bf16_t* base = O;
        float sc = 1.f; if (split_cols) { const int t = colt / split_cols; base += (size_t)t * split_stride; colt -= t * split_cols; if (t == 0) sc = scale0; }
        const int col0 = colt + wc * 32 + 8 * fq, bcol0 = u.pn * BM + wc * 32 + 8 * fq;
        f32x4 bv[2][2];
#pragma unroll
        for (int bj = 0; bj < 2; ++bj)
#pragma unroll
            for (int n = 0; n < 2; ++n) bv[bj][n] = bias ? *(const f32x4*)(bias + bcol0 + bj * HALF + 4 * n) : (f32x4){0.f, 0.f, 0.f, 0.f};
#pragma unroll
        for (int ai = 0; ai < 2; ++ai)
#pragma unroll
            for (int m = 0; m < 4; ++m) { bf16_t* rowp = base + (size_t)(row0 + ai * HALF + m * 16) * ldc + col0;
#pragma unroll
                for (int bj = 0; bj < 2; ++bj) { f32x4 v0 = acc[ai][bj][m][0] + bv[bj][0], v1 = acc[ai][bj][m][1] + bv[bj][1];
                    if (ACT == 1) { f32x2 a = gelu_pk((f32x2){v0[0], v0[1]}), b = gelu_pk((f32x2){v0[2], v0[3]}), c = gelu_pk((f32x2){v1[0], v1[1]}), d = gelu_pk((f32x2){v1[2], v1[3]});
                        v0 = (f32x4){a.x, a.y, b.x, b.y}; v1 = (f32x4){c.x, c.y, d.x, d.y}; }
                    v0 = v0 * sc; v1 = v1 * sc; u32x4 w; w.x = cvt_pk_bf16(v0[0], v0[1]); w.y = cvt_pk_bf16(v0[2], v0[3]); w.z = cvt_pk_bf16(v1[0], v1[1]); w.w = cvt_pk_bf16(v1[2], v1[3]);
                    *(u32x4*)(rowp + bj * HALF) = w; } }
    }
};
__device__ __forceinline__ float rs_from_ss(const float* p) { const f32x4 a = ((const f32x4*)p)[0], b = ((const f32x4*)p)[1], c = ((const f32x4*)p)[2], d = ((const f32x4*)p)[3];
    const float ss = (((a[0] + a[1]) + (a[2] + a[3])) + ((b[0] + b[1]) + (b[2] + b[3]))) + (((c[0] + c[1]) + (c[2] + c[3])) + ((d[0] + d[1]) + (d[2] + d[3])));
    return __builtin_amdgcn_rsqf(ss * (1.0f / 1024.0f) + 1e-6f); }
struct EpiGateUp {
    static constexpr bool PERM = true, AFTER_DRAIN = false;
    bf16_t* H; const float* rowss;
    __device__ __forceinline__ void operator()(const f32x4 (&acc)[2][2][4][2], const Unit& u, int wr, int wc, int fr, int fq) const {
        const int row0 = u.pm * BM + wr * 64 + fr; const int col0 = u.pn * HALF + wc * 32 + 8 * fq;
#pragma unroll
        for (int ai = 0; ai < 2; ++ai)
#pragma unroll
            for (int m = 0; m < 4; ++m) { const int row = row0 + ai * HALF + m * 16; const float r = rs_from_ss(rowss + (size_t)row * 16);
                float hv[8];
#pragma unroll
                for (int n = 0; n < 2; ++n)
#pragma unroll
                    for (int e = 0; e < 4; ++e) { const float g = acc[ai][0][m][n][e] * r, up = acc[ai][1][m][n][e] * r;
                        const float sg = g * __builtin_amdgcn_rcpf(1.0f + __builtin_amdgcn_exp2f(g * -1.4426950408889634f)); hv[n * 4 + e] = sg * up; }
                u32x4 w; w.x = cvt_pk_bf16(hv[0], hv[1]); w.y = cvt_pk_bf16(hv[2], hv[3]); w.z = cvt_pk_bf16(hv[4], hv[5]); w.w = cvt_pk_bf16(hv[6], hv[7]);
                *(u32x4*)(H + (size_t)row * 2816 + col0) = w; }
    }
};
struct EpiResid {
    static constexpr bool PERM = true, AFTER_DRAIN = false;
    const float* xin; float* xout; bf16_t* xb; float* rowss_next; float alpha;
    __device__ __forceinline__ void operator()(const f32x4 (&acc)[2][2][4][2], const Unit& u, int wr, int wc, int fr, int fq) const {
        const int row0 = u.pm * BM + wr * 64 + fr; const int col0 = u.pn * BM + wc * 32 + 8 * fq;
#pragma unroll
        for (int ai = 0; ai < 2; ++ai)
#pragma unroll
            for (int m = 0; m < 4; ++m) { const int row = row0 + ai * HALF + m * 16; float ss = 0.f;
#pragma unroll
                for (int bj = 0; bj < 2; ++bj) { const size_t off = (size_t)row * 1024 + col0 + bj * HALF;
                    const f32x4 a0 = *(const f32x4*)(xin + off), a1 = *(const f32x4*)(xin + off + 4);
                    const f32x4 v0 = a0 + acc[ai][bj][m][0] * alpha, v1 = a1 + acc[ai][bj][m][1] * alpha;
                    *(f32x4*)(xout + off) = v0; *(f32x4*)(xout + off + 4) = v1;
                    ss += (v0[0] * v0[0] + v0[1] * v0[1]) + (v0[2] * v0[2] + v0[3] * v0[3]) + (v1[0] * v1[0] + v1[1] * v1[1]) + (v1[2] * v1[2] + v1[3] * v1[3]);
                    u32x4 w; w.x = cvt_pk_bf16(v0[0], v0[1]); w.y = cvt_pk_bf16(v0[2], v0[3]); w.z = cvt_pk_bf16(v1[0], v1[1]); w.w = cvt_pk_bf16(v1[2], v1[3]);
                    *(u32x4*)(xb + off) = w; }
                ss += __shfl_xor(ss, 16); ss += __shfl_xor(ss, 32);
                if (fq == 0) rowss_next[(size_t)row * 16 + u.pn * 4 + wc] = ss; }
    }
};
struct EpiQKVU {
    static constexpr bool PERM = true, AFTER_DRAIN = false;
    bf16_t* O; const float* rowss; const float* rope;
    __device__ __forceinline__ void operator()(const f32x4 (&acc)[2][2][4][2], const Unit& u, int wr, int wc, int fr, int fq) const {
        const int row0 = u.pm * BM + wr * 64 + fr; const int col0 = u.pn * BM + wc * 32 + 8 * fq; const int sec = u.pn >> 1;
        const int j0 = 16 * (wc & 1) + 4 * fq;
#pragma unroll
        for (int ai = 0; ai < 2; ++ai)
#pragma unroll
            for (int m = 0; m < 4; ++m) { const int row = row0 + ai * HALF + m * 16; float r = rs_from_ss(rowss + (size_t)row * 16); if (sec == 0) r *= 0.125f * 1.4426950408889634f;
                f32x4 cs0 = (f32x4){1.f, 0.f, 1.f, 0.f}, cs1 = cs0;
                if (sec < 2) { const f32x4* rp = (const f32x4*)(rope + ((size_t)row * 32 + j0) * 2); cs0 = rp[0]; cs1 = rp[1]; }
#pragma unroll
                for (int bj = 0; bj < 2; ++bj) { const f32x4 v0 = acc[ai][bj][m][0] * r, v1 = acc[ai][bj][m][1] * r;
                    const float o0 = v0[0] * cs0[0] - v0[1] * cs0[1], o1 = v0[1] * cs0[0] + v0[0] * cs0[1];
                    const float o2 = v0[2] * cs0[2] - v0[3] * cs0[3], o3 = v0[3] * cs0[2] + v0[2] * cs0[3];
                    const float o4 = v1[0] * cs1[0] - v1[1] * cs1[1], o5 = v1[1] * cs1[0] + v1[0] * cs1[1];
                    const float o6 = v1[2] * cs1[2] - v1[3] * cs1[3], o7 = v1[3] * cs1[2] + v1[2] * cs1[3];
                    u32x4 w; w.x = cvt_pk_bf16(o0, o1); w.y = cvt_pk_bf16(o2, o3); w.z = cvt_pk_bf16(o4, o5); w.w = cvt_pk_bf16(o6, o7);
                    *(u32x4*)(O + (size_t)row * 2048 + col0 + bj * HALF) = w; } }
    }
};

template <class Epi, class Sched, bool ALIGN_EPI = false, bool SP2 = false>
__device__ __forceinline__ void gemm_phase(PG8_LAS unsigned char* lds, const Gemm g, const Sched& S, const Epi& E) {
    int tid_ = threadIdx.x; asm volatile("" : "+v"(tid_));
    const int tid = tid_, wid = __builtin_amdgcn_readfirstlane(tid >> 6), lane = tid & 63, wr = wid >> 2, wc = wid & 3, fr = lane & 15, fq = lane >> 4;
    const int K = g.K, nt = K / BK;
    unsigned voffA[2], voffB[2];
#pragma unroll
    for (int i = 0; i < 2; ++i) { int R, C; stage_rc(tid * 16 + i * 8192, R, C); const int Rb = Epi::PERM ? ((R & ~31) + perm32(R & 31)) : R;
        voffA[i] = (unsigned)(R * K + C) * 2u; voffB[i] = (unsigned)(Rb * K + C) * 2u; }
    const size_t kstep = (size_t)(BK * 2);
    const size_t hstep = (size_t)HALF * K * 2;
    const size_t tstep = 2 * hstep;
    const unsigned ldsw = (unsigned)wid * 1024u;
    const int aoff = lds_byte(wr * 64 + fr, fq * 8), boff = lds_byte(wc * 32 + fr, fq * 8);
#define PG8_SA(b, h) (((b) * 2 + (h)) * HTB)
#define PG8_SB(b, h) ((4 + (b) * 2 + (h)) * HTB)
#define PG8_STAGE(bufoff, gbase, voff) do { _Pragma("unroll") for (int _i = 0; _i < 2; ++_i) \
        __builtin_amdgcn_global_load_lds((const unsigned*)((const char*)(gbase) + (voff)[_i]), (PG8_LAS unsigned*)(lds + (bufoff) + ldsw + _i * 8192), 16, 0, 0); } while (0)
#define PG8_LDA(dst, b, h) do { _Pragma("unroll") for (int m = 0; m < 4; ++m) _Pragma("unroll") for (int k = 0; k < 2; ++k) dst[m][k] = *(const PG8_LAS bf16x8*)(lds + PG8_SA(b, h) + aoff + m * 2048 + k * 1024); } while (0)
#define PG8_LDB(dst, b, h) do { _Pragma("unroll") for (int n = 0; n < 2; ++n) _Pragma("unroll") for (int k = 0; k < 2; ++k) dst[n][k] = *(const PG8_LAS bf16x8*)(lds + PG8_SB(b, h) + boff + n * 2048 + k * 1024); } while (0)
#define PG8_MMA(ai, bj, At, Bt) do { __builtin_amdgcn_s_setprio(1); _Pragma("unroll") for (int m = 0; m < 4; ++m) _Pragma("unroll") for (int n = 0; n < 2; ++n) _Pragma("unroll") for (int k = 0; k < 2; ++k) \
        acc[ai][bj][m][n] = __builtin_amdgcn_mfma_f32_16x16x32_bf16(Bt[n][k], At[m][k], acc[ai][bj][m][n], 0, 0, 0); __builtin_amdgcn_s_setprio(0); } while (0)
#define PG8_WAIT_V(n) asm volatile("s_waitcnt vmcnt(" #n ")" ::: "memory")
#define PG8_WAIT_L(n) asm volatile("s_waitcnt lgkmcnt(" #n ")" ::: "memory")
#define PG8_BAR __builtin_amdgcn_s_barrier()
#define PG8_SCHED __builtin_amdgcn_sched_barrier(0)
    Unit cur, nxt; int ui = 0;
    if (!S.next(0, cur)) return;
    f32x4 acc[2][2][4][2];
#pragma unroll
    for (int a = 0; a < 2; ++a)
#pragma unroll
        for (int b = 0; b < 2; ++b)
#pragma unroll
            for (int m = 0; m < 4; ++m)
#pragma unroll
                for (int n = 0; n < 2; ++n) acc[a][b][m][n] = (f32x4){0.f, 0.f, 0.f, 0.f};
    bf16x8 At[4][2], B0[2][2], B1[2][2];
    const char* cA = (const char*)g.A + (size_t)cur.pm * tstep; const char* cB = (const char*)g.Bt + (size_t)cur.pn * tstep;
    S.a_ready(cur);
    if constexpr (SP2) {
        PG8_STAGE(PG8_SB(0, 0), cB, voffB); PG8_STAGE(PG8_SB(0, 1), cB + hstep, voffB); PG8_STAGE(PG8_SA(0, 0), cA, voffA); PG8_STAGE(PG8_SA(0, 1), cA + hstep, voffA);
        if (wr == 1) PG8_BAR;
        PG8_WAIT_V(2); PG8_BAR;
        PG8_STAGE(PG8_SB(1, 0), cB + kstep, voffB); PG8_STAGE(PG8_SA(1, 0), cA + kstep, voffA); PG8_STAGE(PG8_SB(1, 1), cB + hstep + kstep, voffB);
        PG8_WAIT_V(6); PG8_BAR;
    } else {
        PG8_STAGE(PG8_SB(0, 0), cB, voffB); PG8_STAGE(PG8_SA(0, 0), cA, voffA); PG8_STAGE(PG8_SB(0, 1), cB + hstep, voffB); PG8_STAGE(PG8_SA(0, 1), cA + hstep, voffA);
        if (wr == 1) PG8_BAR;
        PG8_WAIT_V(4); PG8_BAR;
        PG8_STAGE(PG8_SB(1, 0), cB + kstep, voffB); PG8_STAGE(PG8_SA(1, 0), cA + kstep, voffA); PG8_STAGE(PG8_SB(1, 1), cB + hstep + kstep, voffB);
        PG8_WAIT_V(6); PG8_BAR;
    }
    for (;;) {
        const bool has_next = S.next(ui + 1, nxt);
        const char* nA = has_next ? (const char*)g.A + (size_t)nxt.pm * tstep : cA; const char* nB = has_next ? (const char*)g.Bt + (size_t)nxt.pn * tstep : cB;
        for (int t = 0; t < nt; t += 2) {
            const bool last = (t == nt - 2);
            const char* a1 = cA + (size_t)(t + 1) * kstep;
            const char* a2 = last ? nA : cA + (size_t)(t + 2) * kstep; const char* b2 = last ? nB : cB + (size_t)(t + 2) * kstep;
            const char* a3 = a2 + kstep; const char* b3 = b2 + kstep;
            if (last && has_next) S.a_ready(nxt);
            if constexpr (SP2) {
            PG8_LDB(B0, 0, 0); PG8_LDB(B1, 0, 1); PG8_SCHED; PG8_LDA(At, 0, 0); PG8_STAGE(PG8_SA(1, 1), a1 + hstep, voffA);
            PG8_WAIT_V(8); PG8_WAIT_L(0); PG8_BAR; PG8_MMA(0, 0, At, B0); PG8_MMA(0, 1, At, B1); PG8_BAR; PG8_SCHED;
            PG8_LDA(At, 0, 1); PG8_STAGE(PG8_SB(0, 0), b2, voffB); PG8_STAGE(PG8_SB(0, 1), b2 + hstep, voffB); PG8_STAGE(PG8_SA(0, 0), a2, voffA);
            PG8_WAIT_V(8); PG8_WAIT_L(0); PG8_BAR; PG8_MMA(1, 0, At, B0); PG8_MMA(1, 1, At, B1); PG8_BAR; PG8_SCHED;
            PG8_LDB(B0, 1, 0); PG8_LDB(B1, 1, 1); PG8_SCHED; PG8_LDA(At, 1, 0); PG8_STAGE(PG8_SA(0, 1), a2 + hstep, voffA);
            PG8_WAIT_V(8); PG8_WAIT_L(0); PG8_BAR; PG8_MMA(0, 0, At, B0); PG8_MMA(0, 1, At, B1); PG8_BAR; PG8_SCHED;
            PG8_LDA(At, 1, 1); PG8_STAGE(PG8_SB(1, 0), b3, voffB); PG8_STAGE(PG8_SB(1, 1), b3 + hstep, voffB); PG8_STAGE(PG8_SA(1, 0), a3, voffA);
            PG8_WAIT_V(8); PG8_WAIT_L(0); PG8_BAR; PG8_MMA(1, 0, At, B0); PG8_MMA(1, 1, At, B1); PG8_BAR; PG8_SCHED;
            } else {
            PG8_LDB(B0, 0, 0); PG8_SCHED; PG8_LDA(At, 0, 0); PG8_STAGE(PG8_SA(1, 1), a1 + hstep, voffA);
            PG8_WAIT_L(8); PG8_BAR; PG8_WAIT_L(0); PG8_MMA(0, 0, At, B0); PG8_BAR; PG8_SCHED;
            PG8_LDB(B1, 0, 1); PG8_STAGE(PG8_SB(0, 0), b2, voffB);
            PG8_BAR; PG8_WAIT_L(0); PG8_MMA(0, 1, At, B1); PG8_BAR;
            PG8_LDA(At, 0, 1); PG8_STAGE(PG8_SA(0, 0), a2, voffA);
            PG8_BAR; PG8_WAIT_L(0); PG8_MMA(1, 0, At, B0); PG8_BAR; PG8_SCHED;
            PG8_STAGE(PG8_SB(0, 1), b2 + hstep, voffB);
            PG8_WAIT_V(6); PG8_BAR; PG8_MMA(1, 1, At, B1); PG8_BAR;
            PG8_LDB(B0, 1, 0); PG8_SCHED; PG8_LDA(At, 1, 0); PG8_STAGE(PG8_SA(0, 1), a2 + hstep, voffA);
            PG8_WAIT_L(8); PG8_BAR; PG8_WAIT_L(0); PG8_MMA(0, 0, At, B0); PG8_BAR; PG8_SCHED;
            PG8_LDB(B1, 1, 1); PG8_STAGE(PG8_SB(1, 0), b3, voffB);
            PG8_BAR; PG8_WAIT_L(0); PG8_MMA(0, 1, At, B1); PG8_BAR;
            PG8_LDA(At, 1, 1); PG8_STAGE(PG8_SA(1, 0), a3, voffA);
            PG8_BAR; PG8_WAIT_L(0); PG8_MMA(1, 0, At, B0); PG8_BAR; PG8_SCHED;
            PG8_STAGE(PG8_SB(1, 1), b3 + hstep, voffB);
            PG8_WAIT_V(6); PG8_BAR; PG8_MMA(1, 1, At, B1); PG8_BAR;
            }
        }
        if constexpr (ALIGN_EPI) { if (wr == 0) PG8_BAR; }
        if constexpr (!Epi::AFTER_DRAIN) { E(acc, cur, wr, wc, fr, fq); S.done(cur); }
        if (!has_next) break;
#pragma unroll
        for (int a = 0; a < 2; ++a)
#pragma unroll
            for (int b = 0; b < 2; ++b)
#pragma unroll
                for (int m = 0; m < 4; ++m)
#pragma unroll
                    for (int n = 0; n < 2; ++n) acc[a][b][m][n] = (f32x4){0.f, 0.f, 0.f, 0.f};
        cur = nxt; cA = nA; cB = nB; ++ui;
        if constexpr (ALIGN_EPI) { if (wr == 1) PG8_BAR; }
    }
    PG8_WAIT_V(0);
    if constexpr (!ALIGN_EPI) { if (wr == 0) PG8_BAR; }
    PG8_BAR;
    if constexpr (Epi::AFTER_DRAIN) { E.fused(acc, cur, wr, wc, fr, fq, lds, wid, lane); S.done(cur); }
#undef PG8_SA
#undef PG8_SB
#undef PG8_STAGE
#undef PG8_LDA
#undef PG8_LDB
#undef PG8_MMA
#undef PG8_WAIT_V
#undef PG8_WAIT_L
#undef PG8_BAR
#undef PG8_SCHED
}
}

#ifndef PG8_SP2
#define PG8_SP2 true
#endif
#ifndef PG8_ALIGN
#define PG8_ALIGN true
#endif
#include <hip/hip_bf16.h>
#include <cmath>
namespace attn_body {
using bf16=__hip_bfloat16;
using bf16x8=__attribute__((ext_vector_type(8)))short;
using s16x4=__attribute__((ext_vector_type(4)))short;
using f32x16=__attribute__((ext_vector_type(16)))float;
using u32x4=__attribute__((ext_vector_type(4)))unsigned;
constexpr int BATCH=1,NHEAD=16,SEQ=16384,D=64,DM=2048,DMO=1024;
constexpr int NW=8,NWA=4,QBLK=32,QB=QBLK*NWA,KVBLK=64,NQB=SEQ/QB;
constexpr int ATTN_PITCH=DM, ATTN_UNIT_ROWS=QB;
__device__ __forceinline__ int crow(int r,int hi){return (r&3)+8*(r>>2)+4*hi;}
#define SBAR() __builtin_amdgcn_sched_barrier(0)
__device__ __forceinline__ void cmask(f32x16&p0,f32x16&p1,int jb,int qrel,int hi){
  const float NEG=-INFINITY; int kb=64*jb+4*hi;
  #pragma unroll
  for(int r=0;r<16;++r){int kv=kb+(r&3)+8*(r>>2); if(kv>qrel)p0[r]=NEG; if(kv+32>qrel)p1[r]=NEG;}
}

constexpr int NSLOT=3, SLOTB=8192;
constexpr int NVSLOT=4, VSLOTB=16384;
constexpr int LDS_K=0, LDS_V=NSLOT*SLOTB, LDS_P=LDS_V+NVSLOT*VSLOTB, LDS_OST=LDS_P+2*NWA*4096, LDS_WS=LDS_OST+NWA*4096, WSF_STRIDE=192, LDS_BYTES=LDS_WS+NWA*WSF_STRIDE*4;
constexpr float C2=0.125f*1.4426950408889634f;
__device__ __forceinline__ void glds16(const void*gsrc,unsigned lds_dst){unsigned keep;
  asm volatile("s_mov_b32 %0, m0\n\ts_mov_b32 m0, %2\n\ts_nop 0\n\tglobal_load_lds_dwordx4 %1, off\n\ts_mov_b32 m0, %0":"=&s"(keep):"v"(gsrc),"s"(lds_dst):"memory");}
__device__ __forceinline__ float max3f(float a,float b,float c){float r;asm("v_max3_f32 %0, %1, %2, %3":"=v"(r):"v"(a),"v"(b),"v"(c));return r;}
__device__ __forceinline__ float max2f(float a,float b){float r;asm("v_max_f32_e32 %0, %1, %2":"=v"(r):"v"(a),"v"(b));return r;}
__device__ __forceinline__ float fadd_s(float a,float b){float r;asm("v_add_f32_e32 %0, %1, %2":"=v"(r):"v"(a),"v"(b));return r;}
__device__ __forceinline__ float fsub_s(float a,float b){float r;asm("v_sub_f32_e32 %0, %1, %2":"=v"(r):"v"(a),"v"(b));return r;}
typedef float f32x2_t __attribute__((ext_vector_type(2))); typedef __bf16 bf16x2_t __attribute__((ext_vector_type(2)));
__device__ __forceinline__ unsigned cvtpk_s(float lo,float hi){f32x2_t v={lo,hi};bf16x2_t b=__builtin_convertvector(v,bf16x2_t);return __builtin_bit_cast(unsigned,b);}
#define WAIT_BAR(N) asm volatile("s_waitcnt vmcnt(" #N ") lgkmcnt(0)\n\ts_barrier":::"memory")

__device__ __forceinline__ void qkt(f32x16&p0,f32x16&p1,const char*Kslot,const bf16x8*qr,const f32x16&negm,int r32,int hi){
  const char*kb=Kslot+hi*1024+r32*16;
  #pragma unroll
  for(int d0=0;d0<4;++d0){
    const bf16x8 b0=*reinterpret_cast<const bf16x8*>(kb+d0*2048);
    const bf16x8 b1=*reinterpret_cast<const bf16x8*>(kb+d0*2048+512);
    if(d0==0){p0=__builtin_amdgcn_mfma_f32_32x32x16_bf16(b0,qr[0],negm,0,0,0);p1=__builtin_amdgcn_mfma_f32_32x32x16_bf16(b1,qr[0],negm,0,0,0);}
    else{p0=__builtin_amdgcn_mfma_f32_32x32x16_bf16(b0,qr[d0],p0,0,0,0);p1=__builtin_amdgcn_mfma_f32_32x32x16_bf16(b1,qr[d0],p1,0,0,0);}}
}
typedef __attribute__((address_space(3))) const char* lds_cptr;
typedef short v4i16_t __attribute__((ext_vector_type(4)));
__device__ __forceinline__ void kload8(bf16x8*kf,lds_cptr kp){
  kf[0]=*(const __attribute__((address_space(3))) bf16x8*)(kp);      kf[1]=*(const __attribute__((address_space(3))) bf16x8*)(kp+512);
  kf[2]=*(const __attribute__((address_space(3))) bf16x8*)(kp+2048); kf[3]=*(const __attribute__((address_space(3))) bf16x8*)(kp+2560);
  kf[4]=*(const __attribute__((address_space(3))) bf16x8*)(kp+4096); kf[5]=*(const __attribute__((address_space(3))) bf16x8*)(kp+4608);
  kf[6]=*(const __attribute__((address_space(3))) bf16x8*)(kp+6144); kf[7]=*(const __attribute__((address_space(3))) bf16x8*)(kp+6656);
}
__device__ __forceinline__ void kload2(bf16x8*kf,lds_cptr kp,int j){ kf[2*j]=*(const __attribute__((address_space(3))) bf16x8*)(kp+j*2048); kf[2*j+1]=*(const __attribute__((address_space(3))) bf16x8*)(kp+j*2048+512); }
__device__ __forceinline__ s16x4 vtr(lds_cptr p){ return __builtin_bit_cast(s16x4,__builtin_amdgcn_ds_read_tr16_b64_v4i16((__attribute__((address_space(3))) v4i16_t*)p)); }
__device__ __forceinline__ float rowmax(const f32x16&p0,const f32x16&p1){
  float a=max3f(p0[0],p0[1],p1[0]),b=max3f(p0[2],p0[3],p1[1]);a=max3f(a,p1[2],p1[3]);
  #pragma unroll
  for(int r=4;r<16;r+=4){a=max3f(a,p0[r],p0[r+1]);b=max3f(b,p0[r+2],p0[r+3]);a=max3f(a,p1[r],p1[r+1]);b=max3f(b,p1[r+2],p1[r+3]);}
  const float m=max2f(a,b);
  auto rr=__builtin_amdgcn_permlane32_swap(__float_as_uint(m),__float_as_uint(m),false,false);
  return max2f(__uint_as_float(rr[0]),__uint_as_float(rr[1]));
}
__device__ __forceinline__ void pv(f32x16*o,int vb,bf16x8 pa0,bf16x8 pa1,bf16x8 pa2,bf16x8 pa3){
  #pragma unroll
  for(int d0=0;d0<2;++d0){s16x4 lo[4],hi[4];
    #pragma unroll
    for(int ks=0;ks<4;++ks){
      asm volatile("ds_read_b64_tr_b16 %0,%1 offset:%c2":"=&v"(lo[ks]):"v"(vb),"i"(d0*4096+ks*1024):"memory");
      asm volatile("ds_read_b64_tr_b16 %0,%1 offset:%c2":"=&v"(hi[ks]):"v"(vb),"i"(d0*4096+ks*1024+512):"memory");}
    asm volatile("s_waitcnt lgkmcnt(0)":::"memory");SBAR();
    #define PK(k) (bf16x8){lo[k][0],lo[k][1],lo[k][2],lo[k][3],hi[k][0],hi[k][1],hi[k][2],hi[k][3]}
    o[d0]=__builtin_amdgcn_mfma_f32_32x32x16_bf16(pa0,PK(0),o[d0],0,0,0);
    o[d0]=__builtin_amdgcn_mfma_f32_32x32x16_bf16(pa1,PK(1),o[d0],0,0,0);
    o[d0]=__builtin_amdgcn_mfma_f32_32x32x16_bf16(pa2,PK(2),o[d0],0,0,0);
    o[d0]=__builtin_amdgcn_mfma_f32_32x32x16_bf16(pa3,PK(3),o[d0],0,0,0);
    #undef PK
  }
}

#ifndef ATTN_STORE16
#define ATTN_STORE16(p,v) (*(u32x4*)(p)=(v))
#endif
template<int THRL> __device__ __forceinline__ void attn_unit(int qb,const bf16*Q,const bf16*__restrict__ K,const bf16*__restrict__ V,bf16*O,char*shm){
  int tid_=threadIdx.x; asm volatile("":"+v"(tid_)); const int tid=tid_,lane=tid&63,r32=lane&31,hi=lane>>5; const int wid=__builtin_amdgcn_readfirstlane(tid>>6);
  const int q0=qb*QB; const int wa=wid&3; const bool roleA=wid<NWA;
  const bf16*Qw=Q+(long)(q0+wa*QBLK)*DM;
  const bf16*Kh=K,*Vh=V;
  const unsigned lds0=(unsigned)(uintptr_t)shm;
  float*wsf=(float*)(shm+LDS_WS)+wa*WSF_STRIDE;
  const bf16*ksrc=Kh+(long)lane*DM+wid*8;
  const bf16*vsrc=Vh+(long)(16*(wid&3)+(lane>>2))*DM+(wid>>2)*32+(lane&3)*8;
  const unsigned kdst=lds0+LDS_K+wid*1024, vdst=lds0+LDS_V+wid*1024;
  #define DMA_K(t,slot) glds16(ksrc+(long)(t)*KVBLK*DM,(unsigned)__builtin_amdgcn_readfirstlane(kdst+(slot)))
  #define VSL(t) ((((t)+4)&3)*VSLOTB)
  #define DMA_V(t) do{ const unsigned vd_=(unsigned)__builtin_amdgcn_readfirstlane(vdst+VSL(t)); glds16(vsrc+(long)(t)*KVBLK*DM,vd_); glds16(vsrc+(long)(t)*KVBLK*DM+64,(unsigned)__builtin_amdgcn_readfirstlane(vd_+8192)); }while(0)
  const int vb0=(int)(lds0+LDS_V)+((lane>>4)&1)*32+(lane&3)*8+(4*hi+((lane&15)>>2))*64;
  const char*Kbase=shm+LDS_K; bf16x8 kf[8];
  const lds_cptr shm3=(lds_cptr)shm; const lds_cptr kp0=shm3+LDS_K+hi*1024+r32*16; const lds_cptr vp0=shm3+LDS_V+((lane>>4)&1)*32+(lane&3)*8+(4*hi+((lane&15)>>2))*64;
  const int NT=(q0+QB)/KVBLK;
  DMA_K(0,0);DMA_V(0);DMA_K(1,SLOTB);
  int sl_cur=0,sl_next=SLOTB;
  #define ROT() do{sl_cur=sl_next;sl_next=(sl_next==(NSLOT-1)*SLOTB)?0:sl_next+SLOTB;}while(0)
  #define ENDW(tt) do{ if((tt)+3<NT){WAIT_BAR(3);} else if((tt)+2<NT){WAIT_BAR(2);} else {WAIT_BAR(0);} }while(0)
  typedef __attribute__((address_space(3))) char* lds_wptr; typedef __attribute__((address_space(3))) u32x4 lds_u32x4;
  if(roleA){
  const lds_wptr pwr0=(lds_wptr)shm+LDS_P+wa*4096+lane*16;
  bf16x8 qr[4];
  #pragma unroll
  for(int d0=0;d0<4;++d0)qr[d0]=*reinterpret_cast<const bf16x8*>(&Qw[(long)r32*DM+d0*16+hi*8]);
  float mhat=0.f,l_reg=0.f;f32x16 o[2];o[0]=f32x16{};o[1]=f32x16{};f32x16 negm=f32x16{};asm volatile("":"+v"(negm));
  const int qrel=wa*QBLK+r32;
  #define CMASK(P0,P1,t) do{int jb_=(t)-(NT-2); if(jb_>=0)cmask(P0,P1,jb_,qrel,hi);}while(0)
  bool resc=false;
  #define START(P0,P1) do{ const float rm=rowmax(P0,P1); resc=false; \
    { const float dl=rm; mhat=fadd_s(mhat,dl); \
      _Pragma("unroll") for(int r=0;r<16;++r){P0[r]=fsub_s(P0[r],dl);P1[r]=fsub_s(P1[r],dl);} \
      _Pragma("unroll") for(int r=0;r<16;++r)negm[r]=-mhat; asm volatile("":"+v"(negm)); } \
    _Pragma("unroll") for(int r=0;r<16;++r)P0[r]=__builtin_amdgcn_exp2f(P0[r]); }while(0)
  #define RESC() do{ if(resc){ asm volatile("s_waitcnt lgkmcnt(0)":::"memory"); \
      _Pragma("unroll") for(int d_=0;d_<2;++d_) _Pragma("unroll") for(int r=0;r<16;++r)o[d_][r]*=wsf[crow(r,hi)]; } }while(0)
  f32x16 pA0,pA1,pB0,pB1;
  DMA_K(2,2*SLOTB);
  WAIT_BAR(3);
  qkt(pA0,pA1,Kbase,qr,negm,r32,hi);asm volatile("s_nop 15\n\ts_nop 7":"+v"(pA0),"+v"(pA1));CMASK(pA0,pA1,0);
  START(pA0,pA1);
  _Pragma("unroll") for(int r=0;r<16;++r)pA1[r]=__builtin_amdgcn_exp2f(pA1[r]);
  WAIT_BAR(0);
  DMA_K(3,0);DMA_V(1);
  ROT();
  kload8(kf,kp0+sl_cur);
  if(NT==2){WAIT_BAR(0);}else{WAIT_BAR(3);}
  s16x4 vlo[8],vhi[8]; u32x4 pw0,pw1,pw2,pw3;
  #define PKW(P,B) cvtpk_s(P[B],P[B+1])
  #define PAF(k) __builtin_bit_cast(bf16x8,pw##k)
  #define VFR(i) (bf16x8){vlo[i][0],vlo[i][1],vlo[i][2],vlo[i][3],vhi[i][0],vhi[i][1],vhi[i][2],vhi[i][3]}
  #define PIN(x) asm volatile("":"+v"(x))
  #define MX3(a,b,c) __builtin_fmaxf(__builtin_fmaxf((a),(b)),(c))
  #define GAPA(MF,A0,A1,A2,A3,W0,W1,PW) do{ MF; sacc+=A0; sacc+=A1; sacc+=A2; sacc+=A3; PIN(sacc); W0; W1; PIN(PW); SBAR(); }while(0)
  #define EX(v) __builtin_amdgcn_exp2f(v)
  #define GAPB(MF,X,B) do{ MF; X[B]=EX(X[B]); X[B+1]=EX(X[B+1]); X[B+2]=EX(X[B+2]); X[B+3]=EX(X[B+3]); PIN(X); SBAR(); }while(0)
  #define VRD(i) do{ vlo[i]=vtr(vp_+(((i)>>2)*4096+((i)&3)*1024)); vhi[i]=vtr(vp_+(((i)>>2)*4096+((i)&3)*1024+512)); }while(0)
  #define KRD(G,j) do{ if(G){ kload2(kf,kp0+sl_next,j); SBAR(); } }while(0)
  #define STEP(C0,C1,P0,P1,t,GK,GV,GL) do{ SBAR(); \
    const lds_cptr vp_=vp0+VSL((t)-1); \
    VRD(0); SBAR(); float sacc=(P0[0]+P0[1]); \
    GAPA(C0=__builtin_amdgcn_mfma_f32_32x32x16_bf16(kf[0],qr[0],negm,0,0,0), P0[2],P0[3],P0[4],P0[5],     pw0[0]=PKW(P0,0), pw0[1]=PKW(P0,2), pw0); \
    VRD(4); SBAR(); GAPA(C1=__builtin_amdgcn_mfma_f32_32x32x16_bf16(kf[1],qr[0],negm,0,0,0), P0[6],P0[7],P0[8],P0[9],     pw0[2]=PKW(P0,4), pw0[3]=PKW(P0,6), pw0); \
    VRD(1); SBAR(); GAPA(C0=__builtin_amdgcn_mfma_f32_32x32x16_bf16(kf[2],qr[1],C0,0,0,0),   P0[10],P0[11],P0[12],P0[13], pw1[0]=PKW(P0,8), pw1[1]=PKW(P0,10), pw1); \
    VRD(5); SBAR(); GAPA(C1=__builtin_amdgcn_mfma_f32_32x32x16_bf16(kf[3],qr[1],C1,0,0,0),   P0[14],P0[15],P1[0],P1[1],   pw1[2]=PKW(P0,12),pw1[3]=PKW(P0,14), pw1); \
    VRD(2); SBAR(); GAPA(C0=__builtin_amdgcn_mfma_f32_32x32x16_bf16(kf[4],qr[2],C0,0,0,0),   P1[2],P1[3],P1[4],P1[5],     pw2[0]=PKW(P1,0), pw2[1]=PKW(P1,2), pw2); \
    VRD(6); SBAR(); GAPA(C1=__builtin_amdgcn_mfma_f32_32x32x16_bf16(kf[5],qr[2],C1,0,0,0),   P1[6],P1[7],P1[8],P1[9],     pw2[2]=PKW(P1,4), pw2[3]=PKW(P1,6), pw2); \
    VRD(3); SBAR(); GAPA(C0=__builtin_amdgcn_mfma_f32_32x32x16_bf16(kf[6],qr[3],C0,0,0,0),   P1[10],P1[11],P1[12],P1[13], pw3[0]=PKW(P1,8), pw3[1]=PKW(P1,10), pw3); \
    VRD(7); SBAR(); GAPA(C1=__builtin_amdgcn_mfma_f32_32x32x16_bf16(kf[7],qr[3],C1,0,0,0),   P1[14],P1[15],0.f,0.f,       pw3[2]=PKW(P1,12),pw3[3]=PKW(P1,14), pw3); \
    l_reg+=sacc; \
    { const lds_wptr pp_=pwr0+((((t)-1)&1)*(NWA*4096)); *(lds_u32x4*)(pp_)=pw0; *(lds_u32x4*)(pp_+1024)=pw1; *(lds_u32x4*)(pp_+2048)=pw2; *(lds_u32x4*)(pp_+3072)=pw3; } \
    if(GK){DMA_K((t)+3,sl_cur);} if(GV){DMA_V((t)+1);} \
    CMASK(C0,C1,t); \
    { float a=MX3(C0[0],C0[1],C1[0]),b=MX3(C0[2],C0[3],C1[1]); a=MX3(a,C1[2],C1[3]); \
      _Pragma("unroll") for(int r=4;r<16;r+=4){a=MX3(a,C0[r],C0[r+1]);b=MX3(b,C0[r+2],C0[r+3]);a=MX3(a,C1[r],C1[r+1]);b=MX3(b,C1[r+2],C1[r+3]);} \
      float rm=__builtin_fmaxf(a,b); { auto rr=__builtin_amdgcn_permlane32_swap(__float_as_uint(rm),__float_as_uint(rm),false,false); rm=__builtin_fmaxf(__uint_as_float(rr[0]),__uint_as_float(rr[1])); } \
      resc=false; \
      if(__builtin_expect(__any(rm>(float)THRL),0)){ const float dl=__builtin_fmaxf(rm,0.f); mhat+=dl; \
        _Pragma("unroll") for(int r=0;r<16;++r){C0[r]-=dl;C1[r]-=dl;} \
        _Pragma("unroll") for(int r=0;r<16;++r)negm[r]=-mhat; asm volatile("":"+v"(negm)); \
        const float f=__builtin_amdgcn_exp2f(-dl); l_reg*=f; if(hi==0){wsf[r32]=f; wsf[64+((t)&1)*32+r32]=f;} resc=true; } \
      if(lane==0)wsf[128+((t)&1)]=resc?1.0f:0.0f; } \
    SBAR(); \
    GAPB(o[0]=__builtin_amdgcn_mfma_f32_32x32x16_bf16(PAF(0),VFR(0),o[0],0,0,0), C0,0); \
    GAPB(o[1]=__builtin_amdgcn_mfma_f32_32x32x16_bf16(PAF(0),VFR(4),o[1],0,0,0), C0,4); \
    KRD(GL,0); GAPB(o[0]=__builtin_amdgcn_mfma_f32_32x32x16_bf16(PAF(1),VFR(1),o[0],0,0,0), C0,8); \
    KRD(GL,1); GAPB(o[1]=__builtin_amdgcn_mfma_f32_32x32x16_bf16(PAF(1),VFR(5),o[1],0,0,0), C0,12); \
    KRD(GL,2); GAPB(o[0]=__builtin_amdgcn_mfma_f32_32x32x16_bf16(PAF(2),VFR(2),o[0],0,0,0), C1,0); \
    KRD(GL,3); GAPB(o[1]=__builtin_amdgcn_mfma_f32_32x32x16_bf16(PAF(2),VFR(6),o[1],0,0,0), C1,4); \
    GAPB(o[0]=__builtin_amdgcn_mfma_f32_32x32x16_bf16(PAF(3),VFR(3),o[0],0,0,0), C1,8); \
    GAPB(o[1]=__builtin_amdgcn_mfma_f32_32x32x16_bf16(PAF(3),VFR(7),o[1],0,0,0), C1,12); \
    }while(0)
  int t=1;
  #undef CMASK
  #define CMASK(P0,P1,t) do{}while(0)
  for(;t+5<NT;t+=2){
    STEP(pB0,pB1,pA0,pA1,t,true,true,true);     WAIT_BAR(3); RESC(); ROT();
    STEP(pA0,pA1,pB0,pB1,t+1,true,true,true);   WAIT_BAR(3); RESC(); ROT();
  }
  #undef CMASK
  #define CMASK(P0,P1,t) do{int jb_=(t)-(NT-2); if(jb_>=0)cmask(P0,P1,jb_,qrel,hi);}while(0)
  for(;t+1<NT;t+=2){
    STEP(pB0,pB1,pA0,pA1,t,(t+3<NT),(t+1<NT),(t+1<NT));       ENDW(t);   RESC(); ROT();
    STEP(pA0,pA1,pB0,pB1,t+1,(t+4<NT),(t+2<NT),(t+2<NT));     ENDW(t+1); RESC(); ROT();
  }
  STEP(pB0,pB1,pA0,pA1,NT-1,false,false,false); RESC();
  { float sacc=pB0[0]+pB0[1]; _Pragma("unroll") for(int r=2;r<16;++r)sacc+=pB0[r]; _Pragma("unroll") for(int r=0;r<16;++r)sacc+=pB1[r]; l_reg+=sacc;
    pw0=(u32x4){PKW(pB0,0),PKW(pB0,2),PKW(pB0,4),PKW(pB0,6)};pw1=(u32x4){PKW(pB0,8),PKW(pB0,10),PKW(pB0,12),PKW(pB0,14)};pw2=(u32x4){PKW(pB1,0),PKW(pB1,2),PKW(pB1,4),PKW(pB1,6)};pw3=(u32x4){PKW(pB1,8),PKW(pB1,10),PKW(pB1,12),PKW(pB1,14)};
    { const lds_wptr pp_=pwr0+(((NT-1)&1)*(NWA*4096)); *(lds_u32x4*)(pp_)=pw0; *(lds_u32x4*)(pp_+1024)=pw1; *(lds_u32x4*)(pp_+2048)=pw2; *(lds_u32x4*)(pp_+3072)=pw3; }
    SBAR(); pv(o,vb0+VSL(NT-1),PAF(0),PAF(1),PAF(2),PAF(3)); }
  #undef PKW
  #undef PAF
  #undef VFR
  #undef PIN
  #undef MX3
  #undef GAPA
  #undef GAPB
  #undef EX
  #undef VRD
  #undef KRD
  #undef STEP
  {auto rr=__builtin_amdgcn_permlane32_swap(__float_as_uint(l_reg),__float_as_uint(l_reg),false,false);l_reg=__uint_as_float(rr[0])+__uint_as_float(rr[1]);}
  if(hi==0)wsf[32+r32]=l_reg;asm volatile("s_waitcnt lgkmcnt(0)":::"memory");
  WAIT_BAR(0);
  float rli[16];
  #pragma unroll
  for(int r=0;r<16;++r)rli[r]=__builtin_amdgcn_rcpf(wsf[32+crow(r,hi)]);
  bf16*Ow=O+(long)(q0+wa*QBLK)*DMO;
  { bf16*stg=(bf16*)(shm+LDS_OST)+wa*2048;
    #pragma unroll
    for(int r=0;r<16;++r){const int orow=crow(r,hi);
      #pragma unroll
      for(int d0=0;d0<2;++d0)stg[orow*64+d0*32+r32]=__float2bfloat16(o[d0][r]*rli[r]);}
    asm volatile("s_waitcnt lgkmcnt(0)":::"memory");
    #pragma unroll
    for(int i=0;i<4;++i){const int row=i*8+(lane>>3),ch=lane&7; const u32x4 v=*(const u32x4*)(stg+row*64+ch*8); ATTN_STORE16(Ow+(long)row*DMO+ch*8,v);} }
  } else {
    f32x16 o[2];o[0]=f32x16{};o[1]=f32x16{};
    const lds_cptr prd0=shm3+LDS_P+wa*4096+lane*16;
    #define PVB(tt) do{ const lds_cptr pp_=prd0+(((tt)&1)*(NWA*4096)); \
      const bf16x8 a0_=*(const __attribute__((address_space(3))) bf16x8*)(pp_),a1_=*(const __attribute__((address_space(3))) bf16x8*)(pp_+1024),a2_=*(const __attribute__((address_space(3))) bf16x8*)(pp_+2048),a3_=*(const __attribute__((address_space(3))) bf16x8*)(pp_+3072); \
      pv(o,vb0+8192+VSL(tt),a0_,a1_,a2_,a3_); }while(0)
    #define RESCB(ts) do{ if(wsf[128+((ts)&1)]!=0.0f){ _Pragma("unroll") for(int d_=0;d_<2;++d_) _Pragma("unroll") for(int r=0;r<16;++r)o[d_][r]*=wsf[64+((ts)&1)*32+crow(r,hi)]; } }while(0)
    #define STEPB(t,GK,GV) do{ if(GK){DMA_K((t)+3,sl_cur);} if(GV){DMA_V((t)+1);} if((t)>=2){ PVB((t)-2); RESCB((t)-1); } }while(0)
    DMA_K(2,2*SLOTB);
    WAIT_BAR(3);
    WAIT_BAR(0);
    DMA_K(3,0);DMA_V(1);
    ROT();
    if(NT==2){WAIT_BAR(0);}else{WAIT_BAR(3);}
    int t=1;
    for(;t+5<NT;t+=2){
      STEPB(t,true,true);     WAIT_BAR(3); ROT();
      STEPB(t+1,true,true);   WAIT_BAR(3); ROT();
    }
    for(;t+1<NT;t+=2){
      STEPB(t,(t+3<NT),(t+1<NT));       ENDW(t);   ROT();
      STEPB(t+1,(t+4<NT),(t+2<NT));     ENDW(t+1); ROT();
    }
    STEPB(NT-1,false,false);
    WAIT_BAR(0);
    PVB(NT-2); RESCB(NT-1); PVB(NT-1);
    float rli[16];
    #pragma unroll
    for(int r=0;r<16;++r)rli[r]=__builtin_amdgcn_rcpf(wsf[32+crow(r,hi)]);
    bf16*Ow=O+(long)(q0+wa*QBLK)*DMO+64;
    { bf16*stg=(bf16*)(shm+LDS_P)+wa*2048;
      #pragma unroll
      for(int r=0;r<16;++r){const int orow=crow(r,hi);
        #pragma unroll
        for(int d0=0;d0<2;++d0)stg[orow*64+d0*32+r32]=__float2bfloat16(o[d0][r]*rli[r]);}
      asm volatile("s_waitcnt lgkmcnt(0)":::"memory");
      #pragma unroll
      for(int i=0;i<4;++i){const int row=i*8+(lane>>3),ch=lane&7; const u32x4 v=*(const u32x4*)(stg+row*64+ch*8); ATTN_STORE16(Ow+(long)row*DMO+ch*8,v);} }
    #undef PVB
    #undef RESCB
    #undef STEPB
  }
  asm volatile("s_waitcnt lgkmcnt(0)\n\ts_barrier":::"memory");
  #undef DMA_K
  #undef DMA_V
  #undef CMASK
  #undef START
  #undef RESC
  #undef ROT
  #undef VSL
  #undef ENDW
}
constexpr int ATTN_LDS_BYTES=LDS_BYTES;
struct AttnTensors { const bf16* Q; const bf16* K; const bf16* V; bf16* O; };
struct AttnUnit { int hc; int qb; };
struct StaticOrder {
  int vcu, G, bx;
  __device__ __forceinline__ StaticOrder(int grid,int block):vcu((grid%8==0)?(block%8)*(grid/8)+block/8:block),G(grid),bx(block){}
  __device__ __forceinline__ bool next(int i,AttnUnit&u)const{
    if(G==256){ if(i>=4)return false; const int s=vcu&31; u.hc=vcu>>5; u.qb=(i==0)?127-s:(i==1)?64+s:(i==2)?63-s:s; return true; }
    const int idx=i*G+bx; if(idx>=8*NQB)return false; u.hc=idx&7; u.qb=NQB-1-(idx>>3); return true; }
};
template<class Sched,int THRL=8> __device__ __forceinline__ void attn_phase(char*lds,const AttnTensors&T,const Sched&S){
  AttnUnit u;
  for(int i=0;S.next(i,u);++i){ const int h=u.hc>>1,c=u.hc&1;
    attn_unit<THRL>(u.qb,T.Q+h*128+c*64,T.K+h*128+c*64,T.V+h*128,T.O+u.hc*128,lds); }
}
#undef SBAR
#undef WAIT_BAR
}
constexpr int NWAVES = 8;
constexpr int M = 16384, D = 1024, FF = 2816, NGU = 2 * FF, NIN = 2048, DEPTH = 4;
constexpr size_t MiB = 1u << 20;
constexpr size_t WS_ROWSS = 1 * MiB;
constexpr size_t WS_ROPE = 2 * MiB;
constexpr size_t WS_XB = 8 * MiB;
constexpr size_t WS_H = 40 * MiB;
constexpr size_t WS_QKVU = 40 * MiB;
constexpr size_t WS_OBUF = 104 * MiB;
constexpr size_t WS_CAT = 136 * MiB;
constexpr size_t WS_W = 168 * MiB;
constexpr size_t OFF_GU1 = 0, OFF_DN1 = 11 * MiB, OFF_IN = 16 * MiB + 512 * 1024, OFF_OUT = 20 * MiB + 512 * 1024, OFF_GU2 = 22 * MiB + 512 * 1024, OFF_DN2 = 33 * MiB + 512 * 1024, W_LAYER = 39 * MiB;
constexpr size_t WS_END = WS_W + DEPTH * W_LAYER;
static_assert(attn_body::ATTN_LDS_BYTES <= 147392 && (size_t)NGU * D * 2 == 11 * MiB && (size_t)D * FF * 2 == 5 * MiB + 512 * 1024 && WS_H + (size_t)M * FF * 2 <= WS_CAT && WS_ROWSS + 16 * (size_t)M * 4 <= WS_ROPE && WS_ROPE + (size_t)M * 64 * 4 <= WS_XB, "ws map");
constexpr int LDS_BYTES = 147456;

#define LAS __attribute__((address_space(3)))
typedef unsigned short bf16;
typedef unsigned v4u __attribute__((ext_vector_type(4)));
typedef unsigned v2u __attribute__((ext_vector_type(2)));
typedef float f32x4 __attribute__((ext_vector_type(4)));
#define LDS_WAIT() asm volatile("s_waitcnt lgkmcnt(0)" ::: "memory")
__device__ __forceinline__ unsigned f2bf(float f) { unsigned u = __builtin_bit_cast(unsigned, f); return (u + 0x7fffu + ((u >> 16) & 1u)) >> 16; }
__device__ __forceinline__ unsigned pk2(float lo, float hi) { return f2bf(lo) | (f2bf(hi) << 16); }
__device__ __forceinline__ float bflo(unsigned w) { return __builtin_bit_cast(float, w << 16); }
__device__ __forceinline__ float bfhi(unsigned w) { return __builtin_bit_cast(float, w & 0xffff0000u); }
__device__ __forceinline__ float wave_sum(float v) {
#pragma unroll
    for (int o = 1; o < 64; o <<= 1) v += __shfl_xor(v, o);
    return v;
}
__device__ __forceinline__ void tr_item(const float* W, int N, int k0, int n0, const float* gk, bf16* WT, int Kd, int rbase, int rstride, LAS float* scr, int lane) {
#pragma unroll 8
    for (int i = 0; i < 32; ++i) { const int kk = 2 * i + (lane >> 5); float w = W[(size_t)(k0 + kk) * N + n0 + (lane & 31)]; if (gk) w *= gk[k0 + kk]; scr[kk * 33 + (lane & 31)] = w; }
    LDS_WAIT(); asm volatile("" ::: "memory");
    const int c = lane & 7;
#pragma unroll
    for (int j = 0; j < 4; ++j) { const int n = (lane >> 3) + 8 * j; const LAS float* s = scr + (8 * c) * 33 + n;
        v4u o; o.x = pk2(s[0 * 33], s[1 * 33]); o.y = pk2(s[2 * 33], s[3 * 33]); o.z = pk2(s[4 * 33], s[5 * 33]); o.w = pk2(s[6 * 33], s[7 * 33]);
        *(v4u*)(WT + (size_t)(rbase + n * rstride) * Kd + k0 + 8 * c) = o; }
    LDS_WAIT(); asm volatile("" ::: "memory");
}

#define XB_TMO      128
#define XB_XCNT(j)  (256  + 64 * (j))
#define XB_XSUB(j)  (1280 + 64 * (j))
#define XB_XGEN(j)  (2304 + 64 * (j))
#define XB_TOP      3328
#define XB_TOPGEN   3392
#define XCD_BAR_WORDS 3456
#define XB_SPIN_CAP (1u << 18)

__device__ __forceinline__ unsigned xb_ld(unsigned* p)              { return __hip_atomic_load(p, __ATOMIC_RELAXED, __HIP_MEMORY_SCOPE_AGENT); }
__device__ __forceinline__ unsigned xb_add(unsigned* p, unsigned v) { return __hip_atomic_fetch_add(p, v, __ATOMIC_RELAXED, __HIP_MEMORY_SCOPE_AGENT); }
__device__ __forceinline__ unsigned xb_xcc_id() { return (unsigned)__builtin_amdgcn_s_getreg((3 << 11) | 20) & 0xFu; }
#define XB_SPIN(cond, bar) do { unsigned _sp = 0; while (cond) { __builtin_amdgcn_s_sleep(1); \
    if ((++_sp & 255u) == 0u) { if (xb_ld(&(bar)[XB_TMO])) break; if (_sp > XB_SPIN_CAP) { atomicAdd(&(bar)[XB_TMO], 1u); break; } } } } while (0)

struct XcdBarrier {
    unsigned* bar; unsigned x;
    volatile LAS unsigned* st;
};

__device__ __forceinline__ XcdBarrier xcd_barrier_post(unsigned* bar, volatile LAS unsigned* st) {
    XcdBarrier b; b.bar = bar; b.x = xb_xcc_id(); b.st = st;
    if (threadIdx.x == 0) (void)xb_add(&bar[XB_XCNT(b.x)], 1u);
    return b;
}
__device__ __forceinline__ void xcd_barrier_complete(unsigned* bar, unsigned x, unsigned& nloc, unsigned& nx) {
    const unsigned G = gridDim.x * gridDim.y * gridDim.z;
    unsigned sum, cnt, mine, sp = 0u;
    for (;;) {
        sum = 0u; cnt = 0u; mine = 0u;
#pragma unroll
        for (unsigned j = 0; j < 16; ++j) { const unsigned c = xb_ld(&bar[XB_XCNT(j)]); sum += c; cnt += (c > 0u) ? 1u : 0u; mine = (j == x) ? c : mine; }
        if (sum == G) break;
        __builtin_amdgcn_s_sleep(1);
        if ((++sp & 255u) == 0u) { if (xb_ld(&bar[XB_TMO])) break; if (sp > XB_SPIN_CAP) { atomicAdd(&bar[XB_TMO], 1u); break; } }
    }
    nloc = mine > 0u ? mine : 1u; nx = cnt > 0u ? cnt : 1u;
}

__device__ __forceinline__ void xcd_barrier(const XcdBarrier& b) {
    asm volatile("s_waitcnt vmcnt(0)" ::: "memory");
    __syncthreads();
    if (threadIdx.x == 0) {
        unsigned* bar = b.bar;
        __builtin_amdgcn_s_waitcnt(0);
        unsigned nloc = b.st[0], nx = b.st[1];
        if (nloc == 0u) { xcd_barrier_complete(bar, b.x, nloc, nx); b.st[0] = nloc; b.st[1] = nx; }
        const unsigned old = xb_add(&bar[XB_XSUB(b.x)], 1u);
        const unsigned gen = old / nloc;
        if (old + 1u == (gen + 1u) * nloc) {
            __builtin_amdgcn_fence(__ATOMIC_RELEASE, "agent");
            asm volatile("s_waitcnt vmcnt(0)" ::: "memory");
            const unsigned og = xb_add(&bar[XB_TOP], 1u);
            const unsigned tg = og / nx;
            if (og + 1u == (tg + 1u) * nx) xb_add(&bar[XB_TOPGEN], 1u);
            else XB_SPIN(xb_ld(&bar[XB_TOPGEN]) == tg, bar);
            __builtin_amdgcn_fence(__ATOMIC_ACQUIRE, "agent");
            xb_add(&bar[XB_XGEN(b.x)], 1u);
            asm volatile("s_waitcnt vmcnt(0)" ::: "memory");
        } else {
            XB_SPIN(xb_ld(&bar[XB_XGEN(b.x)]) == gen, bar);
            __builtin_amdgcn_fence(__ATOMIC_ACQUIRE, "agent");
            asm volatile("s_waitcnt vmcnt(0)" ::: "memory");
        }
    }
    __syncthreads();
}

struct Args { const float* in[20]; float* out; unsigned char* wsp; };
typedef __attribute__((address_space(1))) unsigned char* gptr_t;
__device__ __forceinline__ gptr_t fresh_ptr(unsigned char* p) { asm volatile("" : "+s"(p)); return (gptr_t)p; }

__global__ void __launch_bounds__(NWAVES * 64, 2) hymba_fwd(Args args) {
    extern __shared__ __attribute__((aligned(16))) unsigned char lds[];
    LAS unsigned char* L = (LAS unsigned char*)lds;
    const int tid = threadIdx.x, lane = tid & 63, wave = __builtin_amdgcn_readfirstlane(tid >> 6);
    const int G = gridDim.x, bx = blockIdx.x;
    const int gw = bx * NWAVES + wave, NGW = G * NWAVES;
    const int gtid = bx * (NWAVES * 64) + tid, NT = G * NWAVES * 64;
#define ws (fresh_ptr(args.wsp))
#define rowss ((float*)(unsigned char*)(ws + WS_ROWSS))
#define rope ((float*)(unsigned char*)(ws + WS_ROPE))
#define XB ((bf16*)(unsigned char*)(ws + WS_XB))
#define HB ((bf16*)(unsigned char*)(ws + WS_H))
#define QKVU ((bf16*)(unsigned char*)(ws + WS_QKVU))
#define OBUF ((bf16*)(unsigned char*)(ws + WS_OBUF))
#define CAT ((bf16*)(unsigned char*)(ws + WS_CAT))
#define xout ((float*)(unsigned char*)fresh_ptr((unsigned char*)args.out))
    { volatile LAS unsigned* st0 = (volatile LAS unsigned*)(L + 147392); if (tid < 2) st0[tid] = 0u; }
    __syncthreads();
    const XcdBarrier gbar = xcd_barrier_post((unsigned*)args.wsp, (volatile LAS unsigned*)(L + 147392));

    {
        LAS float* scr = (LAS float*)(L + wave * 16384);
        constexpr int IT_G = 16 * 88, IT_D = 44 * 32, IT_IN = 16 * 64, IT_OUT = 8 * 32, IT_LAYER = 4 * IT_G + 2 * IT_D + IT_IN + IT_OUT;
        static_assert(IT_G == IT_D, "item decode");
        for (int it = gw; it < DEPTH * IT_LAYER; it += NGW) {
            const int l = it / IT_LAYER; int r = it % IT_LAYER; unsigned char* wl = (unsigned char*)(ws + WS_W + (size_t)l * W_LAYER);
            if (r < 6 * IT_G) {
                const int f = r / (3 * IT_G), q = r % (3 * IT_G), kind = q / IT_G, i = q % IT_G;
                if (kind < 2) { const float* W = args.in[(f ? 16 : 2) + kind] + (size_t)l * D * FF; const int kb = i / 88, nb = i % 88, n0 = 32 * nb;
                    tr_item(W, FF, 64 * kb, n0, args.in[f ? 15 : 1] + l * D, (bf16*)(wl + (f ? OFF_GU2 : OFF_GU1)), D, (n0 >> 7) * 256 + kind * 128 + (n0 & 127), 1, scr, lane); }
                else { const float* W = args.in[f ? 18 : 4] + (size_t)l * FF * D; const int kb = i / 32, nb = i % 32;
                    tr_item(W, D, 64 * kb, 32 * nb, nullptr, (bf16*)(wl + (f ? OFF_DN2 : OFF_DN1)), FF, 32 * nb, 1, scr, lane); }
            } else { r -= 6 * IT_G;
                if (r < IT_IN) { const float* W = args.in[6] + (size_t)l * D * NIN; const int kb = r / 64, nb = r % 64, n0 = 32 * nb; int rbase = n0, rstride = 1;
                    if (n0 < 1024) { const int d0 = n0 & 63; rbase = (n0 - d0) + (d0 ? 1 : 0); rstride = 2; }
                    tr_item(W, NIN, 64 * kb, n0, args.in[5] + l * D, (bf16*)(wl + OFF_IN), D, rbase, rstride, scr, lane); }
                else { r -= IT_IN; const float* W = args.in[14] + (size_t)l * D * D; const int kb = r / 32, nb = r % 32;
                    tr_item(W, D, 64 * kb, 32 * nb, nullptr, (bf16*)(wl + OFF_OUT), D, 32 * nb, 1, scr, lane); }
            }
        }
        for (int it = gw; it < DEPTH * 1024; it += NGW) {
            const int l = it >> 10, r = it & 1023, g = r >> 8, cb = (r >> 4) & 15, nb = r & 15, c0 = cb * 8, n = nb * 64 + lane;
            const float* pw = args.in[12] + ((size_t)(l * 4 + g) * 128 + c0) * 128; const float* ps = args.in[13] + l * 512 + g * 128;
            const float* wo = args.in[14] + (size_t)l * D * D + (size_t)(512 + g * 128) * D + n;
            float a[8];
#pragma unroll
            for (int j = 0; j < 8; ++j) a[j] = 0.f;
            for (int e = 0; e < 128; ++e) { const float w = wo[(size_t)e * D] * ps[e];
#pragma unroll
                for (int j = 0; j < 8; ++j) a[j] += pw[j * 128 + e] * w; }
            v4u o; o.x = pk2(a[0], a[1]); o.y = pk2(a[2], a[3]); o.z = pk2(a[4], a[5]); o.w = pk2(a[6], a[7]);
            *(v4u*)((bf16*)(unsigned char*)(ws + WS_W + (size_t)l * W_LAYER + OFF_OUT) + (size_t)n * D + 512 + g * 128 + c0) = o;
        }
        for (int i = gtid; i < M * 32; i += NT) { const int s = i >> 5, j = i & 31; const float inv = (float)pow(10000.0, -(double)j / 32.0); const float ang = (float)s * inv;
            const double a = (double)ang; rope[2 * i] = (float)cos(a); rope[2 * i + 1] = (float)sin(a); }
        for (int m = gw; m < M; m += NGW) { const f32x4* xr = (const f32x4*)(args.in[0] + (size_t)m * D) + lane; f32x4 v[4]; float s = 0.f;
#pragma unroll
            for (int j = 0; j < 4; ++j) { v[j] = xr[64 * j]; s += (v[j].x * v[j].x + v[j].y * v[j].y) + (v[j].z * v[j].z + v[j].w * v[j].w); }
            s = wave_sum(s); if (lane < 16) rowss[(size_t)m * 16 + lane] = (lane == 0) ? s : 0.f;
            v2u* o8 = (v2u*)(XB + (size_t)m * D) + lane;
#pragma unroll
            for (int j = 0; j < 4; ++j) { v2u w; w.x = pk2(v[j].x, v[j].y); w.y = pk2(v[j].z, v[j].w); o8[64 * j] = w; } }
    }
    cg::this_grid().sync();


    for (int step = 0; step < 3 * DEPTH; ++step) {
        const int l = step / 3, kind = step % 3;
#define wl ((unsigned char*)(ws + WS_W + (size_t)l * W_LAYER))
        if (kind != 1) {
            const int f = kind >> 1;
            { pg8::Gemm g{XB, (const bf16*)(wl + (f ? OFF_GU2 : OFF_GU1)), M, NGU, D}; pg8::StaticOrder S; S.init(M, NGU, G, bx);
              pg8::EpiGateUp E{HB, rowss};
              pg8::gemm_phase<pg8::EpiGateUp, pg8::StaticOrder, PG8_ALIGN, PG8_SP2>(L, g, S, E); }
            xcd_barrier(gbar);
            { pg8::Gemm g{HB, (const bf16*)(wl + (f ? OFF_DN2 : OFF_DN1)), M, D, FF}; pg8::StaticOrder S; S.init(M, D, G, bx);
              pg8::EpiResid E{(const float*)(unsigned char*)fresh_ptr((unsigned char*)((step == 0) ? args.in[0] : args.out)), xout, XB, rowss, 0.5f};
              pg8::gemm_phase<pg8::EpiResid, pg8::StaticOrder, PG8_ALIGN, PG8_SP2>(L, g, S, E); }
            xcd_barrier(gbar);
        } else {
            { pg8::Gemm g{XB, (const bf16*)(wl + OFF_IN), M, NIN, D}; pg8::StaticOrder S; S.init(M, NIN, G, bx);
              pg8::EpiQKVU E{QKVU, rowss, rope};
              pg8::gemm_phase<pg8::EpiQKVU, pg8::StaticOrder, PG8_ALIGN, PG8_SP2>(L, g, S, E); }
            xcd_barrier(gbar);
            { const attn_body::AttnTensors AT{(const attn_body::bf16*)QKVU, (const attn_body::bf16*)(QKVU + 512), (const attn_body::bf16*)(QKVU + 1024), (attn_body::bf16*)OBUF};
              const attn_body::StaticOrder S(G, bx);
              attn_body::attn_phase<attn_body::StaticOrder>((char*)lds, AT, S); }
            xcd_barrier(gbar);
            {
                const float li = 0.8f - 0.6f * expf(-0.3f * (float)l);
                const float s1 = wave_sum(args.in[7][l * 64 + lane] * args.in[8][l * 64 + lane]), s2 = wave_sum(args.in[9][l * 64 + lane] * args.in[10][l * 64 + lane]);
                const float lam = expf(s1) - expf(s2) + li;
                const int hd = lane >> 4, j0 = (lane & 15) * 8;
                float gn[8];
#pragma unroll
                for (int j = 0; j < 8; ++j) gn[j] = args.in[11][l * 128 + j0 + j] * (1.0f - li);
                const int win = 2 << hd;
                for (int m = gw; m < M; m += NGW) {
                    const v4u a = *(const v4u*)(OBUF + (size_t)m * 1024 + hd * 256 + j0), b = *(const v4u*)(OBUF + (size_t)m * 1024 + hd * 256 + 128 + j0);
                    float o[8];
                    o[0] = bflo(a.x) - lam * bflo(b.x); o[1] = bfhi(a.x) - lam * bfhi(b.x); o[2] = bflo(a.y) - lam * bflo(b.y); o[3] = bfhi(a.y) - lam * bfhi(b.y);
                    o[4] = bflo(a.z) - lam * bflo(b.z); o[5] = bfhi(a.z) - lam * bfhi(b.z); o[6] = bflo(a.w) - lam * bflo(b.w); o[7] = bfhi(a.w) - lam * bfhi(b.w);
                    float ss = 0.f;
#pragma unroll
                    for (int j = 0; j < 8; ++j) ss += o[j] * o[j];
                    ss += __shfl_xor(ss, 1); ss += __shfl_xor(ss, 2); ss += __shfl_xor(ss, 4); ss += __shfl_xor(ss, 8);
                    const float rr = __builtin_amdgcn_rsqf(ss * (1.0f / 128.0f) + 1e-6f);
                    v4u w; w.x = pk2(o[0] * rr * gn[0], o[1] * rr * gn[1]); w.y = pk2(o[2] * rr * gn[2], o[3] * rr * gn[3]); w.z = pk2(o[4] * rr * gn[4], o[5] * rr * gn[5]); w.w = pk2(o[6] * rr * gn[6], o[7] * rr * gn[7]);
                    *(v4u*)(CAT + (size_t)m * 1024 + hd * 128 + j0) = w;
                    const bf16* up = QKVU + (size_t)m * 2048 + 1536 + hd * 128 + j0;
                    const v4u u0 = *(const v4u*)up;
                    float sm[8] = {bflo(u0.x), bfhi(u0.x), bflo(u0.y), bfhi(u0.y), bflo(u0.z), bfhi(u0.z), bflo(u0.w), bfhi(u0.w)};
                    float us[8];
#pragma unroll
                    for (int j = 0; j < 8; ++j) us[j] = sm[j];
                    for (int t = 1; t < win; ++t) { if (m - t >= 0) { const v4u ut = *(const v4u*)(up - (size_t)t * 2048);
                        sm[0] += bflo(ut.x); sm[1] += bfhi(ut.x); sm[2] += bflo(ut.y); sm[3] += bfhi(ut.y); sm[4] += bflo(ut.z); sm[5] += bfhi(ut.z); sm[6] += bflo(ut.w); sm[7] += bfhi(ut.w); } }
                    const float ic = 1.0f / (float)((m + 1 < win) ? (m + 1) : win);
                    v4u d; d.x = pk2(sm[0] * ic - us[0], sm[1] * ic - us[1]); d.y = pk2(sm[2] * ic - us[2], sm[3] * ic - us[3]); d.z = pk2(sm[4] * ic - us[4], sm[5] * ic - us[5]); d.w = pk2(sm[6] * ic - us[6], sm[7] * ic - us[7]);
                    *(v4u*)(CAT + (size_t)m * 1024 + 512 + hd * 128 + j0) = d;
                }
            }
            xcd_barrier(gbar);
            { pg8::Gemm g{CAT, (const bf16*)(wl + OFF_OUT), M, D, D}; pg8::StaticOrder S; S.init(M, D, G, bx);
              pg8::EpiResid E{xout, xout, XB, rowss, 1.0f};
              pg8::gemm_phase<pg8::EpiResid, pg8::StaticOrder, PG8_ALIGN, PG8_SP2>(L, g, S, E); }
            xcd_barrier(gbar);
        }
    }
    for (int m = gw; m < M; m += NGW) { f32x4* xr = (f32x4*)(xout + (size_t)m * D) + lane; const f32x4* gr = (const f32x4*)args.in[19] + lane;
        const float r = pg8::rs_from_ss(rowss + (size_t)m * 16);
#pragma unroll
        for (int j = 0; j < 4; ++j) { const f32x4 v = xr[64 * j], gg = gr[64 * j]; xr[64 * j] = v * r * gg; } }
}

#undef wl
#undef ws
#undef rowss
#undef rope
#undef XB
#undef HB
#undef QKVU
#undef OBUF
#undef CAT
#undef xout
extern "C" void kernel_launch(void* const* d_in, const int* in_sizes, int n_in, void* d_out, int out_size, void* d_ws, size_t ws_size, hipStream_t stream) {
    static int grid_blocks = 0;
    if (grid_blocks == 0) {
        if (n_in != 20 || out_size != M * D || ws_size < WS_END) { fprintf(stderr, "kernel_launch: unexpected shapes (n_in %d out %d ws %zu, need %zu)\n", n_in, out_size, ws_size, (size_t)WS_END); grid_blocks = -1; return; }
        int dev = 0, cus = 0, per_cu = 0;
        (void)hipGetDevice(&dev); (void)hipDeviceGetAttribute(&cus, hipDeviceAttributeMultiprocessorCount, dev);
        if (hipFuncSetAttribute((const void*)hymba_fwd, hipFuncAttributeMaxDynamicSharedMemorySize, LDS_BYTES) != hipSuccess) { fprintf(stderr, "kernel_launch: hipFuncSetAttribute failed\n"); grid_blocks = -1; return; }
        if (hipOccupancyMaxActiveBlocksPerMultiprocessor(&per_cu, (const void*)hymba_fwd, NWAVES * 64, LDS_BYTES) != hipSuccess || per_cu < 1) { fprintf(stderr, "kernel_launch: occupancy query says %d\n", per_cu); per_cu = 1; }
        (void)hipGetLastError();
        grid_blocks = cus * per_cu;
    }
    if (grid_blocks < 0) return;
    if (hipMemsetAsync(d_ws, 0, 65536, stream) != hipSuccess) { fprintf(stderr, "kernel_launch: memset failed\n"); return; }
    Args a{};
    for (int i = 0; i < 20; ++i) a.in[i] = (const float*)d_in[i];
    a.out = (float*)d_out; a.wsp = (unsigned char*)d_ws;
    void* kargs[] = {&a};
    hipError_t e = hipLaunchCooperativeKernel((const void*)hymba_fwd, dim3(grid_blocks), dim3(NWAVES * 64), kargs, LDS_BYTES, stream);
    if (e != hipSuccess) fprintf(stderr, "cooperative launch failed: %s (grid %d)\n", hipGetErrorString(e), grid_blocks);
}
```

```cpp
#include <hip/hip_runtime.h>
#include <hip/hip_cooperative_groups.h>
#include <cstdio>
#include <cstdint>
namespace cg = cooperative_groups;
namespace pg8 {
#define PG8_LAS __attribute__((address_space(3)))
typedef unsigned short bf16_t;
typedef short bf16x8 __attribute__((ext_vector_type(8)));
typedef float f32x4 __attribute__((ext_vector_type(4)));
typedef unsigned u32x4 __attribute__((ext_vector_type(4)));
constexpr int BM = 256, BK = 64, HALF = 128, HTB = HALF * BK * 2  , STAGE_BYTES = 8 * HTB, NXCD = 8, WGM = 8;

__host__ __device__ __forceinline__ int lds_byte(int r, int c) { const int st = (r >> 4) * 2 + (c >> 5), rr = r & 15, cc = c & 31, ob = rr * 64 + cc * 2; return st * 1024 + (ob ^ (((ob >> 9) & 1) << 5)); }
__host__ __device__ __forceinline__ void stage_rc(int b, int& R, int& C) { const int st = b / 1024, sb = b % 1024, swz = sb ^ (((sb >> 9) & 1) << 5); R = (st >> 1) * 16 + swz / 64; C = (st & 1) * 32 + (swz % 64) / 2; }
__host__ __device__ __forceinline__ int perm32(int rho) { const int n = rho >> 4, i = rho & 15; return 8 * (i >> 2) + 4 * n + (i & 3); }

struct Unit { int pm, pn; };
struct Gemm { const bf16_t* A; const bf16_t* Bt; int M, N, K; };

struct StaticOrder {
    int nM, nN, nwg, G, c;
    __host__ __device__ void init(int M, int N, int G_, int c_) { nM = M / BM; nN = N / BM; nwg = nM * nN; G = G_; c = c_; }
    __host__ __device__ bool next(int i, Unit& u) const {
        const long L = (long)i * G + c; if (L >= nwg) return false;
        int wgid = (int)L; { const int q = nwg / NXCD, r = nwg % NXCD, xcd = wgid % NXCD, off = wgid / NXCD; wgid = (xcd < r ? xcd * (q + 1) : r * (q + 1) + (xcd - r) * q) + off; }
        const int nig = WGM * nN, gid = wgid / nig, fm = gid * WGM, gsz = (nM - fm) < WGM ? (nM - fm) : WGM;
        u.pm = fm + ((wgid % nig) % gsz); u.pn = (wgid % nig) / gsz; return true;
    }
    __device__ __forceinline__ void a_ready(const Unit&) const {}
    __device__ __forceinline__ void done(const Unit&) const {}
};

__device__ __forceinline__ unsigned cvt_pk_bf16(float lo, float hi) { unsigned r; asm volatile("v_cvt_pk_bf16_f32 %0, %1, %2" : "=v"(r) : "v"(lo), "v"(hi)); return r; }
typedef float f32x2 __attribute__((ext_vector_type(2)));
__device__ __forceinline__ f32x2 gelu_pk(f32x2 v) {
    const f32x2 av = __builtin_elementwise_abs(v), d = av * 0.2316418882f + 1.0f;
    f32x2 t; t.x = __builtin_amdgcn_rcpf(d.x); t.y = __builtin_amdgcn_rcpf(d.y);
    f32x2 q = t * 0.5307027145f + (-0.7265760135f); q = q * t + 0.7107068705f; q = q * t + (-0.142248368f); q = q * t + 0.127414796f; q = q * t;
    const f32x2 s = (v * v) * (-0.72134752044f);
    f32x2 e; e.x = __builtin_amdgcn_exp2f(s.x); e.y = __builtin_amdgcn_exp2f(s.y);
    const f32x2 m = v * (q * e), r = v - m;
    f32x2 o; o.x = v.x < 0.f ? m.x : r.x; o.y = v.y < 0.f ? m.y : r.y; return o;
}

template <int ACT  > struct EpiBf16 {
    static constexpr bool PERM = true, AFTER_DRAIN = false; static_assert(ACT == 0 || ACT == 1, "EpiBf16: ACT is 0 (none) or 1 (gelu_pk)");
    bf16_t* O; int ldc; const float* bias; int split_cols; size_t split_stride; float scale0;
    __device__ __forceinline__ void operator()(const f32x4 (&acc)[2][2][4][2], const Unit& u, int wr, int wc, int fr, int fq) const {
        const int row0 = u.pm * BM + wr * 64 + fr; int colt = u.pn * BM; bf16_t* base = O;
        float sc = 1.f; if (split_cols) { const int t = colt / split_cols; base += (size_t)t * split_stride; colt -= t * split_cols; if (t == 0) sc = scale0; }
        const int col0 = colt + wc * 32 + 8 * fq, bcol0 = u.pn * BM + wc * 32 + 8 * fq;
        f32x4 bv[2][2];
#pragma unroll
        for (int bj = 0; bj < 2; ++bj)
#pragma unroll
            for (int n = 0; n < 2; ++n) bv[bj][n] = bias ? *(const f32x4*)(bias + bcol0 + bj * HALF + 4 * n) : (f32x4){0.f, 0.f, 0.f, 0.f};
#pragma unroll
        for (int ai = 0; ai < 2; ++ai)
#pragma unroll
            for (int m = 0; m < 4; ++m) { bf16_t* rowp = base + (size_t)(row0 + ai * HALF + m * 16) * ldc + col0;
#pragma unroll
                for (int bj = 0; bj < 2; ++bj) { f32x4 v0 = acc[ai][bj][m][0] + bv[bj][0], v1 = acc[ai][bj][m][1] + bv[bj][1];
                    if (ACT == 1) { f32x2 a = gelu_pk((f32x2){v0[0], v0[1]}), b = gelu_pk((f32x2){v0[2], v0[3]}), c = gelu_pk((f32x2){v1[0], v1[1]}), d = gelu_pk((f32x2){v1[2], v1[3]});
                        v0 = (f32x4){a.x, a.y, b.x, b.y}; v1 = (f32x4){c.x, c.y, d.x, d.y}; }
                    v0 = v0 * sc; v1 = v1 * sc; u32x4 w; w.x = cvt_pk_bf16(v0[0], v0[1]); w.y = cvt_pk_bf16(v0[2], v0[3]); w.z = cvt_pk_bf16(v1[0], v1[1]); w.w = cvt_pk_bf16(v1[2], v1[3]);
                    *(u32x4*)(rowp + bj * HALF) = w; } }
    }
};
__device__ __forceinline__ float rs_from_ss(const float* p) { const f32x4 a = ((const f32x4*)p)[0], b = ((const f32x4*)p)[1], c = ((const f32x4*)p)[2], d = ((const f32x4*)p)[3];
    const float ss = (((a[0] + a[1]) + (a[2] + a[3])) + ((b[0] + b[1]) + (b[2] + b[3]))) + (((c[0] + c[1]) + (c[2] + c[3])) + ((d[0] + d[1]) + (d[2] + d[3])));
    return __builtin_amdgcn_rsqf(ss * (1.0f / 1024.0f) + 1e-6f); }
struct EpiGateUp {
    static constexpr bool PERM = true, AFTER_DRAIN = false;
    bf16_t* H; const float* rowss;
    __device__ __forceinline__ void operator()(const f32x4 (&acc)[2][2][4][2], const Unit& u, int wr, int wc, int fr, int fq) const {
        const int row0 = u.pm * BM + wr * 64 + fr; const int col0 = u.pn * HALF + wc * 32 + 8 * fq;
#pragma unroll
        for (int ai = 0; ai < 2; ++ai)
#pragma unroll
            for (int m = 0; m < 4; ++m) { const int row = row0 + ai * HALF + m * 16; const float r = rs_from_ss(rowss + (size_t)row * 16);
                float hv[8];
#pragma unroll
                for (int n = 0; n < 2; ++n)
#pragma unroll
                    for (int e = 0; e < 4; ++e) { const float g = acc[ai][0][m][n][e] * r, up = acc[ai][1][m][n][e] * r;
                        const float sg = g * __builtin_amdgcn_rcpf(1.0f + __builtin_amdgcn_exp2f(g * -1.4426950408889634f)); hv[n * 4 + e] = sg * up; }
                u32x4 w; w.x = cvt_pk_bf16(hv[0], hv[1]); w.y = cvt_pk_bf16(hv[2], hv[3]); w.z = cvt_pk_bf16(hv[4], hv[5]); w.w = cvt_pk_bf16(hv[6], hv[7]);
                *(u32x4*)(H + (size_t)row * 2816 + col0) = w; }
    }
};
struct EpiResid {
    static constexpr bool PERM = true, AFTER_DRAIN = false;
    const float* xin; float* xout; bf16_t* xb; float* rowss_next; float alpha;
    __device__ __forceinline__ void operator()(const f32x4 (&acc)[2][2][4][2], const Unit& u, int wr, int wc, int fr, int fq) const {
        const int row0 = u.pm * BM + wr * 64 + fr; const int col0 = u.pn * BM + wc * 32 + 8 * fq;
#pragma unroll
        for (int ai = 0; ai < 2; ++ai)
#pragma unroll
            for (int m = 0; m < 4; ++m) { const int row = row0 + ai * HALF + m * 16; float ss = 0.f;
#pragma unroll
                for (int bj = 0; bj < 2; ++bj) { const size_t off = (size_t)row * 1024 + col0 + bj * HALF;
                    const f32x4 a0 = *(const f32x4*)(xin + off), a1 = *(const f32x4*)(xin + off + 4);
                    const f32x4 v0 = a0 + acc[ai][bj][m][0] * alpha, v1 = a1 + acc[ai][bj][m][1] * alpha;
                    *(f32x4*)(xout + off) = v0; *(f32x4*)(xout + off + 4) = v1;
                    ss += (v0[0] * v0[0] + v0[1] * v0[1]) + (v0[2] * v0[2] + v0[3] * v0[3]) + (v1[0] * v1[0] + v1[1] * v1[1]) + (v1[2] * v1[2] + v1[3] * v1[3]);
                    u32x4 w; w.x = cvt_pk_bf16(v0[0], v0[1]); w.y = cvt_pk_bf16(v0[2], v0[3]); w.z = cvt_pk_bf16(v1[0], v1[1]); w.w = cvt_pk_bf16(v1[2], v1[3]);
                    *(u32x4*)(xb + off) = w; }
                ss += __shfl_xor(ss, 16); ss += __shfl_xor(ss, 32);
                if (fq == 0) rowss_next[(size_t)row * 16 + u.pn * 4 + wc] = ss; }
    }
};
struct EpiQKVU {
    static constexpr bool PERM = true, AFTER_DRAIN = false;
    bf16_t* O; const float* rowss; const float* rope;
    __device__ __forceinline__ void operator()(const f32x4 (&acc)[2][2][4][2], const Unit& u, int wr, int wc, int fr, int fq) const {
        const int row0 = u.pm * BM + wr * 64 + fr; const int col0 = u.pn * BM + wc * 32 + 8 * fq; const int sec = u.pn >> 1;
        const int j0 = 16 * (wc & 1) + 4 * fq;
#pragma unroll
        for (int ai = 0; ai < 2; ++ai)
#pragma unroll
            for (int m = 0; m < 4; ++m) { const int row = row0 + ai * HALF + m * 16; float r = rs_from_ss(rowss + (size_t)row * 16); if (sec == 0) r *= 0.125f * 1.4426950408889634f;
                f32x4 cs0 = (f32x4){1.f, 0.f, 1.f, 0.f}, cs1 = cs0;
                if (sec < 2) { const f32x4* rp = (const f32x4*)(rope + ((size_t)row * 32 + j0) * 2); cs0 = rp[0]; cs1 = rp[1]; }
#pragma unroll
                for (int bj = 0; bj < 2; ++bj) { const f32x4 v0 = acc[ai][bj][m][0] * r, v1 = acc[ai][bj][m][1] * r;
                    const float o0 = v0[0] * cs0[0] - v0[1] * cs0[1], o1 = v0[1] * cs0[0] + v0[0] * cs0[1];
                    const float o2 = v0[2] * cs0[2] - v0[3] * cs0[3], o3 = v0[3] * cs0[2] + v0[2] * cs0[3];
                    const float o4 = v1[0] * cs1[0] - v1[1] * cs1[1], o5 = v1[1] * cs1[0] + v1[0] * cs1[1];
                    const float o6 = v1[2] * cs1[2] - v1[3] * cs1[3], o7 = v1[3] * cs1[2] + v1[2] * cs1[3];
                    u32x4 w; w.x = cvt_pk_bf16(o0, o1); w.y = cvt_pk_bf16(o2, o3); w.z = cvt_pk_bf16(o4, o5); w.w = cvt_pk_bf16(o6, o7);
                    *(u32x4*)(O + (size_t)row * 2048 + col0 + bj * HALF) = w; } }
    }
};

template <class Epi, class Sched, bool ALIGN_EPI = false, bool SP2 = false>
__device__ __forceinline__ void gemm_phase(PG8_LAS unsigned char* lds, const Gemm g, const Sched& S, const Epi& E) {
    int tid_ = threadIdx.x; asm volatile("" : "+v"(tid_));
    const int tid = tid_, wid = __builtin_amdgcn_readfirstlane(tid >> 6), lane = tid & 63, wr = wid >> 2, wc = wid & 3, fr = lane & 15, fq = lane >> 4;
    const int K = g.K, nt = K / BK;
    unsigned voffA[2], voffB[2];
#pragma unroll
    for (int i = 0; i < 2; ++i) { int R, C; stage_rc(tid * 16 + i * 8192, R, C); const int Rb = Epi::PERM ? ((R & ~31) + perm32(R & 31)) : R;
        voffA[i] = (unsigned)(R * K + C) * 2u; voffB[i] = (unsigned)(Rb * K + C) * 2u; }
    const size_t kstep = (size_t)(BK * 2);
    const size_t hstep = (size_t)HALF * K * 2;
    const size_t tstep = 2 * hstep;
    const unsigned ldsw = (unsigned)wid * 1024u;
    const int aoff = lds_byte(wr * 64 + fr, fq * 8), boff = lds_byte(wc * 32 + fr, fq * 8);
#define PG8_SA(b, h) (((b) * 2 + (h)) * HTB)
#define PG8_SB(b, h) ((4 + (b) * 2 + (h)) * HTB)
#define PG8_STAGE(bufoff, gbase, voff) do { _Pragma("unroll") for (int _i = 0; _i < 2; ++_i) \
        __builtin_amdgcn_global_load_lds((const unsigned*)((const char*)(gbase) + (voff)[_i]), (PG8_LAS unsigned*)(lds + (bufoff) + ldsw + _i * 8192), 16, 0, 0); } while (0)
#define PG8_LDA(dst, b, h) do { _Pragma("unroll") for (int m = 0; m < 4; ++m) _Pragma("unroll") for (int k = 0; k < 2; ++k) dst[m][k] = *(const PG8_LAS bf16x8*)(lds + PG8_SA(b, h) + aoff + m * 2048 + k * 1024); } while (0)
#define PG8_LDB(dst, b, h) do { _Pragma("unroll") for (int n = 0; n < 2; ++n) _Pragma("unroll") for (int k = 0; k < 2; ++k) dst[n][k] = *(const PG8_LAS bf16x8*)(lds + PG8_SB(b, h) + boff + n * 2048 + k * 1024); } while (0)
#define PG8_MMA(ai, bj, At, Bt) do { __builtin_amdgcn_s_setprio(1); _Pragma("unroll") for (int m = 0; m < 4; ++m) _Pragma("unroll") for (int n = 0; n < 2; ++n) _Pragma("unroll") for (int k = 0; k < 2; ++k) \
        acc[ai][bj][m][n] = __builtin_amdgcn_mfma_f32_16x16x32_bf16(Bt[n][k], At[m][k], acc[ai][bj][m][n], 0, 0, 0); __builtin_amdgcn_s_setprio(0); } while (0)
#define PG8_WAIT_V(n) asm volatile("s_waitcnt vmcnt(" #n ")" ::: "memory")
#define PG8_WAIT_L(n) asm volatile("s_waitcnt lgkmcnt(" #n ")" ::: "memory")
#define PG8_BAR __builtin_amdgcn_s_barrier()
#define PG8_SCHED __builtin_amdgcn_sched_barrier(0)
    Unit cur, nxt; int ui = 0;
    if (!S.next(0, cur)) return;
    f32x4 acc[2][2][4][2];
#pragma unroll
    for (int a = 0; a < 2; ++a)
#pragma unroll
        for (int b = 0; b < 2; ++b)
#pragma unroll
            for (int m = 0; m < 4; ++m)
#pragma unroll
                for (int n = 0; n < 2; ++n) acc[a][b][m][n] = (f32x4){0.f, 0.f, 0.f, 0.f};
    bf16x8 At[4][2], B0[2][2], B1[2][2];
    const char* cA = (const char*)g.A + (size_t)cur.pm * tstep; const char* cB = (const char*)g.Bt + (size_t)cur.pn * tstep;
    S.a_ready(cur);
    if constexpr (SP2) {
        PG8_STAGE(PG8_SB(0, 0), cB, voffB); PG8_STAGE(PG8_SB(0, 1), cB + hstep, voffB); PG8_STAGE(PG8_SA(0, 0), cA, voffA); PG8_STAGE(PG8_SA(0, 1), cA + hstep, voffA);
        if (wr == 1) PG8_BAR;
        PG8_WAIT_V(2); PG8_BAR;
        PG8_STAGE(PG8_SB(1, 0), cB + kstep, voffB); PG8_STAGE(PG8_SA(1, 0), cA + kstep, voffA); PG8_STAGE(PG8_SB(1, 1), cB + hstep + kstep, voffB);
        PG8_WAIT_V(6); PG8_BAR;
    } else {
        PG8_STAGE(PG8_SB(0, 0), cB, voffB); PG8_STAGE(PG8_SA(0, 0), cA, voffA); PG8_STAGE(PG8_SB(0, 1), cB + hstep, voffB); PG8_STAGE(PG8_SA(0, 1), cA + hstep, voffA);
        if (wr == 1) PG8_BAR;
        PG8_WAIT_V(4); PG8_BAR;
        PG8_STAGE(PG8_SB(1, 0), cB + kstep, voffB); PG8_STAGE(PG8_SA(1, 0), cA + kstep, voffA); PG8_STAGE(PG8_SB(1, 1), cB + hstep + kstep, voffB);
        PG8_WAIT_V(6); PG8_BAR;
    }
    for (;;) {
        const bool has_next = S.next(ui + 1, nxt);
        const char* nA = has_next ? (const char*)g.A + (size_t)nxt.pm * tstep : cA; const char* nB = has_next ? (const char*)g.Bt + (size_t)nxt.pn * tstep : cB;
        for (int t = 0; t < nt; t += 2) {
            const bool last = (t == nt - 2);
            const char* a1 = cA + (size_t)(t + 1) * kstep;
            const char* a2 = last ? nA : cA + (size_t)(t + 2) * kstep; const char* b2 = last ? nB : cB + (size_t)(t + 2) * kstep;
            const char* a3 = a2 + kstep; const char* b3 = b2 + kstep;
            if (last && has_next) S.a_ready(nxt);
            if constexpr (SP2) {
            PG8_LDB(B0, 0, 0); PG8_LDB(B1, 0, 1); PG8_SCHED; PG8_LDA(At, 0, 0); PG8_STAGE(PG8_SA(1, 1), a1 + hstep, voffA);
            PG8_WAIT_V(8); PG8_WAIT_L(0); PG8_BAR; PG8_MMA(0, 0, At, B0); PG8_MMA(0, 1, At, B1); PG8_BAR; PG8_SCHED;
            PG8_LDA(At, 0, 1); PG8_STAGE(PG8_SB(0, 0), b2, voffB); PG8_STAGE(PG8_SB(0, 1), b2 + hstep, voffB); PG8_STAGE(PG8_SA(0, 0), a2, voffA);
            PG8_WAIT_V(8); PG8_WAIT_L(0); PG8_BAR; PG8_MMA(1, 0, At, B0); PG8_MMA(1, 1, At, B1); PG8_BAR; PG8_SCHED;
            PG8_LDB(B0, 1, 0); PG8_LDB(B1, 1, 1); PG8_SCHED; PG8_LDA(At, 1, 0); PG8_STAGE(PG8_SA(0, 1), a2 + hstep, voffA);
            PG8_WAIT_V(8); PG8_WAIT_L(0); PG8_BAR; PG8_MMA(0, 0, At, B0); PG8_MMA(0, 1, At, B1); PG8_BAR; PG8_SCHED;
            PG8_LDA(At, 1, 1); PG8_STAGE(PG8_SB(1, 0), b3, voffB); PG8_STAGE(PG8_SB(1, 1), b3 + hstep, voffB); PG8_STAGE(PG8_SA(1, 0), a3, voffA);
            PG8_WAIT_V(8); PG8_WAIT_L(0); PG8_BAR; PG8_MMA(1, 0, At, B0); PG8_MMA(1, 1, At, B1); PG8_BAR; PG8_SCHED;
            } else {
            PG8_LDB(B0, 0, 0); PG8_SCHED; PG8_LDA(At, 0, 0); PG8_STAGE(PG8_SA(1, 1), a1 + hstep, voffA);
            PG8_WAIT_L(8); PG8_BAR; PG8_WAIT_L(0); PG8_MMA(0, 0, At, B0); PG8_BAR; PG8_SCHED;
            PG8_LDB(B1, 0, 1); PG8_STAGE(PG8_SB(0, 0), b2, voffB);
            PG8_BAR; PG8_WAIT_L(0); PG8_MMA(0, 1, At, B1); PG8_BAR;
            PG8_LDA(At, 0, 1); PG8_STAGE(PG8_SA(0, 0), a2, voffA);
            PG8_BAR; PG8_WAIT_L(0); PG8_MMA(1, 0, At, B0); PG8_BAR; PG8_SCHED;
            PG8_STAGE(PG8_SB(0, 1), b2 + hstep, voffB);
            PG8_WAIT_V(6); PG8_BAR; PG8_MMA(1, 1, At, B1); PG8_BAR;
            PG8_LDB(B0, 1, 0); PG8_SCHED; PG8_LDA(At, 1, 0); PG8_STAGE(PG8_SA(0, 1), a2 + hstep, voffA);
            PG8_WAIT_L(8); PG8_BAR; PG8_WAIT_L(0); PG8_MMA(0, 0, At, B0); PG8_BAR; PG8_SCHED;
            PG8_LDB(B1, 1, 1); PG8_STAGE(PG8_SB(1, 0), b3, voffB);
            PG8_BAR; PG8_WAIT_L(0); PG8_MMA(0, 1, At, B1); PG8_BAR;
            PG8_LDA(At, 1, 1); PG8_STAGE(PG8_SA(1, 0), a3, voffA);
            PG8_BAR; PG8_WAIT_L(0); PG8_MMA(1, 0, At, B0); PG8_BAR; PG8_SCHED;
            PG8_STAGE(PG8_SB(1, 1), b3 + hstep, voffB);
            PG8_WAIT_V(6); PG8_BAR; PG8_MMA(1, 1, At, B1); PG8_BAR;
            }
        }
        if constexpr (ALIGN_EPI) { if (wr == 0) PG8_BAR; }
        if constexpr (!Epi::AFTER_DRAIN) { E(acc, cur, wr, wc, fr, fq); S.done(cur); }
        if (!has_next) break;
#pragma unroll
        for (int a = 0; a < 2; ++a)
#pragma unroll
            for (int b = 0; b < 2; ++b)
#pragma unroll
                for (int m = 0; m < 4; ++m)
#pragma unroll
                    for (int n = 0; n < 2; ++n) acc[a][b][m][n] = (f32x4){0.f, 0.f, 0.f, 0.f};
        cur = nxt; cA = nA; cB = nB; ++ui;
        if constexpr (ALIGN_EPI) { if (wr == 1) PG8_BAR; }
    }
    PG8_WAIT_V(0);
    if constexpr (!ALIGN_EPI) { if (wr == 0) PG8_BAR; }
    PG8_BAR;
    if constexpr (Epi::AFTER_DRAIN) { E.fused(acc, cur, wr, wc, fr, fq, lds, wid, lane); S.done(cur); }
#undef PG8_SA
#undef PG8_SB
#undef PG8_STAGE
#undef PG8_LDA
#undef PG8_LDB
#undef PG8_MMA
#undef PG8_WAIT_V
#undef PG8_WAIT_L
#undef PG8_BAR
#undef PG8_SCHED
}
}

#ifndef PG8_SP2
#define PG8_SP2 true
#endif
#ifndef PG8_ALIGN
#define PG8_ALIGN true
#endif
#include <hip/hip_bf16.h>
#include <cmath>
namespace attn_body {
using bf16=__hip_bfloat16;
using bf16x8=__attribute__((ext_vector_type(8)))short;
using s16x4=__attribute__((ext_vector_type(4)))short;
using f32x16=__attribute__((ext_vector_type(16)))float;
using u32x4=__attribute__((ext_vector_type(4)))unsigned;
constexpr int BATCH=1,NHEAD=16,SEQ=16384,D=64,DM=2048,DMO=1024;
constexpr int NW=8,NWA=4,QBLK=32,QB=QBLK*NWA,KVBLK=64,NQB=SEQ/QB;
constexpr int ATTN_PITCH=DM, ATTN_UNIT_ROWS=QB;
__device__ __forceinline__ int crow(int r,int hi){return (r&3)+8*(r>>2)+4*hi;}
#define SBAR() __builtin_amdgcn_sched_barrier(0)
__device__ __forceinline__ void cmask(f32x16&p0,f32x16&p1,int jb,int qrel,int hi){
  const float NEG=-INFINITY; int kb=64*jb+4*hi;
  #pragma unroll
  for(int r=0;r<16;++r){int kv=kb+(r&3)+8*(r>>2); if(kv>qrel)p0[r]=NEG; if(kv+32>qrel)p1[r]=NEG;}
}

constexpr int NSLOT=3, SLOTB=8192;
constexpr int NVSLOT=4, VSLOTB=16384;
constexpr int LDS_K=0, LDS_V=NSLOT*SLOTB, LDS_P=LDS_V+NVSLOT*VSLOTB, LDS_OST=LDS_P+2*NWA*4096, LDS_WS=LDS_OST+NWA*4096, WSF_STRIDE=192, LDS_BYTES=LDS_WS+NWA*WSF_STRIDE*4;
constexpr float C2=0.125f*1.4426950408889634f;
__device__ __forceinline__ void glds16(const void*gsrc,unsigned lds_dst){unsigned keep;
  asm volatile("s_mov_b32 %0, m0\n\ts_mov_b32 m0, %2\n\ts_nop 0\n\tglobal_load_lds_dwordx4 %1, off\n\ts_mov_b32 m0, %0":"=&s"(keep):"v"(gsrc),"s"(lds_dst):"memory");}
__device__ __forceinline__ float max3f(float a,float b,float c){float r;asm("v_max3_f32 %0, %1, %2, %3":"=v"(r):"v"(a),"v"(b),"v"(c));return r;}
__device__ __forceinline__ float max2f(float a,float b){float r;asm("v_max_f32_e32 %0, %1, %2":"=v"(r):"v"(a),"v"(b));return r;}
__device__ __forceinline__ float fadd_s(float a,float b){float r;asm("v_add_f32_e32 %0, %1, %2":"=v"(r):"v"(a),"v"(b));return r;}
__device__ __forceinline__ float fsub_s(float a,float b){float r;asm("v_sub_f32_e32 %0, %1, %2":"=v"(r):"v"(a),"v"(b));return r;}
typedef float f32x2_t __attribute__((ext_vector_type(2))); typedef __bf16 bf16x2_t __attribute__((ext_vector_type(2)));
__device__ __forceinline__ unsigned cvtpk_s(float lo,float hi){f32x2_t v={lo,hi};bf16x2_t b=__builtin_convertvector(v,bf16x2_t);return __builtin_bit_cast(unsigned,b);}
#define WAIT_BAR(N) asm volatile("s_waitcnt vmcnt(" #N ") lgkmcnt(0)\n\ts_barrier":::"memory")

__device__ __forceinline__ void qkt(f32x16&p0,f32x16&p1,const char*Kslot,const bf16x8*qr,const f32x16&negm,int r32,int hi){
  const char*kb=Kslot+hi*1024+r32*16;
  #pragma unroll
  for(int d0=0;d0<4;++d0){
    const bf16x8 b0=*reinterpret_cast<const bf16x8*>(kb+d0*2048);
    const bf16x8 b1=*reinterpret_cast<const bf16x8*>(kb+d0*2048+512);
    if(d0==0){p0=__builtin_amdgcn_mfma_f32_32x32x16_bf16(b0,qr[0],negm,0,0,0);p1=__builtin_amdgcn_mfma_f32_32x32x16_bf16(b1,qr[0],negm,0,0,0);}
    else{p0=__builtin_amdgcn_mfma_f32_32x32x16_bf16(b0,qr[d0],p0,0,0,0);p1=__builtin_amdgcn_mfma_f32_32x32x16_bf16(b1,qr[d0],p1,0,0,0);}}
}
typedef __attribute__((address_space(3))) const char* lds_cptr;
typedef short v4i16_t __attribute__((ext_vector_type(4)));
__device__ __forceinline__ void kload8(bf16x8*kf,lds_cptr kp){
  kf[0]=*(const __attribute__((address_space(3))) bf16x8*)(kp);      kf[1]=*(const __attribute__((address_space(3))) bf16x8*)(kp+512);
  kf[2]=*(const __attribute__((address_space(3))) bf16x8*)(kp+2048); kf[3]=*(const __attribute__((address_space(3))) bf16x8*)(kp+2560);
  kf[4]=*(const __attribute__((address_space(3))) bf16x8*)(kp+4096); kf[5]=*(const __attribute__((address_space(3))) bf16x8*)(kp+4608);
  kf[6]=*(const __attribute__((address_space(3))) bf16x8*)(kp+6144); kf[7]=*(const __attribute__((address_space(3))) bf16x8*)(kp+6656);
}
__device__ __forceinline__ void kload2(bf16x8*kf,lds_cptr kp,int j){ kf[2*j]=*(const __attribute__((address_space(3))) bf16x8*)(kp+j*2048); kf[2*j+1]=*(const __attribute__((address_space(3))) bf16x8*)(kp+j*2048+512); }
__device__ __forceinline__ s16x4 vtr(lds_cptr p){ return __builtin_bit_cast(s16x4,__builtin_amdgcn_ds_read_tr16_b64_v4i16((__attribute__((address_space(3))) v4i16_t*)p)); }
__device__ __forceinline__ float rowmax(const f32x16&p0,const f32x16&p1){
  float a=max3f(p0[0],p0[1],p1[0]),b=max3f(p0[2],p0[3],p1[1]);a=max3f(a,p1[2],p1[3]);
  #pragma unroll
  for(int r=4;r<16;r+=4){a=max3f(a,p0[r],p0[r+1]);b=max3f(b,p0[r+2],p0[r+3]);a=max3f(a,p1[r],p1[r+1]);b=max3f(b,p1[r+2],p1[r+3]);}
  const float m=max2f(a,b);
  auto rr=__builtin_amdgcn_permlane32_swap(__float_as_uint(m),__float_as_uint(m),false,false);
  return max2f(__uint_as_float(rr[0]),__uint_as_float(rr[1]));
}
__device__ __forceinline__ void pv(f32x16*o,int vb,bf16x8 pa0,bf16x8 pa1,bf16x8 pa2,bf16x8 pa3){
  #pragma unroll
  for(int d0=0;d0<2;++d0){s16x4 lo[4],hi[4];
    #pragma unroll
    for(int ks=0;ks<4;++ks){
      asm volatile("ds_read_b64_tr_b16 %0,%1 offset:%c2":"=&v"(lo[ks]):"v"(vb),"i"(d0*4096+ks*1024):"memory");
      asm volatile("ds_read_b64_tr_b16 %0,%1 offset:%c2":"=&v"(hi[ks]):"v"(vb),"i"(d0*4096+ks*1024+512):"memory");}
    asm volatile("s_waitcnt lgkmcnt(0)":::"memory");SBAR();
    #define PK(k) (bf16x8){lo[k][0],lo[k][1],lo[k][2],lo[k][3],hi[k][0],hi[k][1],hi[k][2],hi[k][3]}
    o[d0]=__builtin_amdgcn_mfma_f32_32x32x16_bf16(pa0,PK(0),o[d0],0,0,0);
    o[d0]=__builtin_amdgcn_mfma_f32_32x32x16_bf16(pa1,PK(1),o[d0],0,0,0);
    o[d0]=__builtin_amdgcn_mfma_f32_32x32x16_bf16(pa2,PK(2),o[d0],0,0,0);
    o[d0]=__builtin_amdgcn_mfma_f32_32x32x16_bf16(pa3,PK(3),o[d0],0,0,0);
    #undef PK
  }
}

#ifndef ATTN_STORE16
#define ATTN_STORE16(p,v) (*(u32x4*)(p)=(v))
#endif
template<int THRL> __device__ __forceinline__ void attn_unit(int qb,const bf16*Q,const bf16*__restrict__ K,const bf16*__restrict__ V,bf16*O,char*shm){
  int tid_=threadIdx.x; asm volatile("":"+v"(tid_)); const int tid=tid_,lane=tid&63,r32=lane&31,hi=lane>>5; const int wid=__builtin_amdgcn_readfirstlane(tid>>6);
  const int q0=qb*QB; const int wa=wid&3; const bool roleA=wid<NWA;
  const bf16*Qw=Q+(long)(q0+wa*QBLK)*DM;
  const bf16*Kh=K,*Vh=V;
  const unsigned lds0=(unsigned)(uintptr_t)shm;
  float*wsf=(float*)(shm+LDS_WS)+wa*WSF_STRIDE;
  const bf16*ksrc=Kh+(long)lane*DM+wid*8;
  const bf16*vsrc=Vh+(long)(16*(wid&3)+(lane>>2))*DM+(wid>>2)*32+(lane&3)*8;
  const unsigned kdst=lds0+LDS_K+wid*1024, vdst=lds0+LDS_V+wid*1024;
  #define DMA_K(t,slot) glds16(ksrc+(long)(t)*KVBLK*DM,(unsigned)__builtin_amdgcn_readfirstlane(kdst+(slot)))
  #define VSL(t) ((((t)+4)&3)*VSLOTB)
  #define DMA_V(t) do{ const unsigned vd_=(unsigned)__builtin_amdgcn_readfirstlane(vdst+VSL(t)); glds16(vsrc+(long)(t)*KVBLK*DM,vd_); glds16(vsrc+(long)(t)*KVBLK*DM+64,(unsigned)__builtin_amdgcn_readfirstlane(vd_+8192)); }while(0)
  const int vb0=(int)(lds0+LDS_V)+((lane>>4)&1)*32+(lane&3)*8+(4*hi+((lane&15)>>2))*64;
  const char*Kbase=shm+LDS_K; bf16x8 kf[8];
  const lds_cptr shm3=(lds_cptr)shm; const lds_cptr kp0=shm3+LDS_K+hi*1024+r32*16; const lds_cptr vp0=shm3+LDS_V+((lane>>4)&1)*32+(lane&3)*8+(4*hi+((lane&15)>>2))*64;
  const int NT=(q0+QB)/KVBLK;
  DMA_K(0,0);DMA_V(0);DMA_K(1,SLOTB);
  int sl_cur=0,sl_next=SLOTB;
  #define ROT() do{sl_cur=sl_next;sl_next=(sl_next==(NSLOT-1)*SLOTB)?0:sl_next+SLOTB;}while(0)
  #define ENDW(tt) do{ if((tt)+3<NT){WAIT_BAR(3);} else if((tt)+2<NT){WAIT_BAR(2);} else {WAIT_BAR(0);} }while(0)
  typedef __attribute__((address_space(3))) char* lds_wptr; typedef __attribute__((address_space(3))) u32x4 lds_u32x4;
  if(roleA){
  const lds_wptr pwr0=(lds_wptr)shm+LDS_P+wa*4096+lane*16;
  bf16x8 qr[4];
  #pragma unroll
  for(int d0=0;d0<4;++d0)qr[d0]=*reinterpret_cast<const bf16x8*>(&Qw[(long)r32*DM+d0*16+hi*8]);
  float mhat=0.f,l_reg=0.f;f32x16 o[2];o[0]=f32x16{};o[1]=f32x16{};f32x16 negm=f32x16{};asm volatile("":"+v"(negm));
  const int qrel=wa*QBLK+r32;
  #define CMASK(P0,P1,t) do{int jb_=(t)-(NT-2); if(jb_>=0)cmask(P0,P1,jb_,qrel,hi);}while(0)
  bool resc=false;
  #define START(P0,P1) do{ const float rm=rowmax(P0,P1); resc=false; \
    { const float dl=rm; mhat=fadd_s(mhat,dl); \
      _Pragma("unroll") for(int r=0;r<16;++r){P0[r]=fsub_s(P0[r],dl);P1[r]=fsub_s(P1[r],dl);} \
      _Pragma("unroll") for(int r=0;r<16;++r)negm[r]=-mhat; asm volatile("":"+v"(negm)); } \
    _Pragma("unroll") for(int r=0;r<16;++r)P0[r]=__builtin_amdgcn_exp2f(P0[r]); }while(0)
  #define RESC() do{ if(resc){ asm volatile("s_waitcnt lgkmcnt(0)":::"memory"); \
      _Pragma("unroll") for(int d_=0;d_<2;++d_) _Pragma("unroll") for(int r=0;r<16;++r)o[d_][r]*=wsf[crow(r,hi)]; } }while(0)
  f32x16 pA0,pA1,pB0,pB1;
  DMA_K(2,2*SLOTB);
  WAIT_BAR(3);
  qkt(pA0,pA1,Kbase,qr,negm,r32,hi);asm volatile("s_nop 15\n\ts_nop 7":"+v"(pA0),"+v"(pA1));CMASK(pA0,pA1,0);
  START(pA0,pA1);
  _Pragma("unroll") for(int r=0;r<16;++r)pA1[r]=__builtin_amdgcn_exp2f(pA1[r]);
  WAIT_BAR(0);
  DMA_K(3,0);DMA_V(1);
  ROT();
  kload8(kf,kp0+sl_cur);
  if(NT==2){WAIT_BAR(0);}else{WAIT_BAR(3);}
  s16x4 vlo[8],vhi[8]; u32x4 pw0,pw1,pw2,pw3;
  #define PKW(P,B) cvtpk_s(P[B],P[B+1])
  #define PAF(k) __builtin_bit_cast(bf16x8,pw##k)
  #define VFR(i) (bf16x8){vlo[i][0],vlo[i][1],vlo[i][2],vlo[i][3],vhi[i][0],vhi[i][1],vhi[i][2],vhi[i][3]}
  #define PIN(x) asm volatile("":"+v"(x))
  #define MX3(a,b,c) __builtin_fmaxf(__builtin_fmaxf((a),(b)),(c))
  #define GAPA(MF,A0,A1,A2,A3,W0,W1,PW) do{ MF; sacc+=A0; sacc+=A1; sacc+=A2; sacc+=A3; PIN(sacc); W0; W1; PIN(PW); SBAR(); }while(0)
  #define EX(v) __builtin_amdgcn_exp2f(v)
  #define GAPB(MF,X,B) do{ MF; X[B]=EX(X[B]); X[B+1]=EX(X[B+1]); X[B+2]=EX(X[B+2]); X[B+3]=EX(X[B+3]); PIN(X); SBAR(); }while(0)
  #define VRD(i) do{ vlo[i]=vtr(vp_+(((i)>>2)*4096+((i)&3)*1024)); vhi[i]=vtr(vp_+(((i)>>2)*4096+((i)&3)*1024+512)); }while(0)
  #define KRD(G,j) do{ if(G){ kload2(kf,kp0+sl_next,j); SBAR(); } }while(0)
  #define STEP(C0,C1,P0,P1,t,GK,GV,GL) do{ SBAR(); \
    const lds_cptr vp_=vp0+VSL((t)-1); \
    VRD(0); SBAR(); float sacc=(P0[0]+P0[1]); \
    GAPA(C0=__builtin_amdgcn_mfma_f32_32x32x16_bf16(kf[0],qr[0],negm,0,0,0), P0[2],P0[3],P0[4],P0[5],     pw0[0]=PKW(P0,0), pw0[1]=PKW(P0,2), pw0); \
    VRD(4); SBAR(); GAPA(C1=__builtin_amdgcn_mfma_f32_32x32x16_bf16(kf[1],qr[0],negm,0,0,0), P0[6],P0[7],P0[8],P0[9],     pw0[2]=PKW(P0,4), pw0[3]=PKW(P0,6), pw0); \
    VRD(1); SBAR(); GAPA(C0=__builtin_amdgcn_mfma_f32_32x32x16_bf16(kf[2],qr[1],C0,0,0,0),   P0[10],P0[11],P0[12],P0[13], pw1[0]=PKW(P0,8), pw1[1]=PKW(P0,10), pw1); \
    VRD(5); SBAR(); GAPA(C1=__builtin_amdgcn_mfma_f32_32x32x16_bf16(kf[3],qr[1],C1,0,0,0),   P0[14],P0[15],P1[0],P1[1],   pw1[2]=PKW(P0,12),pw1[3]=PKW(P0,14), pw1); \
    VRD(2); SBAR(); GAPA(C0=__builtin_amdgcn_mfma_f32_32x32x16_bf16(kf[4],qr[2],C0,0,0,0),   P1[2],P1[3],P1[4],P1[5],     pw2[0]=PKW(P1,0), pw2[1]=PKW(P1,2), pw2); \
    VRD(6); SBAR(); GAPA(C1=__builtin_amdgcn_mfma_f32_32x32x16_bf16(kf[5],qr[2],C1,0,0,0),   P1[6],P1[7],P1[8],P1[9],     pw2[2]=PKW(P1,4), pw2[3]=PKW(P1,6), pw2); \
    VRD(3); SBAR(); GAPA(C0=__builtin_amdgcn_mfma_f32_32x32x16_bf16(kf[6],qr[3],C0,0,0,0),   P1[10],P1[11],P1[12],P1[13], pw3[0]=PKW(P1,8), pw3[1]=PKW(P1,10), pw3); \
    VRD(7); SBAR(); GAPA(C1=__builtin_amdgcn_mfma_f32_32x32x16_bf16(kf[7],qr[3],C1,0,0,0),   P1[14],P1[15],0.f,0.f,       pw3[2]=PKW(P1,12),pw3[3]=PKW(P1,14), pw3); \
    l_reg+=sacc; \
    { const lds_wptr pp_=pwr0+((((t)-1)&1)*(NWA*4096)); *(lds_u32x4*)(pp_)=pw0; *(lds_u32x4*)(pp_+1024)=pw1; *(lds_u32x4*)(pp_+2048)=pw2; *(lds_u32x4*)(pp_+3072)=pw3; } \
    if(GK){DMA_K((t)+3,sl_cur);} if(GV){DMA_V((t)+1);} \
    CMASK(C0,C1,t); \
    { float a=MX3(C0[0],C0[1],C1[0]),b=MX3(C0[2],C0[3],C1[1]); a=MX3(a,C1[2],C1[3]); \
      _Pragma("unroll") for(int r=4;r<16;r+=4){a=MX3(a,C0[r],C0[r+1]);b=MX3(b,C0[r+2],C0[r+3]);a=MX3(a,C1[r],C1[r+1]);b=MX3(b,C1[r+2],C1[r+3]);} \
      float rm=__builtin_fmaxf(a,b); { auto rr=__builtin_amdgcn_permlane32_swap(__float_as_uint(rm),__float_as_uint(rm),false,false); rm=__builtin_fmaxf(__uint_as_float(rr[0]),__uint_as_float(rr[1])); } \
      resc=false; \
      if(__builtin_expect(__any(rm>(float)THRL),0)){ const float dl=__builtin_fmaxf(rm,0.f); mhat+=dl; \
        _Pragma("unroll") for(int r=0;r<16;++r){C0[r]-=dl;C1[r]-=dl;} \
        _Pragma("unroll") for(int r=0;r<16;++r)negm[r]=-mhat; asm volatile("":"+v"(negm)); \
        const float f=__builtin_amdgcn_exp2f(-dl); l_reg*=f; if(hi==0){wsf[r32]=f; wsf[64+((t)&1)*32+r32]=f;} resc=true; } \
      if(lane==0)wsf[128+((t)&1)]=resc?1.0f:0.0f; } \
    SBAR(); \
    GAPB(o[0]=__builtin_amdgcn_mfma_f32_32x32x16_bf16(PAF(0),VFR(0),o[0],0,0,0), C0,0); \
    GAPB(o[1]=__builtin_amdgcn_mfma_f32_32x32x16_bf16(PAF(0),VFR(4),o[1],0,0,0), C0,4); \
    KRD(GL,0); GAPB(o[0]=__builtin_amdgcn_mfma_f32_32x32x16_bf16(PAF(1),VFR(1),o[0],0,0,0), C0,8); \
    KRD(GL,1); GAPB(o[1]=__builtin_amdgcn_mfma_f32_32x32x16_bf16(PAF(1),VFR(5),o[1],0,0,0), C0,12); \
    KRD(GL,2); GAPB(o[0]=__builtin_amdgcn_mfma_f32_32x32x16_bf16(PAF(2),VFR(2),o[0],0,0,0), C1,0); \
    KRD(GL,3); GAPB(o[1]=__builtin_amdgcn_mfma_f32_32x32x16_bf16(PAF(2),VFR(6),o[1],0,0,0), C1,4); \
    GAPB(o[0]=__builtin_amdgcn_mfma_f32_32x32x16_bf16(PAF(3),VFR(3),o[0],0,0,0), C1,8); \
    GAPB(o[1]=__builtin_amdgcn_mfma_f32_32x32x16_bf16(PAF(3),VFR(7),o[1],0,0,0), C1,12); \
    }while(0)
  int t=1;
  #undef CMASK
  #define CMASK(P0,P1,t) do{}while(0)
  for(;t+5<NT;t+=2){
    STEP(pB0,pB1,pA0,pA1,t,true,true,true);     WAIT_BAR(3); RESC(); ROT();
    STEP(pA0,pA1,pB0,pB1,t+1,true,true,true);   WAIT_BAR(3); RESC(); ROT();
  }
  #undef CMASK
  #define CMASK(P0,P1,t) do{int jb_=(t)-(NT-2); if(jb_>=0)cmask(P0,P1,jb_,qrel,hi);}while(0)
  for(;t+1<NT;t+=2){
    STEP(pB0,pB1,pA0,pA1,t,(t+3<NT),(t+1<NT),(t+1<NT));       ENDW(t);   RESC(); ROT();
    STEP(pA0,pA1,pB0,pB1,t+1,(t+4<NT),(t+2<NT),(t+2<NT));     ENDW(t+1); RESC(); ROT();
  }
  STEP(pB0,pB1,pA0,pA1,NT-1,false,false,false); RESC();
  { float sacc=pB0[0]+pB0[1]; _Pragma("unroll") for(int r=2;r<16;++r)sacc+=pB0[r]; _Pragma("unroll") for(int r=0;r<16;++r)sacc+=pB1[r]; l_reg+=sacc;
    pw0=(u32x4){PKW(pB0,0),PKW(pB0,2),PKW(pB0,4),PKW(pB0,6)};pw1=(u32x4){PKW(pB0,8),PKW(pB0,10),PKW(pB0,12),PKW(pB0,14)};pw2=(u32x4){PKW(pB1,0),PKW(pB1,2),PKW(pB1,4),PKW(pB1,6)};pw3=(u32x4){PKW(pB1,8),PKW(pB1,10),PKW(pB1,12),PKW(pB1,14)};
    { const lds_wptr pp_=pwr0+(((NT-1)&1)*(NWA*4096)); *(lds_u32x4*)(pp_)=pw0; *(lds_u32x4*)(pp_+1024)=pw1; *(lds_u32x4*)(pp_+2048)=pw2; *(lds_u32x4*)(pp_+3072)=pw3; }
    SBAR(); pv(o,vb0+VSL(NT-1),PAF(0),PAF(1),PAF(2),PAF(3)); }
  #undef PKW
  #undef PAF
  #undef VFR
  #undef PIN
  #undef MX3
  #undef GAPA
  #undef GAPB
  #undef EX
  #undef VRD
  #undef KRD
  #undef STEP
  {auto rr=__builtin_amdgcn_permlane32_swap(__float_as_uint(l_reg),__float_as_uint(l_reg),false,false);l_reg=__uint_as_float(rr[0])+__uint_as_float(rr[1]);}
  if(hi==0)wsf[32+r32]=l_reg;asm volatile("s_waitcnt lgkmcnt(0)":::"memory");
  WAIT_BAR(0);
  float rli[16];
  #pragma unroll
  for(int r=0;r<16;++r)rli[r]=__builtin_amdgcn_rcpf(wsf[32+crow(r,hi)]);
  bf16*Ow=O+(long)(q0+wa*QBLK)*DMO;
  { bf16*stg=(bf16*)(shm+LDS_OST)+wa*2048;
    #pragma unroll
    for(int r=0;r<16;++r){const int orow=crow(r,hi);
      #pragma unroll
      for(int d0=0;d0<2;++d0)stg[orow*64+d0*32+r32]=__float2bfloat16(o[d0][r]*rli[r]);}
    asm volatile("s_waitcnt lgkmcnt(0)":::"memory");
    #pragma unroll
    for(int i=0;i<4;++i){const int row=i*8+(lane>>3),ch=lane&7; const u32x4 v=*(const u32x4*)(stg+row*64+ch*8); ATTN_STORE16(Ow+(long)row*DMO+ch*8,v);} }
  } else {
    f32x16 o[2];o[0]=f32x16{};o[1]=f32x16{};
    const lds_cptr prd0=shm3+LDS_P+wa*4096+lane*16;
    #define PVB(tt) do{ const lds_cptr pp_=prd0+(((tt)&1)*(NWA*4096)); \
      const bf16x8 a0_=*(const __attribute__((address_space(3))) bf16x8*)(pp_),a1_=*(const __attribute__((address_space(3))) bf16x8*)(pp_+1024),a2_=*(const __attribute__((address_space(3))) bf16x8*)(pp_+2048),a3_=*(const __attribute__((address_space(3))) bf16x8*)(pp_+3072); \
      pv(o,vb0+8192+VSL(tt),a0_,a1_,a2_,a3_); }while(0)
    #define RESCB(ts) do{ if(wsf[128+((ts)&1)]!=0.0f){ _Pragma("unroll") for(int d_=0;d_<2;++d_) _Pragma("unroll") for(int r=0;r<16;++r)o[d_][r]*=wsf[64+((ts)&1)*32+crow(r,hi)]; } }while(0)
    #define STEPB(t,GK,GV) do{ if(GK){DMA_K((t)+3,sl_cur);} if(GV){DMA_V((t)+1);} if((t)>=2){ PVB((t)-2); RESCB((t)-1); } }while(0)
    DMA_K(2,2*SLOTB);
    WAIT_BAR(3);
    WAIT_BAR(0);
    DMA_K(3,0);DMA_V(1);
    ROT();
    if(NT==2){WAIT_BAR(0);}else{WAIT_BAR(3);}
    int t=1;
    for(;t+5<NT;t+=2){
      STEPB(t,true,true);     WAIT_BAR(3); ROT();
      STEPB(t+1,true,true);   WAIT_BAR(3); ROT();
    }
    for(;t+1<NT;t+=2){
      STEPB(t,(t+3<NT),(t+1<NT));       ENDW(t);   ROT();
      STEPB(t+1,(t+4<NT),(t+2<NT));     ENDW(t+1); ROT();
    }
    STEPB(NT-1,false,false);
    WAIT_BAR(0);
    PVB(NT-2); RESCB(NT-1); PVB(NT-1);
    float rli[16];
    #pragma unroll
    for(int r=0;r<16;++r)rli[r]=__builtin_amdgcn_rcpf(wsf[32+crow(r,hi)]);
    bf16*Ow=O+(long)(q0+wa*QBLK)*DMO+64;
    { bf16*stg=(bf16*)(shm+LDS_P)+wa*2048;
      #pragma unroll
      for(int r=0;r<16;++r){const int orow=crow(r,hi);
        #pragma unroll
        for(int d0=0;d0<2;++d0)stg[orow*64+d0*32+r32]=__float2bfloat16(o[d0][r]*rli[r]);}
      asm volatile("s_waitcnt lgkmcnt(0)":::"memory");
      #pragma unroll
      for(int i=0;i<4;++i){const int row=i*8+(lane>>3),ch=lane&7; const u32x4 v=*(const u32x4*)(stg+row*64+ch*8); ATTN_STORE16(Ow+(long)row*DMO+ch*8,v);} }
    #undef PVB
    #undef RESCB
    #undef STEPB
  }
  asm volatile("s_waitcnt lgkmcnt(0)\n\ts_barrier":::"memory");
  #undef DMA_K
  #undef DMA_V
  #undef CMASK
  #undef START
  #undef RESC
  #undef ROT
  #undef VSL
  #undef ENDW
}
constexpr int ATTN_LDS_BYTES=LDS_BYTES;
struct AttnTensors { const bf16* Q; const bf16* K; const bf16* V; bf16* O; };
struct AttnUnit { int hc; int qb; };
struct StaticOrder {
  int vcu, G, bx;
  __device__ __forceinline__ StaticOrder(int grid,int block):vcu((grid%8==0)?(block%8)*(grid/8)+block/8:block),G(grid),bx(block){}
  __device__ __forceinline__ bool next(int i,AttnUnit&u)const{
    if(G==256){ if(i>=4)return false; const int s=vcu&31; u.hc=vcu>>5; u.qb=(i==0)?127-s:(i==1)?64+s:(i==2)?63-s:s; return true; }
    const int idx=i*G+bx; if(idx>=8*NQB)return false; u.hc=idx&7; u.qb=NQB-1-(idx>>3); return true; }
};
template<class Sched,int THRL=8> __device__ __forceinline__ void attn_phase(char*lds,const AttnTensors&T,const Sched&S){
  AttnUnit u;
  for(int i=0;S.next(i,u);++i){ const int h=u.hc>>1,c=u.hc&1;
    attn_unit<THRL>(u.qb,T.Q+h*128+c*64,T.K+h*128+c*64,T.V+h*128,T.O+u.hc*128,lds); }
}
#undef SBAR
#undef WAIT_BAR
}
constexpr int NWAVES = 8;
constexpr int M = 16384, D = 1024, FF = 2816, NGU = 2 * FF, NIN = 2048, DEPTH = 4;
constexpr size_t MiB = 1u << 20;
constexpr size_t WS_ROWSS = 1 * MiB;
constexpr size_t WS_ROPE = 2 * MiB;
constexpr size_t WS_XB = 8 * MiB;
constexpr size_t WS_H = 40 * MiB;
constexpr size_t WS_QKVU = 40 * MiB;
constexpr size_t WS_OBUF = 104 * MiB;
constexpr size_t WS_CAT = 136 * MiB;
constexpr size_t WS_W = 168 * MiB;
constexpr size_t OFF_GU1 = 0, OFF_DN1 = 11 * MiB, OFF_IN = 16 * MiB + 512 * 1024, OFF_OUT = 20 * MiB + 512 * 1024, OFF_GU2 = 22 * MiB + 512 * 1024, OFF_DN2 = 33 * MiB + 512 * 1024, W_LAYER = 39 * MiB;
constexpr size_t WS_END = WS_W + DEPTH * W_LAYER;
static_assert(attn_body::ATTN_LDS_BYTES <= 147392 && (size_t)NGU * D * 2 == 11 * MiB && (size_t)D * FF * 2 == 5 * MiB + 512 * 1024 && WS_H + (size_t)M * FF * 2 <= WS_CAT && WS_ROWSS + 16 * (size_t)M * 4 <= WS_ROPE && WS_ROPE + (size_t)M * 64 * 4 <= WS_XB, "ws map");
constexpr int LDS_BYTES = 147456;

#define LAS __attribute__((address_space(3)))
typedef unsigned short bf16;
typedef unsigned v4u __attribute__((ext_vector_type(4)));
typedef unsigned v2u __attribute__((ext_vector_type(2)));
typedef float f32x4 __attribute__((ext_vector_type(4)));
#define LDS_WAIT() asm volatile("s_waitcnt lgkmcnt(0)" ::: "memory")
__device__ __forceinline__ unsigned f2bf(float f) { unsigned u = __builtin_bit_cast(unsigned, f); return (u + 0x7fffu + ((u >> 16) & 1u)) >> 16; }
__device__ __forceinline__ unsigned pk2(float lo, float hi) { return f2bf(lo) | (f2bf(hi) << 16); }
__device__ __forceinline__ float bflo(unsigned w) { return __builtin_bit_cast(float, w << 16); }
__device__ __forceinline__ float bfhi(unsigned w) { return __builtin_bit_cast(float, w & 0xffff0000u); }
__device__ __forceinline__ float wave_sum(float v) {
#pragma unroll
    for (int o = 1; o < 64; o <<= 1) v += __shfl_xor(v, o);
    return v;
}
__device__ __forceinline__ void tr_item(const float* W, int N, int k0, int n0, const float* gk, bf16* WT, int Kd, int rbase, int rstride, int lane) {
    const int kblk = lane & 7, n4 = lane >> 3;
    const float* src = W + (size_t)(k0 + 8 * kblk) * N + n0 + 4 * n4;
    f32x4 v[8];
#pragma unroll
    for (int i = 0; i < 8; ++i) v[i] = __builtin_nontemporal_load((const f32x4*)(src + (size_t)i * N));
    if (gk) { const f32x4 g0 = *(const f32x4*)(gk + k0 + 8 * kblk), g1 = *(const f32x4*)(gk + k0 + 8 * kblk + 4);
#pragma unroll
        for (int i = 0; i < 4; ++i) { v[i] = v[i] * g0[i]; v[4 + i] = v[4 + i] * g1[i]; } }
#pragma unroll
    for (int e = 0; e < 4; ++e) { v4u o; o.x = pk2(v[0][e], v[1][e]); o.y = pk2(v[2][e], v[3][e]); o.z = pk2(v[4][e], v[5][e]); o.w = pk2(v[6][e], v[7][e]);
        *(v4u*)(WT + (size_t)(rbase + (4 * n4 + e) * rstride) * Kd + k0 + 8 * kblk) = o; }
}

#define XB_TMO      128
#define XB_XCNT(j)  (256  + 64 * (j))
#define XB_XSUB(j)  (1280 + 64 * (j))
#define XB_XGEN(j)  (2304 + 64 * (j))
#define XB_TOP      3328
#define XB_TOPGEN   3392
#define XCD_BAR_WORDS 3456
#define XB_SPIN_CAP (1u << 18)

__device__ __forceinline__ unsigned xb_ld(unsigned* p)              { return __hip_atomic_load(p, __ATOMIC_RELAXED, __HIP_MEMORY_SCOPE_AGENT); }
__device__ __forceinline__ unsigned xb_add(unsigned* p, unsigned v) { return __hip_atomic_fetch_add(p, v, __ATOMIC_RELAXED, __HIP_MEMORY_SCOPE_AGENT); }
__device__ __forceinline__ unsigned xb_xcc_id() { return (unsigned)__builtin_amdgcn_s_getreg((3 << 11) | 20) & 0xFu; }
#define XB_SPIN(cond, bar) do { unsigned _sp = 0; while (cond) { __builtin_amdgcn_s_sleep(1); \
    if ((++_sp & 255u) == 0u) { if (xb_ld(&(bar)[XB_TMO])) break; if (_sp > XB_SPIN_CAP) { atomicAdd(&(bar)[XB_TMO], 1u); break; } } } } while (0)

struct XcdBarrier {
    unsigned* bar; unsigned x;
    volatile LAS unsigned* st;
};

__device__ __forceinline__ XcdBarrier xcd_barrier_post(unsigned* bar, volatile LAS unsigned* st) {
    XcdBarrier b; b.bar = bar; b.x = xb_xcc_id(); b.st = st;
    if (threadIdx.x == 0) (void)xb_add(&bar[XB_XCNT(b.x)], 1u);
    return b;
}
__device__ __forceinline__ void xcd_barrier_complete(unsigned* bar, unsigned x, unsigned& nloc, unsigned& nx) {
    const unsigned G = gridDim.x * gridDim.y * gridDim.z;
    unsigned sum, cnt, mine, sp = 0u;
    for (;;) {
        sum = 0u; cnt = 0u; mine = 0u;
#pragma unroll
        for (unsigned j = 0; j < 16; ++j) { const unsigned c = xb_ld(&bar[XB_XCNT(j)]); sum += c; cnt += (c > 0u) ? 1u : 0u; mine = (j == x) ? c : mine; }
        if (sum == G) break;
        __builtin_amdgcn_s_sleep(1);
        if ((++sp & 255u) == 0u) { if (xb_ld(&bar[XB_TMO])) break; if (sp > XB_SPIN_CAP) { atomicAdd(&bar[XB_TMO], 1u); break; } }
    }
    nloc = mine > 0u ? mine : 1u; nx = cnt > 0u ? cnt : 1u;
}

__device__ __forceinline__ void xcd_barrier(const XcdBarrier& b) {
    asm volatile("s_waitcnt vmcnt(0)" ::: "memory");
    __syncthreads();
    if (threadIdx.x == 0) {
        unsigned* bar = b.bar;
        __builtin_amdgcn_s_waitcnt(0);
        unsigned nloc = b.st[0], nx = b.st[1];
        if (nloc == 0u) { xcd_barrier_complete(bar, b.x, nloc, nx); b.st[0] = nloc; b.st[1] = nx; }
        const unsigned old = xb_add(&bar[XB_XSUB(b.x)], 1u);
        const unsigned gen = old / nloc;
        if (old + 1u == (gen + 1u) * nloc) {
            __builtin_amdgcn_fence(__ATOMIC_RELEASE, "agent");
            asm volatile("s_waitcnt vmcnt(0)" ::: "memory");
            const unsigned og = xb_add(&bar[XB_TOP], 1u);
            const unsigned tg = og / nx;
            if (og + 1u == (tg + 1u) * nx) xb_add(&bar[XB_TOPGEN], 1u);
            else XB_SPIN(xb_ld(&bar[XB_TOPGEN]) == tg, bar);
            __builtin_amdgcn_fence(__ATOMIC_ACQUIRE, "agent");
            xb_add(&bar[XB_XGEN(b.x)], 1u);
            asm volatile("s_waitcnt vmcnt(0)" ::: "memory");
        } else {
            XB_SPIN(xb_ld(&bar[XB_XGEN(b.x)]) == gen, bar);
            __builtin_amdgcn_fence(__ATOMIC_ACQUIRE, "agent");
            asm volatile("s_waitcnt vmcnt(0)" ::: "memory");
        }
    }
    __syncthreads();
}

struct Args { const float* in[20]; float* out; unsigned char* wsp; };
typedef __attribute__((address_space(1))) unsigned char* gptr_t;
__device__ __forceinline__ gptr_t fresh_ptr(unsigned char* p) { asm volatile("" : "+s"(p)); return (gptr_t)p; }

__global__ void __launch_bounds__(NWAVES * 64, 2) hymba_fwd(Args args) {
    extern __shared__ __attribute__((aligned(16))) unsigned char lds[];
    LAS unsigned char* L = (LAS unsigned char*)lds;
    const int tid = threadIdx.x, lane = tid & 63, wave = __builtin_amdgcn_readfirstlane(tid >> 6);
    const int G = gridDim.x, bx = blockIdx.x;
    const int gw = bx * NWAVES + wave, NGW = G * NWAVES;
    const int gtid = bx * (NWAVES * 64) + tid, NT = G * NWAVES * 64;
#define ws (fresh_ptr(args.wsp))
#define rowss ((float*)(unsigned char*)(ws + WS_ROWSS))
#define rope ((float*)(unsigned char*)(ws + WS_ROPE))
#define XB ((bf16*)(unsigned char*)(ws + WS_XB))
#define HB ((bf16*)(unsigned char*)(ws + WS_H))
#define QKVU ((bf16*)(unsigned char*)(ws + WS_QKVU))
#define OBUF ((bf16*)(unsigned char*)(ws + WS_OBUF))
#define CAT ((bf16*)(unsigned char*)(ws + WS_CAT))
#define xout ((float*)(unsigned char*)fresh_ptr((unsigned char*)args.out))
    { volatile LAS unsigned* st0 = (volatile LAS unsigned*)(L + 147392); if (tid < 2) st0[tid] = 0u; }
    __syncthreads();
    const XcdBarrier gbar = xcd_barrier_post((unsigned*)args.wsp, (volatile LAS unsigned*)(L + 147392));

    {
        constexpr int IT_G = 16 * 88, IT_D = 44 * 32, IT_IN = 16 * 64, IT_OUT = 8 * 32, IT_LAYER = 4 * IT_G + 2 * IT_D + IT_IN + IT_OUT;
        static_assert(IT_G == IT_D, "item decode");
        for (int it = gw; it < DEPTH * IT_LAYER; it += NGW) {
            const int l = it / IT_LAYER; int r = it % IT_LAYER; unsigned char* wl = (unsigned char*)(ws + WS_W + (size_t)l * W_LAYER);
            if (r < 6 * IT_G) {
                const int f = r / (3 * IT_G), q = r % (3 * IT_G), kind = q / IT_G, i = q % IT_G;
                if (kind < 2) { const float* W = args.in[(f ? 16 : 2) + kind] + (size_t)l * D * FF; const int kb = i / 88, nb = i % 88, n0 = 32 * nb;
                    tr_item(W, FF, 64 * kb, n0, args.in[f ? 15 : 1] + l * D, (bf16*)(wl + (f ? OFF_GU2 : OFF_GU1)), D, (n0 >> 7) * 256 + kind * 128 + (n0 & 127), 1, lane); }
                else { const float* W = args.in[f ? 18 : 4] + (size_t)l * FF * D; const int kb = i / 32, nb = i % 32;
                    tr_item(W, D, 64 * kb, 32 * nb, nullptr, (bf16*)(wl + (f ? OFF_DN2 : OFF_DN1)), FF, 32 * nb, 1, lane); }
            } else { r -= 6 * IT_G;
                if (r < IT_IN) { const float* W = args.in[6] + (size_t)l * D * NIN; const int kb = r / 64, nb = r % 64, n0 = 32 * nb; int rbase = n0, rstride = 1;
                    if (n0 < 1024) { const int d0 = n0 & 63; rbase = (n0 - d0) + (d0 ? 1 : 0); rstride = 2; }
                    tr_item(W, NIN, 64 * kb, n0, args.in[5] + l * D, (bf16*)(wl + OFF_IN), D, rbase, rstride, lane); }
                else { r -= IT_IN; const float* W = args.in[14] + (size_t)l * D * D; const int kb = r / 32, nb = r % 32;
                    tr_item(W, D, 64 * kb, 32 * nb, nullptr, (bf16*)(wl + OFF_OUT), D, 32 * nb, 1, lane); }
            }
        }
        for (int it = gw; it < DEPTH * 1024; it += NGW) {
            const int l = it >> 10, r = it & 1023, g = r >> 8, cb = (r >> 4) & 15, nb = r & 15, c0 = cb * 8, n = nb * 64 + lane;
            const float* pw = args.in[12] + ((size_t)(l * 4 + g) * 128 + c0) * 128; const float* ps = args.in[13] + l * 512 + g * 128;
            const float* wo = args.in[14] + (size_t)l * D * D + (size_t)(512 + g * 128) * D + n;
            float a[8];
#pragma unroll
            for (int j = 0; j < 8; ++j) a[j] = 0.f;
            for (int e = 0; e < 128; ++e) { const float w = wo[(size_t)e * D] * ps[e];
#pragma unroll
                for (int j = 0; j < 8; ++j) a[j] += pw[j * 128 + e] * w; }
            v4u o; o.x = pk2(a[0], a[1]); o.y = pk2(a[2], a[3]); o.z = pk2(a[4], a[5]); o.w = pk2(a[6], a[7]);
            *(v4u*)((bf16*)(unsigned char*)(ws + WS_W + (size_t)l * W_LAYER + OFF_OUT) + (size_t)n * D + 512 + g * 128 + c0) = o;
        }
        for (int i = gtid; i < M * 32; i += NT) { const int s = i >> 5, j = i & 31; const float inv = (float)pow(10000.0, -(double)j / 32.0); const float ang = (float)s * inv;
            const double a = (double)ang; rope[2 * i] = (float)cos(a); rope[2 * i + 1] = (float)sin(a); }
        for (int m = gw; m < M; m += NGW) { const f32x4* xr = (const f32x4*)(args.in[0] + (size_t)m * D) + lane; f32x4 v[4]; float s = 0.f;
#pragma unroll
            for (int j = 0; j < 4; ++j) { v[j] = xr[64 * j]; s += (v[j].x * v[j].x + v[j].y * v[j].y) + (v[j].z * v[j].z + v[j].w * v[j].w); }
            s = wave_sum(s); if (lane < 16) rowss[(size_t)m * 16 + lane] = (lane == 0) ? s : 0.f;
            v2u* o8 = (v2u*)(XB + (size_t)m * D) + lane;
#pragma unroll
            for (int j = 0; j < 4; ++j) { v2u w; w.x = pk2(v[j].x, v[j].y); w.y = pk2(v[j].z, v[j].w); o8[64 * j] = w; } }
    }
    cg::this_grid().sync();


    for (int step = 0; step < 3 * DEPTH; ++step) {
        const int l = step / 3, kind = step % 3;
#define wl ((unsigned char*)(ws + WS_W + (size_t)l * W_LAYER))
        if (kind != 1) {
            const int f = kind >> 1;
            { pg8::Gemm g{XB, (const bf16*)(wl + (f ? OFF_GU2 : OFF_GU1)), M, NGU, D}; pg8::StaticOrder S; S.init(M, NGU, G, bx);
              pg8::EpiGateUp E{HB, rowss};
              pg8::gemm_phase<pg8::EpiGateUp, pg8::StaticOrder, PG8_ALIGN, PG8_SP2>(L, g, S, E); }
            xcd_barrier(gbar);
            { pg8::Gemm g{HB, (const bf16*)(wl + (f ? OFF_DN2 : OFF_DN1)), M, D, FF}; pg8::StaticOrder S; S.init(M, D, G, bx);
              pg8::EpiResid E{(const float*)(unsigned char*)fresh_ptr((unsigned char*)((step == 0) ? args.in[0] : args.out)), xout, XB, rowss, 0.5f};
              pg8::gemm_phase<pg8::EpiResid, pg8::StaticOrder, PG8_ALIGN, PG8_SP2>(L, g, S, E); }
            xcd_barrier(gbar);
        } else {
            { pg8::Gemm g{XB, (const bf16*)(wl + OFF_IN), M, NIN, D}; pg8::StaticOrder S; S.init(M, NIN, G, bx);
              pg8::EpiQKVU E{QKVU, rowss, rope};
              pg8::gemm_phase<pg8::EpiQKVU, pg8::StaticOrder, PG8_ALIGN, PG8_SP2>(L, g, S, E); }
            xcd_barrier(gbar);
            { const attn_body::AttnTensors AT{(const attn_body::bf16*)QKVU, (const attn_body::bf16*)(QKVU + 512), (const attn_body::bf16*)(QKVU + 1024), (attn_body::bf16*)OBUF};
              const attn_body::StaticOrder S(G, bx);
              attn_body::attn_phase<attn_body::StaticOrder>((char*)lds, AT, S); }
            xcd_barrier(gbar);
            {
                const float li = 0.8f - 0.6f * expf(-0.3f * (float)l);
                const float s1 = wave_sum(args.in[7][l * 64 + lane] * args.in[8][l * 64 + lane]), s2 = wave_sum(args.in[9][l * 64 + lane] * args.in[10][l * 64 + lane]);
                const float lam = expf(s1) - expf(s2) + li;
                const int hd = lane >> 4, j0 = (lane & 15) * 8;
                float gn[8];
#pragma unroll
                for (int j = 0; j < 8; ++j) gn[j] = args.in[11][l * 128 + j0 + j] * (1.0f - li);
                const int win = 2 << hd;
                for (int m = gw; m < M; m += NGW) {
                    const v4u a = *(const v4u*)(OBUF + (size_t)m * 1024 + hd * 256 + j0), b = *(const v4u*)(OBUF + (size_t)m * 1024 + hd * 256 + 128 + j0);
                    float o[8];
                    o[0] = bflo(a.x) - lam * bflo(b.x); o[1] = bfhi(a.x) - lam * bfhi(b.x); o[2] = bflo(a.y) - lam * bflo(b.y); o[3] = bfhi(a.y) - lam * bfhi(b.y);
                    o[4] = bflo(a.z) - lam * bflo(b.z); o[5] = bfhi(a.z) - lam * bfhi(b.z); o[6] = bflo(a.w) - lam * bflo(b.w); o[7] = bfhi(a.w) - lam * bfhi(b.w);
                    float ss = 0.f;
#pragma unroll
                    for (int j = 0; j < 8; ++j) ss += o[j] * o[j];
                    ss += __shfl_xor(ss, 1); ss += __shfl_xor(ss, 2); ss += __shfl_xor(ss, 4); ss += __shfl_xor(ss, 8);
                    const float rr = __builtin_amdgcn_rsqf(ss * (1.0f / 128.0f) + 1e-6f);
                    v4u w; w.x = pk2(o[0] * rr * gn[0], o[1] * rr * gn[1]); w.y = pk2(o[2] * rr * gn[2], o[3] * rr * gn[3]); w.z = pk2(o[4] * rr * gn[4], o[5] * rr * gn[5]); w.w = pk2(o[6] * rr * gn[6], o[7] * rr * gn[7]);
                    *(v4u*)(CAT + (size_t)m * 1024 + hd * 128 + j0) = w;
                    const bf16* up = QKVU + (size_t)m * 2048 + 1536 + hd * 128 + j0;
                    const v4u u0 = *(const v4u*)up;
                    float sm[8] = {bflo(u0.x), bfhi(u0.x), bflo(u0.y), bfhi(u0.y), bflo(u0.z), bfhi(u0.z), bflo(u0.w), bfhi(u0.w)};
                    float us[8];
#pragma unroll
                    for (int j = 0; j < 8; ++j) us[j] = sm[j];
                    for (int t = 1; t < win; ++t) { if (m - t >= 0) { const v4u ut = *(const v4u*)(up - (size_t)t * 2048);
                        sm[0] += bflo(ut.x); sm[1] += bfhi(ut.x); sm[2] += bflo(ut.y); sm[3] += bfhi(ut.y); sm[4] += bflo(ut.z); sm[5] += bfhi(ut.z); sm[6] += bflo(ut.w); sm[7] += bfhi(ut.w); } }
                    const float ic = 1.0f / (float)((m + 1 < win) ? (m + 1) : win);
                    v4u d; d.x = pk2(sm[0] * ic - us[0], sm[1] * ic - us[1]); d.y = pk2(sm[2] * ic - us[2], sm[3] * ic - us[3]); d.z = pk2(sm[4] * ic - us[4], sm[5] * ic - us[5]); d.w = pk2(sm[6] * ic - us[6], sm[7] * ic - us[7]);
                    *(v4u*)(CAT + (size_t)m * 1024 + 512 + hd * 128 + j0) = d;
                }
            }
            xcd_barrier(gbar);
            { pg8::Gemm g{CAT, (const bf16*)(wl + OFF_OUT), M, D, D}; pg8::StaticOrder S; S.init(M, D, G, bx);
              pg8::EpiResid E{xout, xout, XB, rowss, 1.0f};
              pg8::gemm_phase<pg8::EpiResid, pg8::StaticOrder, PG8_ALIGN, PG8_SP2>(L, g, S, E); }
            xcd_barrier(gbar);
        }
    }
    for (int m = gw; m < M; m += NGW) { f32x4* xr = (f32x4*)(xout + (size_t)m * D) + lane; const f32x4* gr = (const f32x4*)args.in[19] + lane;
        const float r = pg8::rs_from_ss(rowss + (size_t)m * 16);
#pragma unroll
        for (int j = 0; j < 4; ++j) { const f32x4 v = xr[64 * j], gg = gr[64 * j]; xr[64 * j] = v * r * gg; } }
}

#undef wl
#undef ws
#undef rowss
#undef rope
#undef XB
#undef HB
#undef QKVU
#undef OBUF
#undef CAT
#undef xout
extern "C" void kernel_launch(void* const* d_in, const int* in_sizes, int n_in, void* d_out, int out_size, void* d_ws, size_t ws_size, hipStream_t stream) {
    static int grid_blocks = 0;
    if (grid_blocks == 0) {
        if (n_in != 20 || out_size != M * D || ws_size < WS_END) { fprintf(stderr, "kernel_launch: unexpected shapes (n_in %d out %d ws %zu, need %zu)\n", n_in, out_size, ws_size, (size_t)WS_END); grid_blocks = -1; return; }
        int dev = 0, cus = 0, per_cu = 0;
        (void)hipGetDevice(&dev); (void)hipDeviceGetAttribute(&cus, hipDeviceAttributeMultiprocessorCount, dev);
        if (hipFuncSetAttribute((const void*)hymba_fwd, hipFuncAttributeMaxDynamicSharedMemorySize, LDS_BYTES) != hipSuccess) { fprintf(stderr, "kernel_launch: hipFuncSetAttribute failed\n"); grid_blocks = -1; return; }
        if (hipOccupancyMaxActiveBlocksPerMultiprocessor(&per_cu, (const void*)hymba_fwd, NWAVES * 64, LDS_BYTES) != hipSuccess || per_cu < 1) { fprintf(stderr, "kernel_launch: occupancy query says %d\n", per_cu); per_cu = 1; }
        (void)hipGetLastError();
        grid_blocks = cus * per_cu;
    }
    if (grid_blocks < 0) return;
    if (hipMemsetAsync(d_ws, 0, 65536, stream) != hipSuccess) { fprintf(stderr, "kernel_launch: memset failed\n"); return; }
    Args a{};
    for (int i = 0; i < 20; ++i) a.in[i] = (const float*)d_in[i];
    a.out = (float*)d_out; a.wsp = (unsigned char*)d_ws;
    void* kargs[] = {&a};
    hipError_t e = hipLaunchCooperativeKernel((const void*)hymba_fwd, dim3(grid_blocks), dim3(NWAVES * 64), kargs, LDS_BYTES, stream);
    if (e != hipSuccess) fprintf(stderr, "cooperative launch failed: %s (grid %d)\n", hipGetErrorString(e), grid_blocks);
}
```

```cpp
#include <hip/hip_runtime.h>
#include <hip/hip_cooperative_groups.h>
#include <cstdio>
#include <cstdint>
namespace cg = cooperative_groups;
namespace pg8 {
#define PG8_LAS __attribute__((address_space(3)))
typedef unsigned short bf16_t;
typedef short bf16x8 __attribute__((ext_vector_type(8)));
typedef float f32x4 __attribute__((ext_vector_type(4)));
typedef unsigned u32x4 __attribute__((ext_vector_type(4)));
constexpr int BM = 256, BK = 64, HALF = 128, HTB = HALF * BK * 2  , STAGE_BYTES = 8 * HTB, NXCD = 8, WGM = 8;

__host__ __device__ __forceinline__ int lds_byte(int r, int c) { const int st = (r >> 4) * 2 + (c >> 5), rr = r & 15, cc = c & 31, ob = rr * 64 + cc * 2; return st * 1024 + (ob ^ (((ob >> 9) & 1) << 5)); }
__host__ __device__ __forceinline__ void stage_rc(int b, int& R, int& C) { const int st = b / 1024, sb = b % 1024, swz = sb ^ (((sb >> 9) & 1) << 5); R = (st >> 1) * 16 + swz / 64; C = (st & 1) * 32 + (swz % 64) / 2; }
__host__ __device__ __forceinline__ int perm32(int rho) { const int n = rho >> 4, i = rho & 15; return 8 * (i >> 2) + 4 * n + (i & 3); }

struct Unit { int pm, pn; };
struct Gemm { const bf16_t* A; const bf16_t* Bt; int M, N, K; };

struct StaticOrder {
    int nM, nN, nwg, G, c;
    __host__ __device__ void init(int M, int N, int G_, int c_) { nM = M / BM; nN = N / BM; nwg = nM * nN; G = G_; c = c_; }
    __host__ __device__ bool next(int i, Unit& u) const {
        const long L = (long)i * G + c; if (L >= nwg) return false;
        int wgid = (int)L; { const int q = nwg / NXCD, r = nwg % NXCD, xcd = wgid % NXCD, off = wgid / NXCD; wgid = (xcd < r ? xcd * (q + 1) : r * (q + 1) + (xcd - r) * q) + off; }
        const int nig = WGM * nN, gid = wgid / nig, fm = gid * WGM, gsz = (nM - fm) < WGM ? (nM - fm) : WGM;
        u.pm = fm + ((wgid % nig) % gsz); u.pn = (wgid % nig) / gsz; return true;
    }
    __device__ __forceinline__ void a_ready(const Unit&) const {}
    __device__ __forceinline__ void done(const Unit&) const {}
};

__device__ __forceinline__ unsigned cvt_pk_bf16(float lo, float hi) { unsigned r; asm volatile("v_cvt_pk_bf16_f32 %0, %1, %2" : "=v"(r) : "v"(lo), "v"(hi)); return r; }
typedef float f32x2 __attribute__((ext_vector_type(2)));
__device__ __forceinline__ f32x2 gelu_pk(f32x2 v) {
    const f32x2 av = __builtin_elementwise_abs(v), d = av * 0.2316418882f + 1.0f;
    f32x2 t; t.x = __builtin_amdgcn_rcpf(d.x); t.y = __builtin_amdgcn_rcpf(d.y);
    f32x2 q = t * 0.5307027145f + (-0.7265760135f); q = q * t + 0.7107068705f; q = q * t + (-0.142248368f); q = q * t + 0.127414796f; q = q * t;
    const f32x2 s = (v * v) * (-0.72134752044f);
    f32x2 e; e.x = __builtin_amdgcn_exp2f(s.x); e.y = __builtin_amdgcn_exp2f(s.y);
    const f32x2 m = v * (q * e), r = v - m;
    f32x2 o; o.x = v.x < 0.f ? m.x : r.x; o.y = v.y < 0.f ? m.y : r.y; return o;
}

template <int ACT  > struct EpiBf16 {
    static constexpr bool PERM = true, AFTER_DRAIN = false; static_assert(ACT == 0 || ACT == 1, "EpiBf16: ACT is 0 (none) or 1 (gelu_pk)");
    bf16_t* O; int ldc; const float* bias; int split_cols; size_t split_stride; float scale0;
    __device__ __forceinline__ void operator()(const f32x4 (&acc)[2][2][4][2], const Unit& u, int wr, int wc, int fr, int fq) const {
        const int row0 = u.pm * BM + wr * 64 + fr; int colt = u.pn * BM; bf16_t* base = O;
        float sc = 1.f; if (split_cols) { const int t = colt / split_cols; base += (size_t)t * split_stride; colt -= t * split_cols; if (t == 0) sc = scale0; }
        const int col0 = colt + wc * 32 + 8 * fq, bcol0 = u.pn * BM + wc * 32 + 8 * fq;
        f32x4 bv[2][2];
#pragma unroll
        for (int bj = 0; bj < 2; ++bj)
#pragma unroll
            for (int n = 0; n < 2; ++n) bv[bj][n] = bias ? *(const f32x4*)(bias + bcol0 + bj * HALF + 4 * n) : (f32x4){0.f, 0.f, 0.f, 0.f};
#pragma unroll
        for (int ai = 0; ai < 2; ++ai)
#pragma unroll
            for (int m = 0; m < 4; ++m) { bf16_t* rowp = base + (size_t)(row0 + ai * HALF + m * 16) * ldc + col0;
#pragma unroll
                for (int bj = 0; bj < 2; ++bj) { f32x4 v0 = acc[ai][bj][m][0] + bv[bj][0], v1 = acc[ai][bj][m][1] + bv[bj][1];
                    if (ACT == 1) { f32x2 a = gelu_pk((f32x2){v0[0], v0[1]}), b = gelu_pk((f32x2){v0[2], v0[3]}), c = gelu_pk((f32x2){v1[0], v1[1]}), d = gelu_pk((f32x2){v1[2], v1[3]});
                        v0 = (f32x4){a.x, a.y, b.x, b.y}; v1 = (f32x4){c.x, c.y, d.x, d.y}; }
                    v0 = v0 * sc; v1 = v1 * sc; u32x4 w; w.x = cvt_pk_bf16(v0[0], v0[1]); w.y = cvt_pk_bf16(v0[2], v0[3]); w.z = cvt_pk_bf16(v1[0], v1[1]); w.w = cvt_pk_bf16(v1[2], v1[3]);
                    *(u32x4*)(rowp + bj * HALF) = w; } }
    }
};
__device__ __forceinline__ float rs_from_ss(const float* p) { const f32x4 a = ((const f32x4*)p)[0], b = ((const f32x4*)p)[1], c = ((const f32x4*)p)[2], d = ((const f32x4*)p)[3];
    const float ss = (((a[0] + a[1]) + (a[2] + a[3])) + ((b[0] + b[1]) + (b[2] + b[3]))) + (((c[0] + c[1]) + (c[2] + c[3])) + ((d[0] + d[1]) + (d[2] + d[3])));
    return __builtin_amdgcn_rsqf(ss * (1.0f / 1024.0f) + 1e-6f); }
struct EpiGateUp {
    static constexpr bool PERM = true, AFTER_DRAIN = false;
    bf16_t* H; const float* rowss;
    __device__ __forceinline__ void operator()(const f32x4 (&acc)[2][2][4][2], const Unit& u, int wr, int wc, int fr, int fq) const {
        const int row0 = u.pm * BM + wr * 64 + fr; const int col0 = u.pn * HALF + wc * 32 + 8 * fq;
#pragma unroll
        for (int ai = 0; ai < 2; ++ai)
#pragma unroll
            for (int m = 0; m < 4; ++m) { const int row = row0 + ai * HALF + m * 16; const float r = rs_from_ss(rowss + (size_t)row * 16);
                float hv[8];
#pragma unroll
                for (int n = 0; n < 2; ++n)
#pragma unroll
                    for (int e = 0; e < 4; ++e) { const float g = acc[ai][0][m][n][e] * r, up = acc[ai][1][m][n][e] * r;
                        const float sg = g * __builtin_amdgcn_rcpf(1.0f + __builtin_amdgcn_exp2f(g * -1.4426950408889634f)); hv[n * 4 + e] = sg * up; }
                u32x4 w; w.x = cvt_pk_bf16(hv[0], hv[1]); w.y = cvt_pk_bf16(hv[2], hv[3]); w.z = cvt_pk_bf16(hv[4], hv[5]); w.w = cvt_pk_bf16(hv[6], hv[7]);
                *(u32x4*)(H + (size_t)row * 2816 + col0) = w; }
    }
};
struct EpiResid {
    static constexpr bool PERM = true, AFTER_DRAIN = false;
    const float* xin; float* xout; bf16_t* xb; float* rowss_next; float alpha;
    __device__ __forceinline__ void operator()(const f32x4 (&acc)[2][2][4][2], const Unit& u, int wr, int wc, int fr, int fq) const {
        const int row0 = u.pm * BM + wr * 64 + fr; const int col0 = u.pn * BM + wc * 32 + 8 * fq;
#pragma unroll
        for (int ai = 0; ai < 2; ++ai)
#pragma unroll
            for (int m = 0; m < 4; ++m) { const int row = row0 + ai * HALF + m * 16; float ss = 0.f;
#pragma unroll
                for (int bj = 0; bj < 2; ++bj) { const size_t off = (size_t)row * 1024 + col0 + bj * HALF;
                    const f32x4 a0 = *(const f32x4*)(xin + off), a1 = *(const f32x4*)(xin + off + 4);
                    const f32x4 v0 = a0 + acc[ai][bj][m][0] * alpha, v1 = a1 + acc[ai][bj][m][1] * alpha;
                    *(f32x4*)(xout + off) = v0; *(f32x4*)(xout + off + 4) = v1;
                    ss += (v0[0] * v0[0] + v0[1] * v0[1]) + (v0[2] * v0[2] + v0[3] * v0[3]) + (v1[0] * v1[0] + v1[1] * v1[1]) + (v1[2] * v1[2] + v1[3] * v1[3]);
                    u32x4 w; w.x = cvt_pk_bf16(v0[0], v0[1]); w.y = cvt_pk_bf16(v0[2], v0[3]); w.z = cvt_pk_bf16(v1[0], v1[1]); w.w = cvt_pk_bf16(v1[2], v1[3]);
                    *(u32x4*)(xb + off) = w; }
                ss += __shfl_xor(ss, 16); ss += __shfl_xor(ss, 32);
                if (fq == 0) rowss_next[(size_t)row * 16 + u.pn * 4 + wc] = ss; }
    }
};
struct EpiQKVU {
    static constexpr bool PERM = true, AFTER_DRAIN = false;
    bf16_t* O; const float* rowss; const float* rope;
    __device__ __forceinline__ void operator()(const f32x4 (&acc)[2][2][4][2], const Unit& u, int wr, int wc, int fr, int fq) const {
        const int row0 = u.pm * BM + wr * 64 + fr; const int col0 = u.pn * BM + wc * 32 + 8 * fq; const int sec = u.pn >> 1;
        const int j0 = 16 * (wc & 1) + 4 * fq;
#pragma unroll
        for (int ai = 0; ai < 2; ++ai)
#pragma unroll
            for (int m = 0; m < 4; ++m) { const int row = row0 + ai * HALF + m * 16; float r = rs_from_ss(rowss + (size_t)row * 16); if (sec == 0) r *= 0.125f * 1.4426950408889634f;
                f32x4 cs0 = (f32x4){1.f, 0.f, 1.f, 0.f}, cs1 = cs0;
                if (sec < 2) { const f32x4* rp = (const f32x4*)(rope + ((size_t)row * 32 + j0) * 2); cs0 = rp[0]; cs1 = rp[1]; }
#pragma unroll
                for (int bj = 0; bj < 2; ++bj) { const f32x4 v0 = acc[ai][bj][m][0] * r, v1 = acc[ai][bj][m][1] * r;
                    const float o0 = v0[0] * cs0[0] - v0[1] * cs0[1], o1 = v0[1] * cs0[0] + v0[0] * cs0[1];
                    const float o2 = v0[2] * cs0[2] - v0[3] * cs0[3], o3 = v0[3] * cs0[2] + v0[2] * cs0[3];
                    const float o4 = v1[0] * cs1[0] - v1[1] * cs1[1], o5 = v1[1] * cs1[0] + v1[0] * cs1[1];
                    const float o6 = v1[2] * cs1[2] - v1[3] * cs1[3], o7 = v1[3] * cs1[2] + v1[2] * cs1[3];
                    u32x4 w; w.x = cvt_pk_bf16(o0, o1); w.y = cvt_pk_bf16(o2, o3); w.z = cvt_pk_bf16(o4, o5); w.w = cvt_pk_bf16(o6, o7);
                    *(u32x4*)(O + (size_t)row * 2112 + col0 + bj * HALF) = w; } }
    }
};

template <class Epi, class Sched, bool ALIGN_EPI = false, bool SP2 = false>
__device__ __forceinline__ void gemm_phase(PG8_LAS unsigned char* lds, const Gemm g, const Sched& S, const Epi& E) {
    int tid_ = threadIdx.x; asm volatile("" : "+v"(tid_));
    const int tid = tid_, wid = __builtin_amdgcn_readfirstlane(tid >> 6), lane = tid & 63, wr = wid >> 2, wc = wid & 3, fr = lane & 15, fq = lane >> 4;
    const int K = g.K, nt = K / BK;
    unsigned voffA[2], voffB[2];
#pragma unroll
    for (int i = 0; i < 2; ++i) { int R, C; stage_rc(tid * 16 + i * 8192, R, C); const int Rb = Epi::PERM ? ((R & ~31) + perm32(R & 31)) : R;
        voffA[i] = (unsigned)(R * K + C) * 2u; voffB[i] = (unsigned)(Rb * K + C) * 2u; }
    const size_t kstep = (size_t)(BK * 2);
    const size_t hstep = (size_t)HALF * K * 2;
    const size_t tstep = 2 * hstep;
    const unsigned ldsw = (unsigned)wid * 1024u;
    const int aoff = lds_byte(wr * 64 + fr, fq * 8), boff = lds_byte(wc * 32 + fr, fq * 8);
#define PG8_SA(b, h) (((b) * 2 + (h)) * HTB)
#define PG8_SB(b, h) ((4 + (b) * 2 + (h)) * HTB)
#define PG8_STAGE(bufoff, gbase, voff) do { _Pragma("unroll") for (int _i = 0; _i < 2; ++_i) \
        __builtin_amdgcn_global_load_lds((const unsigned*)((const char*)(gbase) + (voff)[_i]), (PG8_LAS unsigned*)(lds + (bufoff) + ldsw + _i * 8192), 16, 0, 0); } while (0)
#define PG8_LDA(dst, b, h) do { _Pragma("unroll") for (int m = 0; m < 4; ++m) _Pragma("unroll") for (int k = 0; k < 2; ++k) dst[m][k] = *(const PG8_LAS bf16x8*)(lds + PG8_SA(b, h) + aoff + m * 2048 + k * 1024); } while (0)
#define PG8_LDB(dst, b, h) do { _Pragma("unroll") for (int n = 0; n < 2; ++n) _Pragma("unroll") for (int k = 0; k < 2; ++k) dst[n][k] = *(const PG8_LAS bf16x8*)(lds + PG8_SB(b, h) + boff + n * 2048 + k * 1024); } while (0)
#define PG8_MMA(ai, bj, At, Bt) do { __builtin_amdgcn_s_setprio(1); _Pragma("unroll") for (int m = 0; m < 4; ++m) _Pragma("unroll") for (int n = 0; n < 2; ++n) _Pragma("unroll") for (int k = 0; k < 2; ++k) \
        acc[ai][bj][m][n] = __builtin_amdgcn_mfma_f32_16x16x32_bf16(Bt[n][k], At[m][k], acc[ai][bj][m][n], 0, 0, 0); __builtin_amdgcn_s_setprio(0); } while (0)
#define PG8_WAIT_V(n) asm volatile("s_waitcnt vmcnt(" #n ")" ::: "memory")
#define PG8_WAIT_L(n) asm volatile("s_waitcnt lgkmcnt(" #n ")" ::: "memory")
#define PG8_BAR __builtin_amdgcn_s_barrier()
#define PG8_SCHED __builtin_amdgcn_sched_barrier(0)
    Unit cur, nxt; int ui = 0;
    if (!S.next(0, cur)) return;
    f32x4 acc[2][2][4][2];
#pragma unroll
    for (int a = 0; a < 2; ++a)
#pragma unroll
        for (int b = 0; b < 2; ++b)
#pragma unroll
            for (int m = 0; m < 4; ++m)
#pragma unroll
                for (int n = 0; n < 2; ++n) acc[a][b][m][n] = (f32x4){0.f, 0.f, 0.f, 0.f};
    bf16x8 At[4][2], B0[2][2], B1[2][2];
    const char* cA = (const char*)g.A + (size_t)cur.pm * tstep; const char* cB = (const char*)g.Bt + (size_t)cur.pn * tstep;
    S.a_ready(cur);
    if constexpr (SP2) {
        PG8_STAGE(PG8_SB(0, 0), cB, voffB); PG8_STAGE(PG8_SB(0, 1), cB + hstep, voffB); PG8_STAGE(PG8_SA(0, 0), cA, voffA); PG8_STAGE(PG8_SA(0, 1), cA + hstep, voffA);
        if (wr == 1) PG8_BAR;
        PG8_WAIT_V(2); PG8_BAR;
        PG8_STAGE(PG8_SB(1, 0), cB + kstep, voffB); PG8_STAGE(PG8_SA(1, 0), cA + kstep, voffA); PG8_STAGE(PG8_SB(1, 1), cB + hstep + kstep, voffB);
        PG8_WAIT_V(6); PG8_BAR;
    } else {
        PG8_STAGE(PG8_SB(0, 0), cB, voffB); PG8_STAGE(PG8_SA(0, 0), cA, voffA); PG8_STAGE(PG8_SB(0, 1), cB + hstep, voffB); PG8_STAGE(PG8_SA(0, 1), cA + hstep, voffA);
        if (wr == 1) PG8_BAR;
        PG8_WAIT_V(4); PG8_BAR;
        PG8_STAGE(PG8_SB(1, 0), cB + kstep, voffB); PG8_STAGE(PG8_SA(1, 0), cA + kstep, voffA); PG8_STAGE(PG8_SB(1, 1), cB + hstep + kstep, voffB);
        PG8_WAIT_V(6); PG8_BAR;
    }
    for (;;) {
        const bool has_next = S.next(ui + 1, nxt);
        const char* nA = has_next ? (const char*)g.A + (size_t)nxt.pm * tstep : cA; const char* nB = has_next ? (const char*)g.Bt + (size_t)nxt.pn * tstep : cB;
        for (int t = 0; t < nt; t += 2) {
            const bool last = (t == nt - 2);
            const char* a1 = cA + (size_t)(t + 1) * kstep;
            const char* a2 = last ? nA : cA + (size_t)(t + 2) * kstep; const char* b2 = last ? nB : cB + (size_t)(t + 2) * kstep;
            const char* a3 = a2 + kstep; const char* b3 = b2 + kstep;
            if (last && has_next) S.a_ready(nxt);
            if constexpr (SP2) {
            PG8_LDB(B0, 0, 0); PG8_LDB(B1, 0, 1); PG8_SCHED; PG8_LDA(At, 0, 0); PG8_STAGE(PG8_SA(1, 1), a1 + hstep, voffA);
            PG8_WAIT_V(8); PG8_WAIT_L(0); PG8_BAR; PG8_MMA(0, 0, At, B0); PG8_MMA(0, 1, At, B1); PG8_BAR; PG8_SCHED;
            PG8_LDA(At, 0, 1); PG8_STAGE(PG8_SB(0, 0), b2, voffB); PG8_STAGE(PG8_SB(0, 1), b2 + hstep, voffB); PG8_STAGE(PG8_SA(0, 0), a2, voffA);
            PG8_WAIT_V(8); PG8_WAIT_L(0); PG8_BAR; PG8_MMA(1, 0, At, B0); PG8_MMA(1, 1, At, B1); PG8_BAR; PG8_SCHED;
            PG8_LDB(B0, 1, 0); PG8_LDB(B1, 1, 1); PG8_SCHED; PG8_LDA(At, 1, 0); PG8_STAGE(PG8_SA(0, 1), a2 + hstep, voffA);
            PG8_WAIT_V(8); PG8_WAIT_L(0); PG8_BAR; PG8_MMA(0, 0, At, B0); PG8_MMA(0, 1, At, B1); PG8_BAR; PG8_SCHED;
            PG8_LDA(At, 1, 1); PG8_STAGE(PG8_SB(1, 0), b3, voffB); PG8_STAGE(PG8_SB(1, 1), b3 + hstep, voffB); PG8_STAGE(PG8_SA(1, 0), a3, voffA);
            PG8_WAIT_V(8); PG8_WAIT_L(0); PG8_BAR; PG8_MMA(1, 0, At, B0); PG8_MMA(1, 1, At, B1); PG8_BAR; PG8_SCHED;
            } else {
            PG8_LDB(B0, 0, 0); PG8_SCHED; PG8_LDA(At, 0, 0); PG8_STAGE(PG8_SA(1, 1), a1 + hstep, voffA);
            PG8_WAIT_L(8); PG8_BAR; PG8_WAIT_L(0); PG8_MMA(0, 0, At, B0); PG8_BAR; PG8_SCHED;
            PG8_LDB(B1, 0, 1); PG8_STAGE(PG8_SB(0, 0), b2, voffB);
            PG8_BAR; PG8_WAIT_L(0); PG8_MMA(0, 1, At, B1); PG8_BAR;
            PG8_LDA(At, 0, 1); PG8_STAGE(PG8_SA(0, 0), a2, voffA);
            PG8_BAR; PG8_WAIT_L(0); PG8_MMA(1, 0, At, B0); PG8_BAR; PG8_SCHED;
            PG8_STAGE(PG8_SB(0, 1), b2 + hstep, voffB);
            PG8_WAIT_V(6); PG8_BAR; PG8_MMA(1, 1, At, B1); PG8_BAR;
            PG8_LDB(B0, 1, 0); PG8_SCHED; PG8_LDA(At, 1, 0); PG8_STAGE(PG8_SA(0, 1), a2 + hstep, voffA);
            PG8_WAIT_L(8); PG8_BAR; PG8_WAIT_L(0); PG8_MMA(0, 0, At, B0); PG8_BAR; PG8_SCHED;
            PG8_LDB(B1, 1, 1); PG8_STAGE(PG8_SB(1, 0), b3, voffB);
            PG8_BAR; PG8_WAIT_L(0); PG8_MMA(0, 1, At, B1); PG8_BAR;
            PG8_LDA(At, 1, 1); PG8_STAGE(PG8_SA(1, 0), a3, voffA);
            PG8_BAR; PG8_WAIT_L(0); PG8_MMA(1, 0, At, B0); PG8_BAR; PG8_SCHED;
            PG8_STAGE(PG8_SB(1, 1), b3 + hstep, voffB);
            PG8_WAIT_V(6); PG8_BAR; PG8_MMA(1, 1, At, B1); PG8_BAR;
            }
        }
        if constexpr (ALIGN_EPI) { if (wr == 0) PG8_BAR; }
        if constexpr (!Epi::AFTER_DRAIN) { E(acc, cur, wr, wc, fr, fq); S.done(cur); }
        if (!has_next) break;
#pragma unroll
        for (int a = 0; a < 2; ++a)
#pragma unroll
            for (int b = 0; b < 2; ++b)
#pragma unroll
                for (int m = 0; m < 4; ++m)
#pragma unroll
                    for (int n = 0; n < 2; ++n) acc[a][b][m][n] = (f32x4){0.f, 0.f, 0.f, 0.f};
        cur = nxt; cA = nA; cB = nB; ++ui;
        if constexpr (ALIGN_EPI) { if (wr == 1) PG8_BAR; }
    }
    PG8_WAIT_V(0);
    if constexpr (!ALIGN_EPI) { if (wr == 0) PG8_BAR; }
    PG8_BAR;
    if constexpr (Epi::AFTER_DRAIN) { E.fused(acc, cur, wr, wc, fr, fq, lds, wid, lane); S.done(cur); }
#undef PG8_SA
#undef PG8_SB
#undef PG8_STAGE
#undef PG8_LDA
#undef PG8_LDB
#undef PG8_MMA
#undef PG8_WAIT_V
#undef PG8_WAIT_L
#undef PG8_BAR
#undef PG8_SCHED
}
}

#ifndef PG8_SP2
#define PG8_SP2 true
#endif
#ifndef PG8_ALIGN
#define PG8_ALIGN true
#endif
#include <hip/hip_bf16.h>
#include <cmath>
namespace attn_body {
using bf16=__hip_bfloat16;
using bf16x8=__attribute__((ext_vector_type(8)))short;
using s16x4=__attribute__((ext_vector_type(4)))short;
using f32x16=__attribute__((ext_vector_type(16)))float;
using u32x4=__attribute__((ext_vector_type(4)))unsigned;
constexpr int BATCH=1,NHEAD=16,SEQ=16384,D=64,DM=2112,DMO=1024;
constexpr int NW=8,NWA=4,QBLK=32,RB=2,QB=QBLK*RB*NWA,KVBLK=64,NQB=SEQ/QB;
constexpr int ATTN_PITCH=DM, ATTN_UNIT_ROWS=QB;
__device__ __forceinline__ int crow(int r,int hi){return (r&3)+8*(r>>2)+4*hi;}
#define SBAR() __builtin_amdgcn_sched_barrier(0)
__device__ __forceinline__ void cmask(f32x16&p0,f32x16&p1,int jb,int qrel,int hi){
  const float NEG=-INFINITY; int kb=64*jb+4*hi;
  #pragma unroll
  for(int r=0;r<16;++r){int kv=kb+(r&3)+8*(r>>2); if(kv>qrel)p0[r]=NEG; if(kv+32>qrel)p1[r]=NEG;}
}

constexpr int NSLOT=3, SLOTB=8192;
constexpr int NVSLOT=3, VSLOTB=16384;
constexpr int LDS_K=0, LDS_V=NSLOT*SLOTB, LDS_P=LDS_V+NVSLOT*VSLOTB, LDS_WS=LDS_P+2*RB*NWA*4096, WSF_STRIDE=256, LDS_BYTES=LDS_WS+NWA*WSF_STRIDE*4;
constexpr float C2=0.125f*1.4426950408889634f;
__device__ __forceinline__ void glds16(const void*gsrc,unsigned lds_dst){unsigned keep;
  asm volatile("s_mov_b32 %0, m0\n\ts_mov_b32 m0, %2\n\ts_nop 0\n\tglobal_load_lds_dwordx4 %1, off\n\ts_mov_b32 m0, %0":"=&s"(keep):"v"(gsrc),"s"(lds_dst):"memory");}
__device__ __forceinline__ float max3f(float a,float b,float c){float r;asm("v_max3_f32 %0, %1, %2, %3":"=v"(r):"v"(a),"v"(b),"v"(c));return r;}
__device__ __forceinline__ float max2f(float a,float b){float r;asm("v_max_f32_e32 %0, %1, %2":"=v"(r):"v"(a),"v"(b));return r;}
__device__ __forceinline__ float fadd_s(float a,float b){float r;asm("v_add_f32_e32 %0, %1, %2":"=v"(r):"v"(a),"v"(b));return r;}
__device__ __forceinline__ float fsub_s(float a,float b){float r;asm("v_sub_f32_e32 %0, %1, %2":"=v"(r):"v"(a),"v"(b));return r;}
typedef float f32x2_t __attribute__((ext_vector_type(2))); typedef __bf16 bf16x2_t __attribute__((ext_vector_type(2)));
__device__ __forceinline__ unsigned cvtpk_s(float lo,float hi){f32x2_t v={lo,hi};bf16x2_t b=__builtin_convertvector(v,bf16x2_t);return __builtin_bit_cast(unsigned,b);}
#define WAIT_BAR(N) asm volatile("s_waitcnt vmcnt(" #N ") lgkmcnt(0)\n\ts_barrier":::"memory")

__device__ __forceinline__ void qkt(f32x16&p0,f32x16&p1,const char*Kslot,const bf16x8*qr,const f32x16&negm,int r32,int hi){
  const char*kb=Kslot+hi*1024+r32*16;
  #pragma unroll
  for(int d0=0;d0<4;++d0){
    const bf16x8 b0=*reinterpret_cast<const bf16x8*>(kb+d0*2048);
    const bf16x8 b1=*reinterpret_cast<const bf16x8*>(kb+d0*2048+512);
    if(d0==0){p0=__builtin_amdgcn_mfma_f32_32x32x16_bf16(b0,qr[0],negm,0,0,0);p1=__builtin_amdgcn_mfma_f32_32x32x16_bf16(b1,qr[0],negm,0,0,0);}
    else{p0=__builtin_amdgcn_mfma_f32_32x32x16_bf16(b0,qr[d0],p0,0,0,0);p1=__builtin_amdgcn_mfma_f32_32x32x16_bf16(b1,qr[d0],p1,0,0,0);}}
}
typedef __attribute__((address_space(3))) const char* lds_cptr;
typedef short v4i16_t __attribute__((ext_vector_type(4)));
__device__ __forceinline__ void kload8(bf16x8*kf,lds_cptr kp){
  kf[0]=*(const __attribute__((address_space(3))) bf16x8*)(kp);      kf[1]=*(const __attribute__((address_space(3))) bf16x8*)(kp+512);
  kf[2]=*(const __attribute__((address_space(3))) bf16x8*)(kp+2048); kf[3]=*(const __attribute__((address_space(3))) bf16x8*)(kp+2560);
  kf[4]=*(const __attribute__((address_space(3))) bf16x8*)(kp+4096); kf[5]=*(const __attribute__((address_space(3))) bf16x8*)(kp+4608);
  kf[6]=*(const __attribute__((address_space(3))) bf16x8*)(kp+6144); kf[7]=*(const __attribute__((address_space(3))) bf16x8*)(kp+6656);
}
__device__ __forceinline__ void kload2(bf16x8*kf,lds_cptr kp,int j){ kf[2*j]=*(const __attribute__((address_space(3))) bf16x8*)(kp+j*2048); kf[2*j+1]=*(const __attribute__((address_space(3))) bf16x8*)(kp+j*2048+512); }
__device__ __forceinline__ s16x4 vtr(lds_cptr p){ return __builtin_bit_cast(s16x4,__builtin_amdgcn_ds_read_tr16_b64_v4i16((__attribute__((address_space(3))) v4i16_t*)p)); }
__device__ __forceinline__ float rowmax(const f32x16&p0,const f32x16&p1){
  float a=max3f(p0[0],p0[1],p1[0]),b=max3f(p0[2],p0[3],p1[1]);a=max3f(a,p1[2],p1[3]);
  #pragma unroll
  for(int r=4;r<16;r+=4){a=max3f(a,p0[r],p0[r+1]);b=max3f(b,p0[r+2],p0[r+3]);a=max3f(a,p1[r],p1[r+1]);b=max3f(b,p1[r+2],p1[r+3]);}
  const float m=max2f(a,b);
  auto rr=__builtin_amdgcn_permlane32_swap(__float_as_uint(m),__float_as_uint(m),false,false);
  return max2f(__uint_as_float(rr[0]),__uint_as_float(rr[1]));
}
__device__ __forceinline__ void pv(f32x16*o,int vb,bf16x8 pa0,bf16x8 pa1,bf16x8 pa2,bf16x8 pa3){
  #pragma unroll
  for(int d0=0;d0<2;++d0){s16x4 lo[4],hi[4];
    #pragma unroll
    for(int ks=0;ks<4;++ks){
      asm volatile("ds_read_b64_tr_b16 %0,%1 offset:%c2":"=&v"(lo[ks]):"v"(vb),"i"(d0*4096+ks*1024):"memory");
      asm volatile("ds_read_b64_tr_b16 %0,%1 offset:%c2":"=&v"(hi[ks]):"v"(vb),"i"(d0*4096+ks*1024+512):"memory");}
    asm volatile("s_waitcnt lgkmcnt(0)":::"memory");SBAR();
    #define PK(k) (bf16x8){lo[k][0],lo[k][1],lo[k][2],lo[k][3],hi[k][0],hi[k][1],hi[k][2],hi[k][3]}
    o[d0]=__builtin_amdgcn_mfma_f32_32x32x16_bf16(pa0,PK(0),o[d0],0,0,0);
    o[d0]=__builtin_amdgcn_mfma_f32_32x32x16_bf16(pa1,PK(1),o[d0],0,0,0);
    o[d0]=__builtin_amdgcn_mfma_f32_32x32x16_bf16(pa2,PK(2),o[d0],0,0,0);
    o[d0]=__builtin_amdgcn_mfma_f32_32x32x16_bf16(pa3,PK(3),o[d0],0,0,0);
    #undef PK
  }
}

#ifndef ATTN_STORE16
#define ATTN_STORE16(p,v) (*(u32x4*)(p)=(v))
#endif
template<int THRL> __device__ __forceinline__ void attn_unit(int qb,const bf16*Q,const bf16*__restrict__ K,const bf16*__restrict__ V,bf16*O,char*shm){
  int tid_=threadIdx.x; asm volatile("":"+v"(tid_)); const int tid=tid_,lane=tid&63,r32=lane&31,hi=lane>>5; const int wid=__builtin_amdgcn_readfirstlane(tid>>6);
  const int q0=qb*QB; const int wa=wid&3; const bool roleA=wid<NWA;
  const unsigned lds0=(unsigned)(uintptr_t)shm;
  float*wsf=(float*)(shm+LDS_WS)+wa*WSF_STRIDE;
  const bf16*ksrc=K+(long)lane*DM+wid*8;
  const bf16*vsrc=V+(long)(16*(wid&3)+(lane>>2))*DM+(wid>>2)*32+(lane&3)*8;
  const unsigned kdst=lds0+LDS_K+wid*1024, vdst=lds0+LDS_V+wid*1024;
  #define DMA_K(t,s3) glds16(ksrc+(long)(t)*KVBLK*DM,(unsigned)__builtin_amdgcn_readfirstlane(kdst+(s3)*SLOTB))
  #define DMA_V(t,s3) do{ const unsigned vd_=(unsigned)__builtin_amdgcn_readfirstlane(vdst+(s3)*VSLOTB); glds16(vsrc+(long)(t)*KVBLK*DM,vd_); glds16(vsrc+(long)(t)*KVBLK*DM+64,(unsigned)__builtin_amdgcn_readfirstlane(vd_+8192)); }while(0)
  const lds_cptr shm3=(lds_cptr)shm;
  typedef __attribute__((address_space(3))) char* lds_wptr; typedef __attribute__((address_space(3))) u32x4 lds_u32x4;
  const int NT=(q0+QB)/KVBLK;
  DMA_K(0,0);DMA_V(0,0);DMA_K(1,1);
  int c0=0,c1=1,c2=2;
  #define ROT3() do{ const int x_=c0; c0=c1; c1=c2; c2=x_; }while(0)
  #define PKW(P,B) cvtpk_s(P[B],P[B+1])
  #define MX3(a,b,c) __builtin_fmaxf(__builtin_fmaxf((a),(b)),(c))
  if(roleA){
    const bf16*Qw=Q+(long)(q0+wa*(QBLK*RB))*DM;
    bf16x8 qr[RB][4];
    #pragma unroll
    for(int rb=0;rb<RB;++rb)
      #pragma unroll
      for(int d0=0;d0<4;++d0)qr[rb][d0]=*reinterpret_cast<const bf16x8*>(&Qw[(long)(rb*QBLK+r32)*DM+d0*16+hi*8]);
    float mhat[RB],l_reg[RB]; f32x16 negm[RB];
    #pragma unroll
    for(int rb=0;rb<RB;++rb){mhat[rb]=0.f;l_reg[rb]=0.f;negm[rb]=f32x16{};}
    const lds_wptr pwr0=(lds_wptr)shm+LDS_P+wa*(2*RB*4096)+lane*16;
    const lds_cptr kp0=shm3+LDS_K+hi*1024+r32*16;
    WAIT_BAR(3);
    for(int t=0;t<NT;++t){
      if(t+2<NT)DMA_K(t+2,c2); if(t+1<NT)DMA_V(t+1,c1);
      bf16x8 kf[8]; kload8(kf,kp0+c0*SLOTB); SBAR();
      #pragma unroll
      for(int rb=0;rb<RB;++rb){
        f32x16 C0,C1;
        C0=__builtin_amdgcn_mfma_f32_32x32x16_bf16(kf[0],qr[rb][0],negm[rb],0,0,0); C1=__builtin_amdgcn_mfma_f32_32x32x16_bf16(kf[1],qr[rb][0],negm[rb],0,0,0);
        C0=__builtin_amdgcn_mfma_f32_32x32x16_bf16(kf[2],qr[rb][1],C0,0,0,0);       C1=__builtin_amdgcn_mfma_f32_32x32x16_bf16(kf[3],qr[rb][1],C1,0,0,0);
        C0=__builtin_amdgcn_mfma_f32_32x32x16_bf16(kf[4],qr[rb][2],C0,0,0,0);       C1=__builtin_amdgcn_mfma_f32_32x32x16_bf16(kf[5],qr[rb][2],C1,0,0,0);
        C0=__builtin_amdgcn_mfma_f32_32x32x16_bf16(kf[6],qr[rb][3],C0,0,0,0);       C1=__builtin_amdgcn_mfma_f32_32x32x16_bf16(kf[7],qr[rb][3],C1,0,0,0);
        { const int jb_=t-(NT-4); if(jb_>=0)cmask(C0,C1,jb_,wa*(QBLK*RB)+rb*QBLK+r32,hi); }
        float a=MX3(C0[0],C0[1],C1[0]),b=MX3(C0[2],C0[3],C1[1]); a=MX3(a,C1[2],C1[3]);
        #pragma unroll
        for(int r=4;r<16;r+=4){a=MX3(a,C0[r],C0[r+1]);b=MX3(b,C0[r+2],C0[r+3]);a=MX3(a,C1[r],C1[r+1]);b=MX3(b,C1[r+2],C1[r+3]);}
        float rm=__builtin_fmaxf(a,b); { auto rr=__builtin_amdgcn_permlane32_swap(__float_as_uint(rm),__float_as_uint(rm),false,false); rm=__builtin_fmaxf(__uint_as_float(rr[0]),__uint_as_float(rr[1])); }
        bool resc=false;
        if(t==0 || __any(rm>(float)THRL)){
          const float dl=(t==0)?rm:__builtin_fmaxf(rm,0.f); mhat[rb]+=dl;
          #pragma unroll
          for(int r=0;r<16;++r){C0[r]-=dl;C1[r]-=dl;}
          #pragma unroll
          for(int r=0;r<16;++r)negm[rb][r]=-mhat[rb];
          if(t!=0){ const float f=__builtin_amdgcn_exp2f(-dl); l_reg[rb]*=f; if(hi==0)wsf[64+((t&1)*RB+rb)*32+r32]=f; resc=true; } }
        if(lane==0)wsf[192+(t&1)*RB+rb]=resc?1.0f:0.0f;
        #pragma unroll
        for(int r=0;r<16;++r){C0[r]=__builtin_amdgcn_exp2f(C0[r]);C1[r]=__builtin_amdgcn_exp2f(C1[r]);}
        { float s0=C0[0]+C0[1],s1=C1[0]+C1[1];
          #pragma unroll
          for(int r=2;r<16;++r){s0+=C0[r];s1+=C1[r];}
          l_reg[rb]+=s0+s1; }
        { const u32x4 pw0=(u32x4){PKW(C0,0),PKW(C0,2),PKW(C0,4),PKW(C0,6)},pw1=(u32x4){PKW(C0,8),PKW(C0,10),PKW(C0,12),PKW(C0,14)},pw2=(u32x4){PKW(C1,0),PKW(C1,2),PKW(C1,4),PKW(C1,6)},pw3=(u32x4){PKW(C1,8),PKW(C1,10),PKW(C1,12),PKW(C1,14)};
          const lds_wptr pp_=pwr0+((t&1)*RB+rb)*4096; *(lds_u32x4*)(pp_)=pw0; *(lds_u32x4*)(pp_+1024)=pw1; *(lds_u32x4*)(pp_+2048)=pw2; *(lds_u32x4*)(pp_+3072)=pw3; }
        if(t==NT-1){ auto rr=__builtin_amdgcn_permlane32_swap(__float_as_uint(l_reg[rb]),__float_as_uint(l_reg[rb]),false,false); const float lt=__uint_as_float(rr[0])+__uint_as_float(rr[1]); if(hi==0)wsf[rb*32+r32]=lt; }
      }
      if(t+2<NT){WAIT_BAR(3);}else if(t+1<NT){WAIT_BAR(2);}else{WAIT_BAR(0);}
      ROT3();
    }
  } else {
    f32x16 o[RB][4];
    #pragma unroll
    for(int rb=0;rb<RB;++rb){o[rb][0]=f32x16{};o[rb][1]=f32x16{};o[rb][2]=f32x16{};o[rb][3]=f32x16{};}
    const lds_cptr prd0=shm3+LDS_P+wa*(2*RB*4096)+lane*16;
    const lds_cptr vp0=shm3+LDS_V+((lane>>4)&1)*32+(lane&3)*8+(4*hi+((lane&15)>>2))*64;
    #define CONSUME(tt,vs3) do{ const int par_=(tt)&1; \
      _Pragma("unroll") for(int rb=0;rb<RB;++rb){ if(wsf[192+par_*RB+rb]!=0.0f){ _Pragma("unroll") for(int d_=0;d_<4;++d_) _Pragma("unroll") for(int r=0;r<16;++r)o[rb][d_][r]*=wsf[64+(par_*RB+rb)*32+crow(r,hi)]; } } \
      const lds_cptr pp_=prd0+par_*(RB*4096); const lds_cptr vp_=vp0+(vs3)*VSLOTB; \
      _Pragma("unroll") for(int h_=0;h_<2;++h_){ bf16x8 pa_[RB][2]; s16x4 vl_[8],vh_[8]; \
        _Pragma("unroll") for(int k2_=0;k2_<2;++k2_){ const int k_=2*h_+k2_; \
          _Pragma("unroll") for(int rb=0;rb<RB;++rb)pa_[rb][k2_]=*(const __attribute__((address_space(3))) bf16x8*)(pp_+rb*4096+k_*1024); \
          _Pragma("unroll") for(int d_=0;d_<4;++d_){ vl_[d_*2+k2_]=vtr(vp_+(d_*4096+k_*1024)); vh_[d_*2+k2_]=vtr(vp_+(d_*4096+k_*1024+512)); } } \
        SBAR(); \
        _Pragma("unroll") for(int k2_=0;k2_<2;++k2_) _Pragma("unroll") for(int d_=0;d_<4;++d_){ const int i_=d_*2+k2_; const bf16x8 vf_=(bf16x8){vl_[i_][0],vl_[i_][1],vl_[i_][2],vl_[i_][3],vh_[i_][0],vh_[i_][1],vh_[i_][2],vh_[i_][3]}; \
          _Pragma("unroll") for(int rb=0;rb<RB;++rb)o[rb][d_]=__builtin_amdgcn_mfma_f32_32x32x16_bf16(pa_[rb][k2_],vf_,o[rb][d_],0,0,0); } \
        SBAR(); } }while(0)
    WAIT_BAR(3);
    for(int t=0;t<NT;++t){
      if(t+2<NT)DMA_K(t+2,c2); if(t+1<NT)DMA_V(t+1,c1);
      if(t>=1)CONSUME(t-1,c2);
      if(t+2<NT){WAIT_BAR(3);}else if(t+1<NT){WAIT_BAR(2);}else{WAIT_BAR(0);}
      ROT3();
    }
    CONSUME(NT-1,c2);
    bf16*Ow=O+(long)(q0+wa*(QBLK*RB))*DMO;
    { bf16*stg=(bf16*)(shm+LDS_P)+wa*(RB*4096);
      asm volatile("s_waitcnt lgkmcnt(0)":::"memory");
      #pragma unroll
      for(int rb=0;rb<RB;++rb){
        #pragma unroll
        for(int r=0;r<16;++r){const int orow=rb*32+crow(r,hi); const float rl=__builtin_amdgcn_rcpf(wsf[orow]);
          #pragma unroll
          for(int d0=0;d0<4;++d0)stg[orow*128+d0*32+r32]=__float2bfloat16(o[rb][d0][r]*rl);} }
      asm volatile("s_waitcnt lgkmcnt(0)":::"memory");
      #pragma unroll
      for(int i=0;i<16;++i){const int row=i*4+(lane>>4),ch=lane&15; const u32x4 v=*(const u32x4*)(stg+row*128+ch*8); ATTN_STORE16(Ow+(long)row*DMO+ch*8,v);} }
    #undef CONSUME
  }
  asm volatile("s_waitcnt lgkmcnt(0)\n\ts_barrier":::"memory");
  #undef DMA_K
  #undef DMA_V
  #undef ROT3
  #undef PKW
  #undef MX3
}
constexpr int ATTN_LDS_BYTES=LDS_BYTES;
struct AttnTensors { const bf16* Q; const bf16* K; const bf16* V; bf16* O; };
struct AttnUnit { int hc; int qb; };
struct StaticOrder {
  int vcu, G, bx;
  __device__ __forceinline__ StaticOrder(int grid,int block):vcu((grid%8==0)?(block%8)*(grid/8)+block/8:block),G(grid),bx(block){}
  __device__ __forceinline__ bool next(int i,AttnUnit&u)const{
    if(G==256){ if(i>=2)return false; const int s=vcu&31; u.hc=vcu>>5; u.qb=(i==0)?63-s:s; return true; }
    const int idx=i*G+bx; if(idx>=8*NQB)return false; u.hc=idx&7; u.qb=NQB-1-(idx>>3); return true; }
};
template<class Sched,int THRL=8> __device__ __forceinline__ void attn_phase(char*lds,const AttnTensors&T,const Sched&S){
  AttnUnit u;
  for(int i=0;S.next(i,u);++i){ const int h=u.hc>>1,c=u.hc&1;
    attn_unit<THRL>(u.qb,T.Q+h*128+c*64,T.K+h*128+c*64,T.V+h*128,T.O+u.hc*128,lds); }
}
#undef SBAR
#undef WAIT_BAR
}
constexpr int NWAVES = 8;
constexpr int M = 16384, D = 1024, FF = 2816, NGU = 2 * FF, NIN = 2048, DEPTH = 4;
constexpr size_t MiB = 1u << 20;
constexpr size_t WS_ROWSS = 1 * MiB;
constexpr size_t WS_ROPE = 2 * MiB;
constexpr size_t WS_XB = 8 * MiB;
constexpr size_t WS_H = 40 * MiB;
constexpr size_t WS_QKVU = 40 * MiB;
constexpr size_t WS_OBUF = 108 * MiB;
constexpr size_t WS_CAT = 140 * MiB;
constexpr size_t WS_W = 172 * MiB;
constexpr size_t OFF_GU1 = 0, OFF_DN1 = 11 * MiB, OFF_IN = 16 * MiB + 512 * 1024, OFF_OUT = 20 * MiB + 512 * 1024, OFF_GU2 = 22 * MiB + 512 * 1024, OFF_DN2 = 33 * MiB + 512 * 1024, W_LAYER = 39 * MiB;
constexpr size_t WS_END = WS_W + DEPTH * W_LAYER;
static_assert(attn_body::ATTN_LDS_BYTES <= 147392 && (size_t)NGU * D * 2 == 11 * MiB && (size_t)D * FF * 2 == 5 * MiB + 512 * 1024 && WS_H + (size_t)M * FF * 2 <= WS_CAT && WS_ROWSS + 16 * (size_t)M * 4 <= WS_ROPE && WS_ROPE + (size_t)M * 64 * 4 <= WS_XB, "ws map");
constexpr int LDS_BYTES = 147456;

#define LAS __attribute__((address_space(3)))
typedef unsigned short bf16;
typedef unsigned v4u __attribute__((ext_vector_type(4)));
typedef unsigned v2u __attribute__((ext_vector_type(2)));
typedef float f32x4 __attribute__((ext_vector_type(4)));
#define LDS_WAIT() asm volatile("s_waitcnt lgkmcnt(0)" ::: "memory")
__device__ __forceinline__ unsigned f2bf(float f) { unsigned u = __builtin_bit_cast(unsigned, f); return (u + 0x7fffu + ((u >> 16) & 1u)) >> 16; }
__device__ __forceinline__ unsigned pk2(float lo, float hi) { return f2bf(lo) | (f2bf(hi) << 16); }
__device__ __forceinline__ float bflo(unsigned w) { return __builtin_bit_cast(float, w << 16); }
__device__ __forceinline__ float bfhi(unsigned w) { return __builtin_bit_cast(float, w & 0xffff0000u); }
__device__ __forceinline__ float wave_sum(float v) {
#pragma unroll
    for (int o = 1; o < 64; o <<= 1) v += __shfl_xor(v, o);
    return v;
}
__device__ __forceinline__ void tr_item(const float* W, int N, int k0, int n0, const float* gk, bf16* WT, int Kd, int rbase, int rstride, int lane) {
    const int kblk = lane & 7, n4 = lane >> 3;
    const float* src = W + (size_t)(k0 + 8 * kblk) * N + n0 + 4 * n4;
    f32x4 v[8];
#pragma unroll
    for (int i = 0; i < 8; ++i) v[i] = __builtin_nontemporal_load((const f32x4*)(src + (size_t)i * N));
    if (gk) { const f32x4 g0 = *(const f32x4*)(gk + k0 + 8 * kblk), g1 = *(const f32x4*)(gk + k0 + 8 * kblk + 4);
#pragma unroll
        for (int i = 0; i < 4; ++i) { v[i] = v[i] * g0[i]; v[4 + i] = v[4 + i] * g1[i]; } }
#pragma unroll
    for (int e = 0; e < 4; ++e) { v4u o; o.x = pk2(v[0][e], v[1][e]); o.y = pk2(v[2][e], v[3][e]); o.z = pk2(v[4][e], v[5][e]); o.w = pk2(v[6][e], v[7][e]);
        *(v4u*)(WT + (size_t)(rbase + (4 * n4 + e) * rstride) * Kd + k0 + 8 * kblk) = o; }
}

#define XB_TMO      128
#define XB_XCNT(j)  (256  + 64 * (j))
#define XB_XSUB(j)  (1280 + 64 * (j))
#define XB_XGEN(j)  (2304 + 64 * (j))
#define XB_TOP      3328
#define XB_TOPGEN   3392
#define XCD_BAR_WORDS 3456
#define XB_SPIN_CAP (1u << 18)

__device__ __forceinline__ unsigned xb_ld(unsigned* p)              { return __hip_atomic_load(p, __ATOMIC_RELAXED, __HIP_MEMORY_SCOPE_AGENT); }
__device__ __forceinline__ unsigned xb_add(unsigned* p, unsigned v) { return __hip_atomic_fetch_add(p, v, __ATOMIC_RELAXED, __HIP_MEMORY_SCOPE_AGENT); }
__device__ __forceinline__ unsigned xb_xcc_id() { return (unsigned)__builtin_amdgcn_s_getreg((3 << 11) | 20) & 0xFu; }
#define XB_SPIN(cond, bar) do { unsigned _sp = 0; while (cond) { __builtin_amdgcn_s_sleep(1); \
    if ((++_sp & 255u) == 0u) { if (xb_ld(&(bar)[XB_TMO])) break; if (_sp > XB_SPIN_CAP) { atomicAdd(&(bar)[XB_TMO], 1u); break; } } } } while (0)

struct XcdBarrier {
    unsigned* bar; unsigned x;
    volatile LAS unsigned* st;
};

__device__ __forceinline__ XcdBarrier xcd_barrier_post(unsigned* bar, volatile LAS unsigned* st) {
    XcdBarrier b; b.bar = bar; b.x = xb_xcc_id(); b.st = st;
    if (threadIdx.x == 0) (void)xb_add(&bar[XB_XCNT(b.x)], 1u);
    return b;
}
__device__ __forceinline__ void xcd_barrier_complete(unsigned* bar, unsigned x, unsigned& nloc, unsigned& nx) {
    const unsigned G = gridDim.x * gridDim.y * gridDim.z;
    unsigned sum, cnt, mine, sp = 0u;
    for (;;) {
        sum = 0u; cnt = 0u; mine = 0u;
#pragma unroll
        for (unsigned j = 0; j < 16; ++j) { const unsigned c = xb_ld(&bar[XB_XCNT(j)]); sum += c; cnt += (c > 0u) ? 1u : 0u; mine = (j == x) ? c : mine; }
        if (sum == G) break;
        __builtin_amdgcn_s_sleep(1);
        if ((++sp & 255u) == 0u) { if (xb_ld(&bar[XB_TMO])) break; if (sp > XB_SPIN_CAP) { atomicAdd(&bar[XB_TMO], 1u); break; } }
    }
    nloc = mine > 0u ? mine : 1u; nx = cnt > 0u ? cnt : 1u;
}

__device__ __forceinline__ void xcd_barrier(const XcdBarrier& b) {
    asm volatile("s_waitcnt vmcnt(0)" ::: "memory");
    __syncthreads();
    if (threadIdx.x == 0) {
        unsigned* bar = b.bar;
        __builtin_amdgcn_s_waitcnt(0);
        unsigned nloc = b.st[0], nx = b.st[1];
        if (nloc == 0u) { xcd_barrier_complete(bar, b.x, nloc, nx); b.st[0] = nloc; b.st[1] = nx; }
        const unsigned old = xb_add(&bar[XB_XSUB(b.x)], 1u);
        const unsigned gen = old / nloc;
        if (old + 1u == (gen + 1u) * nloc) {
            __builtin_amdgcn_fence(__ATOMIC_RELEASE, "agent");
            asm volatile("s_waitcnt vmcnt(0)" ::: "memory");
            const unsigned og = xb_add(&bar[XB_TOP], 1u);
            const unsigned tg = og / nx;
            if (og + 1u == (tg + 1u) * nx) xb_add(&bar[XB_TOPGEN], 1u);
            else XB_SPIN(xb_ld(&bar[XB_TOPGEN]) == tg, bar);
            __builtin_amdgcn_fence(__ATOMIC_ACQUIRE, "agent");
            xb_add(&bar[XB_XGEN(b.x)], 1u);
            asm volatile("s_waitcnt vmcnt(0)" ::: "memory");
        } else {
            XB_SPIN(xb_ld(&bar[XB_XGEN(b.x)]) == gen, bar);
            __builtin_amdgcn_fence(__ATOMIC_ACQUIRE, "agent");
            asm volatile("s_waitcnt vmcnt(0)" ::: "memory");
        }
    }
    __syncthreads();
}

struct Args { const float* in[20]; float* out; unsigned char* wsp; };
typedef __attribute__((address_space(1))) unsigned char* gptr_t;
__device__ __forceinline__ gptr_t fresh_ptr(unsigned char* p) { asm volatile("" : "+s"(p)); return (gptr_t)p; }

__global__ void __launch_bounds__(NWAVES * 64, 2) hymba_fwd(Args args) {
    extern __shared__ __attribute__((aligned(16))) unsigned char lds[];
    LAS unsigned char* L = (LAS unsigned char*)lds;
    const int tid = threadIdx.x, lane = tid & 63, wave = __builtin_amdgcn_readfirstlane(tid >> 6);
    const int G = gridDim.x, bx = blockIdx.x;
    const int gw = bx * NWAVES + wave, NGW = G * NWAVES;
    const int gtid = bx * (NWAVES * 64) + tid, NT = G * NWAVES * 64;
#define ws (fresh_ptr(args.wsp))
#define rowss ((float*)(unsigned char*)(ws + WS_ROWSS))
#define rope ((float*)(unsigned char*)(ws + WS_ROPE))
#define XB ((bf16*)(unsigned char*)(ws + WS_XB))
#define HB ((bf16*)(unsigned char*)(ws + WS_H))
#define QKVU ((bf16*)(unsigned char*)(ws + WS_QKVU))
#define OBUF ((bf16*)(unsigned char*)(ws + WS_OBUF))
#define CAT ((bf16*)(unsigned char*)(ws + WS_CAT))
#define xout ((float*)(unsigned char*)fresh_ptr((unsigned char*)args.out))
    { volatile LAS unsigned* st0 = (volatile LAS unsigned*)(L + 147392); if (tid < 2) st0[tid] = 0u; }
    __syncthreads();
    const XcdBarrier gbar = xcd_barrier_post((unsigned*)args.wsp, (volatile LAS unsigned*)(L + 147392));

    {
        constexpr int IT_G = 16 * 88, IT_D = 44 * 32, IT_IN = 16 * 64, IT_OUT = 8 * 32, IT_LAYER = 4 * IT_G + 2 * IT_D + IT_IN + IT_OUT;
        static_assert(IT_G == IT_D, "item decode");
        for (int it = gw; it < DEPTH * IT_LAYER; it += NGW) {
            const int l = it / IT_LAYER; int r = it % IT_LAYER; unsigned char* wl = (unsigned char*)(ws + WS_W + (size_t)l * W_LAYER);
            if (r < 6 * IT_G) {
                const int f = r / (3 * IT_G), q = r % (3 * IT_G), kind = q / IT_G, i = q % IT_G;
                if (kind < 2) { const float* W = args.in[(f ? 16 : 2) + kind] + (size_t)l * D * FF; const int kb = i / 88, nb = i % 88, n0 = 32 * nb;
                    tr_item(W, FF, 64 * kb, n0, args.in[f ? 15 : 1] + l * D, (bf16*)(wl + (f ? OFF_GU2 : OFF_GU1)), D, (n0 >> 7) * 256 + kind * 128 + (n0 & 127), 1, lane); }
                else { const float* W = args.in[f ? 18 : 4] + (size_t)l * FF * D; const int kb = i / 32, nb = i % 32;
                    tr_item(W, D, 64 * kb, 32 * nb, nullptr, (bf16*)(wl + (f ? OFF_DN2 : OFF_DN1)), FF, 32 * nb, 1, lane); }
            } else { r -= 6 * IT_G;
                if (r < IT_IN) { const float* W = args.in[6] + (size_t)l * D * NIN; const int kb = r / 64, nb = r % 64, n0 = 32 * nb; int rbase = n0, rstride = 1;
                    if (n0 < 1024) { const int d0 = n0 & 63; rbase = (n0 - d0) + (d0 ? 1 : 0); rstride = 2; }
                    tr_item(W, NIN, 64 * kb, n0, args.in[5] + l * D, (bf16*)(wl + OFF_IN), D, rbase, rstride, lane); }
                else { r -= IT_IN; const float* W = args.in[14] + (size_t)l * D * D; const int kb = r / 32, nb = r % 32;
                    tr_item(W, D, 64 * kb, 32 * nb, nullptr, (bf16*)(wl + OFF_OUT), D, 32 * nb, 1, lane); }
            }
        }
        for (int it = gw; it < DEPTH * 1024; it += NGW) {
            const int l = it >> 10, r = it & 1023, g = r >> 8, cb = (r >> 4) & 15, nb = r & 15, c0 = cb * 8, n = nb * 64 + lane;
            const float* pw = args.in[12] + ((size_t)(l * 4 + g) * 128 + c0) * 128; const float* ps = args.in[13] + l * 512 + g * 128;
            const float* wo = args.in[14] + (size_t)l * D * D + (size_t)(512 + g * 128) * D + n;
            float a[8];
#pragma unroll
            for (int j = 0; j < 8; ++j) a[j] = 0.f;
            for (int e = 0; e < 128; ++e) { const float w = wo[(size_t)e * D] * ps[e];
#pragma unroll
                for (int j = 0; j < 8; ++j) a[j] += pw[j * 128 + e] * w; }
            v4u o; o.x = pk2(a[0], a[1]); o.y = pk2(a[2], a[3]); o.z = pk2(a[4], a[5]); o.w = pk2(a[6], a[7]);
            *(v4u*)((bf16*)(unsigned char*)(ws + WS_W + (size_t)l * W_LAYER + OFF_OUT) + (size_t)n * D + 512 + g * 128 + c0) = o;
        }
        for (int i = gtid; i < M * 32; i += NT) { const int s = i >> 5, j = i & 31; const float inv = (float)pow(10000.0, -(double)j / 32.0); const float ang = (float)s * inv;
            const double a = (double)ang; rope[2 * i] = (float)cos(a); rope[2 * i + 1] = (float)sin(a); }
        for (int m = gw; m < M; m += NGW) { const f32x4* xr = (const f32x4*)(args.in[0] + (size_t)m * D) + lane; f32x4 v[4]; float s = 0.f;
#pragma unroll
            for (int j = 0; j < 4; ++j) { v[j] = xr[64 * j]; s += (v[j].x * v[j].x + v[j].y * v[j].y) + (v[j].z * v[j].z + v[j].w * v[j].w); }
            s = wave_sum(s); if (lane < 16) rowss[(size_t)m * 16 + lane] = (lane == 0) ? s : 0.f;
            v2u* o8 = (v2u*)(XB + (size_t)m * D) + lane;
#pragma unroll
            for (int j = 0; j < 4; ++j) { v2u w; w.x = pk2(v[j].x, v[j].y); w.y = pk2(v[j].z, v[j].w); o8[64 * j] = w; } }
    }
    cg::this_grid().sync();


    for (int step = 0; step < 3 * DEPTH; ++step) {
        const int l = step / 3, kind = step % 3;
#define wl ((unsigned char*)(ws + WS_W + (size_t)l * W_LAYER))
        if (kind != 1) {
            const int f = kind >> 1;
            { pg8::Gemm g{XB, (const bf16*)(wl + (f ? OFF_GU2 : OFF_GU1)), M, NGU, D}; pg8::StaticOrder S; S.init(M, NGU, G, bx);
              pg8::EpiGateUp E{HB, rowss};
              pg8::gemm_phase<pg8::EpiGateUp, pg8::StaticOrder, PG8_ALIGN, PG8_SP2>(L, g, S, E); }
            xcd_barrier(gbar);
            { pg8::Gemm g{HB, (const bf16*)(wl + (f ? OFF_DN2 : OFF_DN1)), M, D, FF}; pg8::StaticOrder S; S.init(M, D, G, bx);
              pg8::EpiResid E{(const float*)(unsigned char*)fresh_ptr((unsigned char*)((step == 0) ? args.in[0] : args.out)), xout, XB, rowss, 0.5f};
              pg8::gemm_phase<pg8::EpiResid, pg8::StaticOrder, PG8_ALIGN, PG8_SP2>(L, g, S, E); }
            xcd_barrier(gbar);
        } else {
            { pg8::Gemm g{XB, (const bf16*)(wl + OFF_IN), M, NIN, D}; pg8::StaticOrder S; S.init(M, NIN, G, bx);
              pg8::EpiQKVU E{QKVU, rowss, rope};
              pg8::gemm_phase<pg8::EpiQKVU, pg8::StaticOrder, PG8_ALIGN, PG8_SP2>(L, g, S, E); }
            xcd_barrier(gbar);
            { const attn_body::AttnTensors AT{(const attn_body::bf16*)QKVU, (const attn_body::bf16*)(QKVU + 512), (const attn_body::bf16*)(QKVU + 1024), (attn_body::bf16*)OBUF};
              const attn_body::StaticOrder S(G, bx);
              attn_body::attn_phase<attn_body::StaticOrder>((char*)lds, AT, S); }
            xcd_barrier(gbar);
            {
                const float li = 0.8f - 0.6f * expf(-0.3f * (float)l);
                const float s1 = wave_sum(args.in[7][l * 64 + lane] * args.in[8][l * 64 + lane]), s2 = wave_sum(args.in[9][l * 64 + lane] * args.in[10][l * 64 + lane]);
                const float lam = expf(s1) - expf(s2) + li;
                const int hd = lane >> 4, j0 = (lane & 15) * 8;
                float gn[8];
#pragma unroll
                for (int j = 0; j < 8; ++j) gn[j] = args.in[11][l * 128 + j0 + j] * (1.0f - li);
                const int win = 2 << hd;
                for (int m = gw; m < M; m += NGW) {
                    const v4u a = *(const v4u*)(OBUF + (size_t)m * 1024 + hd * 256 + j0), b = *(const v4u*)(OBUF + (size_t)m * 1024 + hd * 256 + 128 + j0);
                    float o[8];
                    o[0] = bflo(a.x) - lam * bflo(b.x); o[1] = bfhi(a.x) - lam * bfhi(b.x); o[2] = bflo(a.y) - lam * bflo(b.y); o[3] = bfhi(a.y) - lam * bfhi(b.y);
                    o[4] = bflo(a.z) - lam * bflo(b.z); o[5] = bfhi(a.z) - lam * bfhi(b.z); o[6] = bflo(a.w) - lam * bflo(b.w); o[7] = bfhi(a.w) - lam * bfhi(b.w);
                    float ss = 0.f;
#pragma unroll
                    for (int j = 0; j < 8; ++j) ss += o[j] * o[j];
                    ss += __shfl_xor(ss, 1); ss += __shfl_xor(ss, 2); ss += __shfl_xor(ss, 4); ss += __shfl_xor(ss, 8);
                    const float rr = __builtin_amdgcn_rsqf(ss * (1.0f / 128.0f) + 1e-6f);
                    v4u w; w.x = pk2(o[0] * rr * gn[0], o[1] * rr * gn[1]); w.y = pk2(o[2] * rr * gn[2], o[3] * rr * gn[3]); w.z = pk2(o[4] * rr * gn[4], o[5] * rr * gn[5]); w.w = pk2(o[6] * rr * gn[6], o[7] * rr * gn[7]);
                    *(v4u*)(CAT + (size_t)m * 1024 + hd * 128 + j0) = w;
                    const bf16* up = QKVU + (size_t)m * 2112 + 1536 + hd * 128 + j0;
                    const v4u u0 = *(const v4u*)up;
                    float sm[8] = {bflo(u0.x), bfhi(u0.x), bflo(u0.y), bfhi(u0.y), bflo(u0.z), bfhi(u0.z), bflo(u0.w), bfhi(u0.w)};
                    float us[8];
#pragma unroll
                    for (int j = 0; j < 8; ++j) us[j] = sm[j];
                    for (int t = 1; t < win; ++t) { if (m - t >= 0) { const v4u ut = *(const v4u*)(up - (size_t)t * 2112);
                        sm[0] += bflo(ut.x); sm[1] += bfhi(ut.x); sm[2] += bflo(ut.y); sm[3] += bfhi(ut.y); sm[4] += bflo(ut.z); sm[5] += bfhi(ut.z); sm[6] += bflo(ut.w); sm[7] += bfhi(ut.w); } }
                    const float ic = 1.0f / (float)((m + 1 < win) ? (m + 1) : win);
                    v4u d; d.x = pk2(sm[0] * ic - us[0], sm[1] * ic - us[1]); d.y = pk2(sm[2] * ic - us[2], sm[3] * ic - us[3]); d.z = pk2(sm[4] * ic - us[4], sm[5] * ic - us[5]); d.w = pk2(sm[6] * ic - us[6], sm[7] * ic - us[7]);
                    *(v4u*)(CAT + (size_t)m * 1024 + 512 + hd * 128 + j0) = d;
                }
            }
            xcd_barrier(gbar);
            { pg8::Gemm g{CAT, (const bf16*)(wl + OFF_OUT), M, D, D}; pg8::StaticOrder S; S.init(M, D, G, bx);
              pg8::EpiResid E{xout, xout, XB, rowss, 1.0f};
              pg8::gemm_phase<pg8::EpiResid, pg8::StaticOrder, PG8_ALIGN, PG8_SP2>(L, g, S, E); }
            xcd_barrier(gbar);
        }
    }
    for (int m = gw; m < M; m += NGW) { f32x4* xr = (f32x4*)(xout + (size_t)m * D) + lane; const f32x4* gr = (const f32x4*)args.in[19] + lane;
        const float r = pg8::rs_from_ss(rowss + (size_t)m * 16);
#pragma unroll
        for (int j = 0; j < 4; ++j) { const f32x4 v = xr[64 * j], gg = gr[64 * j]; xr[64 * j] = v * r * gg; } }
}

#undef wl
#undef ws
#undef rowss
#undef rope
#undef XB
#undef HB
#undef QKVU
#undef OBUF
#undef CAT
#undef xout
extern "C" void kernel_launch(void* const* d_in, const int* in_sizes, int n_in, void* d_out, int out_size, void* d_ws, size_t ws_size, hipStream_t stream) {
    static int grid_blocks = 0;
    if (grid_blocks == 0) {
        if (n_in != 20 || out_size != M * D || ws_size < WS_END) { fprintf(stderr, "kernel_launch: unexpected shapes (n_in %d out %d ws %zu, need %zu)\n", n_in, out_size, ws_size, (size_t)WS_END); grid_blocks = -1; return; }
        int dev = 0, cus = 0, per_cu = 0;
        (void)hipGetDevice(&dev); (void)hipDeviceGetAttribute(&cus, hipDeviceAttributeMultiprocessorCount, dev);
        if (hipFuncSetAttribute((const void*)hymba_fwd, hipFuncAttributeMaxDynamicSharedMemorySize, LDS_BYTES) != hipSuccess) { fprintf(stderr, "kernel_launch: hipFuncSetAttribute failed\n"); grid_blocks = -1; return; }
        if (hipOccupancyMaxActiveBlocksPerMultiprocessor(&per_cu, (const void*)hymba_fwd, NWAVES * 64, LDS_BYTES) != hipSuccess || per_cu < 1) { fprintf(stderr, "kernel_launch: occupancy query says %d\n", per_cu); per_cu = 1; }
        (void)hipGetLastError();
        grid_blocks = cus * per_cu;
    }
    if (grid_blocks < 0) return;
    if (hipMemsetAsync(d_ws, 0, 65536, stream) != hipSuccess) { fprintf(stderr, "kernel_launch: memset failed\n"); return; }
    Args a{};
    for (int i = 0; i < 20; ++i) a.in[i] = (const float*)d_in[i];
    a.out = (float*)d_out; a.wsp = (unsigned char*)d_ws;
    void* kargs[] = {&a};
    hipError_t e = hipLaunchCooperativeKernel((const void*)hymba_fwd, dim3(grid_blocks), dim3(NWAVES * 64), kargs, LDS_BYTES, stream);
    if (e != hipSuccess) fprintf(stderr, "cooperative launch failed: %s (grid %d)\n", hipGetErrorString(e), grid_blocks);
}
```

```cpp
#include <hip/hip_runtime.h>
#include <hip/hip_cooperative_groups.h>
#include <cstdio>
#include <cstdint>
namespace cg = cooperative_groups;
namespace pg8 {
#define PG8_LAS __attribute__((address_space(3)))
typedef unsigned short bf16_t;
typedef short bf16x8 __attribute__((ext_vector_type(8)));
typedef float f32x4 __attribute__((ext_vector_type(4)));
typedef unsigned u32x4 __attribute__((ext_vector_type(4)));
constexpr int BM = 256, BK = 64, HALF = 128, HTB = HALF * BK * 2  , STAGE_BYTES = 8 * HTB, NXCD = 8, WGM = 8;

__host__ __device__ __forceinline__ int lds_byte(int r, int c) { const int st = (r >> 4) * 2 + (c >> 5), rr = r & 15, cc = c & 31, ob = rr * 64 + cc * 2; return st * 1024 + (ob ^ (((ob >> 9) & 1) << 5)); }
__host__ __device__ __forceinline__ void stage_rc(int b, int& R, int& C) { const int st = b / 1024, sb = b % 1024, swz = sb ^ (((sb >> 9) & 1) << 5); R = (st >> 1) * 16 + swz / 64; C = (st & 1) * 32 + (swz % 64) / 2; }
__host__ __device__ __forceinline__ int perm32(int rho) { const int n = rho >> 4, i = rho & 15; return 8 * (i >> 2) + 4 * n + (i & 3); }

struct Unit { int pm, pn; };
struct Gemm { const bf16_t* A; const bf16_t* Bt; int M, N, K; };

struct StaticOrder {
    int nM, nN, nwg, G, c;
    __host__ __device__ void init(int M, int N, int G_, int c_) { nM = M / BM; nN = N / BM; nwg = nM * nN; G = G_; c = c_; }
    __host__ __device__ bool next(int i, Unit& u) const {
        const long L = (long)i * G + c; if (L >= nwg) return false;
        int wgid = (int)L; { const int q = nwg / NXCD, r = nwg % NXCD, xcd = wgid % NXCD, off = wgid / NXCD; wgid = (xcd < r ? xcd * (q + 1) : r * (q + 1) + (xcd - r) * q) + off; }
        const int nig = WGM * nN, gid = wgid / nig, fm = gid * WGM, gsz = (nM - fm) < WGM ? (nM - fm) : WGM;
        u.pm = fm + ((wgid % nig) % gsz); u.pn = (wgid % nig) / gsz; return true;
    }
    __device__ __forceinline__ void a_ready(const Unit&) const {}
    __device__ __forceinline__ void done(const Unit&) const {}
};

__device__ __forceinline__ unsigned cvt_pk_bf16(float lo, float hi) { unsigned r; asm volatile("v_cvt_pk_bf16_f32 %0, %1, %2" : "=v"(r) : "v"(lo), "v"(hi)); return r; }
typedef float f32x2 __attribute__((ext_vector_type(2)));
__device__ __forceinline__ f32x2 gelu_pk(f32x2 v) {
    const f32x2 av = __builtin_elementwise_abs(v), d = av * 0.2316418882f + 1.0f;
    f32x2 t; t.x = __builtin_amdgcn_rcpf(d.x); t.y = __builtin_amdgcn_rcpf(d.y);
    f32x2 q = t * 0.5307027145f + (-0.7265760135f); q = q * t + 0.7107068705f; q = q * t + (-0.142248368f); q = q * t + 0.127414796f; q = q * t;
    const f32x2 s = (v * v) * (-0.72134752044f);
    f32x2 e; e.x = __builtin_amdgcn_exp2f(s.x); e.y = __builtin_amdgcn_exp2f(s.y);
    const f32x2 m = v * (q * e), r = v - m;
    f32x2 o; o.x = v.x < 0.f ? m.x : r.x; o.y = v.y < 0.f ? m.y : r.y; return o;
}

template <int ACT  > struct EpiBf16 {
    static constexpr bool PERM = true, AFTER_DRAIN = false; static_assert(ACT == 0 || ACT == 1, "EpiBf16: ACT is 0 (none) or 1 (gelu_pk)");
    bf16_t* O; int ldc; const float* bias; int split_cols; size_t split_stride; float scale0;
    __device__ __forceinline__ void operator()(const f32x4 (&acc)[2][2][4][2], const Unit& u, int wr, int wc, int fr, int fq) const {
        const int row0 = u.pm * BM + wr * 64 + fr; int colt = u.pn * BM; bf16_t* base = O;
        float sc = 1.f; if (split_cols) { const int t = colt / split_cols; base += (size_t)t * split_stride; colt -= t * split_cols; if (t == 0) sc = scale0; }
        const int col0 = colt + wc * 32 + 8 * fq, bcol0 = u.pn * BM + wc * 32 + 8 * fq;
        f32x4 bv[2][2];
#pragma unroll
        for (int bj = 0; bj < 2; ++bj)
#pragma unroll
            for (int n = 0; n < 2; ++n) bv[bj][n] = bias ? *(const f32x4*)(bias + bcol0 + bj * HALF + 4 * n) : (f32x4){0.f, 0.f, 0.f, 0.f};
#pragma unroll
        for (int ai = 0; ai < 2; ++ai)
#pragma unroll
            for (int m = 0; m < 4; ++m) { bf16_t* rowp = base + (size_t)(row0 + ai * HALF + m * 16) * ldc + col0;
#pragma unroll
                for (int bj = 0; bj < 2; ++bj) { f32x4 v0 = acc[ai][bj][m][0] + bv[bj][0], v1 = acc[ai][bj][m][1] + bv[bj][1];
                    if (ACT == 1) { f32x2 a = gelu_pk((f32x2){v0[0], v0[1]}), b = gelu_pk((f32x2){v0[2], v0[3]}), c = gelu_pk((f32x2){v1[0], v1[1]}), d = gelu_pk((f32x2){v1[2], v1[3]});
                        v0 = (f32x4){a.x, a.y, b.x, b.y}; v1 = (f32x4){c.x, c.y, d.x, d.y}; }
                    v0 = v0 * sc; v1 = v1 * sc; u32x4 w; w.x = cvt_pk_bf16(v0[0], v0[1]); w.y = cvt_pk_bf16(v0[2], v0[3]); w.z = cvt_pk_bf16(v1[0], v1[1]); w.w = cvt_pk_bf16(v1[2], v1[3]);
                    *(u32x4*)(rowp + bj * HALF) = w; } }
    }
};
__device__ __forceinline__ float rs_from_ss(const float* p) { const f32x4 a = ((const f32x4*)p)[0], b = ((const f32x4*)p)[1], c = ((const f32x4*)p)[2], d = ((const f32x4*)p)[3];
    const float ss = (((a[0] + a[1]) + (a[2] + a[3])) + ((b[0] + b[1]) + (b[2] + b[3]))) + (((c[0] + c[1]) + (c[2] + c[3])) + ((d[0] + d[1]) + (d[2] + d[3])));
    return __builtin_amdgcn_rsqf(ss * (1.0f / 1024.0f) + 1e-6f); }
struct EpiGateUp {
    static constexpr bool PERM = true, AFTER_DRAIN = false;
    bf16_t* H; const float* rowss;
    __device__ __forceinline__ void operator()(const f32x4 (&acc)[2][2][4][2], const Unit& u, int wr, int wc, int fr, int fq) const {
        const int row0 = u.pm * BM + wr * 64 + fr; const int col0 = u.pn * HALF + wc * 32 + 8 * fq;
#pragma unroll
        for (int ai = 0; ai < 2; ++ai)
#pragma unroll
            for (int m = 0; m < 4; ++m) { const int row = row0 + ai * HALF + m * 16; const float r = rs_from_ss(rowss + (size_t)row * 16);
                float hv[8];
#pragma unroll
                for (int n = 0; n < 2; ++n)
#pragma unroll
                    for (int e = 0; e < 4; ++e) { const float g = acc[ai][0][m][n][e] * r, up = acc[ai][1][m][n][e] * r;
                        const float sg = g * __builtin_amdgcn_rcpf(1.0f + __builtin_amdgcn_exp2f(g * -1.4426950408889634f)); hv[n * 4 + e] = sg * up; }
                u32x4 w; w.x = cvt_pk_bf16(hv[0], hv[1]); w.y = cvt_pk_bf16(hv[2], hv[3]); w.z = cvt_pk_bf16(hv[4], hv[5]); w.w = cvt_pk_bf16(hv[6], hv[7]);
                *(u32x4*)(H + (size_t)row * 2816 + col0) = w; }
    }
};
struct EpiResid {
    static constexpr bool PERM = true, AFTER_DRAIN = false;
    const float* xin; float* xout; bf16_t* xb; float* rowss_next; float alpha;
    __device__ __forceinline__ void operator()(const f32x4 (&acc)[2][2][4][2], const Unit& u, int wr, int wc, int fr, int fq) const {
        const int row0 = u.pm * BM + wr * 64 + fr; const int col0 = u.pn * BM + wc * 32 + 8 * fq;
#pragma unroll
        for (int ai = 0; ai < 2; ++ai)
#pragma unroll
            for (int m = 0; m < 4; ++m) { const int row = row0 + ai * HALF + m * 16; float ss = 0.f;
#pragma unroll
                for (int bj = 0; bj < 2; ++bj) { const size_t off = (size_t)row * 1024 + col0 + bj * HALF;
                    const f32x4 a0 = *(const f32x4*)(xin + off), a1 = *(const f32x4*)(xin + off + 4);
                    const f32x4 v0 = a0 + acc[ai][bj][m][0] * alpha, v1 = a1 + acc[ai][bj][m][1] * alpha;
                    *(f32x4*)(xout + off) = v0; *(f32x4*)(xout + off + 4) = v1;
                    ss += (v0[0] * v0[0] + v0[1] * v0[1]) + (v0[2] * v0[2] + v0[3] * v0[3]) + (v1[0] * v1[0] + v1[1] * v1[1]) + (v1[2] * v1[2] + v1[3] * v1[3]);
                    u32x4 w; w.x = cvt_pk_bf16(v0[0], v0[1]); w.y = cvt_pk_bf16(v0[2], v0[3]); w.z = cvt_pk_bf16(v1[0], v1[1]); w.w = cvt_pk_bf16(v1[2], v1[3]);
                    *(u32x4*)(xb + off) = w; }
                ss += __shfl_xor(ss, 16); ss += __shfl_xor(ss, 32);
                if (fq == 0) rowss_next[(size_t)row * 16 + u.pn * 4 + wc] = ss; }
    }
};
struct EpiQKVU {
    static constexpr bool PERM = true, AFTER_DRAIN = false;
    bf16_t* O; const float* rowss; const float* rope;
    __device__ __forceinline__ void operator()(const f32x4 (&acc)[2][2][4][2], const Unit& u, int wr, int wc, int fr, int fq) const {
        const int row0 = u.pm * BM + wr * 64 + fr; const int col0 = u.pn * BM + wc * 32 + 8 * fq; const int sec = u.pn >> 1;
        const int j0 = 16 * (wc & 1) + 4 * fq;
#pragma unroll
        for (int ai = 0; ai < 2; ++ai)
#pragma unroll
            for (int m = 0; m < 4; ++m) { const int row = row0 + ai * HALF + m * 16; float r = rs_from_ss(rowss + (size_t)row * 16); if (sec == 0) r *= 0.125f * 1.4426950408889634f;
                f32x4 cs0 = (f32x4){1.f, 0.f, 1.f, 0.f}, cs1 = cs0;
                if (sec < 2) { const f32x4* rp = (const f32x4*)(rope + ((size_t)row * 32 + j0) * 2); cs0 = rp[0]; cs1 = rp[1]; }
#pragma unroll
                for (int bj = 0; bj < 2; ++bj) { const f32x4 v0 = acc[ai][bj][m][0] * r, v1 = acc[ai][bj][m][1] * r;
                    const float o0 = v0[0] * cs0[0] - v0[1] * cs0[1], o1 = v0[1] * cs0[0] + v0[0] * cs0[1];
                    const float o2 = v0[2] * cs0[2] - v0[3] * cs0[3], o3 = v0[3] * cs0[2] + v0[2] * cs0[3];
                    const float o4 = v1[0] * cs1[0] - v1[1] * cs1[1], o5 = v1[1] * cs1[0] + v1[0] * cs1[1];
                    const float o6 = v1[2] * cs1[2] - v1[3] * cs1[3], o7 = v1[3] * cs1[2] + v1[2] * cs1[3];
                    u32x4 w; w.x = cvt_pk_bf16(o0, o1); w.y = cvt_pk_bf16(o2, o3); w.z = cvt_pk_bf16(o4, o5); w.w = cvt_pk_bf16(o6, o7);
                    *(u32x4*)(O + (size_t)row * 2112 + col0 + bj * HALF) = w; } }
    }
};

template <class Epi, class Sched, bool ALIGN_EPI = false, bool SP2 = false>
__device__ __forceinline__ void gemm_phase(PG8_LAS unsigned char* lds, const Gemm g, const Sched& S, const Epi& E) {
    int tid_ = threadIdx.x; asm volatile("" : "+v"(tid_));
    const int tid = tid_, wid = __builtin_amdgcn_readfirstlane(tid >> 6), lane = tid & 63, wr = wid >> 2, wc = wid & 3, fr = lane & 15, fq = lane >> 4;
    const int K = g.K, nt = K / BK;
    unsigned voffA[2], voffB[2];
#pragma unroll
    for (int i = 0; i < 2; ++i) { int R, C; stage_rc(tid * 16 + i * 8192, R, C); const int Rb = Epi::PERM ? ((R & ~31) + perm32(R & 31)) : R;
        voffA[i] = (unsigned)(R * K + C) * 2u; voffB[i] = (unsigned)(Rb * K + C) * 2u; }
    const size_t kstep = (size_t)(BK * 2);
    const size_t hstep = (size_t)HALF * K * 2;
    const size_t tstep = 2 * hstep;
    const unsigned ldsw = (unsigned)wid * 1024u;
    const int aoff = lds_byte(wr * 64 + fr, fq * 8), boff = lds_byte(wc * 32 + fr, fq * 8);
#define PG8_SA(b, h) (((b) * 2 + (h)) * HTB)
#define PG8_SB(b, h) ((4 + (b) * 2 + (h)) * HTB)
#define PG8_STAGE(bufoff, gbase, voff) do { _Pragma("unroll") for (int _i = 0; _i < 2; ++_i) \
        __builtin_amdgcn_global_load_lds((const unsigned*)((const char*)(gbase) + (voff)[_i]), (PG8_LAS unsigned*)(lds + (bufoff) + ldsw + _i * 8192), 16, 0, 0); } while (0)
#define PG8_LDA(dst, b, h) do { _Pragma("unroll") for (int m = 0; m < 4; ++m) _Pragma("unroll") for (int k = 0; k < 2; ++k) dst[m][k] = *(const PG8_LAS bf16x8*)(lds + PG8_SA(b, h) + aoff + m * 2048 + k * 1024); } while (0)
#define PG8_LDB(dst, b, h) do { _Pragma("unroll") for (int n = 0; n < 2; ++n) _Pragma("unroll") for (int k = 0; k < 2; ++k) dst[n][k] = *(const PG8_LAS bf16x8*)(lds + PG8_SB(b, h) + boff + n * 2048 + k * 1024); } while (0)
#define PG8_MMA(ai, bj, At, Bt) do { __builtin_amdgcn_s_setprio(1); _Pragma("unroll") for (int m = 0; m < 4; ++m) _Pragma("unroll") for (int n = 0; n < 2; ++n) _Pragma("unroll") for (int k = 0; k < 2; ++k) \
        acc[ai][bj][m][n] = __builtin_amdgcn_mfma_f32_16x16x32_bf16(Bt[n][k], At[m][k], acc[ai][bj][m][n], 0, 0, 0); __builtin_amdgcn_s_setprio(0); } while (0)
#define PG8_WAIT_V(n) asm volatile("s_waitcnt vmcnt(" #n ")" ::: "memory")
#define PG8_WAIT_L(n) asm volatile("s_waitcnt lgkmcnt(" #n ")" ::: "memory")
#define PG8_BAR __builtin_amdgcn_s_barrier()
#define PG8_SCHED __builtin_amdgcn_sched_barrier(0)
    Unit cur, nxt; int ui = 0;
    if (!S.next(0, cur)) return;
    f32x4 acc[2][2][4][2];
#pragma unroll
    for (int a = 0; a < 2; ++a)
#pragma unroll
        for (int b = 0; b < 2; ++b)
#pragma unroll
            for (int m = 0; m < 4; ++m)
#pragma unroll
                for (int n = 0; n < 2; ++n) acc[a][b][m][n] = (f32x4){0.f, 0.f, 0.f, 0.f};
    bf16x8 At[4][2], B0[2][2], B1[2][2];
    const char* cA = (const char*)g.A + (size_t)cur.pm * tstep; const char* cB = (const char*)g.Bt + (size_t)cur.pn * tstep;
    S.a_ready(cur);
    if constexpr (SP2) {
        PG8_STAGE(PG8_SB(0, 0), cB, voffB); PG8_STAGE(PG8_SB(0, 1), cB + hstep, voffB); PG8_STAGE(PG8_SA(0, 0), cA, voffA); PG8_STAGE(PG8_SA(0, 1), cA + hstep, voffA);
        if (wr == 1) PG8_BAR;
        PG8_WAIT_V(2); PG8_BAR;
        PG8_STAGE(PG8_SB(1, 0), cB + kstep, voffB); PG8_STAGE(PG8_SA(1, 0), cA + kstep, voffA); PG8_STAGE(PG8_SB(1, 1), cB + hstep + kstep, voffB);
        PG8_WAIT_V(6); PG8_BAR;
    } else {
        PG8_STAGE(PG8_SB(0, 0), cB, voffB); PG8_STAGE(PG8_SA(0, 0), cA, voffA); PG8_STAGE(PG8_SB(0, 1), cB + hstep, voffB); PG8_STAGE(PG8_SA(0, 1), cA + hstep, voffA);
        if (wr == 1) PG8_BAR;
        PG8_WAIT_V(4); PG8_BAR;
        PG8_STAGE(PG8_SB(1, 0), cB + kstep, voffB); PG8_STAGE(PG8_SA(1, 0), cA + kstep, voffA); PG8_STAGE(PG8_SB(1, 1), cB + hstep + kstep, voffB);
        PG8_WAIT_V(6); PG8_BAR;
    }
    for (;;) {
        const bool has_next = S.next(ui + 1, nxt);
        const char* nA = has_next ? (const char*)g.A + (size_t)nxt.pm * tstep : cA; const char* nB = has_next ? (const char*)g.Bt + (size_t)nxt.pn * tstep : cB;
        for (int t = 0; t < nt; t += 2) {
            const bool last = (t == nt - 2);
            const char* a1 = cA + (size_t)(t + 1) * kstep;
            const char* a2 = last ? nA : cA + (size_t)(t + 2) * kstep; const char* b2 = last ? nB : cB + (size_t)(t + 2) * kstep;
            const char* a3 = a2 + kstep; const char* b3 = b2 + kstep;
            if (last && has_next) S.a_ready(nxt);
            if constexpr (SP2) {
            PG8_LDB(B0, 0, 0); PG8_LDB(B1, 0, 1); PG8_SCHED; PG8_LDA(At, 0, 0); PG8_STAGE(PG8_SA(1, 1), a1 + hstep, voffA);
            PG8_WAIT_V(8); PG8_WAIT_L(0); PG8_BAR; PG8_MMA(0, 0, At, B0); PG8_MMA(0, 1, At, B1); PG8_BAR; PG8_SCHED;
            PG8_LDA(At, 0, 1); PG8_STAGE(PG8_SB(0, 0), b2, voffB); PG8_STAGE(PG8_SB(0, 1), b2 + hstep, voffB); PG8_STAGE(PG8_SA(0, 0), a2, voffA);
            PG8_WAIT_V(8); PG8_WAIT_L(0); PG8_BAR; PG8_MMA(1, 0, At, B0); PG8_MMA(1, 1, At, B1); PG8_BAR; PG8_SCHED;
            PG8_LDB(B0, 1, 0); PG8_LDB(B1, 1, 1); PG8_SCHED; PG8_LDA(At, 1, 0); PG8_STAGE(PG8_SA(0, 1), a2 + hstep, voffA);
            PG8_WAIT_V(8); PG8_WAIT_L(0); PG8_BAR; PG8_MMA(0, 0, At, B0); PG8_MMA(0, 1, At, B1); PG8_BAR; PG8_SCHED;
            PG8_LDA(At, 1, 1); PG8_STAGE(PG8_SB(1, 0), b3, voffB); PG8_STAGE(PG8_SB(1, 1), b3 + hstep, voffB); PG8_STAGE(PG8_SA(1, 0), a3, voffA);
            PG8_WAIT_V(8); PG8_WAIT_L(0); PG8_BAR; PG8_MMA(1, 0, At, B0); PG8_MMA(1, 1, At, B1); PG8_BAR; PG8_SCHED;
            } else {
            PG8_LDB(B0, 0, 0); PG8_SCHED; PG8_LDA(At, 0, 0); PG8_STAGE(PG8_SA(1, 1), a1 + hstep, voffA);
            PG8_WAIT_L(8); PG8_BAR; PG8_WAIT_L(0); PG8_MMA(0, 0, At, B0); PG8_BAR; PG8_SCHED;
            PG8_LDB(B1, 0, 1); PG8_STAGE(PG8_SB(0, 0), b2, voffB);
            PG8_BAR; PG8_WAIT_L(0); PG8_MMA(0, 1, At, B1); PG8_BAR;
            PG8_LDA(At, 0, 1); PG8_STAGE(PG8_SA(0, 0), a2, voffA);
            PG8_BAR; PG8_WAIT_L(0); PG8_MMA(1, 0, At, B0); PG8_BAR; PG8_SCHED;
            PG8_STAGE(PG8_SB(0, 1), b2 + hstep, voffB);
            PG8_WAIT_V(6); PG8_BAR; PG8_MMA(1, 1, At, B1); PG8_BAR;
            PG8_LDB(B0, 1, 0); PG8_SCHED; PG8_LDA(At, 1, 0); PG8_STAGE(PG8_SA(0, 1), a2 + hstep, voffA);
            PG8_WAIT_L(8); PG8_BAR; PG8_WAIT_L(0); PG8_MMA(0, 0, At, B0); PG8_BAR; PG8_SCHED;
            PG8_LDB(B1, 1, 1); PG8_STAGE(PG8_SB(1, 0), b3, voffB);
            PG8_BAR; PG8_WAIT_L(0); PG8_MMA(0, 1, At, B1); PG8_BAR;
            PG8_LDA(At, 1, 1); PG8_STAGE(PG8_SA(1, 0), a3, voffA);
            PG8_BAR; PG8_WAIT_L(0); PG8_MMA(1, 0, At, B0); PG8_BAR; PG8_SCHED;
            PG8_STAGE(PG8_SB(1, 1), b3 + hstep, voffB);
            PG8_WAIT_V(6); PG8_BAR; PG8_MMA(1, 1, At, B1); PG8_BAR;
            }
        }
        if constexpr (ALIGN_EPI) { if (wr == 0) PG8_BAR; }
        if constexpr (!Epi::AFTER_DRAIN) { E(acc, cur, wr, wc, fr, fq); S.done(cur); }
        if (!has_next) break;
#pragma unroll
        for (int a = 0; a < 2; ++a)
#pragma unroll
            for (int b = 0; b < 2; ++b)
#pragma unroll
                for (int m = 0; m < 4; ++m)
#pragma unroll
                    for (int n = 0; n < 2; ++n) acc[a][b][m][n] = (f32x4){0.f, 0.f, 0.f, 0.f};
        cur = nxt; cA = nA; cB = nB; ++ui;
        if constexpr (ALIGN_EPI) { if (wr == 1) PG8_BAR; }
    }
    PG8_WAIT_V(0);
    if constexpr (!ALIGN_EPI) { if (wr == 0) PG8_BAR; }
    PG8_BAR;
    if constexpr (Epi::AFTER_DRAIN) { E.fused(acc, cur, wr, wc, fr, fq, lds, wid, lane); S.done(cur); }
#undef PG8_SA
#undef PG8_SB
#undef PG8_STAGE
#undef PG8_LDA
#undef PG8_LDB
#undef PG8_MMA
#undef PG8_WAIT_V
#undef PG8_WAIT_L
#undef PG8_BAR
#undef PG8_SCHED
}
}

#ifndef PG8_SP2
#define PG8_SP2 true
#endif
#ifndef PG8_ALIGN
#define PG8_ALIGN true
#endif
#include <hip/hip_bf16.h>
#include <cmath>
namespace attn_body {
using bf16=__hip_bfloat16;
using bf16x8=__attribute__((ext_vector_type(8)))short;
using s16x4=__attribute__((ext_vector_type(4)))short;
using f32x16=__attribute__((ext_vector_type(16)))float;
using u32x4=__attribute__((ext_vector_type(4)))unsigned;
constexpr int BATCH=1,NHEAD=16,SEQ=16384,D=64,DM=2112,DMO=1024;
constexpr int NW=8,QBLK=32,QB=QBLK*NW,KVBLK=64,NQB=SEQ/QB;
constexpr int ATTN_PITCH=DM, ATTN_UNIT_ROWS=QB;
__device__ __forceinline__ int crow(int r,int hi){return (r&3)+8*(r>>2)+4*hi;}
#define SBAR() __builtin_amdgcn_sched_barrier(0)
__device__ __forceinline__ void cmask(f32x16&p0,f32x16&p1,int jb,int qrel,int hi){
  const float NEG=-INFINITY; int kb=64*jb+4*hi;
  #pragma unroll
  for(int r=0;r<16;++r){int kv=kb+(r&3)+8*(r>>2); if(kv>qrel)p0[r]=NEG; if(kv+32>qrel)p1[r]=NEG;}
}

constexpr int NSLOT=3, SLOTB=8192;
constexpr int NVSLOT=3, VSLOTB=16384;
constexpr int LDS_K=0, LDS_V=NSLOT*SLOTB, LDS_P=LDS_V+NVSLOT*VSLOTB, LDS_WS=LDS_P+NW*8192, WSF_STRIDE=64, LDS_BYTES=LDS_WS+NW*WSF_STRIDE*4;
constexpr float C2=0.125f*1.4426950408889634f;
__device__ __forceinline__ void glds16(const void*gsrc,unsigned lds_dst){unsigned keep;
  asm volatile("s_mov_b32 %0, m0\n\ts_mov_b32 m0, %2\n\ts_nop 0\n\tglobal_load_lds_dwordx4 %1, off\n\ts_mov_b32 m0, %0":"=&s"(keep):"v"(gsrc),"s"(lds_dst):"memory");}
__device__ __forceinline__ float max3f(float a,float b,float c){float r;asm("v_max3_f32 %0, %1, %2, %3":"=v"(r):"v"(a),"v"(b),"v"(c));return r;}
__device__ __forceinline__ float max2f(float a,float b){float r;asm("v_max_f32_e32 %0, %1, %2":"=v"(r):"v"(a),"v"(b));return r;}
__device__ __forceinline__ float fadd_s(float a,float b){float r;asm("v_add_f32_e32 %0, %1, %2":"=v"(r):"v"(a),"v"(b));return r;}
__device__ __forceinline__ float fsub_s(float a,float b){float r;asm("v_sub_f32_e32 %0, %1, %2":"=v"(r):"v"(a),"v"(b));return r;}
typedef float f32x2_t __attribute__((ext_vector_type(2))); typedef __bf16 bf16x2_t __attribute__((ext_vector_type(2)));
__device__ __forceinline__ unsigned cvtpk_s(float lo,float hi){f32x2_t v={lo,hi};bf16x2_t b=__builtin_convertvector(v,bf16x2_t);return __builtin_bit_cast(unsigned,b);}
#define WAIT_BAR(N) asm volatile("s_waitcnt vmcnt(" #N ") lgkmcnt(0)\n\ts_barrier":::"memory")

__device__ __forceinline__ void qkt(f32x16&p0,f32x16&p1,const char*Kslot,const bf16x8*qr,const f32x16&negm,int r32,int hi){
  const char*kb=Kslot+hi*1024+r32*16;
  #pragma unroll
  for(int d0=0;d0<4;++d0){
    const bf16x8 b0=*reinterpret_cast<const bf16x8*>(kb+d0*2048);
    const bf16x8 b1=*reinterpret_cast<const bf16x8*>(kb+d0*2048+512);
    if(d0==0){p0=__builtin_amdgcn_mfma_f32_32x32x16_bf16(b0,qr[0],negm,0,0,0);p1=__builtin_amdgcn_mfma_f32_32x32x16_bf16(b1,qr[0],negm,0,0,0);}
    else{p0=__builtin_amdgcn_mfma_f32_32x32x16_bf16(b0,qr[d0],p0,0,0,0);p1=__builtin_amdgcn_mfma_f32_32x32x16_bf16(b1,qr[d0],p1,0,0,0);}}
}
typedef __attribute__((address_space(3))) const char* lds_cptr;
typedef short v4i16_t __attribute__((ext_vector_type(4)));
__device__ __forceinline__ void kload8(bf16x8*kf,lds_cptr kp){
  kf[0]=*(const __attribute__((address_space(3))) bf16x8*)(kp);      kf[1]=*(const __attribute__((address_space(3))) bf16x8*)(kp+512);
  kf[2]=*(const __attribute__((address_space(3))) bf16x8*)(kp+2048); kf[3]=*(const __attribute__((address_space(3))) bf16x8*)(kp+2560);
  kf[4]=*(const __attribute__((address_space(3))) bf16x8*)(kp+4096); kf[5]=*(const __attribute__((address_space(3))) bf16x8*)(kp+4608);
  kf[6]=*(const __attribute__((address_space(3))) bf16x8*)(kp+6144); kf[7]=*(const __attribute__((address_space(3))) bf16x8*)(kp+6656);
}
__device__ __forceinline__ void kload2(bf16x8*kf,lds_cptr kp,int j){ kf[2*j]=*(const __attribute__((address_space(3))) bf16x8*)(kp+j*2048); kf[2*j+1]=*(const __attribute__((address_space(3))) bf16x8*)(kp+j*2048+512); }
__device__ __forceinline__ s16x4 vtr(lds_cptr p){ return __builtin_bit_cast(s16x4,__builtin_amdgcn_ds_read_tr16_b64_v4i16((__attribute__((address_space(3))) v4i16_t*)p)); }
__device__ __forceinline__ float rowmax(const f32x16&p0,const f32x16&p1){
  float a=max3f(p0[0],p0[1],p1[0]),b=max3f(p0[2],p0[3],p1[1]);a=max3f(a,p1[2],p1[3]);
  #pragma unroll
  for(int r=4;r<16;r+=4){a=max3f(a,p0[r],p0[r+1]);b=max3f(b,p0[r+2],p0[r+3]);a=max3f(a,p1[r],p1[r+1]);b=max3f(b,p1[r+2],p1[r+3]);}
  const float m=max2f(a,b);
  auto rr=__builtin_amdgcn_permlane32_swap(__float_as_uint(m),__float_as_uint(m),false,false);
  return max2f(__uint_as_float(rr[0]),__uint_as_float(rr[1]));
}
__device__ __forceinline__ void pv(f32x16*o,int vb,bf16x8 pa0,bf16x8 pa1,bf16x8 pa2,bf16x8 pa3){
  #pragma unroll
  for(int d0=0;d0<2;++d0){s16x4 lo[4],hi[4];
    #pragma unroll
    for(int ks=0;ks<4;++ks){
      asm volatile("ds_read_b64_tr_b16 %0,%1 offset:%c2":"=&v"(lo[ks]):"v"(vb),"i"(d0*4096+ks*1024):"memory");
      asm volatile("ds_read_b64_tr_b16 %0,%1 offset:%c2":"=&v"(hi[ks]):"v"(vb),"i"(d0*4096+ks*1024+512):"memory");}
    asm volatile("s_waitcnt lgkmcnt(0)":::"memory");SBAR();
    #define PK(k) (bf16x8){lo[k][0],lo[k][1],lo[k][2],lo[k][3],hi[k][0],hi[k][1],hi[k][2],hi[k][3]}
    o[d0]=__builtin_amdgcn_mfma_f32_32x32x16_bf16(pa0,PK(0),o[d0],0,0,0);
    o[d0]=__builtin_amdgcn_mfma_f32_32x32x16_bf16(pa1,PK(1),o[d0],0,0,0);
    o[d0]=__builtin_amdgcn_mfma_f32_32x32x16_bf16(pa2,PK(2),o[d0],0,0,0);
    o[d0]=__builtin_amdgcn_mfma_f32_32x32x16_bf16(pa3,PK(3),o[d0],0,0,0);
    #undef PK
  }
}

#ifndef ATTN_STORE16
#define ATTN_STORE16(p,v) (*(u32x4*)(p)=(v))
#endif
template<int THRL> __device__ __forceinline__ void attn_unit(int qb,const bf16*Q,const bf16*__restrict__ K,const bf16*__restrict__ V,bf16*O,char*shm){
  int tid_=threadIdx.x; asm volatile("":"+v"(tid_)); const int tid=tid_,lane=tid&63,r32=lane&31,hi=lane>>5; const int wid=__builtin_amdgcn_readfirstlane(tid>>6);
  const int q0=qb*QB;
  const unsigned lds0=(unsigned)(uintptr_t)shm;
  float*wsf=(float*)(shm+LDS_WS)+wid*WSF_STRIDE;
  const bf16*ksrc=K+(long)lane*DM+wid*8;
  const bf16*vsrc=V+(long)(16*(wid&3)+(lane>>2))*DM+(wid>>2)*32+(lane&3)*8;
  const unsigned kdst=lds0+LDS_K+wid*1024, vdst=lds0+LDS_V+wid*1024;
  #define DMA_K(t,s3) glds16(ksrc+(long)(t)*KVBLK*DM,(unsigned)__builtin_amdgcn_readfirstlane(kdst+(s3)*SLOTB))
  #define DMA_V(t,s3) do{ const unsigned vd_=(unsigned)__builtin_amdgcn_readfirstlane(vdst+(s3)*VSLOTB); glds16(vsrc+(long)(t)*KVBLK*DM,vd_); glds16(vsrc+(long)(t)*KVBLK*DM+64,(unsigned)__builtin_amdgcn_readfirstlane(vd_+8192)); }while(0)
  const lds_cptr shm3=(lds_cptr)shm;
  const int NT=(q0+QB)/KVBLK;
  DMA_K(0,0);DMA_V(0,0);DMA_K(1,1);DMA_V(1,1);
  int c0=0,c1=1,c2=2;
  #define ROT3() do{ const int x_=c0; c0=c1; c1=c2; c2=x_; }while(0)
  #define PKW(P,B) cvtpk_s(P[B],P[B+1])
  #define MX3(a,b,c) __builtin_fmaxf(__builtin_fmaxf((a),(b)),(c))
  const bf16*Qw=Q+(long)(q0+wid*QBLK)*DM;
  bf16x8 qr[4];
  #pragma unroll
  for(int d0=0;d0<4;++d0)qr[d0]=*reinterpret_cast<const bf16x8*>(&Qw[(long)r32*DM+d0*16+hi*8]);
  float mhat=0.f,l_reg=0.f; f32x16 negm=f32x16{};
  f32x16 o[4]; o[0]=f32x16{};o[1]=f32x16{};o[2]=f32x16{};o[3]=f32x16{};
  const int qrel=wid*QBLK+r32;
  const lds_cptr kp0=shm3+LDS_K+hi*1024+r32*16;
  const lds_cptr vp0=shm3+LDS_V+((lane>>4)&1)*32+(lane&3)*8+(4*hi+((lane&15)>>2))*64;
  WAIT_BAR(3);
  for(int t=0;t<NT;++t){
    if(t+2<NT){DMA_K(t+2,c2);DMA_V(t+2,c2);}
    f32x16 C0,C1;
    { bf16x8 kf[8]; kload8(kf,kp0+c0*SLOTB); SBAR();
      C0=__builtin_amdgcn_mfma_f32_32x32x16_bf16(kf[0],qr[0],negm,0,0,0); C1=__builtin_amdgcn_mfma_f32_32x32x16_bf16(kf[1],qr[0],negm,0,0,0);
      C0=__builtin_amdgcn_mfma_f32_32x32x16_bf16(kf[2],qr[1],C0,0,0,0);   C1=__builtin_amdgcn_mfma_f32_32x32x16_bf16(kf[3],qr[1],C1,0,0,0);
      C0=__builtin_amdgcn_mfma_f32_32x32x16_bf16(kf[4],qr[2],C0,0,0,0);   C1=__builtin_amdgcn_mfma_f32_32x32x16_bf16(kf[5],qr[2],C1,0,0,0);
      C0=__builtin_amdgcn_mfma_f32_32x32x16_bf16(kf[6],qr[3],C0,0,0,0);   C1=__builtin_amdgcn_mfma_f32_32x32x16_bf16(kf[7],qr[3],C1,0,0,0); }
    const lds_cptr vp_=vp0+c0*VSLOTB; s16x4 vl_[8],vh_[8];
    #pragma unroll
    for(int k2=0;k2<2;++k2)
      #pragma unroll
      for(int d_=0;d_<4;++d_){ vl_[d_*2+k2]=vtr(vp_+(d_*4096+k2*1024)); vh_[d_*2+k2]=vtr(vp_+(d_*4096+k2*1024+512)); }
    SBAR();
    { const int jb_=t-(NT-4); if(jb_>=0)cmask(C0,C1,jb_,qrel,hi); }
    float a=MX3(C0[0],C0[1],C1[0]),b=MX3(C0[2],C0[3],C1[1]); a=MX3(a,C1[2],C1[3]);
    #pragma unroll
    for(int r=4;r<16;r+=4){a=MX3(a,C0[r],C0[r+1]);b=MX3(b,C0[r+2],C0[r+3]);a=MX3(a,C1[r],C1[r+1]);b=MX3(b,C1[r+2],C1[r+3]);}
    float rm=__builtin_fmaxf(a,b); { auto rr=__builtin_amdgcn_permlane32_swap(__float_as_uint(rm),__float_as_uint(rm),false,false); rm=__builtin_fmaxf(__uint_as_float(rr[0]),__uint_as_float(rr[1])); }
    if(t==0 || __any(rm>(float)THRL)){
      const float dl=(t==0)?rm:__builtin_fmaxf(rm,0.f); mhat+=dl;
      #pragma unroll
      for(int r=0;r<16;++r){C0[r]-=dl;C1[r]-=dl;}
      #pragma unroll
      for(int r=0;r<16;++r)negm[r]=-mhat;
      if(t!=0){ const float f=__builtin_amdgcn_exp2f(-dl); l_reg*=f; if(hi==0)wsf[r32]=f; asm volatile("s_waitcnt lgkmcnt(0)":::"memory");
        #pragma unroll
        for(int d_=0;d_<4;++d_)
          #pragma unroll
          for(int r=0;r<16;++r)o[d_][r]*=wsf[crow(r,hi)]; } }
    #pragma unroll
    for(int r=0;r<16;++r){C0[r]=__builtin_amdgcn_exp2f(C0[r]);C1[r]=__builtin_amdgcn_exp2f(C1[r]);}
    { float s0=C0[0]+C0[1],s1=C1[0]+C1[1];
      #pragma unroll
      for(int r=2;r<16;++r){s0+=C0[r];s1+=C1[r];}
      l_reg+=s0+s1; }
    const u32x4 pw0=(u32x4){PKW(C0,0),PKW(C0,2),PKW(C0,4),PKW(C0,6)},pw1=(u32x4){PKW(C0,8),PKW(C0,10),PKW(C0,12),PKW(C0,14)},pw2=(u32x4){PKW(C1,0),PKW(C1,2),PKW(C1,4),PKW(C1,6)},pw3=(u32x4){PKW(C1,8),PKW(C1,10),PKW(C1,12),PKW(C1,14)};
    SBAR();
    #pragma unroll
    for(int d_=0;d_<4;++d_){ o[d_]=__builtin_amdgcn_mfma_f32_32x32x16_bf16(__builtin_bit_cast(bf16x8,pw0),(bf16x8){vl_[d_*2][0],vl_[d_*2][1],vl_[d_*2][2],vl_[d_*2][3],vh_[d_*2][0],vh_[d_*2][1],vh_[d_*2][2],vh_[d_*2][3]},o[d_],0,0,0); }
    #pragma unroll
    for(int d_=0;d_<4;++d_){ o[d_]=__builtin_amdgcn_mfma_f32_32x32x16_bf16(__builtin_bit_cast(bf16x8,pw1),(bf16x8){vl_[d_*2+1][0],vl_[d_*2+1][1],vl_[d_*2+1][2],vl_[d_*2+1][3],vh_[d_*2+1][0],vh_[d_*2+1][1],vh_[d_*2+1][2],vh_[d_*2+1][3]},o[d_],0,0,0); }
    SBAR();
    { s16x4 wl_[8],wh_[8];
      #pragma unroll
      for(int k2=0;k2<2;++k2)
        #pragma unroll
        for(int d_=0;d_<4;++d_){ wl_[d_*2+k2]=vtr(vp_+(d_*4096+(2+k2)*1024)); wh_[d_*2+k2]=vtr(vp_+(d_*4096+(2+k2)*1024+512)); }
      SBAR();
      #pragma unroll
      for(int d_=0;d_<4;++d_){ o[d_]=__builtin_amdgcn_mfma_f32_32x32x16_bf16(__builtin_bit_cast(bf16x8,pw2),(bf16x8){wl_[d_*2][0],wl_[d_*2][1],wl_[d_*2][2],wl_[d_*2][3],wh_[d_*2][0],wh_[d_*2][1],wh_[d_*2][2],wh_[d_*2][3]},o[d_],0,0,0); }
      #pragma unroll
      for(int d_=0;d_<4;++d_){ o[d_]=__builtin_amdgcn_mfma_f32_32x32x16_bf16(__builtin_bit_cast(bf16x8,pw3),(bf16x8){wl_[d_*2+1][0],wl_[d_*2+1][1],wl_[d_*2+1][2],wl_[d_*2+1][3],wh_[d_*2+1][0],wh_[d_*2+1][1],wh_[d_*2+1][2],wh_[d_*2+1][3]},o[d_],0,0,0); } }
    if(t+2<NT){WAIT_BAR(3);}else{WAIT_BAR(0);}
    ROT3();
  }
  { auto rr=__builtin_amdgcn_permlane32_swap(__float_as_uint(l_reg),__float_as_uint(l_reg),false,false); l_reg=__uint_as_float(rr[0])+__uint_as_float(rr[1]); }
  if(hi==0)wsf[32+r32]=l_reg; asm volatile("s_waitcnt lgkmcnt(0)":::"memory");
  bf16*Ow=O+(long)(q0+wid*QBLK)*DMO;
  { bf16*stg=(bf16*)(shm+LDS_P)+wid*4096;
    #pragma unroll
    for(int r=0;r<16;++r){const int orow=crow(r,hi); const float rl=__builtin_amdgcn_rcpf(wsf[32+orow]);
      #pragma unroll
      for(int d0=0;d0<4;++d0)stg[orow*128+d0*32+r32]=__float2bfloat16(o[d0][r]*rl);}
    asm volatile("s_waitcnt lgkmcnt(0)":::"memory");
    #pragma unroll
    for(int i=0;i<8;++i){const int row=i*4+(lane>>4),ch=lane&15; const u32x4 v=*(const u32x4*)(stg+row*128+ch*8); ATTN_STORE16(Ow+(long)row*DMO+ch*8,v);} }
  asm volatile("s_waitcnt lgkmcnt(0)\n\ts_barrier":::"memory");
  #undef DMA_K
  #undef DMA_V
  #undef ROT3
  #undef PKW
  #undef MX3
}
constexpr int ATTN_LDS_BYTES=LDS_BYTES;
struct AttnTensors { const bf16* Q; const bf16* K; const bf16* V; bf16* O; };
struct AttnUnit { int hc; int qb; };
struct StaticOrder {
  int vcu, G, bx;
  __device__ __forceinline__ StaticOrder(int grid,int block):vcu((grid%8==0)?(block%8)*(grid/8)+block/8:block),G(grid),bx(block){}
  __device__ __forceinline__ bool next(int i,AttnUnit&u)const{
    if(G==256){ if(i>=2)return false; const int s=vcu&31; u.hc=vcu>>5; u.qb=(i==0)?63-s:s; return true; }
    const int idx=i*G+bx; if(idx>=8*NQB)return false; u.hc=idx&7; u.qb=NQB-1-(idx>>3); return true; }
};
template<class Sched,int THRL=8> __device__ __forceinline__ void attn_phase(char*lds,const AttnTensors&T,const Sched&S){
  AttnUnit u;
  for(int i=0;S.next(i,u);++i){ const int h=u.hc>>1,c=u.hc&1;
    attn_unit<THRL>(u.qb,T.Q+h*128+c*64,T.K+h*128+c*64,T.V+h*128,T.O+u.hc*128,lds); }
}
#undef SBAR
#undef WAIT_BAR
}
constexpr int NWAVES = 8;
constexpr int M = 16384, D = 1024, FF = 2816, NGU = 2 * FF, NIN = 2048, DEPTH = 4;
constexpr size_t MiB = 1u << 20;
constexpr size_t WS_ROWSS = 1 * MiB;
constexpr size_t WS_ROPE = 2 * MiB;
constexpr size_t WS_XB = 8 * MiB;
constexpr size_t WS_H = 40 * MiB;
constexpr size_t WS_QKVU = 40 * MiB;
constexpr size_t WS_OBUF = 108 * MiB;
constexpr size_t WS_CAT = 140 * MiB;
constexpr size_t WS_W = 172 * MiB;
constexpr size_t OFF_GU1 = 0, OFF_DN1 = 11 * MiB, OFF_IN = 16 * MiB + 512 * 1024, OFF_OUT = 20 * MiB + 512 * 1024, OFF_GU2 = 22 * MiB + 512 * 1024, OFF_DN2 = 33 * MiB + 512 * 1024, W_LAYER = 39 * MiB;
constexpr size_t WS_END = WS_W + DEPTH * W_LAYER;
static_assert(attn_body::ATTN_LDS_BYTES <= 147392 && (size_t)NGU * D * 2 == 11 * MiB && (size_t)D * FF * 2 == 5 * MiB + 512 * 1024 && WS_H + (size_t)M * FF * 2 <= WS_CAT && WS_ROWSS + 16 * (size_t)M * 4 <= WS_ROPE && WS_ROPE + (size_t)M * 64 * 4 <= WS_XB, "ws map");
constexpr int LDS_BYTES = 147456;

#define LAS __attribute__((address_space(3)))
typedef unsigned short bf16;
typedef unsigned v4u __attribute__((ext_vector_type(4)));
typedef unsigned v2u __attribute__((ext_vector_type(2)));
typedef float f32x4 __attribute__((ext_vector_type(4)));
#define LDS_WAIT() asm volatile("s_waitcnt lgkmcnt(0)" ::: "memory")
__device__ __forceinline__ unsigned f2bf(float f) { unsigned u = __builtin_bit_cast(unsigned, f); return (u + 0x7fffu + ((u >> 16) & 1u)) >> 16; }
__device__ __forceinline__ unsigned pk2(float lo, float hi) { return f2bf(lo) | (f2bf(hi) << 16); }
__device__ __forceinline__ float bflo(unsigned w) { return __builtin_bit_cast(float, w << 16); }
__device__ __forceinline__ float bfhi(unsigned w) { return __builtin_bit_cast(float, w & 0xffff0000u); }
__device__ __forceinline__ float wave_sum(float v) {
#pragma unroll
    for (int o = 1; o < 64; o <<= 1) v += __shfl_xor(v, o);
    return v;
}
__device__ __forceinline__ void tr_item(const float* W, int N, int k0, int n0, const float* gk, bf16* WT, int Kd, int rbase, int rstride, int lane) {
    const int kblk = lane & 7, n4 = lane >> 3;
    const float* src = W + (size_t)(k0 + 8 * kblk) * N + n0 + 4 * n4;
    f32x4 v[8];
#pragma unroll
    for (int i = 0; i < 8; ++i) v[i] = __builtin_nontemporal_load((const f32x4*)(src + (size_t)i * N));
    if (gk) { const f32x4 g0 = *(const f32x4*)(gk + k0 + 8 * kblk), g1 = *(const f32x4*)(gk + k0 + 8 * kblk + 4);
#pragma unroll
        for (int i = 0; i < 4; ++i) { v[i] = v[i] * g0[i]; v[4 + i] = v[4 + i] * g1[i]; } }
#pragma unroll
    for (int e = 0; e < 4; ++e) { v4u o; o.x = pk2(v[0][e], v[1][e]); o.y = pk2(v[2][e], v[3][e]); o.z = pk2(v[4][e], v[5][e]); o.w = pk2(v[6][e], v[7][e]);
        *(v4u*)(WT + (size_t)(rbase + (4 * n4 + e) * rstride) * Kd + k0 + 8 * kblk) = o; }
}

#define XB_TMO      128
#define XB_XCNT(j)  (256  + 64 * (j))
#define XB_XSUB(j)  (1280 + 64 * (j))
#define XB_XGEN(j)  (2304 + 64 * (j))
#define XB_TOP      3328
#define XB_TOPGEN   3392
#define XCD_BAR_WORDS 3456
#define XB_SPIN_CAP (1u << 18)

__device__ __forceinline__ unsigned xb_ld(unsigned* p)              { return __hip_atomic_load(p, __ATOMIC_RELAXED, __HIP_MEMORY_SCOPE_AGENT); }
__device__ __forceinline__ unsigned xb_add(unsigned* p, unsigned v) { return __hip_atomic_fetch_add(p, v, __ATOMIC_RELAXED, __HIP_MEMORY_SCOPE_AGENT); }
__device__ __forceinline__ unsigned xb_xcc_id() { return (unsigned)__builtin_amdgcn_s_getreg((3 << 11) | 20) & 0xFu; }
#define XB_SPIN(cond, bar) do { unsigned _sp = 0; while (cond) { __builtin_amdgcn_s_sleep(1); \
    if ((++_sp & 255u) == 0u) { if (xb_ld(&(bar)[XB_TMO])) break; if (_sp > XB_SPIN_CAP) { atomicAdd(&(bar)[XB_TMO], 1u); break; } } } } while (0)

struct XcdBarrier {
    unsigned* bar; unsigned x;
    volatile LAS unsigned* st;
};

__device__ __forceinline__ XcdBarrier xcd_barrier_post(unsigned* bar, volatile LAS unsigned* st) {
    XcdBarrier b; b.bar = bar; b.x = xb_xcc_id(); b.st = st;
    if (threadIdx.x == 0) (void)xb_add(&bar[XB_XCNT(b.x)], 1u);
    return b;
}
__device__ __forceinline__ void xcd_barrier_complete(unsigned* bar, unsigned x, unsigned& nloc, unsigned& nx) {
    const unsigned G = gridDim.x * gridDim.y * gridDim.z;
    unsigned sum, cnt, mine, sp = 0u;
    for (;;) {
        sum = 0u; cnt = 0u; mine = 0u;
#pragma unroll
        for (unsigned j = 0; j < 16; ++j) { const unsigned c = xb_ld(&bar[XB_XCNT(j)]); sum += c; cnt += (c > 0u) ? 1u : 0u; mine = (j == x) ? c : mine; }
        if (sum == G) break;
        __builtin_amdgcn_s_sleep(1);
        if ((++sp & 255u) == 0u) { if (xb_ld(&bar[XB_TMO])) break; if (sp > XB_SPIN_CAP) { atomicAdd(&bar[XB_TMO], 1u); break; } }
    }
    nloc = mine > 0u ? mine : 1u; nx = cnt > 0u ? cnt : 1u;
}

__device__ __forceinline__ void xcd_barrier(const XcdBarrier& b) {
    asm volatile("s_waitcnt vmcnt(0)" ::: "memory");
    __syncthreads();
    if (threadIdx.x == 0) {
        unsigned* bar = b.bar;
        __builtin_amdgcn_s_waitcnt(0);
        unsigned nloc = b.st[0], nx = b.st[1];
        if (nloc == 0u) { xcd_barrier_complete(bar, b.x, nloc, nx); b.st[0] = nloc; b.st[1] = nx; }
        const unsigned old = xb_add(&bar[XB_XSUB(b.x)], 1u);
        const unsigned gen = old / nloc;
        if (old + 1u == (gen + 1u) * nloc) {
            __builtin_amdgcn_fence(__ATOMIC_RELEASE, "agent");
            asm volatile("s_waitcnt vmcnt(0)" ::: "memory");
            const unsigned og = xb_add(&bar[XB_TOP], 1u);
            const unsigned tg = og / nx;
            if (og + 1u == (tg + 1u) * nx) xb_add(&bar[XB_TOPGEN], 1u);
            else XB_SPIN(xb_ld(&bar[XB_TOPGEN]) == tg, bar);
            __builtin_amdgcn_fence(__ATOMIC_ACQUIRE, "agent");
            xb_add(&bar[XB_XGEN(b.x)], 1u);
            asm volatile("s_waitcnt vmcnt(0)" ::: "memory");
        } else {
            XB_SPIN(xb_ld(&bar[XB_XGEN(b.x)]) == gen, bar);
            __builtin_amdgcn_fence(__ATOMIC_ACQUIRE, "agent");
            asm volatile("s_waitcnt vmcnt(0)" ::: "memory");
        }
    }
    __syncthreads();
}

struct Args { const float* in[20]; float* out; unsigned char* wsp; };
typedef __attribute__((address_space(1))) unsigned char* gptr_t;
__device__ __forceinline__ gptr_t fresh_ptr(unsigned char* p) { asm volatile("" : "+s"(p)); return (gptr_t)p; }

__global__ void __launch_bounds__(NWAVES * 64, 2) hymba_fwd(Args args) {
    extern __shared__ __attribute__((aligned(16))) unsigned char lds[];
    LAS unsigned char* L = (LAS unsigned char*)lds;
    const int tid = threadIdx.x, lane = tid & 63, wave = __builtin_amdgcn_readfirstlane(tid >> 6);
    const int G = gridDim.x, bx = blockIdx.x;
    const int gw = bx * NWAVES + wave, NGW = G * NWAVES;
    const int gtid = bx * (NWAVES * 64) + tid, NT = G * NWAVES * 64;
#define ws (fresh_ptr(args.wsp))
#define rowss ((float*)(unsigned char*)(ws + WS_ROWSS))
#define rope ((float*)(unsigned char*)(ws + WS_ROPE))
#define XB ((bf16*)(unsigned char*)(ws + WS_XB))
#define HB ((bf16*)(unsigned char*)(ws + WS_H))
#define QKVU ((bf16*)(unsigned char*)(ws + WS_QKVU))
#define OBUF ((bf16*)(unsigned char*)(ws + WS_OBUF))
#define CAT ((bf16*)(unsigned char*)(ws + WS_CAT))
#define xout ((float*)(unsigned char*)fresh_ptr((unsigned char*)args.out))
    { volatile LAS unsigned* st0 = (volatile LAS unsigned*)(L + 147392); if (tid < 2) st0[tid] = 0u; }
    __syncthreads();
    const XcdBarrier gbar = xcd_barrier_post((unsigned*)args.wsp, (volatile LAS unsigned*)(L + 147392));

    {
        constexpr int IT_G = 16 * 88, IT_D = 44 * 32, IT_IN = 16 * 64, IT_OUT = 8 * 32, IT_LAYER = 4 * IT_G + 2 * IT_D + IT_IN + IT_OUT;
        static_assert(IT_G == IT_D, "item decode");
        for (int it = gw; it < DEPTH * IT_LAYER; it += NGW) {
            const int l = it / IT_LAYER; int r = it % IT_LAYER; unsigned char* wl = (unsigned char*)(ws + WS_W + (size_t)l * W_LAYER);
            if (r < 6 * IT_G) {
                const int f = r / (3 * IT_G), q = r % (3 * IT_G), kind = q / IT_G, i = q % IT_G;
                if (kind < 2) { const float* W = args.in[(f ? 16 : 2) + kind] + (size_t)l * D * FF; const int kb = i / 88, nb = i % 88, n0 = 32 * nb;
                    tr_item(W, FF, 64 * kb, n0, args.in[f ? 15 : 1] + l * D, (bf16*)(wl + (f ? OFF_GU2 : OFF_GU1)), D, (n0 >> 7) * 256 + kind * 128 + (n0 & 127), 1, lane); }
                else { const float* W = args.in[f ? 18 : 4] + (size_t)l * FF * D; const int kb = i / 32, nb = i % 32;
                    tr_item(W, D, 64 * kb, 32 * nb, nullptr, (bf16*)(wl + (f ? OFF_DN2 : OFF_DN1)), FF, 32 * nb, 1, lane); }
            } else { r -= 6 * IT_G;
                if (r < IT_IN) { const float* W = args.in[6] + (size_t)l * D * NIN; const int kb = r / 64, nb = r % 64, n0 = 32 * nb; int rbase = n0, rstride = 1;
                    if (n0 < 1024) { const int d0 = n0 & 63; rbase = (n0 - d0) + (d0 ? 1 : 0); rstride = 2; }
                    tr_item(W, NIN, 64 * kb, n0, args.in[5] + l * D, (bf16*)(wl + OFF_IN), D, rbase, rstride, lane); }
                else { r -= IT_IN; const float* W = args.in[14] + (size_t)l * D * D; const int kb = r / 32, nb = r % 32;
                    tr_item(W, D, 64 * kb, 32 * nb, nullptr, (bf16*)(wl + OFF_OUT), D, 32 * nb, 1, lane); }
            }
        }
        for (int it = gw; it < DEPTH * 1024; it += NGW) {
            const int l = it >> 10, r = it & 1023, g = r >> 8, cb = (r >> 4) & 15, nb = r & 15, c0 = cb * 8, n = nb * 64 + lane;
            const float* pw = args.in[12] + ((size_t)(l * 4 + g) * 128 + c0) * 128; const float* ps = args.in[13] + l * 512 + g * 128;
            const float* wo = args.in[14] + (size_t)l * D * D + (size_t)(512 + g * 128) * D + n;
            float a[8];
#pragma unroll
            for (int j = 0; j < 8; ++j) a[j] = 0.f;
            for (int e = 0; e < 128; ++e) { const float w = wo[(size_t)e * D] * ps[e];
#pragma unroll
                for (int j = 0; j < 8; ++j) a[j] += pw[j * 128 + e] * w; }
            v4u o; o.x = pk2(a[0], a[1]); o.y = pk2(a[2], a[3]); o.z = pk2(a[4], a[5]); o.w = pk2(a[6], a[7]);
            *(v4u*)((bf16*)(unsigned char*)(ws + WS_W + (size_t)l * W_LAYER + OFF_OUT) + (size_t)n * D + 512 + g * 128 + c0) = o;
        }
        for (int i = gtid; i < M * 32; i += NT) { const int s = i >> 5, j = i & 31; const float inv = (float)pow(10000.0, -(double)j / 32.0); const float ang = (float)s * inv;
            const double a = (double)ang; rope[2 * i] = (float)cos(a); rope[2 * i + 1] = (float)sin(a); }
        for (int m = gw; m < M; m += NGW) { const f32x4* xr = (const f32x4*)(args.in[0] + (size_t)m * D) + lane; f32x4 v[4]; float s = 0.f;
#pragma unroll
            for (int j = 0; j < 4; ++j) { v[j] = xr[64 * j]; s += (v[j].x * v[j].x + v[j].y * v[j].y) + (v[j].z * v[j].z + v[j].w * v[j].w); }
            s = wave_sum(s); if (lane < 16) rowss[(size_t)m * 16 + lane] = (lane == 0) ? s : 0.f;
            v2u* o8 = (v2u*)(XB + (size_t)m * D) + lane;
#pragma unroll
            for (int j = 0; j < 4; ++j) { v2u w; w.x = pk2(v[j].x, v[j].y); w.y = pk2(v[j].z, v[j].w); o8[64 * j] = w; } }
    }
    cg::this_grid().sync();


    for (int step = 0; step < 3 * DEPTH; ++step) {
        const int l = step / 3, kind = step % 3;
#define wl ((unsigned char*)(ws + WS_W + (size_t)l * W_LAYER))
        if (kind != 1) {
            const int f = kind >> 1;
            { pg8::Gemm g{XB, (const bf16*)(wl + (f ? OFF_GU2 : OFF_GU1)), M, NGU, D}; pg8::StaticOrder S; S.init(M, NGU, G, bx);
              pg8::EpiGateUp E{HB, rowss};
              pg8::gemm_phase<pg8::EpiGateUp, pg8::StaticOrder, PG8_ALIGN, PG8_SP2>(L, g, S, E); }
            xcd_barrier(gbar);
            { pg8::Gemm g{HB, (const bf16*)(wl + (f ? OFF_DN2 : OFF_DN1)), M, D, FF}; pg8::StaticOrder S; S.init(M, D, G, bx);
              pg8::EpiResid E{(const float*)(unsigned char*)fresh_ptr((unsigned char*)((step == 0) ? args.in[0] : args.out)), xout, XB, rowss, 0.5f};
              pg8::gemm_phase<pg8::EpiResid, pg8::StaticOrder, PG8_ALIGN, PG8_SP2>(L, g, S, E); }
            xcd_barrier(gbar);
        } else {
            { pg8::Gemm g{XB, (const bf16*)(wl + OFF_IN), M, NIN, D}; pg8::StaticOrder S; S.init(M, NIN, G, bx);
              pg8::EpiQKVU E{QKVU, rowss, rope};
              pg8::gemm_phase<pg8::EpiQKVU, pg8::StaticOrder, PG8_ALIGN, PG8_SP2>(L, g, S, E); }
            xcd_barrier(gbar);
            { const attn_body::AttnTensors AT{(const attn_body::bf16*)QKVU, (const attn_body::bf16*)(QKVU + 512), (const attn_body::bf16*)(QKVU + 1024), (attn_body::bf16*)OBUF};
              const attn_body::StaticOrder S(G, bx);
              attn_body::attn_phase<attn_body::StaticOrder>((char*)lds, AT, S); }
            xcd_barrier(gbar);
            {
                const float li = 0.8f - 0.6f * expf(-0.3f * (float)l);
                const float s1 = wave_sum(args.in[7][l * 64 + lane] * args.in[8][l * 64 + lane]), s2 = wave_sum(args.in[9][l * 64 + lane] * args.in[10][l * 64 + lane]);
                const float lam = expf(s1) - expf(s2) + li;
                const int hd = lane >> 4, j0 = (lane & 15) * 8;
                float gn[8];
#pragma unroll
                for (int j = 0; j < 8; ++j) gn[j] = args.in[11][l * 128 + j0 + j] * (1.0f - li);
                const int win = 2 << hd;
                for (int m = gw; m < M; m += NGW) {
                    const v4u a = *(const v4u*)(OBUF + (size_t)m * 1024 + hd * 256 + j0), b = *(const v4u*)(OBUF + (size_t)m * 1024 + hd * 256 + 128 + j0);
                    float o[8];
                    o[0] = bflo(a.x) - lam * bflo(b.x); o[1] = bfhi(a.x) - lam * bfhi(b.x); o[2] = bflo(a.y) - lam * bflo(b.y); o[3] = bfhi(a.y) - lam * bfhi(b.y);
                    o[4] = bflo(a.z) - lam * bflo(b.z); o[5] = bfhi(a.z) - lam * bfhi(b.z); o[6] = bflo(a.w) - lam * bflo(b.w); o[7] = bfhi(a.w) - lam * bfhi(b.w);
                    float ss = 0.f;
#pragma unroll
                    for (int j = 0; j < 8; ++j) ss += o[j] * o[j];
                    ss += __shfl_xor(ss, 1); ss += __shfl_xor(ss, 2); ss += __shfl_xor(ss, 4); ss += __shfl_xor(ss, 8);
                    const float rr = __builtin_amdgcn_rsqf(ss * (1.0f / 128.0f) + 1e-6f);
                    v4u w; w.x = pk2(o[0] * rr * gn[0], o[1] * rr * gn[1]); w.y = pk2(o[2] * rr * gn[2], o[3] * rr * gn[3]); w.z = pk2(o[4] * rr * gn[4], o[5] * rr * gn[5]); w.w = pk2(o[6] * rr * gn[6], o[7] * rr * gn[7]);
                    *(v4u*)(CAT + (size_t)m * 1024 + hd * 128 + j0) = w;
                    const bf16* up = QKVU + (size_t)m * 2112 + 1536 + hd * 128 + j0;
                    const v4u u0 = *(const v4u*)up;
                    float sm[8] = {bflo(u0.x), bfhi(u0.x), bflo(u0.y), bfhi(u0.y), bflo(u0.z), bfhi(u0.z), bflo(u0.w), bfhi(u0.w)};
                    float us[8];
#pragma unroll
                    for (int j = 0; j < 8; ++j) us[j] = sm[j];
                    for (int t = 1; t < win; ++t) { if (m - t >= 0) { const v4u ut = *(const v4u*)(up - (size_t)t * 2112);
                        sm[0] += bflo(ut.x); sm[1] += bfhi(ut.x); sm[2] += bflo(ut.y); sm[3] += bfhi(ut.y); sm[4] += bflo(ut.z); sm[5] += bfhi(ut.z); sm[6] += bflo(ut.w); sm[7] += bfhi(ut.w); } }
                    const float ic = 1.0f / (float)((m + 1 < win) ? (m + 1) : win);
                    v4u d; d.x = pk2(sm[0] * ic - us[0], sm[1] * ic - us[1]); d.y = pk2(sm[2] * ic - us[2], sm[3] * ic - us[3]); d.z = pk2(sm[4] * ic - us[4], sm[5] * ic - us[5]); d.w = pk2(sm[6] * ic - us[6], sm[7] * ic - us[7]);
                    *(v4u*)(CAT + (size_t)m * 1024 + 512 + hd * 128 + j0) = d;
                }
            }
            xcd_barrier(gbar);
            { pg8::Gemm g{CAT, (const bf16*)(wl + OFF_OUT), M, D, D}; pg8::StaticOrder S; S.init(M, D, G, bx);
              pg8::EpiResid E{xout, xout, XB, rowss, 1.0f};
              pg8::gemm_phase<pg8::EpiResid, pg8::StaticOrder, PG8_ALIGN, PG8_SP2>(L, g, S, E); }
            xcd_barrier(gbar);
        }
    }
    for (int m = gw; m < M; m += NGW) { f32x4* xr = (f32x4*)(xout + (size_t)m * D) + lane; const f32x4* gr = (const f32x4*)args.in[19] + lane;
        const float r = pg8::rs_from_ss(rowss + (size_t)m * 16);
#pragma unroll
        for (int j = 0; j < 4; ++j) { const f32x4 v = xr[64 * j], gg = gr[64 * j]; xr[64 * j] = v * r * gg; } }
}

#undef wl
#undef ws
#undef rowss
#undef rope
#undef XB
#undef HB
#undef QKVU
#undef OBUF
#undef CAT
#undef xout
extern "C" void kernel_launch(void* const* d_in, const int* in_sizes, int n_in, void* d_out, int out_size, void* d_ws, size_t ws_size, hipStream_t stream) {
    static int grid_blocks = 0;
    if (grid_blocks == 0) {
        if (n_in != 20 || out_size != M * D || ws_size < WS_END) { fprintf(stderr, "kernel_launch: unexpected shapes (n_in %d out %d ws %zu, need %zu)\n", n_in, out_size, ws_size, (size_t)WS_END); grid_blocks = -1; return; }
        int dev = 0, cus = 0, per_cu = 0;
        (void)hipGetDevice(&dev); (void)hipDeviceGetAttribute(&cus, hipDeviceAttributeMultiprocessorCount, dev);
        if (hipFuncSetAttribute((const void*)hymba_fwd, hipFuncAttributeMaxDynamicSharedMemorySize, LDS_BYTES) != hipSuccess) { fprintf(stderr, "kernel_launch: hipFuncSetAttribute failed\n"); grid_blocks = -1; return; }
        if (hipOccupancyMaxActiveBlocksPerMultiprocessor(&per_cu, (const void*)hymba_fwd, NWAVES * 64, LDS_BYTES) != hipSuccess || per_cu < 1) { fprintf(stderr, "kernel_launch: occupancy query says %d\n", per_cu); per_cu = 1; }
        (void)hipGetLastError();
        grid_blocks = cus * per_cu;
    }
    if (grid_blocks < 0) return;
    if (hipMemsetAsync(d_ws, 0, 65536, stream) != hipSuccess) { fprintf(stderr, "kernel_launch: memset failed\n"); return; }
    Args a{};
    for (int i = 0; i < 20; ++i) a.in[i] = (const float*)d_in[i];
    a.out = (float*)d_out; a.wsp = (unsigned char*)d_ws;
    void* kargs[] = {&a};
    hipError_t e = hipLaunchCooperativeKernel((const void*)hymba_fwd, dim3(grid_blocks), dim3(NWAVES * 64), kargs, LDS_BYTES, stream);
    if (e != hipSuccess) fprintf(stderr, "cooperative launch failed: %s (grid %d)\n", hipGetErrorString(e), grid_blocks);
}
```

```cpp
#include <hip/hip_runtime.h>
#include <hip/hip_cooperative_groups.h>
#include <cstdio>
#include <cstdint>
namespace cg = cooperative_groups;
namespace pg8 {
#define PG8_LAS __attribute__((address_space(3)))
typedef unsigned short bf16_t;
typedef short bf16x8 __attribute__((ext_vector_type(8)));
typedef float f32x4 __attribute__((ext_vector_type(4)));
typedef unsigned u32x4 __attribute__((ext_vector_type(4)));
constexpr int BM = 256, BK = 64, HALF = 128, HTB = HALF * BK * 2  , STAGE_BYTES = 8 * HTB, NXCD = 8, WGM = 8;

__host__ __device__ __forceinline__ int lds_byte(int r, int c) { const int st = (r >> 4) * 2 + (c >> 5), rr = r & 15, cc = c & 31, ob = rr * 64 + cc * 2; return st * 1024 + (ob ^ (((ob >> 9) & 1) << 5)); }
__host__ __device__ __forceinline__ void stage_rc(int b, int& R, int& C) { const int st = b / 1024, sb = b % 1024, swz = sb ^ (((sb >> 9) & 1) << 5); R = (st >> 1) * 16 + swz / 64; C = (st & 1) * 32 + (swz % 64) / 2; }
__host__ __device__ __forceinline__ int perm32(int rho) { const int n = rho >> 4, i = rho & 15; return 8 * (i >> 2) + 4 * n + (i & 3); }

struct Unit { int pm, pn; };
struct Gemm { const bf16_t* A; const bf16_t* Bt; int M, N, K; };

struct StaticOrder {
    int nM, nN, nwg, G, c;
    __host__ __device__ void init(int M, int N, int G_, int c_) { nM = M / BM; nN = N / BM; nwg = nM * nN; G = G_; c = c_; }
    __host__ __device__ bool next(int i, Unit& u) const {
        const long L = (long)i * G + c; if (L >= nwg) return false;
        int wgid = (int)L; { const int q = nwg / NXCD, r = nwg % NXCD, xcd = wgid % NXCD, off = wgid / NXCD; wgid = (xcd < r ? xcd * (q + 1) : r * (q + 1) + (xcd - r) * q) + off; }
        const int nig = WGM * nN, gid = wgid / nig, fm = gid * WGM, gsz = (nM - fm) < WGM ? (nM - fm) : WGM;
        u.pm = fm + ((wgid % nig) % gsz); u.pn = (wgid % nig) / gsz; return true;
    }
    __device__ __forceinline__ void a_ready(const Unit&) const {}
    __device__ __forceinline__ void done(const Unit&) const {}
};

__device__ __forceinline__ unsigned cvt_pk_bf16(float lo, float hi) { unsigned r; asm volatile("v_cvt_pk_bf16_f32 %0, %1, %2" : "=v"(r) : "v"(lo), "v"(hi)); return r; }
typedef float f32x2 __attribute__((ext_vector_type(2)));
__device__ __forceinline__ f32x2 gelu_pk(f32x2 v) {
    const f32x2 av = __builtin_elementwise_abs(v), d = av * 0.2316418882f + 1.0f;
    f32x2 t; t.x = __builtin_amdgcn_rcpf(d.x); t.y = __builtin_amdgcn_rcpf(d.y);
    f32x2 q = t * 0.5307027145f + (-0.7265760135f); q = q * t + 0.7107068705f; q = q * t + (-0.142248368f); q = q * t + 0.127414796f; q = q * t;
    const f32x2 s = (v * v) * (-0.72134752044f);
    f32x2 e; e.x = __builtin_amdgcn_exp2f(s.x); e.y = __builtin_amdgcn_exp2f(s.y);
    const f32x2 m = v * (q * e), r = v - m;
    f32x2 o; o.x = v.x < 0.f ? m.x : r.x; o.y = v.y < 0.f ? m.y : r.y; return o;
}

template <int ACT  > struct EpiBf16 {
    static constexpr bool PERM = true, AFTER_DRAIN = false; static_assert(ACT == 0 || ACT == 1, "EpiBf16: ACT is 0 (none) or 1 (gelu_pk)");
    bf16_t* O; int ldc; const float* bias; int split_cols; size_t split_stride; float scale0;
    __device__ __forceinline__ void operator()(const f32x4 (&acc)[2][2][4][2], const Unit& u, int wr, int wc, int fr, int fq) const {
        const int row0 = u.pm * BM + wr * 64 + fr; int colt = u.pn * BM; bf16_t* base = O;
        float sc = 1.f; if (split_cols) { const int t = colt / split_cols; base += (size_t)t * split_stride; colt -= t * split_cols; if (t == 0) sc = scale0; }
        const int col0 = colt + wc * 32 + 8 * fq, bcol0 = u.pn * BM + wc * 32 + 8 * fq;
        f32x4 bv[2][2];
#pragma unroll
        for (int bj = 0; bj < 2; ++bj)
#pragma unroll
            for (int n = 0; n < 2; ++n) bv[bj][n] = bias ? *(const f32x4*)(bias + bcol0 + bj * HALF + 4 * n) : (f32x4){0.f, 0.f, 0.f, 0.f};
#pragma unroll
        for (int ai = 0; ai < 2; ++ai)
#pragma unroll
            for (int m = 0; m < 4; ++m) { bf16_t* rowp = base + (size_t)(row0 + ai * HALF + m * 16) * ldc + col0;
#pragma unroll
                for (int bj = 0; bj < 2; ++bj) { f32x4 v0 = acc[ai][bj][m][0] + bv[bj][0], v1 = acc[ai][bj][m][1] + bv[bj][1];
                    if (ACT == 1) { f32x2 a = gelu_pk((f32x2){v0[0], v0[1]}), b = gelu_pk((f32x2){v0[2], v0[3]}), c = gelu_pk((f32x2){v1[0], v1[1]}), d = gelu_pk((f32x2){v1[2], v1[3]});
                        v0 = (f32x4){a.x, a.y, b.x, b.y}; v1 = (f32x4){c.x, c.y, d.x, d.y}; }
                    v0 = v0 * sc; v1 = v1 * sc; u32x4 w; w.x = cvt_pk_bf16(v0[0], v0[1]); w.y = cvt_pk_bf16(v0[2], v0[3]); w.z = cvt_pk_bf16(v1[0], v1[1]); w.w = cvt_pk_bf16(v1[2], v1[3]);
                    *(u32x4*)(rowp + bj * HALF) = w; } }
    }
};
__device__ __forceinline__ float rs_from_ss(const float* p) { const f32x4 a = ((const f32x4*)p)[0], b = ((const f32x4*)p)[1], c = ((const f32x4*)p)[2], d = ((const f32x4*)p)[3];
    const float ss = (((a[0] + a[1]) + (a[2] + a[3])) + ((b[0] + b[1]) + (b[2] + b[3]))) + (((c[0] + c[1]) + (c[2] + c[3])) + ((d[0] + d[1]) + (d[2] + d[3])));
    return __builtin_amdgcn_rsqf(ss * (1.0f / 1024.0f) + 1e-6f); }
struct EpiGateUp {
    static constexpr bool PERM = true, AFTER_DRAIN = false;
    bf16_t* H; const float* rowss;
    __device__ __forceinline__ void operator()(const f32x4 (&acc)[2][2][4][2], const Unit& u, int wr, int wc, int fr, int fq) const {
        const int row0 = u.pm * BM + wr * 64 + fr; const int col0 = u.pn * HALF + wc * 32 + 8 * fq;
#pragma unroll
        for (int ai = 0; ai < 2; ++ai)
#pragma unroll
            for (int m = 0; m < 4; ++m) { const int row = row0 + ai * HALF + m * 16; const float r = rs_from_ss(rowss + (size_t)row * 16);
                float hv[8];
#pragma unroll
                for (int n = 0; n < 2; ++n)
#pragma unroll
                    for (int e = 0; e < 4; ++e) { const float g = acc[ai][0][m][n][e] * r, up = acc[ai][1][m][n][e] * r;
                        const float sg = g * __builtin_amdgcn_rcpf(1.0f + __builtin_amdgcn_exp2f(g * -1.4426950408889634f)); hv[n * 4 + e] = sg * up; }
                u32x4 w; w.x = cvt_pk_bf16(hv[0], hv[1]); w.y = cvt_pk_bf16(hv[2], hv[3]); w.z = cvt_pk_bf16(hv[4], hv[5]); w.w = cvt_pk_bf16(hv[6], hv[7]);
                *(u32x4*)(H + (size_t)row * 2816 + col0) = w; }
    }
};
struct EpiResid {
    static constexpr bool PERM = true, AFTER_DRAIN = false;
    const float* xin; float* xout; bf16_t* xb; float* rowss_next; float alpha;
    __device__ __forceinline__ void operator()(const f32x4 (&acc)[2][2][4][2], const Unit& u, int wr, int wc, int fr, int fq) const {
        const int row0 = u.pm * BM + wr * 64 + fr; const int col0 = u.pn * BM + wc * 32 + 8 * fq;
#pragma unroll
        for (int ai = 0; ai < 2; ++ai)
#pragma unroll
            for (int m = 0; m < 4; ++m) { const int row = row0 + ai * HALF + m * 16; float ss = 0.f;
#pragma unroll
                for (int bj = 0; bj < 2; ++bj) { const size_t off = (size_t)row * 1024 + col0 + bj * HALF;
                    const f32x4 a0 = *(const f32x4*)(xin + off), a1 = *(const f32x4*)(xin + off + 4);
                    const f32x4 v0 = a0 + acc[ai][bj][m][0] * alpha, v1 = a1 + acc[ai][bj][m][1] * alpha;
                    *(f32x4*)(xout + off) = v0; *(f32x4*)(xout + off + 4) = v1;
                    ss += (v0[0] * v0[0] + v0[1] * v0[1]) + (v0[2] * v0[2] + v0[3] * v0[3]) + (v1[0] * v1[0] + v1[1] * v1[1]) + (v1[2] * v1[2] + v1[3] * v1[3]);
                    u32x4 w; w.x = cvt_pk_bf16(v0[0], v0[1]); w.y = cvt_pk_bf16(v0[2], v0[3]); w.z = cvt_pk_bf16(v1[0], v1[1]); w.w = cvt_pk_bf16(v1[2], v1[3]);
                    *(u32x4*)(xb + off) = w; }
                ss += __shfl_xor(ss, 16); ss += __shfl_xor(ss, 32);
                if (fq == 0) rowss_next[(size_t)row * 16 + u.pn * 4 + wc] = ss; }
    }
};
struct EpiQKVU {
    static constexpr bool PERM = true, AFTER_DRAIN = false;
    bf16_t* O; const float* rowss; const float* rope;
    __device__ __forceinline__ void operator()(const f32x4 (&acc)[2][2][4][2], const Unit& u, int wr, int wc, int fr, int fq) const {
        const int row0 = u.pm * BM + wr * 64 + fr; const int col0 = u.pn * BM + wc * 32 + 8 * fq; const int sec = u.pn >> 1;
        const int j0 = 16 * (wc & 1) + 4 * fq;
#pragma unroll
        for (int ai = 0; ai < 2; ++ai)
#pragma unroll
            for (int m = 0; m < 4; ++m) { const int row = row0 + ai * HALF + m * 16; float r = rs_from_ss(rowss + (size_t)row * 16); if (sec == 0) r *= 0.125f * 1.4426950408889634f;
                f32x4 cs0 = (f32x4){1.f, 0.f, 1.f, 0.f}, cs1 = cs0;
                if (sec < 2) { const f32x4* rp = (const f32x4*)(rope + ((size_t)row * 32 + j0) * 2); cs0 = rp[0]; cs1 = rp[1]; }
#pragma unroll
                for (int bj = 0; bj < 2; ++bj) { const f32x4 v0 = acc[ai][bj][m][0] * r, v1 = acc[ai][bj][m][1] * r;
                    const float o0 = v0[0] * cs0[0] - v0[1] * cs0[1], o1 = v0[1] * cs0[0] + v0[0] * cs0[1];
                    const float o2 = v0[2] * cs0[2] - v0[3] * cs0[3], o3 = v0[3] * cs0[2] + v0[2] * cs0[3];
                    const float o4 = v1[0] * cs1[0] - v1[1] * cs1[1], o5 = v1[1] * cs1[0] + v1[0] * cs1[1];
                    const float o6 = v1[2] * cs1[2] - v1[3] * cs1[3], o7 = v1[3] * cs1[2] + v1[2] * cs1[3];
                    u32x4 w; w.x = cvt_pk_bf16(o0, o1); w.y = cvt_pk_bf16(o2, o3); w.z = cvt_pk_bf16(o4, o5); w.w = cvt_pk_bf16(o6, o7);
                    *(u32x4*)(O + (size_t)row * 2112 + col0 + bj * HALF) = w; } }
    }
};

template <class Epi, class Sched, bool ALIGN_EPI = false, bool SP2 = false>
__device__ __forceinline__ void gemm_phase(PG8_LAS unsigned char* lds, const Gemm g, const Sched& S, const Epi& E) {
    int tid_ = threadIdx.x; asm volatile("" : "+v"(tid_));
    const int tid = tid_, wid = __builtin_amdgcn_readfirstlane(tid >> 6), lane = tid & 63, wr = wid >> 2, wc = wid & 3, fr = lane & 15, fq = lane >> 4;
    const int K = g.K, nt = K / BK;
    unsigned voffA[2], voffB[2];
#pragma unroll
    for (int i = 0; i < 2; ++i) { int R, C; stage_rc(tid * 16 + i * 8192, R, C); const int Rb = Epi::PERM ? ((R & ~31) + perm32(R & 31)) : R;
        voffA[i] = (unsigned)(R * K + C) * 2u; voffB[i] = (unsigned)(Rb * K + C) * 2u; }
    const size_t kstep = (size_t)(BK * 2);
    const size_t hstep = (size_t)HALF * K * 2;
    const size_t tstep = 2 * hstep;
    const unsigned ldsw = (unsigned)wid * 1024u;
    const int aoff = lds_byte(wr * 64 + fr, fq * 8), boff = lds_byte(wc * 32 + fr, fq * 8);
#define PG8_SA(b, h) (((b) * 2 + (h)) * HTB)
#define PG8_SB(b, h) ((4 + (b) * 2 + (h)) * HTB)
#define PG8_STAGE(bufoff, gbase, voff) do { _Pragma("unroll") for (int _i = 0; _i < 2; ++_i) \
        __builtin_amdgcn_global_load_lds((const unsigned*)((const char*)(gbase) + (voff)[_i]), (PG8_LAS unsigned*)(lds + (bufoff) + ldsw + _i * 8192), 16, 0, 0); } while (0)
#define PG8_LDA(dst, b, h) do { _Pragma("unroll") for (int m = 0; m < 4; ++m) _Pragma("unroll") for (int k = 0; k < 2; ++k) dst[m][k] = *(const PG8_LAS bf16x8*)(lds + PG8_SA(b, h) + aoff + m * 2048 + k * 1024); } while (0)
#define PG8_LDB(dst, b, h) do { _Pragma("unroll") for (int n = 0; n < 2; ++n) _Pragma("unroll") for (int k = 0; k < 2; ++k) dst[n][k] = *(const PG8_LAS bf16x8*)(lds + PG8_SB(b, h) + boff + n * 2048 + k * 1024); } while (0)
#define PG8_MMA(ai, bj, At, Bt) do { __builtin_amdgcn_s_setprio(1); _Pragma("unroll") for (int m = 0; m < 4; ++m) _Pragma("unroll") for (int n = 0; n < 2; ++n) _Pragma("unroll") for (int k = 0; k < 2; ++k) \
        acc[ai][bj][m][n] = __builtin_amdgcn_mfma_f32_16x16x32_bf16(Bt[n][k], At[m][k], acc[ai][bj][m][n], 0, 0, 0); __builtin_amdgcn_s_setprio(0); } while (0)
#define PG8_WAIT_V(n) asm volatile("s_waitcnt vmcnt(" #n ")" ::: "memory")
#define PG8_WAIT_L(n) asm volatile("s_waitcnt lgkmcnt(" #n ")" ::: "memory")
#define PG8_BAR __builtin_amdgcn_s_barrier()
#define PG8_SCHED __builtin_amdgcn_sched_barrier(0)
    Unit cur, nxt; int ui = 0;
    if (!S.next(0, cur)) return;
    f32x4 acc[2][2][4][2];
#pragma unroll
    for (int a = 0; a < 2; ++a)
#pragma unroll
        for (int b = 0; b < 2; ++b)
#pragma unroll
            for (int m = 0; m < 4; ++m)
#pragma unroll
                for (int n = 0; n < 2; ++n) acc[a][b][m][n] = (f32x4){0.f, 0.f, 0.f, 0.f};
    bf16x8 At[4][2], B0[2][2], B1[2][2];
    const char* cA = (const char*)g.A + (size_t)cur.pm * tstep; const char* cB = (const char*)g.Bt + (size_t)cur.pn * tstep;
    S.a_ready(cur);
    if constexpr (SP2) {
        PG8_STAGE(PG8_SB(0, 0), cB, voffB); PG8_STAGE(PG8_SB(0, 1), cB + hstep, voffB); PG8_STAGE(PG8_SA(0, 0), cA, voffA); PG8_STAGE(PG8_SA(0, 1), cA + hstep, voffA);
        if (wr == 1) PG8_BAR;
        PG8_WAIT_V(2); PG8_BAR;
        PG8_STAGE(PG8_SB(1, 0), cB + kstep, voffB); PG8_STAGE(PG8_SA(1, 0), cA + kstep, voffA); PG8_STAGE(PG8_SB(1, 1), cB + hstep + kstep, voffB);
        PG8_WAIT_V(6); PG8_BAR;
    } else {
        PG8_STAGE(PG8_SB(0, 0), cB, voffB); PG8_STAGE(PG8_SA(0, 0), cA, voffA); PG8_STAGE(PG8_SB(0, 1), cB + hstep, voffB); PG8_STAGE(PG8_SA(0, 1), cA + hstep, voffA);
        if (wr == 1) PG8_BAR;
        PG8_WAIT_V(4); PG8_BAR;
        PG8_STAGE(PG8_SB(1, 0), cB + kstep, voffB); PG8_STAGE(PG8_SA(1, 0), cA + kstep, voffA); PG8_STAGE(PG8_SB(1, 1), cB + hstep + kstep, voffB);
        PG8_WAIT_V(6); PG8_BAR;
    }
    for (;;) {
        const bool has_next = S.next(ui + 1, nxt);
        const char* nA = has_next ? (const char*)g.A + (size_t)nxt.pm * tstep : cA; const char* nB = has_next ? (const char*)g.Bt + (size_t)nxt.pn * tstep : cB;
        for (int t = 0; t < nt; t += 2) {
            const bool last = (t == nt - 2);
            const char* a1 = cA + (size_t)(t + 1) * kstep;
            const char* a2 = last ? nA : cA + (size_t)(t + 2) * kstep; const char* b2 = last ? nB : cB + (size_t)(t + 2) * kstep;
            const char* a3 = a2 + kstep; const char* b3 = b2 + kstep;
            if (last && has_next) S.a_ready(nxt);
            if constexpr (SP2) {
            PG8_LDB(B0, 0, 0); PG8_LDB(B1, 0, 1); PG8_SCHED; PG8_LDA(At, 0, 0); PG8_STAGE(PG8_SA(1, 1), a1 + hstep, voffA);
            PG8_WAIT_V(8); PG8_WAIT_L(0); PG8_BAR; PG8_MMA(0, 0, At, B0); PG8_MMA(0, 1, At, B1); PG8_BAR; PG8_SCHED;
            PG8_LDA(At, 0, 1); PG8_STAGE(PG8_SB(0, 0), b2, voffB); PG8_STAGE(PG8_SB(0, 1), b2 + hstep, voffB); PG8_STAGE(PG8_SA(0, 0), a2, voffA);
            PG8_WAIT_V(8); PG8_WAIT_L(0); PG8_BAR; PG8_MMA(1, 0, At, B0); PG8_MMA(1, 1, At, B1); PG8_BAR; PG8_SCHED;
            PG8_LDB(B0, 1, 0); PG8_LDB(B1, 1, 1); PG8_SCHED; PG8_LDA(At, 1, 0); PG8_STAGE(PG8_SA(0, 1), a2 + hstep, voffA);
            PG8_WAIT_V(8); PG8_WAIT_L(0); PG8_BAR; PG8_MMA(0, 0, At, B0); PG8_MMA(0, 1, At, B1); PG8_BAR; PG8_SCHED;
            PG8_LDA(At, 1, 1); PG8_STAGE(PG8_SB(1, 0), b3, voffB); PG8_STAGE(PG8_SB(1, 1), b3 + hstep, voffB); PG8_STAGE(PG8_SA(1, 0), a3, voffA);
            PG8_WAIT_V(8); PG8_WAIT_L(0); PG8_BAR; PG8_MMA(1, 0, At, B0); PG8_MMA(1, 1, At, B1); PG8_BAR; PG8_SCHED;
            } else {
            PG8_LDB(B0, 0, 0); PG8_SCHED; PG8_LDA(At, 0, 0); PG8_STAGE(PG8_SA(1, 1), a1 + hstep, voffA);
            PG8_WAIT_L(8); PG8_BAR; PG8_WAIT_L(0); PG8_MMA(0, 0, At, B0); PG8_BAR; PG8_SCHED;
            PG8_LDB(B1, 0, 1); PG8_STAGE(PG8_SB(0, 0), b2, voffB);
            PG8_BAR; PG8_WAIT_L(0); PG8_MMA(0, 1, At, B1); PG8_BAR;
            PG8_LDA(At, 0, 1); PG8_STAGE(PG8_SA(0, 0), a2, voffA);
            PG8_BAR; PG8_WAIT_L(0); PG8_MMA(1, 0, At, B0); PG8_BAR; PG8_SCHED;
            PG8_STAGE(PG8_SB(0, 1), b2 + hstep, voffB);
            PG8_WAIT_V(6); PG8_BAR; PG8_MMA(1, 1, At, B1); PG8_BAR;
            PG8_LDB(B0, 1, 0); PG8_SCHED; PG8_LDA(At, 1, 0); PG8_STAGE(PG8_SA(0, 1), a2 + hstep, voffA);
            PG8_WAIT_L(8); PG8_BAR; PG8_WAIT_L(0); PG8_MMA(0, 0, At, B0); PG8_BAR; PG8_SCHED;
            PG8_LDB(B1, 1, 1); PG8_STAGE(PG8_SB(1, 0), b3, voffB);
            PG8_BAR; PG8_WAIT_L(0); PG8_MMA(0, 1, At, B1); PG8_BAR;
            PG8_LDA(At, 1, 1); PG8_STAGE(PG8_SA(1, 0), a3, voffA);
            PG8_BAR; PG8_WAIT_L(0); PG8_MMA(1, 0, At, B0); PG8_BAR; PG8_SCHED;
            PG8_STAGE(PG8_SB(1, 1), b3 + hstep, voffB);
            PG8_WAIT_V(6); PG8_BAR; PG8_MMA(1, 1, At, B1); PG8_BAR;
            }
        }
        if constexpr (ALIGN_EPI) { if (wr == 0) PG8_BAR; }
        if constexpr (!Epi::AFTER_DRAIN) { E(acc, cur, wr, wc, fr, fq); S.done(cur); }
        if (!has_next) break;
#pragma unroll
        for (int a = 0; a < 2; ++a)
#pragma unroll
            for (int b = 0; b < 2; ++b)
#pragma unroll
                for (int m = 0; m < 4; ++m)
#pragma unroll
                    for (int n = 0; n < 2; ++n) acc[a][b][m][n] = (f32x4){0.f, 0.f, 0.f, 0.f};
        cur = nxt; cA = nA; cB = nB; ++ui;
        if constexpr (ALIGN_EPI) { if (wr == 1) PG8_BAR; }
    }
    PG8_WAIT_V(0);
    if constexpr (!ALIGN_EPI) { if (wr == 0) PG8_BAR; }
    PG8_BAR;
    if constexpr (Epi::AFTER_DRAIN) { E.fused(acc, cur, wr, wc, fr, fq, lds, wid, lane); S.done(cur); }
#undef PG8_SA
#undef PG8_SB
#undef PG8_STAGE
#undef PG8_LDA
#undef PG8_LDB
#undef PG8_MMA
#undef PG8_WAIT_V
#undef PG8_WAIT_L
#undef PG8_BAR
#undef PG8_SCHED
}
}

#ifndef PG8_SP2
#define PG8_SP2 true
#endif
#ifndef PG8_ALIGN
#define PG8_ALIGN true
#endif
#include <hip/hip_bf16.h>
#include <cmath>
namespace attn_body {
using bf16=__hip_bfloat16;
using bf16x8=__attribute__((ext_vector_type(8)))short;
using s16x4=__attribute__((ext_vector_type(4)))short;
using f32x16=__attribute__((ext_vector_type(16)))float;
using u32x4=__attribute__((ext_vector_type(4)))unsigned;
constexpr int BATCH=1,NHEAD=16,SEQ=16384,D=64,DM=2112,DMO=1024;
constexpr int NW=8,QBLK=32,QB=QBLK*NW,KVBLK=64,NQB=SEQ/QB;
constexpr int ATTN_PITCH=DM, ATTN_UNIT_ROWS=QB;
__device__ __forceinline__ int crow(int r,int hi){return (r&3)+8*(r>>2)+4*hi;}
#define SBAR() __builtin_amdgcn_sched_barrier(0)
__device__ __forceinline__ void cmask(f32x16&p0,f32x16&p1,int jb,int qrel,int hi){
  const float NEG=-INFINITY; int kb=64*jb+4*hi;
  #pragma unroll
  for(int r=0;r<16;++r){int kv=kb+(r&3)+8*(r>>2); if(kv>qrel)p0[r]=NEG; if(kv+32>qrel)p1[r]=NEG;}
}

constexpr int NSLOT=3, SLOTB=8192;
constexpr int NVSLOT=3, VSLOTB=16384;
constexpr int LDS_K=0, LDS_V=NSLOT*SLOTB, LDS_P=LDS_V+NVSLOT*VSLOTB, LDS_WS=LDS_P+NW*8192, WSF_STRIDE=64, LDS_BYTES=LDS_WS+NW*WSF_STRIDE*4;
constexpr float C2=0.125f*1.4426950408889634f;
__device__ __forceinline__ void glds16(const void*gsrc,unsigned lds_dst){unsigned keep;
  asm volatile("s_mov_b32 %0, m0\n\ts_mov_b32 m0, %2\n\ts_nop 0\n\tglobal_load_lds_dwordx4 %1, off\n\ts_mov_b32 m0, %0":"=&s"(keep):"v"(gsrc),"s"(lds_dst):"memory");}
__device__ __forceinline__ float max3f(float a,float b,float c){float r;asm("v_max3_f32 %0, %1, %2, %3":"=v"(r):"v"(a),"v"(b),"v"(c));return r;}
__device__ __forceinline__ float max2f(float a,float b){float r;asm("v_max_f32_e32 %0, %1, %2":"=v"(r):"v"(a),"v"(b));return r;}
__device__ __forceinline__ float fadd_s(float a,float b){float r;asm("v_add_f32_e32 %0, %1, %2":"=v"(r):"v"(a),"v"(b));return r;}
__device__ __forceinline__ float fsub_s(float a,float b){float r;asm("v_sub_f32_e32 %0, %1, %2":"=v"(r):"v"(a),"v"(b));return r;}
typedef float f32x2_t __attribute__((ext_vector_type(2))); typedef __bf16 bf16x2_t __attribute__((ext_vector_type(2)));
__device__ __forceinline__ unsigned cvtpk_s(float lo,float hi){f32x2_t v={lo,hi};bf16x2_t b=__builtin_convertvector(v,bf16x2_t);return __builtin_bit_cast(unsigned,b);}
#define WAIT_BAR(N) asm volatile("s_waitcnt vmcnt(" #N ") lgkmcnt(0)\n\ts_barrier":::"memory")

__device__ __forceinline__ void qkt(f32x16&p0,f32x16&p1,const char*Kslot,const bf16x8*qr,const f32x16&negm,int r32,int hi){
  const char*kb=Kslot+hi*1024+r32*16;
  #pragma unroll
  for(int d0=0;d0<4;++d0){
    const bf16x8 b0=*reinterpret_cast<const bf16x8*>(kb+d0*2048);
    const bf16x8 b1=*reinterpret_cast<const bf16x8*>(kb+d0*2048+512);
    if(d0==0){p0=__builtin_amdgcn_mfma_f32_32x32x16_bf16(b0,qr[0],negm,0,0,0);p1=__builtin_amdgcn_mfma_f32_32x32x16_bf16(b1,qr[0],negm,0,0,0);}
    else{p0=__builtin_amdgcn_mfma_f32_32x32x16_bf16(b0,qr[d0],p0,0,0,0);p1=__builtin_amdgcn_mfma_f32_32x32x16_bf16(b1,qr[d0],p1,0,0,0);}}
}
typedef __attribute__((address_space(3))) const char* lds_cptr;
typedef short v4i16_t __attribute__((ext_vector_type(4)));
__device__ __forceinline__ void kload8(bf16x8*kf,lds_cptr kp){
  kf[0]=*(const __attribute__((address_space(3))) bf16x8*)(kp);      kf[1]=*(const __attribute__((address_space(3))) bf16x8*)(kp+512);
  kf[2]=*(const __attribute__((address_space(3))) bf16x8*)(kp+2048); kf[3]=*(const __attribute__((address_space(3))) bf16x8*)(kp+2560);
  kf[4]=*(const __attribute__((address_space(3))) bf16x8*)(kp+4096); kf[5]=*(const __attribute__((address_space(3))) bf16x8*)(kp+4608);
  kf[6]=*(const __attribute__((address_space(3))) bf16x8*)(kp+6144); kf[7]=*(const __attribute__((address_space(3))) bf16x8*)(kp+6656);
}
__device__ __forceinline__ void kload2(bf16x8*kf,lds_cptr kp,int j){ kf[2*j]=*(const __attribute__((address_space(3))) bf16x8*)(kp+j*2048); kf[2*j+1]=*(const __attribute__((address_space(3))) bf16x8*)(kp+j*2048+512); }
__device__ __forceinline__ s16x4 vtr(lds_cptr p){ return __builtin_bit_cast(s16x4,__builtin_amdgcn_ds_read_tr16_b64_v4i16((__attribute__((address_space(3))) v4i16_t*)p)); }
__device__ __forceinline__ float rowmax(const f32x16&p0,const f32x16&p1){
  float a=max3f(p0[0],p0[1],p1[0]),b=max3f(p0[2],p0[3],p1[1]);a=max3f(a,p1[2],p1[3]);
  #pragma unroll
  for(int r=4;r<16;r+=4){a=max3f(a,p0[r],p0[r+1]);b=max3f(b,p0[r+2],p0[r+3]);a=max3f(a,p1[r],p1[r+1]);b=max3f(b,p1[r+2],p1[r+3]);}
  const float m=max2f(a,b);
  auto rr=__builtin_amdgcn_permlane32_swap(__float_as_uint(m),__float_as_uint(m),false,false);
  return max2f(__uint_as_float(rr[0]),__uint_as_float(rr[1]));
}
__device__ __forceinline__ void pv(f32x16*o,int vb,bf16x8 pa0,bf16x8 pa1,bf16x8 pa2,bf16x8 pa3){
  #pragma unroll
  for(int d0=0;d0<2;++d0){s16x4 lo[4],hi[4];
    #pragma unroll
    for(int ks=0;ks<4;++ks){
      asm volatile("ds_read_b64_tr_b16 %0,%1 offset:%c2":"=&v"(lo[ks]):"v"(vb),"i"(d0*4096+ks*1024):"memory");
      asm volatile("ds_read_b64_tr_b16 %0,%1 offset:%c2":"=&v"(hi[ks]):"v"(vb),"i"(d0*4096+ks*1024+512):"memory");}
    asm volatile("s_waitcnt lgkmcnt(0)":::"memory");SBAR();
    #define PK(k) (bf16x8){lo[k][0],lo[k][1],lo[k][2],lo[k][3],hi[k][0],hi[k][1],hi[k][2],hi[k][3]}
    o[d0]=__builtin_amdgcn_mfma_f32_32x32x16_bf16(pa0,PK(0),o[d0],0,0,0);
    o[d0]=__builtin_amdgcn_mfma_f32_32x32x16_bf16(pa1,PK(1),o[d0],0,0,0);
    o[d0]=__builtin_amdgcn_mfma_f32_32x32x16_bf16(pa2,PK(2),o[d0],0,0,0);
    o[d0]=__builtin_amdgcn_mfma_f32_32x32x16_bf16(pa3,PK(3),o[d0],0,0,0);
    #undef PK
  }
}

#ifndef ATTN_STORE16
#define ATTN_STORE16(p,v) (*(u32x4*)(p)=(v))
#endif
template<int THRL> __device__ __forceinline__ void attn_unit(int qb,const bf16*Q,const bf16*__restrict__ K,const bf16*__restrict__ V,bf16*O,char*shm){
  int tid_=threadIdx.x; asm volatile("":"+v"(tid_)); const int tid=tid_,lane=tid&63,r32=lane&31,hi=lane>>5; const int wid=__builtin_amdgcn_readfirstlane(tid>>6);
  const int q0=qb*QB;
  const unsigned lds0=(unsigned)(uintptr_t)shm;
  float*wsf=(float*)(shm+LDS_WS)+wid*WSF_STRIDE;
  const bf16*ksrc=K+(long)lane*DM+wid*8;
  const bf16*vsrc=V+(long)(16*(wid&3)+(lane>>2))*DM+(wid>>2)*32+(lane&3)*8;
  const unsigned kdst=lds0+LDS_K+wid*1024, vdst=lds0+LDS_V+wid*1024;
  #define DMA_K(t,s3) glds16(ksrc+(long)(t)*KVBLK*DM,(unsigned)__builtin_amdgcn_readfirstlane(kdst+(s3)*SLOTB))
  #define DMA_V(t,s3) do{ const unsigned vd_=(unsigned)__builtin_amdgcn_readfirstlane(vdst+(s3)*VSLOTB); glds16(vsrc+(long)(t)*KVBLK*DM,vd_); glds16(vsrc+(long)(t)*KVBLK*DM+64,(unsigned)__builtin_amdgcn_readfirstlane(vd_+8192)); }while(0)
  const lds_cptr shm3=(lds_cptr)shm;
  const int NT=(q0+QB)/KVBLK;
  DMA_K(0,0);DMA_V(0,0);DMA_K(1,1);DMA_V(1,1);
  int c0=0,c1=1,c2=2;
  #define ROT3() do{ const int x_=c0; c0=c1; c1=c2; c2=x_; }while(0)
  #define PKW(P,B) cvtpk_s(P[B],P[B+1])
  #define MX3(a,b,c) __builtin_fmaxf(__builtin_fmaxf((a),(b)),(c))
  const bf16*Qw=Q+(long)(q0+wid*QBLK)*DM;
  bf16x8 qr[4];
  #pragma unroll
  for(int d0=0;d0<4;++d0)qr[d0]=*reinterpret_cast<const bf16x8*>(&Qw[(long)r32*DM+d0*16+hi*8]);
  float mhat=0.f,l_reg=0.f; f32x16 negm=f32x16{};
  f32x16 o[4]; o[0]=f32x16{};o[1]=f32x16{};o[2]=f32x16{};o[3]=f32x16{};
  const int qrel=wid*QBLK+r32;
  const lds_cptr kp0=shm3+LDS_K+hi*1024+r32*16;
  const lds_cptr vp0=shm3+LDS_V+((lane>>4)&1)*32+(lane&3)*8+(4*hi+((lane&15)>>2))*64;
  WAIT_BAR(3);
  for(int t=0;t<NT;++t){
    if(t+2<NT){DMA_K(t+2,c2);DMA_V(t+2,c2);}
    bf16x8 kf[8]; kload8(kf,kp0+c0*SLOTB);
    SBAR();
    f32x16 C0,C1;
    {
      C0=__builtin_amdgcn_mfma_f32_32x32x16_bf16(kf[0],qr[0],negm,0,0,0); C1=__builtin_amdgcn_mfma_f32_32x32x16_bf16(kf[1],qr[0],negm,0,0,0);
      C0=__builtin_amdgcn_mfma_f32_32x32x16_bf16(kf[2],qr[1],C0,0,0,0);   C1=__builtin_amdgcn_mfma_f32_32x32x16_bf16(kf[3],qr[1],C1,0,0,0);
      C0=__builtin_amdgcn_mfma_f32_32x32x16_bf16(kf[4],qr[2],C0,0,0,0);   C1=__builtin_amdgcn_mfma_f32_32x32x16_bf16(kf[5],qr[2],C1,0,0,0);
      C0=__builtin_amdgcn_mfma_f32_32x32x16_bf16(kf[6],qr[3],C0,0,0,0);   C1=__builtin_amdgcn_mfma_f32_32x32x16_bf16(kf[7],qr[3],C1,0,0,0); }
    SBAR();
    const lds_cptr vp_=vp0+c0*VSLOTB; s16x4 vl_[8],vh_[8];
    #pragma unroll
    for(int k2=0;k2<2;++k2)
      #pragma unroll
      for(int d_=0;d_<4;++d_){ vl_[d_*2+k2]=vtr(vp_+(d_*4096+k2*1024)); vh_[d_*2+k2]=vtr(vp_+(d_*4096+k2*1024+512)); }
    SBAR();
    { const int jb_=t-(NT-4); if(jb_>=0)cmask(C0,C1,jb_,qrel,hi); }
    float a=MX3(C0[0],C0[1],C1[0]),b=MX3(C0[2],C0[3],C1[1]); a=MX3(a,C1[2],C1[3]);
    #pragma unroll
    for(int r=4;r<16;r+=4){a=MX3(a,C0[r],C0[r+1]);b=MX3(b,C0[r+2],C0[r+3]);a=MX3(a,C1[r],C1[r+1]);b=MX3(b,C1[r+2],C1[r+3]);}
    float rm=__builtin_fmaxf(a,b); { auto rr=__builtin_amdgcn_permlane32_swap(__float_as_uint(rm),__float_as_uint(rm),false,false); rm=__builtin_fmaxf(__uint_as_float(rr[0]),__uint_as_float(rr[1])); }
    if(t==0 || __any(rm>(float)THRL)){
      const float dl=(t==0)?rm:__builtin_fmaxf(rm,0.f); mhat+=dl;
      #pragma unroll
      for(int r=0;r<16;++r){C0[r]-=dl;C1[r]-=dl;}
      #pragma unroll
      for(int r=0;r<16;++r)negm[r]=-mhat;
      if(t!=0){ const float f=__builtin_amdgcn_exp2f(-dl); l_reg*=f; if(hi==0)wsf[r32]=f; asm volatile("s_waitcnt lgkmcnt(0)":::"memory");
        #pragma unroll
        for(int d_=0;d_<4;++d_)
          #pragma unroll
          for(int r=0;r<16;++r)o[d_][r]*=wsf[crow(r,hi)]; } }
    #pragma unroll
    for(int r=0;r<16;++r){C0[r]=__builtin_amdgcn_exp2f(C0[r]);C1[r]=__builtin_amdgcn_exp2f(C1[r]);}
    { float s0=C0[0]+C0[1],s1=C1[0]+C1[1];
      #pragma unroll
      for(int r=2;r<16;++r){s0+=C0[r];s1+=C1[r];}
      l_reg+=s0+s1; }
    const u32x4 pw0=(u32x4){PKW(C0,0),PKW(C0,2),PKW(C0,4),PKW(C0,6)},pw1=(u32x4){PKW(C0,8),PKW(C0,10),PKW(C0,12),PKW(C0,14)},pw2=(u32x4){PKW(C1,0),PKW(C1,2),PKW(C1,4),PKW(C1,6)},pw3=(u32x4){PKW(C1,8),PKW(C1,10),PKW(C1,12),PKW(C1,14)};
    SBAR();
    #define VFRAG(L_,H_,i_) (bf16x8){L_[i_][0],L_[i_][1],L_[i_][2],L_[i_][3],H_[i_][0],H_[i_][1],H_[i_][2],H_[i_][3]}
    s16x4 w2l_[4],w2h_[4],w3l_[4],w3h_[4];
    #pragma unroll
    for(int d_=0;d_<4;++d_){ w2l_[d_]=vtr(vp_+(d_*4096+2*1024)); w2h_[d_]=vtr(vp_+(d_*4096+2*1024+512)); }
    SBAR();
    #pragma unroll
    for(int d_=0;d_<4;++d_){ o[d_]=__builtin_amdgcn_mfma_f32_32x32x16_bf16(__builtin_bit_cast(bf16x8,pw0),VFRAG(vl_,vh_,d_*2),o[d_],0,0,0); }
    SBAR();
    #pragma unroll
    for(int d_=0;d_<4;++d_){ w3l_[d_]=vtr(vp_+(d_*4096+3*1024)); w3h_[d_]=vtr(vp_+(d_*4096+3*1024+512)); }
    SBAR();
    #pragma unroll
    for(int d_=0;d_<4;++d_){ o[d_]=__builtin_amdgcn_mfma_f32_32x32x16_bf16(__builtin_bit_cast(bf16x8,pw1),VFRAG(vl_,vh_,d_*2+1),o[d_],0,0,0); }
    #pragma unroll
    for(int d_=0;d_<4;++d_){ o[d_]=__builtin_amdgcn_mfma_f32_32x32x16_bf16(__builtin_bit_cast(bf16x8,pw2),VFRAG(w2l_,w2h_,d_),o[d_],0,0,0); }
    #pragma unroll
    for(int d_=0;d_<4;++d_){ o[d_]=__builtin_amdgcn_mfma_f32_32x32x16_bf16(__builtin_bit_cast(bf16x8,pw3),VFRAG(w3l_,w3h_,d_),o[d_],0,0,0); }
    SBAR();
    #undef VFRAG
    if(t+2<NT){WAIT_BAR(3);}else{WAIT_BAR(0);}
    ROT3();
  }
  { auto rr=__builtin_amdgcn_permlane32_swap(__float_as_uint(l_reg),__float_as_uint(l_reg),false,false); l_reg=__uint_as_float(rr[0])+__uint_as_float(rr[1]); }
  if(hi==0)wsf[32+r32]=l_reg; asm volatile("s_waitcnt lgkmcnt(0)":::"memory");
  bf16*Ow=O+(long)(q0+wid*QBLK)*DMO;
  { bf16*stg=(bf16*)(shm+LDS_P)+wid*4096;
    #pragma unroll
    for(int r=0;r<16;++r){const int orow=crow(r,hi); const float rl=__builtin_amdgcn_rcpf(wsf[32+orow]);
      #pragma unroll
      for(int d0=0;d0<4;++d0)stg[orow*128+d0*32+r32]=__float2bfloat16(o[d0][r]*rl);}
    asm volatile("s_waitcnt lgkmcnt(0)":::"memory");
    #pragma unroll
    for(int i=0;i<8;++i){const int row=i*4+(lane>>4),ch=lane&15; const u32x4 v=*(const u32x4*)(stg+row*128+ch*8); ATTN_STORE16(Ow+(long)row*DMO+ch*8,v);} }
  asm volatile("s_waitcnt lgkmcnt(0)\n\ts_barrier":::"memory");
  #undef DMA_K
  #undef DMA_V
  #undef ROT3
  #undef PKW
  #undef MX3
}
constexpr int ATTN_LDS_BYTES=LDS_BYTES;
struct AttnTensors { const bf16* Q; const bf16* K; const bf16* V; bf16* O; };
struct AttnUnit { int hc; int qb; };
struct StaticOrder {
  int vcu, G, bx;
  __device__ __forceinline__ StaticOrder(int grid,int block):vcu((grid%8==0)?(block%8)*(grid/8)+block/8:block),G(grid),bx(block){}
  __device__ __forceinline__ bool next(int i,AttnUnit&u)const{
    if(G==256){ if(i>=2)return false; const int s=vcu&31; u.hc=vcu>>5; u.qb=(i==0)?63-s:s; return true; }
    const int idx=i*G+bx; if(idx>=8*NQB)return false; u.hc=idx&7; u.qb=NQB-1-(idx>>3); return true; }
};
template<class Sched,int THRL=8> __device__ __forceinline__ void attn_phase(char*lds,const AttnTensors&T,const Sched&S){
  AttnUnit u;
  for(int i=0;S.next(i,u);++i){ const int h=u.hc>>1,c=u.hc&1;
    attn_unit<THRL>(u.qb,T.Q+h*128+c*64,T.K+h*128+c*64,T.V+h*128,T.O+u.hc*128,lds); }
}
#undef SBAR
#undef WAIT_BAR
}
constexpr int NWAVES = 8;
constexpr int M = 16384, D = 1024, FF = 2816, NGU = 2 * FF, NIN = 2048, DEPTH = 4;
constexpr size_t MiB = 1u << 20;
constexpr size_t WS_ROWSS = 1 * MiB;
constexpr size_t WS_ROPE = 2 * MiB;
constexpr size_t WS_XB = 8 * MiB;
constexpr size_t WS_H = 40 * MiB;
constexpr size_t WS_QKVU = 40 * MiB;
constexpr size_t WS_OBUF = 108 * MiB;
constexpr size_t WS_CAT = 140 * MiB;
constexpr size_t WS_W = 172 * MiB;
constexpr size_t OFF_GU1 = 0, OFF_DN1 = 11 * MiB, OFF_IN = 16 * MiB + 512 * 1024, OFF_OUT = 20 * MiB + 512 * 1024, OFF_GU2 = 22 * MiB + 512 * 1024, OFF_DN2 = 33 * MiB + 512 * 1024, W_LAYER = 39 * MiB;
constexpr size_t WS_END = WS_W + DEPTH * W_LAYER;
static_assert(attn_body::ATTN_LDS_BYTES <= 147392 && (size_t)NGU * D * 2 == 11 * MiB && (size_t)D * FF * 2 == 5 * MiB + 512 * 1024 && WS_H + (size_t)M * FF * 2 <= WS_CAT && WS_ROWSS + 16 * (size_t)M * 4 <= WS_ROPE && WS_ROPE + (size_t)M * 64 * 4 <= WS_XB, "ws map");
constexpr int LDS_BYTES = 147456;

#define LAS __attribute__((address_space(3)))
typedef unsigned short bf16;
typedef unsigned v4u __attribute__((ext_vector_type(4)));
typedef unsigned v2u __attribute__((ext_vector_type(2)));
typedef float f32x4 __attribute__((ext_vector_type(4)));
#define LDS_WAIT() asm volatile("s_waitcnt lgkmcnt(0)" ::: "memory")
__device__ __forceinline__ unsigned f2bf(float f) { unsigned u = __builtin_bit_cast(unsigned, f); return (u + 0x7fffu + ((u >> 16) & 1u)) >> 16; }
__device__ __forceinline__ unsigned pk2(float lo, float hi) { return f2bf(lo) | (f2bf(hi) << 16); }
__device__ __forceinline__ float bflo(unsigned w) { return __builtin_bit_cast(float, w << 16); }
__device__ __forceinline__ float bfhi(unsigned w) { return __builtin_bit_cast(float, w & 0xffff0000u); }
__device__ __forceinline__ float wave_sum(float v) {
#pragma unroll
    for (int o = 1; o < 64; o <<= 1) v += __shfl_xor(v, o);
    return v;
}
__device__ __forceinline__ void tr_item(const float* W, int N, int k0, int n0, const float* gk, bf16* WT, int Kd, int rbase, int rstride, int lane) {
    const int kblk = lane & 7, n4 = lane >> 3;
    const float* src = W + (size_t)(k0 + 8 * kblk) * N + n0 + 4 * n4;
    f32x4 v[8];
#pragma unroll
    for (int i = 0; i < 8; ++i) v[i] = __builtin_nontemporal_load((const f32x4*)(src + (size_t)i * N));
    if (gk) { const f32x4 g0 = *(const f32x4*)(gk + k0 + 8 * kblk), g1 = *(const f32x4*)(gk + k0 + 8 * kblk + 4);
#pragma unroll
        for (int i = 0; i < 4; ++i) { v[i] = v[i] * g0[i]; v[4 + i] = v[4 + i] * g1[i]; } }
#pragma unroll
    for (int e = 0; e < 4; ++e) { v4u o; o.x = pk2(v[0][e], v[1][e]); o.y = pk2(v[2][e], v[3][e]); o.z = pk2(v[4][e], v[5][e]); o.w = pk2(v[6][e], v[7][e]);
        *(v4u*)(WT + (size_t)(rbase + (4 * n4 + e) * rstride) * Kd + k0 + 8 * kblk) = o; }
}

#define XB_TMO      128
#define XB_XCNT(j)  (256  + 64 * (j))
#define XB_XSUB(j)  (1280 + 64 * (j))
#define XB_XGEN(j)  (2304 + 64 * (j))
#define XB_TOP      3328
#define XB_TOPGEN   3392
#define XCD_BAR_WORDS 3456
#define XB_SPIN_CAP (1u << 18)

__device__ __forceinline__ unsigned xb_ld(unsigned* p)              { return __hip_atomic_load(p, __ATOMIC_RELAXED, __HIP_MEMORY_SCOPE_AGENT); }
__device__ __forceinline__ unsigned xb_add(unsigned* p, unsigned v) { return __hip_atomic_fetch_add(p, v, __ATOMIC_RELAXED, __HIP_MEMORY_SCOPE_AGENT); }
__device__ __forceinline__ unsigned xb_xcc_id() { return (unsigned)__builtin_amdgcn_s_getreg((3 << 11) | 20) & 0xFu; }
#define XB_SPIN(cond, bar) do { unsigned _sp = 0; while (cond) { __builtin_amdgcn_s_sleep(1); \
    if ((++_sp & 255u) == 0u) { if (xb_ld(&(bar)[XB_TMO])) break; if (_sp > XB_SPIN_CAP) { atomicAdd(&(bar)[XB_TMO], 1u); break; } } } } while (0)

struct XcdBarrier {
    unsigned* bar; unsigned x;
    volatile LAS unsigned* st;
};

__device__ __forceinline__ XcdBarrier xcd_barrier_post(unsigned* bar, volatile LAS unsigned* st) {
    XcdBarrier b; b.bar = bar; b.x = xb_xcc_id(); b.st = st;
    if (threadIdx.x == 0) (void)xb_add(&bar[XB_XCNT(b.x)], 1u);
    return b;
}
__device__ __forceinline__ void xcd_barrier_complete(unsigned* bar, unsigned x, unsigned& nloc, unsigned& nx) {
    const unsigned G = gridDim.x * gridDim.y * gridDim.z;
    unsigned sum, cnt, mine, sp = 0u;
    for (;;) {
        sum = 0u; cnt = 0u; mine = 0u;
#pragma unroll
        for (unsigned j = 0; j < 16; ++j) { const unsigned c = xb_ld(&bar[XB_XCNT(j)]); sum += c; cnt += (c > 0u) ? 1u : 0u; mine = (j == x) ? c : mine; }
        if (sum == G) break;
        __builtin_amdgcn_s_sleep(1);
        if ((++sp & 255u) == 0u) { if (xb_ld(&bar[XB_TMO])) break; if (sp > XB_SPIN_CAP) { atomicAdd(&bar[XB_TMO], 1u); break; } }
    }
    nloc = mine > 0u ? mine : 1u; nx = cnt > 0u ? cnt : 1u;
}

__device__ __forceinline__ void xcd_barrier(const XcdBarrier& b) {
    asm volatile("s_waitcnt vmcnt(0)" ::: "memory");
    __syncthreads();
    if (threadIdx.x == 0) {
        unsigned* bar = b.bar;
        __builtin_amdgcn_s_waitcnt(0);
        unsigned nloc = b.st[0], nx = b.st[1];
        if (nloc == 0u) { xcd_barrier_complete(bar, b.x, nloc, nx); b.st[0] = nloc; b.st[1] = nx; }
        const unsigned old = xb_add(&bar[XB_XSUB(b.x)], 1u);
        const unsigned gen = old / nloc;
        if (old + 1u == (gen + 1u) * nloc) {
            __builtin_amdgcn_fence(__ATOMIC_RELEASE, "agent");
            asm volatile("s_waitcnt vmcnt(0)" ::: "memory");
            const unsigned og = xb_add(&bar[XB_TOP], 1u);
            const unsigned tg = og / nx;
            if (og + 1u == (tg + 1u) * nx) xb_add(&bar[XB_TOPGEN], 1u);
            else XB_SPIN(xb_ld(&bar[XB_TOPGEN]) == tg, bar);
            __builtin_amdgcn_fence(__ATOMIC_ACQUIRE, "agent");
            xb_add(&bar[XB_XGEN(b.x)], 1u);
            asm volatile("s_waitcnt vmcnt(0)" ::: "memory");
        } else {
            XB_SPIN(xb_ld(&bar[XB_XGEN(b.x)]) == gen, bar);
            __builtin_amdgcn_fence(__ATOMIC_ACQUIRE, "agent");
            asm volatile("s_waitcnt vmcnt(0)" ::: "memory");
        }
    }
    __syncthreads();
}

struct Args { const float* in[20]; float* out; unsigned char* wsp; };
typedef __attribute__((address_space(1))) unsigned char* gptr_t;
__device__ __forceinline__ gptr_t fresh_ptr(unsigned char* p) { asm volatile("" : "+s"(p)); return (gptr_t)p; }

__global__ void __launch_bounds__(NWAVES * 64, 2) hymba_fwd(Args args) {
    extern __shared__ __attribute__((aligned(16))) unsigned char lds[];
    LAS unsigned char* L = (LAS unsigned char*)lds;
    const int tid = threadIdx.x, lane = tid & 63, wave = __builtin_amdgcn_readfirstlane(tid >> 6);
    const int G = gridDim.x, bx = blockIdx.x;
    const int gw = bx * NWAVES + wave, NGW = G * NWAVES;
    const int gtid = bx * (NWAVES * 64) + tid, NT = G * NWAVES * 64;
#define ws (fresh_ptr(args.wsp))
#define rowss ((float*)(unsigned char*)(ws + WS_ROWSS))
#define rope ((float*)(unsigned char*)(ws + WS_ROPE))
#define XB ((bf16*)(unsigned char*)(ws + WS_XB))
#define HB ((bf16*)(unsigned char*)(ws + WS_H))
#define QKVU ((bf16*)(unsigned char*)(ws + WS_QKVU))
#define OBUF ((bf16*)(unsigned char*)(ws + WS_OBUF))
#define CAT ((bf16*)(unsigned char*)(ws + WS_CAT))
#define xout ((float*)(unsigned char*)fresh_ptr((unsigned char*)args.out))
    { volatile LAS unsigned* st0 = (volatile LAS unsigned*)(L + 147392); if (tid < 2) st0[tid] = 0u; }
    __syncthreads();
    const XcdBarrier gbar = xcd_barrier_post((unsigned*)args.wsp, (volatile LAS unsigned*)(L + 147392));

    {
        constexpr int IT_G = 16 * 88, IT_D = 44 * 32, IT_IN = 16 * 64, IT_OUT = 8 * 32, IT_LAYER = 4 * IT_G + 2 * IT_D + IT_IN + IT_OUT;
        static_assert(IT_G == IT_D, "item decode");
        for (int it = gw; it < DEPTH * IT_LAYER; it += NGW) {
            const int l = it / IT_LAYER; int r = it % IT_LAYER; unsigned char* wl = (unsigned char*)(ws + WS_W + (size_t)l * W_LAYER);
            if (r < 6 * IT_G) {
                const int f = r / (3 * IT_G), q = r % (3 * IT_G), kind = q / IT_G, i = q % IT_G;
                if (kind < 2) { const float* W = args.in[(f ? 16 : 2) + kind] + (size_t)l * D * FF; const int kb = i / 88, nb = i % 88, n0 = 32 * nb;
                    tr_item(W, FF, 64 * kb, n0, args.in[f ? 15 : 1] + l * D, (bf16*)(wl + (f ? OFF_GU2 : OFF_GU1)), D, (n0 >> 7) * 256 + kind * 128 + (n0 & 127), 1, lane); }
                else { const float* W = args.in[f ? 18 : 4] + (size_t)l * FF * D; const int kb = i / 32, nb = i % 32;
                    tr_item(W, D, 64 * kb, 32 * nb, nullptr, (bf16*)(wl + (f ? OFF_DN2 : OFF_DN1)), FF, 32 * nb, 1, lane); }
            } else { r -= 6 * IT_G;
                if (r < IT_IN) { const float* W = args.in[6] + (size_t)l * D * NIN; const int kb = r / 64, nb = r % 64, n0 = 32 * nb; int rbase = n0, rstride = 1;
                    if (n0 < 1024) { const int d0 = n0 & 63; rbase = (n0 - d0) + (d0 ? 1 : 0); rstride = 2; }
                    tr_item(W, NIN, 64 * kb, n0, args.in[5] + l * D, (bf16*)(wl + OFF_IN), D, rbase, rstride, lane); }
                else { r -= IT_IN; const float* W = args.in[14] + (size_t)l * D * D; const int kb = r / 32, nb = r % 32;
                    tr_item(W, D, 64 * kb, 32 * nb, nullptr, (bf16*)(wl + OFF_OUT), D, 32 * nb, 1, lane); }
            }
        }
        for (int it = gw; it < DEPTH * 1024; it += NGW) {
            const int l = it >> 10, r = it & 1023, g = r >> 8, cb = (r >> 4) & 15, nb = r & 15, c0 = cb * 8, n = nb * 64 + lane;
            const float* pw = args.in[12] + ((size_t)(l * 4 + g) * 128 + c0) * 128; const float* ps = args.in[13] + l * 512 + g * 128;
            const float* wo = args.in[14] + (size_t)l * D * D + (size_t)(512 + g * 128) * D + n;
            float a[8];
#pragma unroll
            for (int j = 0; j < 8; ++j) a[j] = 0.f;
            for (int e = 0; e < 128; ++e) { const float w = wo[(size_t)e * D] * ps[e];
#pragma unroll
                for (int j = 0; j < 8; ++j) a[j] += pw[j * 128 + e] * w; }
            v4u o; o.x = pk2(a[0], a[1]); o.y = pk2(a[2], a[3]); o.z = pk2(a[4], a[5]); o.w = pk2(a[6], a[7]);
            *(v4u*)((bf16*)(unsigned char*)(ws + WS_W + (size_t)l * W_LAYER + OFF_OUT) + (size_t)n * D + 512 + g * 128 + c0) = o;
        }
        for (int i = gtid; i < M * 32; i += NT) { const int s = i >> 5, j = i & 31; const float inv = (float)pow(10000.0, -(double)j / 32.0); const float ang = (float)s * inv;
            const double a = (double)ang; rope[2 * i] = (float)cos(a); rope[2 * i + 1] = (float)sin(a); }
        for (int m = gw; m < M; m += NGW) { const f32x4* xr = (const f32x4*)(args.in[0] + (size_t)m * D) + lane; f32x4 v[4]; float s = 0.f;
#pragma unroll
            for (int j = 0; j < 4; ++j) { v[j] = xr[64 * j]; s += (v[j].x * v[j].x + v[j].y * v[j].y) + (v[j].z * v[j].z + v[j].w * v[j].w); }
            s = wave_sum(s); if (lane < 16) rowss[(size_t)m * 16 + lane] = (lane == 0) ? s : 0.f;
            v2u* o8 = (v2u*)(XB + (size_t)m * D) + lane;
#pragma unroll
            for (int j = 0; j < 4; ++j) { v2u w; w.x = pk2(v[j].x, v[j].y); w.y = pk2(v[j].z, v[j].w); o8[64 * j] = w; } }
    }
    cg::this_grid().sync();


    for (int step = 0; step < 3 * DEPTH; ++step) {
        const int l = step / 3, kind = step % 3;
#define wl ((unsigned char*)(ws + WS_W + (size_t)l * W_LAYER))
        if (kind != 1) {
            const int f = kind >> 1;
            { pg8::Gemm g{XB, (const bf16*)(wl + (f ? OFF_GU2 : OFF_GU1)), M, NGU, D}; pg8::StaticOrder S; S.init(M, NGU, G, bx);
              pg8::EpiGateUp E{HB, rowss};
              pg8::gemm_phase<pg8::EpiGateUp, pg8::StaticOrder, PG8_ALIGN, PG8_SP2>(L, g, S, E); }
            xcd_barrier(gbar);
            { pg8::Gemm g{HB, (const bf16*)(wl + (f ? OFF_DN2 : OFF_DN1)), M, D, FF}; pg8::StaticOrder S; S.init(M, D, G, bx);
              pg8::EpiResid E{(const float*)(unsigned char*)fresh_ptr((unsigned char*)((step == 0) ? args.in[0] : args.out)), xout, XB, rowss, 0.5f};
              pg8::gemm_phase<pg8::EpiResid, pg8::StaticOrder, PG8_ALIGN, PG8_SP2>(L, g, S, E); }
            xcd_barrier(gbar);
        } else {
            { pg8::Gemm g{XB, (const bf16*)(wl + OFF_IN), M, NIN, D}; pg8::StaticOrder S; S.init(M, NIN, G, bx);
              pg8::EpiQKVU E{QKVU, rowss, rope};
              pg8::gemm_phase<pg8::EpiQKVU, pg8::StaticOrder, PG8_ALIGN, PG8_SP2>(L, g, S, E); }
            xcd_barrier(gbar);
            { const attn_body::AttnTensors AT{(const attn_body::bf16*)QKVU, (const attn_body::bf16*)(QKVU + 512), (const attn_body::bf16*)(QKVU + 1024), (attn_body::bf16*)OBUF};
              const attn_body::StaticOrder S(G, bx);
              attn_body::attn_phase<attn_body::StaticOrder>((char*)lds, AT, S); }
            xcd_barrier(gbar);
            {
                const float li = 0.8f - 0.6f * expf(-0.3f * (float)l);
                const float s1 = wave_sum(args.in[7][l * 64 + lane] * args.in[8][l * 64 + lane]), s2 = wave_sum(args.in[9][l * 64 + lane] * args.in[10][l * 64 + lane]);
                const float lam = expf(s1) - expf(s2) + li;
                const int hd = lane >> 4, j0 = (lane & 15) * 8;
                float gn[8];
#pragma unroll
                for (int j = 0; j < 8; ++j) gn[j] = args.in[11][l * 128 + j0 + j] * (1.0f - li);
                const int win = 2 << hd;
                for (int mc = gw; mc < M / 8; mc += NGW) { float wsum[8];
                  for (int mr = 0; mr < 8; ++mr) { const int m = mc * 8 + mr;
                    const v4u a = *(const v4u*)(OBUF + (size_t)m * 1024 + hd * 256 + j0), b = *(const v4u*)(OBUF + (size_t)m * 1024 + hd * 256 + 128 + j0);
                    float o[8];
                    o[0] = bflo(a.x) - lam * bflo(b.x); o[1] = bfhi(a.x) - lam * bfhi(b.x); o[2] = bflo(a.y) - lam * bflo(b.y); o[3] = bfhi(a.y) - lam * bfhi(b.y);
                    o[4] = bflo(a.z) - lam * bflo(b.z); o[5] = bfhi(a.z) - lam * bfhi(b.z); o[6] = bflo(a.w) - lam * bflo(b.w); o[7] = bfhi(a.w) - lam * bfhi(b.w);
                    float ss = 0.f;
#pragma unroll
                    for (int j = 0; j < 8; ++j) ss += o[j] * o[j];
                    ss += __shfl_xor(ss, 1); ss += __shfl_xor(ss, 2); ss += __shfl_xor(ss, 4); ss += __shfl_xor(ss, 8);
                    const float rr = __builtin_amdgcn_rsqf(ss * (1.0f / 128.0f) + 1e-6f);
                    v4u w; w.x = pk2(o[0] * rr * gn[0], o[1] * rr * gn[1]); w.y = pk2(o[2] * rr * gn[2], o[3] * rr * gn[3]); w.z = pk2(o[4] * rr * gn[4], o[5] * rr * gn[5]); w.w = pk2(o[6] * rr * gn[6], o[7] * rr * gn[7]);
                    *(v4u*)(CAT + (size_t)m * 1024 + hd * 128 + j0) = w;
                    const bf16* up = QKVU + (size_t)m * 2112 + 1536 + hd * 128 + j0;
                    const v4u u0 = *(const v4u*)up;
                    const float us[8] = {bflo(u0.x), bfhi(u0.x), bflo(u0.y), bfhi(u0.y), bflo(u0.z), bfhi(u0.z), bflo(u0.w), bfhi(u0.w)};
                    float sm[8];
                    if (mr == 0) {
                        v4u ut[15]; float wt[15];
#pragma unroll
                        for (int j = 0; j < 8; ++j) sm[j] = us[j];
#pragma unroll
                        for (int t = 1; t < 16; ++t) { const bool ok = (t < win) && (m - t >= 0); ut[t - 1] = *(const v4u*)(up - (size_t)(ok ? t : 0) * 2112); wt[t - 1] = ok ? 1.0f : 0.0f; }
#pragma unroll
                        for (int t = 0; t < 15; ++t) { const float w = wt[t];
                            sm[0] += w * bflo(ut[t].x); sm[1] += w * bfhi(ut[t].x); sm[2] += w * bflo(ut[t].y); sm[3] += w * bfhi(ut[t].y); sm[4] += w * bflo(ut[t].z); sm[5] += w * bfhi(ut[t].z); sm[6] += w * bflo(ut[t].w); sm[7] += w * bfhi(ut[t].w); }
                    } else {
                        const bool dr = (m - win >= 0); const v4u ud = *(const v4u*)(up - (size_t)(dr ? win : 0) * 2112); const float wd = dr ? 1.0f : 0.0f;
                        sm[0] = wsum[0] + us[0] - wd * bflo(ud.x); sm[1] = wsum[1] + us[1] - wd * bfhi(ud.x); sm[2] = wsum[2] + us[2] - wd * bflo(ud.y); sm[3] = wsum[3] + us[3] - wd * bfhi(ud.y);
                        sm[4] = wsum[4] + us[4] - wd * bflo(ud.z); sm[5] = wsum[5] + us[5] - wd * bfhi(ud.z); sm[6] = wsum[6] + us[6] - wd * bflo(ud.w); sm[7] = wsum[7] + us[7] - wd * bfhi(ud.w);
                    }
#pragma unroll
                    for (int j = 0; j < 8; ++j) wsum[j] = sm[j];
                    const float ic = 1.0f / (float)((m + 1 < win) ? (m + 1) : win);
                    v4u d; d.x = pk2(sm[0] * ic - us[0], sm[1] * ic - us[1]); d.y = pk2(sm[2] * ic - us[2], sm[3] * ic - us[3]); d.z = pk2(sm[4] * ic - us[4], sm[5] * ic - us[5]); d.w = pk2(sm[6] * ic - us[6], sm[7] * ic - us[7]);
                    *(v4u*)(CAT + (size_t)m * 1024 + 512 + hd * 128 + j0) = d;
                  }
                }
            }
            xcd_barrier(gbar);
            { pg8::Gemm g{CAT, (const bf16*)(wl + OFF_OUT), M, D, D}; pg8::StaticOrder S; S.init(M, D, G, bx);
              pg8::EpiResid E{xout, xout, XB, rowss, 1.0f};
              pg8::gemm_phase<pg8::EpiResid, pg8::StaticOrder, PG8_ALIGN, PG8_SP2>(L, g, S, E); }
            xcd_barrier(gbar);
        }
    }
    for (int m = gw; m < M; m += NGW) { f32x4* xr = (f32x4*)(xout + (size_t)m * D) + lane; const f32x4* gr = (const f32x4*)args.in[19] + lane;
        const float r = pg8::rs_from_ss(rowss + (size_t)m * 16);
#pragma unroll
        for (int j = 0; j < 4; ++j) { const f32x4 v = xr[64 * j], gg = gr[64 * j]; xr[64 * j] = v * r * gg; } }
}

#undef wl
#undef ws
#undef rowss
#undef rope
#undef XB
#undef HB
#undef QKVU
#undef OBUF
#undef CAT
#undef xout
extern "C" void kernel_launch(void* const* d_in, const int* in_sizes, int n_in, void* d_out, int out_size, void* d_ws, size_t ws_size, hipStream_t stream) {
    static int grid_blocks = 0;
    if (grid_blocks == 0) {
        if (n_in != 20 || out_size != M * D || ws_size < WS_END) { fprintf(stderr, "kernel_launch: unexpected shapes (n_in %d out %d ws %zu, need %zu)\n", n_in, out_size, ws_size, (size_t)WS_END); grid_blocks = -1; return; }
        int dev = 0, cus = 0, per_cu = 0;
        (void)hipGetDevice(&dev); (void)hipDeviceGetAttribute(&cus, hipDeviceAttributeMultiprocessorCount, dev);
        if (hipFuncSetAttribute((const void*)hymba_fwd, hipFuncAttributeMaxDynamicSharedMemorySize, LDS_BYTES) != hipSuccess) { fprintf(stderr, "kernel_launch: hipFuncSetAttribute failed\n"); grid_blocks = -1; return; }
        if (hipOccupancyMaxActiveBlocksPerMultiprocessor(&per_cu, (const void*)hymba_fwd, NWAVES * 64, LDS_BYTES) != hipSuccess || per_cu < 1) { fprintf(stderr, "kernel_launch: occupancy query says %d\n", per_cu); per_cu = 1; }
        (void)hipGetLastError();
        grid_blocks = cus * per_cu;
    }
    if (grid_blocks < 0) return;
    if (hipMemsetAsync(d_ws, 0, 65536, stream) != hipSuccess) { fprintf(stderr, "kernel_launch: memset failed\n"); return; }
    Args a{};
    for (int i = 0; i < 20; ++i) a.in[i] = (const float*)d_in[i];
    a.out = (float*)d_out; a.wsp = (unsigned char*)d_ws;
    void* kargs[] = {&a};
    hipError_t e = hipLaunchCooperativeKernel((const void*)hymba_fwd, dim3(grid_blocks), dim3(NWAVES * 64), kargs, LDS_BYTES, stream);
    if (e != hipSuccess) fprintf(stderr, "cooperative launch failed: %s (grid %d)\n", hipGetErrorString(e), grid_blocks);
}
```

```cpp
#include <hip/hip_runtime.h>
#include <hip/hip_cooperative_groups.h>
#include <cstdio>
#include <cstdint>
namespace cg = cooperative_groups;
namespace pg8 {
#define PG8_LAS __attribute__((address_space(3)))
typedef unsigned short bf16_t;
typedef short bf16x8 __attribute__((ext_vector_type(8)));
typedef float f32x4 __attribute__((ext_vector_type(4)));
typedef unsigned u32x4 __attribute__((ext_vector_type(4)));
constexpr int BM = 256, BK = 64, HALF = 128, HTB = HALF * BK * 2  , STAGE_BYTES = 8 * HTB, NXCD = 8, WGM = 8;

__host__ __device__ __forceinline__ int lds_byte(int r, int c) { const int st = (r >> 4) * 2 + (c >> 5), rr = r & 15, cc = c & 31, ob = rr * 64 + cc * 2; return st * 1024 + (ob ^ (((ob >> 9) & 1) << 5)); }
__host__ __device__ __forceinline__ void stage_rc(int b, int& R, int& C) { const int st = b / 1024, sb = b % 1024, swz = sb ^ (((sb >> 9) & 1) << 5); R = (st >> 1) * 16 + swz / 64; C = (st & 1) * 32 + (swz % 64) / 2; }
__host__ __device__ __forceinline__ int perm32(int rho) { const int n = rho >> 4, i = rho & 15; return 8 * (i >> 2) + 4 * n + (i & 3); }

struct Unit { int pm, pn; };
struct Gemm { const bf16_t* A; const bf16_t* Bt; int M, N, K; };

struct StaticOrder {
    int nM, nN, nwg, G, c;
    __host__ __device__ void init(int M, int N, int G_, int c_) { nM = M / BM; nN = N / BM; nwg = nM * nN; G = G_; c = c_; }
    __host__ __device__ bool next(int i, Unit& u) const {
        const long L = (long)i * G + c; if (L >= nwg) return false;
        int wgid = (int)L; { const int q = nwg / NXCD, r = nwg % NXCD, xcd = wgid % NXCD, off = wgid / NXCD; wgid = (xcd < r ? xcd * (q + 1) : r * (q + 1) + (xcd - r) * q) + off; }
        const int nig = WGM * nN, gid = wgid / nig, fm = gid * WGM, gsz = (nM - fm) < WGM ? (nM - fm) : WGM;
        u.pm = fm + ((wgid % nig) % gsz); u.pn = (wgid % nig) / gsz; return true;
    }
    __device__ __forceinline__ void a_ready(const Unit&) const {}
    __device__ __forceinline__ void done(const Unit&) const {}
};

__device__ __forceinline__ unsigned cvt_pk_bf16(float lo, float hi) { unsigned r; asm volatile("v_cvt_pk_bf16_f32 %0, %1, %2" : "=v"(r) : "v"(lo), "v"(hi)); return r; }
typedef float f32x2 __attribute__((ext_vector_type(2)));
__device__ __forceinline__ f32x2 gelu_pk(f32x2 v) {
    const f32x2 av = __builtin_elementwise_abs(v), d = av * 0.2316418882f + 1.0f;
    f32x2 t; t.x = __builtin_amdgcn_rcpf(d.x); t.y = __builtin_amdgcn_rcpf(d.y);
    f32x2 q = t * 0.5307027145f + (-0.7265760135f); q = q * t + 0.7107068705f; q = q * t + (-0.142248368f); q = q * t + 0.127414796f; q = q * t;
    const f32x2 s = (v * v) * (-0.72134752044f);
    f32x2 e; e.x = __builtin_amdgcn_exp2f(s.x); e.y = __builtin_amdgcn_exp2f(s.y);
    const f32x2 m = v * (q * e), r = v - m;
    f32x2 o; o.x = v.x < 0.f ? m.x : r.x; o.y = v.y < 0.f ? m.y : r.y; return o;
}

template <int ACT  > struct EpiBf16 {
    static constexpr bool PERM = true, AFTER_DRAIN = false; static_assert(ACT == 0 || ACT == 1, "EpiBf16: ACT is 0 (none) or 1 (gelu_pk)");
    bf16_t* O; int ldc; const float* bias; int split_cols; size_t split_stride; float scale0;
    __device__ __forceinline__ void operator()(const f32x4 (&acc)[2][2][4][2], const Unit& u, int wr, int wc, int fr, int fq) const {
        const int row0 = u.pm * BM + wr * 64 + fr; int colt = u.pn * BM; bf16_t* base = O;
        float sc = 1.f; if (split_cols) { const int t = colt / split_cols; base += (size_t)t * split_stride; colt -= t * split_cols; if (t == 0) sc = scale0; }
        const int col0 = colt + wc * 32 + 8 * fq, bcol0 = u.pn * BM + wc * 32 + 8 * fq;
        f32x4 bv[2][2];
#pragma unroll
        for (int bj = 0; bj < 2; ++bj)
#pragma unroll
            for (int n = 0; n < 2; ++n) bv[bj][n] = bias ? *(const f32x4*)(bias + bcol0 + bj * HALF + 4 * n) : (f32x4){0.f, 0.f, 0.f, 0.f};
#pragma unroll
        for (int ai = 0; ai < 2; ++ai)
#pragma unroll
            for (int m = 0; m < 4; ++m) { bf16_t* rowp = base + (size_t)(row0 + ai * HALF + m * 16) * ldc + col0;
#pragma unroll
                for (int bj = 0; bj < 2; ++bj) { f32x4 v0 = acc[ai][bj][m][0] + bv[bj][0], v1 = acc[ai][bj][m][1] + bv[bj][1];
                    if (ACT == 1) { f32x2 a = gelu_pk((f32x2){v0[0], v0[1]}), b = gelu_pk((f32x2){v0[2], v0[3]}), c = gelu_pk((f32x2){v1[0], v1[1]}), d = gelu_pk((f32x2){v1[2], v1[3]});
                        v0 = (f32x4){a.x, a.y, b.x, b.y}; v1 = (f32x4){c.x, c.y, d.x, d.y}; }
                    v0 = v0 * sc; v1 = v1 * sc; u32x4 w; w.x = cvt_pk_bf16(v0[0], v0[1]); w.y = cvt_pk_bf16(v0[2], v0[3]); w.z = cvt_pk_bf16(v1[0], v1[1]); w.w = cvt_pk_bf16(v1[2], v1[3]);
                    *(u32x4*)(rowp + bj * HALF) = w; } }
    }
};
__device__ __forceinline__ float rs_from_ss(const float* p) { const f32x4 a = ((const f32x4*)p)[0], b = ((const f32x4*)p)[1], c = ((const f32x4*)p)[2], d = ((const f32x4*)p)[3];
    const float ss = (((a[0] + a[1]) + (a[2] + a[3])) + ((b[0] + b[1]) + (b[2] + b[3]))) + (((c[0] + c[1]) + (c[2] + c[3])) + ((d[0] + d[1]) + (d[2] + d[3])));
    return __builtin_amdgcn_rsqf(ss * (1.0f / 1024.0f) + 1e-6f); }
#define EPI_ROW_SCALES(rs_, rowss_, row0_) do { f32x4 q_[8]; \
    _Pragma("unroll") for (int i_ = 0; i_ < 8; ++i_) q_[i_] = *(const f32x4*)((rowss_) + (size_t)((row0_) + (i_ >> 2) * HALF + (i_ & 3) * 16) * 16 + fq * 4); \
    _Pragma("unroll") for (int i_ = 0; i_ < 8; ++i_) { float s_ = (q_[i_][0] + q_[i_][1]) + (q_[i_][2] + q_[i_][3]); s_ += __shfl_xor(s_, 16); s_ += __shfl_xor(s_, 32); \
        rs_[i_] = __builtin_amdgcn_rsqf(s_ * (1.0f / 1024.0f) + 1e-6f); } } while (0)
struct EpiGateUp {
    static constexpr bool PERM = true, AFTER_DRAIN = false;
    bf16_t* H; const float* rowss;
    __device__ __forceinline__ void operator()(const f32x4 (&acc)[2][2][4][2], const Unit& u, int wr, int wc, int fr, int fq) const {
        const int row0 = u.pm * BM + wr * 64 + fr; const int col0 = u.pn * HALF + wc * 32 + 8 * fq;
        float rs[8]; EPI_ROW_SCALES(rs, rowss, row0);
#pragma unroll
        for (int ai = 0; ai < 2; ++ai)
#pragma unroll
            for (int m = 0; m < 4; ++m) { const int row = row0 + ai * HALF + m * 16; const float r = rs[ai * 4 + m];
                float hv[8];
#pragma unroll
                for (int n = 0; n < 2; ++n)
#pragma unroll
                    for (int e = 0; e < 4; ++e) { const float g = acc[ai][0][m][n][e] * r, up = acc[ai][1][m][n][e] * r;
                        const float sg = g * __builtin_amdgcn_rcpf(1.0f + __builtin_amdgcn_exp2f(g * -1.4426950408889634f)); hv[n * 4 + e] = sg * up; }
                u32x4 w; w.x = cvt_pk_bf16(hv[0], hv[1]); w.y = cvt_pk_bf16(hv[2], hv[3]); w.z = cvt_pk_bf16(hv[4], hv[5]); w.w = cvt_pk_bf16(hv[6], hv[7]);
                *(u32x4*)(H + (size_t)row * 2816 + col0) = w; }
    }
};
struct EpiResid {
    static constexpr bool PERM = true, AFTER_DRAIN = false;
    typedef __attribute__((address_space(1))) float gf32; typedef __attribute__((address_space(1))) f32x4 gf32x4;
    const gf32* xin; gf32* xout; bf16_t* xb; float* rowss_next; float alpha;
    __device__ __forceinline__ void operator()(const f32x4 (&acc)[2][2][4][2], const Unit& u, int wr, int wc, int fr, int fq) const {
        const int row0 = u.pm * BM + wr * 64 + fr; const int col0 = u.pn * BM + wc * 32 + 8 * fq;
        f32x4 b0[8], b1[8];
#define EPR_LD(B, dst) do { _Pragma("unroll") for (int mm = 0; mm < 2; ++mm) _Pragma("unroll") for (int bj = 0; bj < 2; ++bj) { \
            const size_t off = (size_t)(row0 + ((B) >> 1) * HALF + (((B) & 1) * 2 + mm) * 16) * 1024 + col0 + bj * HALF; \
            dst[mm * 4 + bj * 2] = *(const gf32x4*)(xin + off); dst[mm * 4 + bj * 2 + 1] = *(const gf32x4*)(xin + off + 4); } } while (0)
#define EPR_ST(B, src) do { _Pragma("unroll") for (int mm = 0; mm < 2; ++mm) { const int ai = (B) >> 1, m = ((B) & 1) * 2 + mm; const int row = row0 + ai * HALF + m * 16; float ss = 0.f; \
            _Pragma("unroll") for (int bj = 0; bj < 2; ++bj) { const size_t off = (size_t)row * 1024 + col0 + bj * HALF; \
                const f32x4 v0 = src[mm * 4 + bj * 2] + acc[ai][bj][m][0] * alpha, v1 = src[mm * 4 + bj * 2 + 1] + acc[ai][bj][m][1] * alpha; \
                *(gf32x4*)(xout + off) = v0; *(gf32x4*)(xout + off + 4) = v1; \
                ss += (v0[0] * v0[0] + v0[1] * v0[1]) + (v0[2] * v0[2] + v0[3] * v0[3]) + (v1[0] * v1[0] + v1[1] * v1[1]) + (v1[2] * v1[2] + v1[3] * v1[3]); \
                u32x4 w; w.x = cvt_pk_bf16(v0[0], v0[1]); w.y = cvt_pk_bf16(v0[2], v0[3]); w.z = cvt_pk_bf16(v1[0], v1[1]); w.w = cvt_pk_bf16(v1[2], v1[3]); \
                *(u32x4*)(xb + off) = w; } \
            ss += __shfl_xor(ss, 16); ss += __shfl_xor(ss, 32); \
            if (fq == 0) rowss_next[(size_t)row * 16 + u.pn * 4 + wc] = ss; } } while (0)
        EPR_LD(0, b0); EPR_LD(1, b1); __builtin_amdgcn_sched_barrier(0);
        EPR_ST(0, b0); __builtin_amdgcn_sched_barrier(0); EPR_LD(2, b0); __builtin_amdgcn_sched_barrier(0);
        EPR_ST(1, b1); __builtin_amdgcn_sched_barrier(0); EPR_LD(3, b1); __builtin_amdgcn_sched_barrier(0);
        EPR_ST(2, b0); __builtin_amdgcn_sched_barrier(0);
        EPR_ST(3, b1);
#undef EPR_LD
#undef EPR_ST
    }
};
struct EpiQKVU {
    static constexpr bool PERM = true, AFTER_DRAIN = false;
    bf16_t* O; const float* rowss; const float* rope;
    __device__ __forceinline__ void operator()(const f32x4 (&acc)[2][2][4][2], const Unit& u, int wr, int wc, int fr, int fq) const {
        const int row0 = u.pm * BM + wr * 64 + fr; const int col0 = u.pn * BM + wc * 32 + 8 * fq; const int sec = u.pn >> 1;
        const int j0 = 16 * (wc & 1) + 4 * fq;
        float rs[8]; EPI_ROW_SCALES(rs, rowss, row0);
#pragma unroll
        for (int ai = 0; ai < 2; ++ai) {
            f32x4 cs[4][2];
#pragma unroll
            for (int m = 0; m < 4; ++m) { cs[m][0] = (f32x4){1.f, 0.f, 1.f, 0.f}; cs[m][1] = cs[m][0];
                if (sec < 2) { const f32x4* rp = (const f32x4*)(rope + ((size_t)(row0 + ai * HALF + m * 16) * 32 + j0) * 2); cs[m][0] = rp[0]; cs[m][1] = rp[1]; } }
#pragma unroll
            for (int m = 0; m < 4; ++m) { const int row = row0 + ai * HALF + m * 16; float r = rs[ai * 4 + m]; if (sec == 0) r *= 0.125f * 1.4426950408889634f;
                const f32x4 cs0 = cs[m][0], cs1 = cs[m][1];
#pragma unroll
                for (int bj = 0; bj < 2; ++bj) { const f32x4 v0 = acc[ai][bj][m][0] * r, v1 = acc[ai][bj][m][1] * r;
                    const float o0 = v0[0] * cs0[0] - v0[1] * cs0[1], o1 = v0[1] * cs0[0] + v0[0] * cs0[1];
                    const float o2 = v0[2] * cs0[2] - v0[3] * cs0[3], o3 = v0[3] * cs0[2] + v0[2] * cs0[3];
                    const float o4 = v1[0] * cs1[0] - v1[1] * cs1[1], o5 = v1[1] * cs1[0] + v1[0] * cs1[1];
                    const float o6 = v1[2] * cs1[2] - v1[3] * cs1[3], o7 = v1[3] * cs1[2] + v1[2] * cs1[3];
                    u32x4 w; w.x = cvt_pk_bf16(o0, o1); w.y = cvt_pk_bf16(o2, o3); w.z = cvt_pk_bf16(o4, o5); w.w = cvt_pk_bf16(o6, o7);
                    *(u32x4*)(O + (size_t)row * 2112 + col0 + bj * HALF) = w; } } }
    }
};

template <class Epi, class Sched, bool ALIGN_EPI = false, bool SP2 = false>
__device__ __forceinline__ void gemm_phase(PG8_LAS unsigned char* lds, const Gemm g, const Sched& S, const Epi& E) {
    int tid_ = threadIdx.x; asm volatile("" : "+v"(tid_));
    const int tid = tid_, wid = __builtin_amdgcn_readfirstlane(tid >> 6), lane = tid & 63, wr = wid >> 2, wc = wid & 3, fr = lane & 15, fq = lane >> 4;
    const int K = g.K, nt = K / BK;
    unsigned voffA[2], voffB[2];
#pragma unroll
    for (int i = 0; i < 2; ++i) { int R, C; stage_rc(tid * 16 + i * 8192, R, C); const int Rb = Epi::PERM ? ((R & ~31) + perm32(R & 31)) : R;
        voffA[i] = (unsigned)(R * K + C) * 2u; voffB[i] = (unsigned)(Rb * K + C) * 2u; }
    const size_t kstep = (size_t)(BK * 2);
    const size_t hstep = (size_t)HALF * K * 2;
    const size_t tstep = 2 * hstep;
    const unsigned ldsw = (unsigned)wid * 1024u;
    const int aoff = lds_byte(wr * 64 + fr, fq * 8), boff = lds_byte(wc * 32 + fr, fq * 8);
#define PG8_SA(b, h) (((b) * 2 + (h)) * HTB)
#define PG8_SB(b, h) ((4 + (b) * 2 + (h)) * HTB)
#define PG8_STAGE(bufoff, gbase, voff) do { _Pragma("unroll") for (int _i = 0; _i < 2; ++_i) \
        __builtin_amdgcn_global_load_lds((const unsigned*)((const char*)(gbase) + (voff)[_i]), (PG8_LAS unsigned*)(lds + (bufoff) + ldsw + _i * 8192), 16, 0, 0); } while (0)
#define PG8_LDA(dst, b, h) do { _Pragma("unroll") for (int m = 0; m < 4; ++m) _Pragma("unroll") for (int k = 0; k < 2; ++k) dst[m][k] = *(const PG8_LAS bf16x8*)(lds + PG8_SA(b, h) + aoff + m * 2048 + k * 1024); } while (0)
#define PG8_LDB(dst, b, h) do { _Pragma("unroll") for (int n = 0; n < 2; ++n) _Pragma("unroll") for (int k = 0; k < 2; ++k) dst[n][k] = *(const PG8_LAS bf16x8*)(lds + PG8_SB(b, h) + boff + n * 2048 + k * 1024); } while (0)
#define PG8_MMA(ai, bj, At, Bt) do { __builtin_amdgcn_s_setprio(1); _Pragma("unroll") for (int m = 0; m < 4; ++m) _Pragma("unroll") for (int n = 0; n < 2; ++n) _Pragma("unroll") for (int k = 0; k < 2; ++k) \
        acc[ai][bj][m][n] = __builtin_amdgcn_mfma_f32_16x16x32_bf16(Bt[n][k], At[m][k], acc[ai][bj][m][n], 0, 0, 0); __builtin_amdgcn_s_setprio(0); } while (0)
#define PG8_WAIT_V(n) asm volatile("s_waitcnt vmcnt(" #n ")" ::: "memory")
#define PG8_WAIT_L(n) asm volatile("s_waitcnt lgkmcnt(" #n ")" ::: "memory")
#define PG8_BAR __builtin_amdgcn_s_barrier()
#define PG8_SCHED __builtin_amdgcn_sched_barrier(0)
    Unit cur, nxt; int ui = 0;
    if (!S.next(0, cur)) return;
    f32x4 acc[2][2][4][2];
#pragma unroll
    for (int a = 0; a < 2; ++a)
#pragma unroll
        for (int b = 0; b < 2; ++b)
#pragma unroll
            for (int m = 0; m < 4; ++m)
#pragma unroll
                for (int n = 0; n < 2; ++n) acc[a][b][m][n] = (f32x4){0.f, 0.f, 0.f, 0.f};
    bf16x8 At[4][2], B0[2][2], B1[2][2];
    const char* cA = (const char*)g.A + (size_t)cur.pm * tstep; const char* cB = (const char*)g.Bt + (size_t)cur.pn * tstep;
    S.a_ready(cur);
    if constexpr (SP2) {
        PG8_STAGE(PG8_SB(0, 0), cB, voffB); PG8_STAGE(PG8_SB(0, 1), cB + hstep, voffB); PG8_STAGE(PG8_SA(0, 0), cA, voffA); PG8_STAGE(PG8_SA(0, 1), cA + hstep, voffA);
        if (wr == 1) PG8_BAR;
        PG8_WAIT_V(2); PG8_BAR;
        PG8_STAGE(PG8_SB(1, 0), cB + kstep, voffB); PG8_STAGE(PG8_SA(1, 0), cA + kstep, voffA); PG8_STAGE(PG8_SB(1, 1), cB + hstep + kstep, voffB);
        PG8_WAIT_V(6); PG8_BAR;
    } else {
        PG8_STAGE(PG8_SB(0, 0), cB, voffB); PG8_STAGE(PG8_SA(0, 0), cA, voffA); PG8_STAGE(PG8_SB(0, 1), cB + hstep, voffB); PG8_STAGE(PG8_SA(0, 1), cA + hstep, voffA);
        if (wr == 1) PG8_BAR;
        PG8_WAIT_V(4); PG8_BAR;
        PG8_STAGE(PG8_SB(1, 0), cB + kstep, voffB); PG8_STAGE(PG8_SA(1, 0), cA + kstep, voffA); PG8_STAGE(PG8_SB(1, 1), cB + hstep + kstep, voffB);
        PG8_WAIT_V(6); PG8_BAR;
    }
    for (;;) {
        const bool has_next = S.next(ui + 1, nxt);
        const char* nA = has_next ? (const char*)g.A + (size_t)nxt.pm * tstep : cA; const char* nB = has_next ? (const char*)g.Bt + (size_t)nxt.pn * tstep : cB;
        for (int t = 0; t < nt; t += 2) {
            const bool last = (t == nt - 2);
            const char* a1 = cA + (size_t)(t + 1) * kstep;
            const char* a2 = last ? nA : cA + (size_t)(t + 2) * kstep; const char* b2 = last ? nB : cB + (size_t)(t + 2) * kstep;
            const char* a3 = a2 + kstep; const char* b3 = b2 + kstep;
            if (last && has_next) S.a_ready(nxt);
            if constexpr (SP2) {
            PG8_LDB(B0, 0, 0); PG8_LDB(B1, 0, 1); PG8_SCHED; PG8_LDA(At, 0, 0); PG8_STAGE(PG8_SA(1, 1), a1 + hstep, voffA);
            PG8_WAIT_V(8); PG8_WAIT_L(0); PG8_BAR; PG8_MMA(0, 0, At, B0); PG8_MMA(0, 1, At, B1); PG8_BAR; PG8_SCHED;
            PG8_LDA(At, 0, 1); PG8_STAGE(PG8_SB(0, 0), b2, voffB); PG8_STAGE(PG8_SB(0, 1), b2 + hstep, voffB); PG8_STAGE(PG8_SA(0, 0), a2, voffA);
            PG8_WAIT_V(8); PG8_WAIT_L(0); PG8_BAR; PG8_MMA(1, 0, At, B0); PG8_MMA(1, 1, At, B1); PG8_BAR; PG8_SCHED;
            PG8_LDB(B0, 1, 0); PG8_LDB(B1, 1, 1); PG8_SCHED; PG8_LDA(At, 1, 0); PG8_STAGE(PG8_SA(0, 1), a2 + hstep, voffA);
            PG8_WAIT_V(8); PG8_WAIT_L(0); PG8_BAR; PG8_MMA(0, 0, At, B0); PG8_MMA(0, 1, At, B1); PG8_BAR; PG8_SCHED;
            PG8_LDA(At, 1, 1); PG8_STAGE(PG8_SB(1, 0), b3, voffB); PG8_STAGE(PG8_SB(1, 1), b3 + hstep, voffB); PG8_STAGE(PG8_SA(1, 0), a3, voffA);
            PG8_WAIT_V(8); PG8_WAIT_L(0); PG8_BAR; PG8_MMA(1, 0, At, B0); PG8_MMA(1, 1, At, B1); PG8_BAR; PG8_SCHED;
            } else {
            PG8_LDB(B0, 0, 0); PG8_SCHED; PG8_LDA(At, 0, 0); PG8_STAGE(PG8_SA(1, 1), a1 + hstep, voffA);
            PG8_WAIT_L(8); PG8_BAR; PG8_WAIT_L(0); PG8_MMA(0, 0, At, B0); PG8_BAR; PG8_SCHED;
            PG8_LDB(B1, 0, 1); PG8_STAGE(PG8_SB(0, 0), b2, voffB);
            PG8_BAR; PG8_WAIT_L(0); PG8_MMA(0, 1, At, B1); PG8_BAR;
            PG8_LDA(At, 0, 1); PG8_STAGE(PG8_SA(0, 0), a2, voffA);
            PG8_BAR; PG8_WAIT_L(0); PG8_MMA(1, 0, At, B0); PG8_BAR; PG8_SCHED;
            PG8_STAGE(PG8_SB(0, 1), b2 + hstep, voffB);
            PG8_WAIT_V(6); PG8_BAR; PG8_MMA(1, 1, At, B1); PG8_BAR;
            PG8_LDB(B0, 1, 0); PG8_SCHED; PG8_LDA(At, 1, 0); PG8_STAGE(PG8_SA(0, 1), a2 + hstep, voffA);
            PG8_WAIT_L(8); PG8_BAR; PG8_WAIT_L(0); PG8_MMA(0, 0, At, B0); PG8_BAR; PG8_SCHED;
            PG8_LDB(B1, 1, 1); PG8_STAGE(PG8_SB(1, 0), b3, voffB);
            PG8_BAR; PG8_WAIT_L(0); PG8_MMA(0, 1, At, B1); PG8_BAR;
            PG8_LDA(At, 1, 1); PG8_STAGE(PG8_SA(1, 0), a3, voffA);
            PG8_BAR; PG8_WAIT_L(0); PG8_MMA(1, 0, At, B0); PG8_BAR; PG8_SCHED;
            PG8_STAGE(PG8_SB(1, 1), b3 + hstep, voffB);
            PG8_WAIT_V(6); PG8_BAR; PG8_MMA(1, 1, At, B1); PG8_BAR;
            }
        }
        if constexpr (ALIGN_EPI) { if (wr == 0) PG8_BAR; }
        if constexpr (!Epi::AFTER_DRAIN) { E(acc, cur, wr, wc, fr, fq); S.done(cur); }
        if (!has_next) break;
#pragma unroll
        for (int a = 0; a < 2; ++a)
#pragma unroll
            for (int b = 0; b < 2; ++b)
#pragma unroll
                for (int m = 0; m < 4; ++m)
#pragma unroll
                    for (int n = 0; n < 2; ++n) acc[a][b][m][n] = (f32x4){0.f, 0.f, 0.f, 0.f};
        cur = nxt; cA = nA; cB = nB; ++ui;
        if constexpr (ALIGN_EPI) { if (wr == 1) PG8_BAR; }
    }
    PG8_WAIT_V(0);
    if constexpr (!ALIGN_EPI) { if (wr == 0) PG8_BAR; }
    PG8_BAR;
    if constexpr (Epi::AFTER_DRAIN) { E.fused(acc, cur, wr, wc, fr, fq, lds, wid, lane); S.done(cur); }
#undef PG8_SA
#undef PG8_SB
#undef PG8_STAGE
#undef PG8_LDA
#undef PG8_LDB
#undef PG8_MMA
#undef PG8_WAIT_V
#undef PG8_WAIT_L
#undef PG8_BAR
#undef PG8_SCHED
}
}

#ifndef PG8_SP2
#define PG8_SP2 true
#endif
#ifndef PG8_ALIGN
#define PG8_ALIGN true
#endif
#include <hip/hip_bf16.h>
#include <cmath>
namespace attn_body {
using bf16=__hip_bfloat16;
using bf16x8=__attribute__((ext_vector_type(8)))short;
using s16x4=__attribute__((ext_vector_type(4)))short;
using f32x16=__attribute__((ext_vector_type(16)))float;
using u32x4=__attribute__((ext_vector_type(4)))unsigned;
constexpr int BATCH=1,NHEAD=16,SEQ=16384,D=64,DM=2112,DMO=1024;
constexpr int NW=8,QBLK=32,QB=QBLK*NW,KVBLK=64,NQB=SEQ/QB;
constexpr int ATTN_PITCH=DM, ATTN_UNIT_ROWS=QB;
__device__ __forceinline__ int crow(int r,int hi){return (r&3)+8*(r>>2)+4*hi;}
#define SBAR() __builtin_amdgcn_sched_barrier(0)
__device__ __forceinline__ void cmask(f32x16&p0,f32x16&p1,int jb,int qrel,int hi){
  const float NEG=-INFINITY; int kb=64*jb+4*hi;
  #pragma unroll
  for(int r=0;r<16;++r){int kv=kb+(r&3)+8*(r>>2); if(kv>qrel)p0[r]=NEG; if(kv+32>qrel)p1[r]=NEG;}
}

constexpr int NSLOT=3, SLOTB=8192;
constexpr int NVSLOT=3, VSLOTB=16384;
constexpr int LDS_K=0, LDS_V=NSLOT*SLOTB, LDS_P=LDS_V+NVSLOT*VSLOTB, LDS_WS=LDS_P+NW*8192, WSF_STRIDE=64, LDS_BYTES=LDS_WS+NW*WSF_STRIDE*4;
constexpr float C2=0.125f*1.4426950408889634f;
__device__ __forceinline__ void glds16(const void*gsrc,unsigned lds_dst){unsigned keep;
  asm volatile("s_mov_b32 %0, m0\n\ts_mov_b32 m0, %2\n\ts_nop 0\n\tglobal_load_lds_dwordx4 %1, off\n\ts_mov_b32 m0, %0":"=&s"(keep):"v"(gsrc),"s"(lds_dst):"memory");}
__device__ __forceinline__ float max3f(float a,float b,float c){float r;asm("v_max3_f32 %0, %1, %2, %3":"=v"(r):"v"(a),"v"(b),"v"(c));return r;}
__device__ __forceinline__ float max2f(float a,float b){float r;asm("v_max_f32_e32 %0, %1, %2":"=v"(r):"v"(a),"v"(b));return r;}
__device__ __forceinline__ float fadd_s(float a,float b){float r;asm("v_add_f32_e32 %0, %1, %2":"=v"(r):"v"(a),"v"(b));return r;}
__device__ __forceinline__ float fsub_s(float a,float b){float r;asm("v_sub_f32_e32 %0, %1, %2":"=v"(r):"v"(a),"v"(b));return r;}
typedef float f32x2_t __attribute__((ext_vector_type(2))); typedef __bf16 bf16x2_t __attribute__((ext_vector_type(2)));
__device__ __forceinline__ unsigned cvtpk_s(float lo,float hi){f32x2_t v={lo,hi};bf16x2_t b=__builtin_convertvector(v,bf16x2_t);return __builtin_bit_cast(unsigned,b);}
#define WAIT_BAR(N) asm volatile("s_waitcnt vmcnt(" #N ") lgkmcnt(0)\n\ts_barrier":::"memory")

__device__ __forceinline__ void qkt(f32x16&p0,f32x16&p1,const char*Kslot,const bf16x8*qr,const f32x16&negm,int r32,int hi){
  const char*kb=Kslot+hi*1024+r32*16;
  #pragma unroll
  for(int d0=0;d0<4;++d0){
    const bf16x8 b0=*reinterpret_cast<const bf16x8*>(kb+d0*2048);
    const bf16x8 b1=*reinterpret_cast<const bf16x8*>(kb+d0*2048+512);
    if(d0==0){p0=__builtin_amdgcn_mfma_f32_32x32x16_bf16(b0,qr[0],negm,0,0,0);p1=__builtin_amdgcn_mfma_f32_32x32x16_bf16(b1,qr[0],negm,0,0,0);}
    else{p0=__builtin_amdgcn_mfma_f32_32x32x16_bf16(b0,qr[d0],p0,0,0,0);p1=__builtin_amdgcn_mfma_f32_32x32x16_bf16(b1,qr[d0],p1,0,0,0);}}
}
typedef __attribute__((address_space(3))) const char* lds_cptr;
typedef short v4i16_t __attribute__((ext_vector_type(4)));
__device__ __forceinline__ void kload8(bf16x8*kf,lds_cptr kp){
  kf[0]=*(const __attribute__((address_space(3))) bf16x8*)(kp);      kf[1]=*(const __attribute__((address_space(3))) bf16x8*)(kp+512);
  kf[2]=*(const __attribute__((address_space(3))) bf16x8*)(kp+2048); kf[3]=*(const __attribute__((address_space(3))) bf16x8*)(kp+2560);
  kf[4]=*(const __attribute__((address_space(3))) bf16x8*)(kp+4096); kf[5]=*(const __attribute__((address_space(3))) bf16x8*)(kp+4608);
  kf[6]=*(const __attribute__((address_space(3))) bf16x8*)(kp+6144); kf[7]=*(const __attribute__((address_space(3))) bf16x8*)(kp+6656);
}
__device__ __forceinline__ void kload2(bf16x8*kf,lds_cptr kp,int j){ kf[2*j]=*(const __attribute__((address_space(3))) bf16x8*)(kp+j*2048); kf[2*j+1]=*(const __attribute__((address_space(3))) bf16x8*)(kp+j*2048+512); }
__device__ __forceinline__ s16x4 vtr(lds_cptr p){ return __builtin_bit_cast(s16x4,__builtin_amdgcn_ds_read_tr16_b64_v4i16((__attribute__((address_space(3))) v4i16_t*)p)); }
__device__ __forceinline__ float rowmax(const f32x16&p0,const f32x16&p1){
  float a=max3f(p0[0],p0[1],p1[0]),b=max3f(p0[2],p0[3],p1[1]);a=max3f(a,p1[2],p1[3]);
  #pragma unroll
  for(int r=4;r<16;r+=4){a=max3f(a,p0[r],p0[r+1]);b=max3f(b,p0[r+2],p0[r+3]);a=max3f(a,p1[r],p1[r+1]);b=max3f(b,p1[r+2],p1[r+3]);}
  const float m=max2f(a,b);
  auto rr=__builtin_amdgcn_permlane32_swap(__float_as_uint(m),__float_as_uint(m),false,false);
  return max2f(__uint_as_float(rr[0]),__uint_as_float(rr[1]));
}
__device__ __forceinline__ void pv(f32x16*o,int vb,bf16x8 pa0,bf16x8 pa1,bf16x8 pa2,bf16x8 pa3){
  #pragma unroll
  for(int d0=0;d0<2;++d0){s16x4 lo[4],hi[4];
    #pragma unroll
    for(int ks=0;ks<4;++ks){
      asm volatile("ds_read_b64_tr_b16 %0,%1 offset:%c2":"=&v"(lo[ks]):"v"(vb),"i"(d0*4096+ks*1024):"memory");
      asm volatile("ds_read_b64_tr_b16 %0,%1 offset:%c2":"=&v"(hi[ks]):"v"(vb),"i"(d0*4096+ks*1024+512):"memory");}
    asm volatile("s_waitcnt lgkmcnt(0)":::"memory");SBAR();
    #define PK(k) (bf16x8){lo[k][0],lo[k][1],lo[k][2],lo[k][3],hi[k][0],hi[k][1],hi[k][2],hi[k][3]}
    o[d0]=__builtin_amdgcn_mfma_f32_32x32x16_bf16(pa0,PK(0),o[d0],0,0,0);
    o[d0]=__builtin_amdgcn_mfma_f32_32x32x16_bf16(pa1,PK(1),o[d0],0,0,0);
    o[d0]=__builtin_amdgcn_mfma_f32_32x32x16_bf16(pa2,PK(2),o[d0],0,0,0);
    o[d0]=__builtin_amdgcn_mfma_f32_32x32x16_bf16(pa3,PK(3),o[d0],0,0,0);
    #undef PK
  }
}

#ifndef ATTN_STORE16
#define ATTN_STORE16(p,v) (*(u32x4*)(p)=(v))
#endif
template<int THRL> __device__ __forceinline__ void attn_unit(int qb,const bf16*Q,const bf16*__restrict__ K,const bf16*__restrict__ V,bf16*O,char*shm){
  int tid_=threadIdx.x; asm volatile("":"+v"(tid_)); const int tid=tid_,lane=tid&63,r32=lane&31,hi=lane>>5; const int wid=__builtin_amdgcn_readfirstlane(tid>>6);
  const int q0=qb*QB;
  const unsigned lds0=(unsigned)(uintptr_t)shm;
  float*wsf=(float*)(shm+LDS_WS)+wid*WSF_STRIDE;
  const bf16*ksrc=K+(long)lane*DM+wid*8;
  const bf16*vsrc=V+(long)(16*(wid&3)+(lane>>2))*DM+(wid>>2)*32+(lane&3)*8;
  const unsigned kdst=lds0+LDS_K+wid*1024, vdst=lds0+LDS_V+wid*1024;
  #define DMA_K(t,s3) glds16(ksrc+(long)(t)*KVBLK*DM,(unsigned)__builtin_amdgcn_readfirstlane(kdst+(s3)*SLOTB))
  #define DMA_V(t,s3) do{ const unsigned vd_=(unsigned)__builtin_amdgcn_readfirstlane(vdst+(s3)*VSLOTB); glds16(vsrc+(long)(t)*KVBLK*DM,vd_); glds16(vsrc+(long)(t)*KVBLK*DM+64,(unsigned)__builtin_amdgcn_readfirstlane(vd_+8192)); }while(0)
  const lds_cptr shm3=(lds_cptr)shm;
  const int NT=(q0+QB)/KVBLK;
  DMA_K(0,0);DMA_V(0,0);DMA_K(1,1);DMA_V(1,1);
  int c0=0,c1=1,c2=2;
  #define ROT3() do{ const int x_=c0; c0=c1; c1=c2; c2=x_; }while(0)
  #define PKW(P,B) cvtpk_s(P[B],P[B+1])
  #define MX3(a,b,c) __builtin_fmaxf(__builtin_fmaxf((a),(b)),(c))
  const bf16*Qw=Q+(long)(q0+wid*QBLK)*DM;
  bf16x8 qr[4];
  #pragma unroll
  for(int d0=0;d0<4;++d0)qr[d0]=*reinterpret_cast<const bf16x8*>(&Qw[(long)r32*DM+d0*16+hi*8]);
  float mhat=0.f,l_reg=0.f; f32x16 negm=f32x16{};
  f32x16 o[4]; o[0]=f32x16{};o[1]=f32x16{};o[2]=f32x16{};o[3]=f32x16{};
  const int qrel=wid*QBLK+r32;
  const lds_cptr kp0=shm3+LDS_K+hi*1024+r32*16;
  const lds_cptr vp0=shm3+LDS_V+((lane>>4)&1)*32+(lane&3)*8+(4*hi+((lane&15)>>2))*64;
  WAIT_BAR(3);
  for(int t=0;t<NT;++t){
    if(t+2<NT){DMA_K(t+2,c2);DMA_V(t+2,c2);}
    bf16x8 kf[8]; kload8(kf,kp0+c0*SLOTB);
    SBAR();
    f32x16 C0,C1;
    {
      C0=__builtin_amdgcn_mfma_f32_32x32x16_bf16(kf[0],qr[0],negm,0,0,0); C1=__builtin_amdgcn_mfma_f32_32x32x16_bf16(kf[1],qr[0],negm,0,0,0);
      C0=__builtin_amdgcn_mfma_f32_32x32x16_bf16(kf[2],qr[1],C0,0,0,0);   C1=__builtin_amdgcn_mfma_f32_32x32x16_bf16(kf[3],qr[1],C1,0,0,0);
      C0=__builtin_amdgcn_mfma_f32_32x32x16_bf16(kf[4],qr[2],C0,0,0,0);   C1=__builtin_amdgcn_mfma_f32_32x32x16_bf16(kf[5],qr[2],C1,0,0,0);
      C0=__builtin_amdgcn_mfma_f32_32x32x16_bf16(kf[6],qr[3],C0,0,0,0);   C1=__builtin_amdgcn_mfma_f32_32x32x16_bf16(kf[7],qr[3],C1,0,0,0); }
    SBAR();
    const lds_cptr vp_=vp0+c0*VSLOTB; s16x4 vl_[8],vh_[8];
    #pragma unroll
    for(int k2=0;k2<2;++k2)
      #pragma unroll
      for(int d_=0;d_<4;++d_){ vl_[d_*2+k2]=vtr(vp_+(d_*4096+k2*1024)); vh_[d_*2+k2]=vtr(vp_+(d_*4096+k2*1024+512)); }
    SBAR();
    { const int jb_=t-(NT-4); if(jb_>=0)cmask(C0,C1,jb_,qrel,hi); }
    float a=MX3(C0[0],C0[1],C1[0]),b=MX3(C0[2],C0[3],C1[1]); a=MX3(a,C1[2],C1[3]);
    #pragma unroll
    for(int r=4;r<16;r+=4){a=MX3(a,C0[r],C0[r+1]);b=MX3(b,C0[r+2],C0[r+3]);a=MX3(a,C1[r],C1[r+1]);b=MX3(b,C1[r+2],C1[r+3]);}
    float rm=__builtin_fmaxf(a,b); { auto rr=__builtin_amdgcn_permlane32_swap(__float_as_uint(rm),__float_as_uint(rm),false,false); rm=__builtin_fmaxf(__uint_as_float(rr[0]),__uint_as_float(rr[1])); }
    if(t==0 || __any(rm>(float)THRL)){
      const float dl=(t==0)?rm:__builtin_fmaxf(rm,0.f); mhat+=dl;
      #pragma unroll
      for(int r=0;r<16;++r){C0[r]-=dl;C1[r]-=dl;}
      #pragma unroll
      for(int r=0;r<16;++r)negm[r]=-mhat;
      if(t!=0){ const float f=__builtin_amdgcn_exp2f(-dl); l_reg*=f; if(hi==0)wsf[r32]=f; asm volatile("s_waitcnt lgkmcnt(0)":::"memory");
        #pragma unroll
        for(int d_=0;d_<4;++d_)
          #pragma unroll
          for(int r=0;r<16;++r)o[d_][r]*=wsf[crow(r,hi)]; } }
    #pragma unroll
    for(int r=0;r<16;++r){C0[r]=__builtin_amdgcn_exp2f(C0[r]);C1[r]=__builtin_amdgcn_exp2f(C1[r]);}
    { float s0=C0[0]+C0[1],s1=C1[0]+C1[1];
      #pragma unroll
      for(int r=2;r<16;++r){s0+=C0[r];s1+=C1[r];}
      l_reg+=s0+s1; }
    const u32x4 pw0=(u32x4){PKW(C0,0),PKW(C0,2),PKW(C0,4),PKW(C0,6)},pw1=(u32x4){PKW(C0,8),PKW(C0,10),PKW(C0,12),PKW(C0,14)},pw2=(u32x4){PKW(C1,0),PKW(C1,2),PKW(C1,4),PKW(C1,6)},pw3=(u32x4){PKW(C1,8),PKW(C1,10),PKW(C1,12),PKW(C1,14)};
    SBAR();
    #define VFRAG(L_,H_,i_) (bf16x8){L_[i_][0],L_[i_][1],L_[i_][2],L_[i_][3],H_[i_][0],H_[i_][1],H_[i_][2],H_[i_][3]}
    s16x4 w2l_[4],w2h_[4],w3l_[4],w3h_[4];
    #pragma unroll
    for(int d_=0;d_<4;++d_){ w2l_[d_]=vtr(vp_+(d_*4096+2*1024)); w2h_[d_]=vtr(vp_+(d_*4096+2*1024+512)); }
    SBAR();
    #pragma unroll
    for(int d_=0;d_<4;++d_){ o[d_]=__builtin_amdgcn_mfma_f32_32x32x16_bf16(__builtin_bit_cast(bf16x8,pw0),VFRAG(vl_,vh_,d_*2),o[d_],0,0,0); }
    SBAR();
    #pragma unroll
    for(int d_=0;d_<4;++d_){ w3l_[d_]=vtr(vp_+(d_*4096+3*1024)); w3h_[d_]=vtr(vp_+(d_*4096+3*1024+512)); }
    SBAR();
    #pragma unroll
    for(int d_=0;d_<4;++d_){ o[d_]=__builtin_amdgcn_mfma_f32_32x32x16_bf16(__builtin_bit_cast(bf16x8,pw1),VFRAG(vl_,vh_,d_*2+1),o[d_],0,0,0); }
    #pragma unroll
    for(int d_=0;d_<4;++d_){ o[d_]=__builtin_amdgcn_mfma_f32_32x32x16_bf16(__builtin_bit_cast(bf16x8,pw2),VFRAG(w2l_,w2h_,d_),o[d_],0,0,0); }
    #pragma unroll
    for(int d_=0;d_<4;++d_){ o[d_]=__builtin_amdgcn_mfma_f32_32x32x16_bf16(__builtin_bit_cast(bf16x8,pw3),VFRAG(w3l_,w3h_,d_),o[d_],0,0,0); }
    SBAR();
    #undef VFRAG
    if(t+2<NT){WAIT_BAR(3);}else{WAIT_BAR(0);}
    ROT3();
  }
  { auto rr=__builtin_amdgcn_permlane32_swap(__float_as_uint(l_reg),__float_as_uint(l_reg),false,false); l_reg=__uint_as_float(rr[0])+__uint_as_float(rr[1]); }
  if(hi==0)wsf[32+r32]=l_reg; asm volatile("s_waitcnt lgkmcnt(0)":::"memory");
  bf16*Ow=O+(long)(q0+wid*QBLK)*DMO;
  { bf16*stg=(bf16*)(shm+LDS_P)+wid*4096;
    #pragma unroll
    for(int r=0;r<16;++r){const int orow=crow(r,hi); const float rl=__builtin_amdgcn_rcpf(wsf[32+orow]);
      #pragma unroll
      for(int d0=0;d0<4;++d0)stg[orow*128+d0*32+r32]=__float2bfloat16(o[d0][r]*rl);}
    asm volatile("s_waitcnt lgkmcnt(0)":::"memory");
    #pragma unroll
    for(int i=0;i<8;++i){const int row=i*4+(lane>>4),ch=lane&15; const u32x4 v=*(const u32x4*)(stg+row*128+ch*8); ATTN_STORE16(Ow+(long)row*DMO+ch*8,v);} }
  asm volatile("s_waitcnt lgkmcnt(0)\n\ts_barrier":::"memory");
  #undef DMA_K
  #undef DMA_V
  #undef ROT3
  #undef PKW
  #undef MX3
}
constexpr int ATTN_LDS_BYTES=LDS_BYTES;
struct AttnTensors { const bf16* Q; const bf16* K; const bf16* V; bf16* O; };
struct AttnUnit { int hc; int qb; };
struct StaticOrder {
  int vcu, G, bx;
  __device__ __forceinline__ StaticOrder(int grid,int block):vcu((grid%8==0)?(block%8)*(grid/8)+block/8:block),G(grid),bx(block){}
  __device__ __forceinline__ bool next(int i,AttnUnit&u)const{
    if(G==256){ if(i>=2)return false; const int s=vcu&31; u.hc=vcu>>5; u.qb=(i==0)?63-s:s; return true; }
    const int idx=i*G+bx; if(idx>=8*NQB)return false; u.hc=idx&7; u.qb=NQB-1-(idx>>3); return true; }
};
template<class Sched,int THRL=8> __device__ __forceinline__ void attn_phase(char*lds,const AttnTensors&T,const Sched&S){
  AttnUnit u;
  for(int i=0;S.next(i,u);++i){ const int h=u.hc>>1,c=u.hc&1;
    attn_unit<THRL>(u.qb,T.Q+h*128+c*64,T.K+h*128+c*64,T.V+h*128,T.O+u.hc*128,lds); }
}
#undef SBAR
#undef WAIT_BAR
}
constexpr int NWAVES = 8;
constexpr int M = 16384, D = 1024, FF = 2816, NGU = 2 * FF, NIN = 2048, DEPTH = 4;
constexpr size_t MiB = 1u << 20;
constexpr size_t WS_ROWSS = 1 * MiB;
constexpr size_t WS_ROPE = 2 * MiB;
constexpr size_t WS_XB = 8 * MiB;
constexpr size_t WS_H = 40 * MiB;
constexpr size_t WS_QKVU = 40 * MiB;
constexpr size_t WS_OBUF = 108 * MiB;
constexpr size_t WS_CAT = 140 * MiB;
constexpr size_t WS_W = 172 * MiB;
constexpr size_t OFF_GU1 = 0, OFF_DN1 = 11 * MiB, OFF_IN = 16 * MiB + 512 * 1024, OFF_OUT = 20 * MiB + 512 * 1024, OFF_GU2 = 22 * MiB + 512 * 1024, OFF_DN2 = 33 * MiB + 512 * 1024, W_LAYER = 39 * MiB;
constexpr size_t WS_END = WS_W + DEPTH * W_LAYER;
static_assert(attn_body::ATTN_LDS_BYTES <= 147392 && (size_t)NGU * D * 2 == 11 * MiB && (size_t)D * FF * 2 == 5 * MiB + 512 * 1024 && WS_H + (size_t)M * FF * 2 <= WS_CAT && WS_ROWSS + 16 * (size_t)M * 4 <= WS_ROPE && WS_ROPE + (size_t)M * 64 * 4 <= WS_XB, "ws map");
constexpr int LDS_BYTES = 147456;

#define LAS __attribute__((address_space(3)))
typedef unsigned short bf16;
typedef unsigned v4u __attribute__((ext_vector_type(4)));
typedef unsigned v2u __attribute__((ext_vector_type(2)));
typedef float f32x4 __attribute__((ext_vector_type(4)));
#define LDS_WAIT() asm volatile("s_waitcnt lgkmcnt(0)" ::: "memory")
__device__ __forceinline__ unsigned f2bf(float f) { unsigned u = __builtin_bit_cast(unsigned, f); return (u + 0x7fffu + ((u >> 16) & 1u)) >> 16; }
__device__ __forceinline__ unsigned pk2(float lo, float hi) { return f2bf(lo) | (f2bf(hi) << 16); }
__device__ __forceinline__ float bflo(unsigned w) { return __builtin_bit_cast(float, w << 16); }
__device__ __forceinline__ float bfhi(unsigned w) { return __builtin_bit_cast(float, w & 0xffff0000u); }
__device__ __forceinline__ float wave_sum(float v) {
#pragma unroll
    for (int o = 1; o < 64; o <<= 1) v += __shfl_xor(v, o);
    return v;
}
__device__ __forceinline__ void tr_item(const float* W, int N, int k0, int n0, const float* gk, bf16* WT, int Kd, int rbase, int rstride, int lane) {
    const int kblk = lane & 7, n4 = lane >> 3;
    const float* src = W + (size_t)(k0 + 8 * kblk) * N + n0 + 4 * n4;
    f32x4 v[8];
#pragma unroll
    for (int i = 0; i < 8; ++i) v[i] = __builtin_nontemporal_load((const f32x4*)(src + (size_t)i * N));
    if (gk) { const f32x4 g0 = *(const f32x4*)(gk + k0 + 8 * kblk), g1 = *(const f32x4*)(gk + k0 + 8 * kblk + 4);
#pragma unroll
        for (int i = 0; i < 4; ++i) { v[i] = v[i] * g0[i]; v[4 + i] = v[4 + i] * g1[i]; } }
#pragma unroll
    for (int e = 0; e < 4; ++e) { v4u o; o.x = pk2(v[0][e], v[1][e]); o.y = pk2(v[2][e], v[3][e]); o.z = pk2(v[4][e], v[5][e]); o.w = pk2(v[6][e], v[7][e]);
        *(v4u*)(WT + (size_t)(rbase + (4 * n4 + e) * rstride) * Kd + k0 + 8 * kblk) = o; }
}

#define XB_TMO      128
#define XB_XCNT(j)  (256  + 64 * (j))
#define XB_XSUB(j)  (1280 + 64 * (j))
#define XB_XGEN(j)  (2304 + 64 * (j))
#define XB_TOP      3328
#define XB_TOPGEN   3392
#define XCD_BAR_WORDS 3456
#define XB_SPIN_CAP (1u << 18)

__device__ __forceinline__ unsigned xb_ld(unsigned* p)              { return __hip_atomic_load(p, __ATOMIC_RELAXED, __HIP_MEMORY_SCOPE_AGENT); }
__device__ __forceinline__ unsigned xb_add(unsigned* p, unsigned v) { return __hip_atomic_fetch_add(p, v, __ATOMIC_RELAXED, __HIP_MEMORY_SCOPE_AGENT); }
__device__ __forceinline__ unsigned xb_xcc_id() { return (unsigned)__builtin_amdgcn_s_getreg((3 << 11) | 20) & 0xFu; }
#define XB_SPIN(cond, bar) do { unsigned _sp = 0; while (cond) { __builtin_amdgcn_s_sleep(1); \
    if ((++_sp & 255u) == 0u) { if (xb_ld(&(bar)[XB_TMO])) break; if (_sp > XB_SPIN_CAP) { atomicAdd(&(bar)[XB_TMO], 1u); break; } } } } while (0)

struct XcdBarrier {
    unsigned* bar; unsigned x;
    volatile LAS unsigned* st;
};

__device__ __forceinline__ XcdBarrier xcd_barrier_post(unsigned* bar, volatile LAS unsigned* st) {
    XcdBarrier b; b.bar = bar; b.x = xb_xcc_id(); b.st = st;
    if (threadIdx.x == 0) (void)xb_add(&bar[XB_XCNT(b.x)], 1u);
    return b;
}
__device__ __forceinline__ void xcd_barrier_complete(unsigned* bar, unsigned x, unsigned& nloc, unsigned& nx) {
    const unsigned G = gridDim.x * gridDim.y * gridDim.z;
    unsigned sum, cnt, mine, sp = 0u;
    for (;;) {
        sum = 0u; cnt = 0u; mine = 0u;
#pragma unroll
        for (unsigned j = 0; j < 16; ++j) { const unsigned c = xb_ld(&bar[XB_XCNT(j)]); sum += c; cnt += (c > 0u) ? 1u : 0u; mine = (j == x) ? c : mine; }
        if (sum == G) break;
        __builtin_amdgcn_s_sleep(1);
        if ((++sp & 255u) == 0u) { if (xb_ld(&bar[XB_TMO])) break; if (sp > XB_SPIN_CAP) { atomicAdd(&bar[XB_TMO], 1u); break; } }
    }
    nloc = mine > 0u ? mine : 1u; nx = cnt > 0u ? cnt : 1u;
}

__device__ __forceinline__ void xcd_barrier(const XcdBarrier& b) {
    asm volatile("s_waitcnt vmcnt(0)" ::: "memory");
    __syncthreads();
    if (threadIdx.x == 0) {
        unsigned* bar = b.bar;
        __builtin_amdgcn_s_waitcnt(0);
        unsigned nloc = b.st[0], nx = b.st[1];
        if (nloc == 0u) { xcd_barrier_complete(bar, b.x, nloc, nx); b.st[0] = nloc; b.st[1] = nx; }
        const unsigned old = xb_add(&bar[XB_XSUB(b.x)], 1u);
        const unsigned gen = old / nloc;
        if (old + 1u == (gen + 1u) * nloc) {
            __builtin_amdgcn_fence(__ATOMIC_RELEASE, "agent");
            asm volatile("s_waitcnt vmcnt(0)" ::: "memory");
            const unsigned og = xb_add(&bar[XB_TOP], 1u);
            const unsigned tg = og / nx;
            if (og + 1u == (tg + 1u) * nx) xb_add(&bar[XB_TOPGEN], 1u);
            else XB_SPIN(xb_ld(&bar[XB_TOPGEN]) == tg, bar);
            __builtin_amdgcn_fence(__ATOMIC_ACQUIRE, "agent");
            xb_add(&bar[XB_XGEN(b.x)], 1u);
            asm volatile("s_waitcnt vmcnt(0)" ::: "memory");
        } else {
            XB_SPIN(xb_ld(&bar[XB_XGEN(b.x)]) == gen, bar);
            __builtin_amdgcn_fence(__ATOMIC_ACQUIRE, "agent");
            asm volatile("s_waitcnt vmcnt(0)" ::: "memory");
        }
    }
    __syncthreads();
}

struct Args { const float* in[20]; float* out; unsigned char* wsp; };
typedef __attribute__((address_space(1))) unsigned char* gptr_t;
__device__ __forceinline__ gptr_t fresh_ptr(unsigned char* p) { asm volatile("" : "+s"(p)); return (gptr_t)p; }

__global__ void __launch_bounds__(NWAVES * 64, 2) hymba_fwd(Args args) {
    extern __shared__ __attribute__((aligned(16))) unsigned char lds[];
    LAS unsigned char* L = (LAS unsigned char*)lds;
    const int tid = threadIdx.x, lane = tid & 63, wave = __builtin_amdgcn_readfirstlane(tid >> 6);
    const int G = gridDim.x, bx = blockIdx.x;
    const int gw = bx * NWAVES + wave, NGW = G * NWAVES;
    const int gtid = bx * (NWAVES * 64) + tid, NT = G * NWAVES * 64;
#define ws (fresh_ptr(args.wsp))
#define rowss ((float*)(unsigned char*)(ws + WS_ROWSS))
#define rope ((float*)(unsigned char*)(ws + WS_ROPE))
#define XB ((bf16*)(unsigned char*)(ws + WS_XB))
#define HB ((bf16*)(unsigned char*)(ws + WS_H))
#define QKVU ((bf16*)(unsigned char*)(ws + WS_QKVU))
#define OBUF ((bf16*)(unsigned char*)(ws + WS_OBUF))
#define CAT ((bf16*)(unsigned char*)(ws + WS_CAT))
#define xout ((float*)(unsigned char*)fresh_ptr((unsigned char*)args.out))
    { volatile LAS unsigned* st0 = (volatile LAS unsigned*)(L + 147392); if (tid < 2) st0[tid] = 0u; }
    __syncthreads();
    const XcdBarrier gbar = xcd_barrier_post((unsigned*)args.wsp, (volatile LAS unsigned*)(L + 147392));

    {
        constexpr int IT_G = 16 * 88, IT_D = 44 * 32, IT_IN = 16 * 64, IT_OUT = 8 * 32, IT_LAYER = 4 * IT_G + 2 * IT_D + IT_IN + IT_OUT;
        static_assert(IT_G == IT_D, "item decode");
        for (int it = gw; it < DEPTH * IT_LAYER; it += NGW) {
            const int l = it / IT_LAYER; int r = it % IT_LAYER; unsigned char* wl = (unsigned char*)(ws + WS_W + (size_t)l * W_LAYER);
            if (r < 6 * IT_G) {
                const int f = r / (3 * IT_G), q = r % (3 * IT_G), kind = q / IT_G, i = q % IT_G;
                if (kind < 2) { const float* W = args.in[(f ? 16 : 2) + kind] + (size_t)l * D * FF; const int kb = i / 88, nb = i % 88, n0 = 32 * nb;
                    tr_item(W, FF, 64 * kb, n0, args.in[f ? 15 : 1] + l * D, (bf16*)(wl + (f ? OFF_GU2 : OFF_GU1)), D, (n0 >> 7) * 256 + kind * 128 + (n0 & 127), 1, lane); }
                else { const float* W = args.in[f ? 18 : 4] + (size_t)l * FF * D; const int kb = i / 32, nb = i % 32;
                    tr_item(W, D, 64 * kb, 32 * nb, nullptr, (bf16*)(wl + (f ? OFF_DN2 : OFF_DN1)), FF, 32 * nb, 1, lane); }
            } else { r -= 6 * IT_G;
                if (r < IT_IN) { const float* W = args.in[6] + (size_t)l * D * NIN; const int kb = r / 64, nb = r % 64, n0 = 32 * nb; int rbase = n0, rstride = 1;
                    if (n0 < 1024) { const int d0 = n0 & 63; rbase = (n0 - d0) + (d0 ? 1 : 0); rstride = 2; }
                    tr_item(W, NIN, 64 * kb, n0, args.in[5] + l * D, (bf16*)(wl + OFF_IN), D, rbase, rstride, lane); }
                else { r -= IT_IN; const float* W = args.in[14] + (size_t)l * D * D; const int kb = r / 32, nb = r % 32;
                    tr_item(W, D, 64 * kb, 32 * nb, nullptr, (bf16*)(wl + OFF_OUT), D, 32 * nb, 1, lane); }
            }
        }
        for (int it = gw; it < DEPTH * 1024; it += NGW) {
            const int l = it >> 10, r = it & 1023, g = r >> 8, cb = (r >> 4) & 15, nb = r & 15, c0 = cb * 8, n = nb * 64 + lane;
            const float* pw = args.in[12] + ((size_t)(l * 4 + g) * 128 + c0) * 128; const float* ps = args.in[13] + l * 512 + g * 128;
            const float* wo = args.in[14] + (size_t)l * D * D + (size_t)(512 + g * 128) * D + n;
            float a[8];
#pragma unroll
            for (int j = 0; j < 8; ++j) a[j] = 0.f;
            for (int e = 0; e < 128; ++e) { const float w = wo[(size_t)e * D] * ps[e];
#pragma unroll
                for (int j = 0; j < 8; ++j) a[j] += pw[j * 128 + e] * w; }
            v4u o; o.x = pk2(a[0], a[1]); o.y = pk2(a[2], a[3]); o.z = pk2(a[4], a[5]); o.w = pk2(a[6], a[7]);
            *(v4u*)((bf16*)(unsigned char*)(ws + WS_W + (size_t)l * W_LAYER + OFF_OUT) + (size_t)n * D + 512 + g * 128 + c0) = o;
        }
        for (int i = gtid; i < M * 32; i += NT) { const int s = i >> 5, j = i & 31; const float inv = (float)pow(10000.0, -(double)j / 32.0); const float ang = (float)s * inv;
            const double a = (double)ang; rope[2 * i] = (float)cos(a); rope[2 * i + 1] = (float)sin(a); }
        for (int m = gw; m < M; m += NGW) { const f32x4* xr = (const f32x4*)(args.in[0] + (size_t)m * D) + lane; f32x4 v[4]; float s = 0.f;
#pragma unroll
            for (int j = 0; j < 4; ++j) { v[j] = xr[64 * j]; s += (v[j].x * v[j].x + v[j].y * v[j].y) + (v[j].z * v[j].z + v[j].w * v[j].w); }
            s = wave_sum(s); if (lane < 16) rowss[(size_t)m * 16 + lane] = (lane == 0) ? s : 0.f;
            v2u* o8 = (v2u*)(XB + (size_t)m * D) + lane;
#pragma unroll
            for (int j = 0; j < 4; ++j) { v2u w; w.x = pk2(v[j].x, v[j].y); w.y = pk2(v[j].z, v[j].w); o8[64 * j] = w; } }
    }
    cg::this_grid().sync();


    for (int step = 0; step < 3 * DEPTH; ++step) {
        const int l = step / 3, kind = step % 3;
#define wl ((unsigned char*)(ws + WS_W + (size_t)l * W_LAYER))
        if (kind != 1) {
            const int f = kind >> 1;
            { pg8::Gemm g{XB, (const bf16*)(wl + (f ? OFF_GU2 : OFF_GU1)), M, NGU, D}; pg8::StaticOrder S; S.init(M, NGU, G, bx);
              pg8::EpiGateUp E{HB, rowss};
              pg8::gemm_phase<pg8::EpiGateUp, pg8::StaticOrder, PG8_ALIGN, PG8_SP2>(L, g, S, E); }
            xcd_barrier(gbar);
            { pg8::Gemm g{HB, (const bf16*)(wl + (f ? OFF_DN2 : OFF_DN1)), M, D, FF}; pg8::StaticOrder S; S.init(M, D, G, bx);
              pg8::EpiResid E{(const pg8::EpiResid::gf32*)fresh_ptr((unsigned char*)((step == 0) ? args.in[0] : args.out)), (pg8::EpiResid::gf32*)fresh_ptr((unsigned char*)args.out), XB, rowss, 0.5f};
              pg8::gemm_phase<pg8::EpiResid, pg8::StaticOrder, PG8_ALIGN, PG8_SP2>(L, g, S, E); }
            xcd_barrier(gbar);
        } else {
            { pg8::Gemm g{XB, (const bf16*)(wl + OFF_IN), M, NIN, D}; pg8::StaticOrder S; S.init(M, NIN, G, bx);
              pg8::EpiQKVU E{QKVU, rowss, rope};
              pg8::gemm_phase<pg8::EpiQKVU, pg8::StaticOrder, PG8_ALIGN, PG8_SP2>(L, g, S, E); }
            xcd_barrier(gbar);
            { const attn_body::AttnTensors AT{(const attn_body::bf16*)QKVU, (const attn_body::bf16*)(QKVU + 512), (const attn_body::bf16*)(QKVU + 1024), (attn_body::bf16*)OBUF};
              const attn_body::StaticOrder S(G, bx);
              attn_body::attn_phase<attn_body::StaticOrder>((char*)lds, AT, S); }
            xcd_barrier(gbar);
            {
                const float li = 0.8f - 0.6f * expf(-0.3f * (float)l);
                const float s1 = wave_sum(args.in[7][l * 64 + lane] * args.in[8][l * 64 + lane]), s2 = wave_sum(args.in[9][l * 64 + lane] * args.in[10][l * 64 + lane]);
                const float lam = expf(s1) - expf(s2) + li;
                const int hd = lane >> 4, j0 = (lane & 15) * 8;
                float gn[8];
#pragma unroll
                for (int j = 0; j < 8; ++j) gn[j] = args.in[11][l * 128 + j0 + j] * (1.0f - li);
                const int win = 2 << hd;
                for (int mc = gw; mc < M / 8; mc += NGW) { float wsum[8];
                  for (int mr = 0; mr < 8; ++mr) { const int m = mc * 8 + mr;
                    const v4u a = *(const v4u*)(OBUF + (size_t)m * 1024 + hd * 256 + j0), b = *(const v4u*)(OBUF + (size_t)m * 1024 + hd * 256 + 128 + j0);
                    float o[8];
                    o[0] = bflo(a.x) - lam * bflo(b.x); o[1] = bfhi(a.x) - lam * bfhi(b.x); o[2] = bflo(a.y) - lam * bflo(b.y); o[3] = bfhi(a.y) - lam * bfhi(b.y);
                    o[4] = bflo(a.z) - lam * bflo(b.z); o[5] = bfhi(a.z) - lam * bfhi(b.z); o[6] = bflo(a.w) - lam * bflo(b.w); o[7] = bfhi(a.w) - lam * bfhi(b.w);
                    float ss = 0.f;
#pragma unroll
                    for (int j = 0; j < 8; ++j) ss += o[j] * o[j];
                    ss += __shfl_xor(ss, 1); ss += __shfl_xor(ss, 2); ss += __shfl_xor(ss, 4); ss += __shfl_xor(ss, 8);
                    const float rr = __builtin_amdgcn_rsqf(ss * (1.0f / 128.0f) + 1e-6f);
                    v4u w; w.x = pk2(o[0] * rr * gn[0], o[1] * rr * gn[1]); w.y = pk2(o[2] * rr * gn[2], o[3] * rr * gn[3]); w.z = pk2(o[4] * rr * gn[4], o[5] * rr * gn[5]); w.w = pk2(o[6] * rr * gn[6], o[7] * rr * gn[7]);
                    *(v4u*)(CAT + (size_t)m * 1024 + hd * 128 + j0) = w;
                    const bf16* up = QKVU + (size_t)m * 2112 + 1536 + hd * 128 + j0;
                    const v4u u0 = *(const v4u*)up;
                    const float us[8] = {bflo(u0.x), bfhi(u0.x), bflo(u0.y), bfhi(u0.y), bflo(u0.z), bfhi(u0.z), bflo(u0.w), bfhi(u0.w)};
                    float sm[8];
                    if (mr == 0) {
                        v4u ut[15]; float wt[15];
#pragma unroll
                        for (int j = 0; j < 8; ++j) sm[j] = us[j];
#pragma unroll
                        for (int t = 1; t < 16; ++t) { const bool ok = (t < win) && (m - t >= 0); ut[t - 1] = *(const v4u*)(up - (size_t)(ok ? t : 0) * 2112); wt[t - 1] = ok ? 1.0f : 0.0f; }
#pragma unroll
                        for (int t = 0; t < 15; ++t) { const float w = wt[t];
                            sm[0] += w * bflo(ut[t].x); sm[1] += w * bfhi(ut[t].x); sm[2] += w * bflo(ut[t].y); sm[3] += w * bfhi(ut[t].y); sm[4] += w * bflo(ut[t].z); sm[5] += w * bfhi(ut[t].z); sm[6] += w * bflo(ut[t].w); sm[7] += w * bfhi(ut[t].w); }
                    } else {
                        const bool dr = (m - win >= 0); const v4u ud = *(const v4u*)(up - (size_t)(dr ? win : 0) * 2112); const float wd = dr ? 1.0f : 0.0f;
                        sm[0] = wsum[0] + us[0] - wd * bflo(ud.x); sm[1] = wsum[1] + us[1] - wd * bfhi(ud.x); sm[2] = wsum[2] + us[2] - wd * bflo(ud.y); sm[3] = wsum[3] + us[3] - wd * bfhi(ud.y);
                        sm[4] = wsum[4] + us[4] - wd * bflo(ud.z); sm[5] = wsum[5] + us[5] - wd * bfhi(ud.z); sm[6] = wsum[6] + us[6] - wd * bflo(ud.w); sm[7] = wsum[7] + us[7] - wd * bfhi(ud.w);
                    }
#pragma unroll
                    for (int j = 0; j < 8; ++j) wsum[j] = sm[j];
                    const float ic = 1.0f / (float)((m + 1 < win) ? (m + 1) : win);
                    v4u d; d.x = pk2(sm[0] * ic - us[0], sm[1] * ic - us[1]); d.y = pk2(sm[2] * ic - us[2], sm[3] * ic - us[3]); d.z = pk2(sm[4] * ic - us[4], sm[5] * ic - us[5]); d.w = pk2(sm[6] * ic - us[6], sm[7] * ic - us[7]);
                    *(v4u*)(CAT + (size_t)m * 1024 + 512 + hd * 128 + j0) = d;
                  }
                }
            }
            xcd_barrier(gbar);
            { pg8::Gemm g{CAT, (const bf16*)(wl + OFF_OUT), M, D, D}; pg8::StaticOrder S; S.init(M, D, G, bx);
              pg8::EpiResid E{(const pg8::EpiResid::gf32*)fresh_ptr((unsigned char*)args.out), (pg8::EpiResid::gf32*)fresh_ptr((unsigned char*)args.out), XB, rowss, 1.0f};
              pg8::gemm_phase<pg8::EpiResid, pg8::StaticOrder, PG8_ALIGN, PG8_SP2>(L, g, S, E); }
            xcd_barrier(gbar);
        }
    }
    for (int m = gw; m < M; m += NGW) { f32x4* xr = (f32x4*)(xout + (size_t)m * D) + lane; const f32x4* gr = (const f32x4*)args.in[19] + lane;
        const float r = pg8::rs_from_ss(rowss + (size_t)m * 16);
#pragma unroll
        for (int j = 0; j < 4; ++j) { const f32x4 v = xr[64 * j], gg = gr[64 * j]; xr[64 * j] = v * r * gg; } }
}

#undef wl
#undef ws
#undef rowss
#undef rope
#undef XB
#undef HB
#undef QKVU
#undef OBUF
#undef CAT
#undef xout
extern "C" void kernel_launch(void* const* d_in, const int* in_sizes, int n_in, void* d_out, int out_size, void* d_ws, size_t ws_size, hipStream_t stream) {
    static int grid_blocks = 0;
    if (grid_blocks == 0) {
        if (n_in != 20 || out_size != M * D || ws_size < WS_END) { fprintf(stderr, "kernel_launch: unexpected shapes (n_in %d out %d ws %zu, need %zu)\n", n_in, out_size, ws_size, (size_t)WS_END); grid_blocks = -1; return; }
        int dev = 0, cus = 0, per_cu = 0;
        (void)hipGetDevice(&dev); (void)hipDeviceGetAttribute(&cus, hipDeviceAttributeMultiprocessorCount, dev);
        if (hipFuncSetAttribute((const void*)hymba_fwd, hipFuncAttributeMaxDynamicSharedMemorySize, LDS_BYTES) != hipSuccess) { fprintf(stderr, "kernel_launch: hipFuncSetAttribute failed\n"); grid_blocks = -1; return; }
        if (hipOccupancyMaxActiveBlocksPerMultiprocessor(&per_cu, (const void*)hymba_fwd, NWAVES * 64, LDS_BYTES) != hipSuccess || per_cu < 1) { fprintf(stderr, "kernel_launch: occupancy query says %d\n", per_cu); per_cu = 1; }
        (void)hipGetLastError();
        grid_blocks = cus * per_cu;
    }
    if (grid_blocks < 0) return;
    if (hipMemsetAsync(d_ws, 0, 65536, stream) != hipSuccess) { fprintf(stderr, "kernel_launch: memset failed\n"); return; }
    Args a{};
    for (int i = 0; i < 20; ++i) a.in[i] = (const float*)d_in[i];
    a.out = (float*)d_out; a.wsp = (unsigned char*)d_ws;
    void* kargs[] = {&a};
    hipError_t e = hipLaunchCooperativeKernel((const void*)hymba_fwd, dim3(grid_blocks), dim3(NWAVES * 64), kargs, LDS_BYTES, stream);
    if (e != hipSuccess) fprintf(stderr, "cooperative launch failed: %s (grid %d)\n", hipGetErrorString(e), grid_blocks);
}
```

```cpp
#include <hip/hip_runtime.h>
#include <hip/hip_cooperative_groups.h>
#include <cstdio>
#include <cstdint>
namespace cg = cooperative_groups;
namespace pg8 {
#define PG8_LAS __attribute__((address_space(3)))
typedef unsigned short bf16_t;
typedef short bf16x8 __attribute__((ext_vector_type(8)));
typedef float f32x4 __attribute__((ext_vector_type(4)));
typedef unsigned u32x4 __attribute__((ext_vector_type(4)));
constexpr int BM = 256, BK = 64, HALF = 128, HTB = HALF * BK * 2  , STAGE_BYTES = 8 * HTB, NXCD = 8, WGM = 8;

__host__ __device__ __forceinline__ int lds_byte(int r, int c) { const int st = (r >> 4) * 2 + (c >> 5), rr = r & 15, cc = c & 31, ob = rr * 64 + cc * 2; return st * 1024 + (ob ^ (((ob >> 9) & 1) << 5)); }
__host__ __device__ __forceinline__ void stage_rc(int b, int& R, int& C) { const int st = b / 1024, sb = b % 1024, swz = sb ^ (((sb >> 9) & 1) << 5); R = (st >> 1) * 16 + swz / 64; C = (st & 1) * 32 + (swz % 64) / 2; }
__host__ __device__ __forceinline__ int perm32(int rho) { const int n = rho >> 4, i = rho & 15; return 8 * (i >> 2) + 4 * n + (i & 3); }

struct Unit { int pm, pn; };
struct Gemm { const bf16_t* A; const bf16_t* Bt; int M, N, K; };

struct StaticOrder {
    int nM, nN, nwg, G, c;
    __host__ __device__ void init(int M, int N, int G_, int c_) { nM = M / BM; nN = N / BM; nwg = nM * nN; G = G_; c = c_; }
    __host__ __device__ bool next(int i, Unit& u) const {
        const long L = (long)i * G + c; if (L >= nwg) return false;
        int wgid = (int)L; { const int q = nwg / NXCD, r = nwg % NXCD, xcd = wgid % NXCD, off = wgid / NXCD; wgid = (xcd < r ? xcd * (q + 1) : r * (q + 1) + (xcd - r) * q) + off; }
        const int nig = WGM * nN, gid = wgid / nig, fm = gid * WGM, gsz = (nM - fm) < WGM ? (nM - fm) : WGM;
        u.pm = fm + ((wgid % nig) % gsz); u.pn = (wgid % nig) / gsz; return true;
    }
    __device__ __forceinline__ void a_ready(const Unit&) const {}
    __device__ __forceinline__ void done(const Unit&) const {}
};

__device__ __forceinline__ unsigned cvt_pk_bf16(float lo, float hi) { unsigned r; asm volatile("v_cvt_pk_bf16_f32 %0, %1, %2" : "=v"(r) : "v"(lo), "v"(hi)); return r; }
typedef float f32x2 __attribute__((ext_vector_type(2)));
__device__ __forceinline__ f32x2 gelu_pk(f32x2 v) {
    const f32x2 av = __builtin_elementwise_abs(v), d = av * 0.2316418882f + 1.0f;
    f32x2 t; t.x = __builtin_amdgcn_rcpf(d.x); t.y = __builtin_amdgcn_rcpf(d.y);
    f32x2 q = t * 0.5307027145f + (-0.7265760135f); q = q * t + 0.7107068705f; q = q * t + (-0.142248368f); q = q * t + 0.127414796f; q = q * t;
    const f32x2 s = (v * v) * (-0.72134752044f);
    f32x2 e; e.x = __builtin_amdgcn_exp2f(s.x); e.y = __builtin_amdgcn_exp2f(s.y);
    const f32x2 m = v * (q * e), r = v - m;
    f32x2 o; o.x = v.x < 0.f ? m.x : r.x; o.y = v.y < 0.f ? m.y : r.y; return o;
}

template <int ACT  > struct EpiBf16 {
    static constexpr bool PERM = true, AFTER_DRAIN = false; static_assert(ACT == 0 || ACT == 1, "EpiBf16: ACT is 0 (none) or 1 (gelu_pk)");
    bf16_t* O; int ldc; const float* bias; int split_cols; size_t split_stride; float scale0;
    __device__ __forceinline__ void operator()(const f32x4 (&acc)[2][2][4][2], const Unit& u, int wr, int wc, int fr, int fq) const {
        const int row0 = u.pm * BM + wr * 64 + fr; int colt = u.pn * BM; bf16_t* base = O;
        float sc = 1.f; if (split_cols) { const int t = colt / split_cols; base += (size_t)t * split_stride; colt -= t * split_cols; if (t == 0) sc = scale0; }
        const int col0 = colt + wc * 32 + 8 * fq, bcol0 = u.pn * BM + wc * 32 + 8 * fq;
        f32x4 bv[2][2];
#pragma unroll
        for (int bj = 0; bj < 2; ++bj)
#pragma unroll
            for (int n = 0; n < 2; ++n) bv[bj][n] = bias ? *(const f32x4*)(bias + bcol0 + bj * HALF + 4 * n) : (f32x4){0.f, 0.f, 0.f, 0.f};
#pragma unroll
        for (int ai = 0; ai < 2; ++ai)
#pragma unroll
            for (int m = 0; m < 4; ++m) { bf16_t* rowp = base + (size_t)(row0 + ai * HALF + m * 16) * ldc + col0;
#pragma unroll
                for (int bj = 0; bj < 2; ++bj) { f32x4 v0 = acc[ai][bj][m][0] + bv[bj][0], v1 = acc[ai][bj][m][1] + bv[bj][1];
                    if (ACT == 1) { f32x2 a = gelu_pk((f32x2){v0[0], v0[1]}), b = gelu_pk((f32x2){v0[2], v0[3]}), c = gelu_pk((f32x2){v1[0], v1[1]}), d = gelu_pk((f32x2){v1[2], v1[3]});
                        v0 = (f32x4){a.x, a.y, b.x, b.y}; v1 = (f32x4){c.x, c.y, d.x, d.y}; }
                    v0 = v0 * sc; v1 = v1 * sc; u32x4 w; w.x = cvt_pk_bf16(v0[0], v0[1]); w.y = cvt_pk_bf16(v0[2], v0[3]); w.z = cvt_pk_bf16(v1[0], v1[1]); w.w = cvt_pk_bf16(v1[2], v1[3]);
                    *(u32x4*)(rowp + bj * HALF) = w; } }
    }
};
__device__ __forceinline__ float rs_from_ss(const float* p) { const f32x4 a = ((const f32x4*)p)[0], b = ((const f32x4*)p)[1], c = ((const f32x4*)p)[2], d = ((const f32x4*)p)[3];
    const float ss = (((a[0] + a[1]) + (a[2] + a[3])) + ((b[0] + b[1]) + (b[2] + b[3]))) + (((c[0] + c[1]) + (c[2] + c[3])) + ((d[0] + d[1]) + (d[2] + d[3])));
    return __builtin_amdgcn_rsqf(ss * (1.0f / 1024.0f) + 1e-6f); }
#define EPI_ROW_SCALES(rs_, rowss_, row0_) do { f32x4 q_[8]; \
    _Pragma("unroll") for (int i_ = 0; i_ < 8; ++i_) q_[i_] = *(const f32x4*)((rowss_) + (size_t)((row0_) + (i_ >> 2) * HALF + (i_ & 3) * 16) * 16 + fq * 4); \
    _Pragma("unroll") for (int i_ = 0; i_ < 8; ++i_) { float s_ = (q_[i_][0] + q_[i_][1]) + (q_[i_][2] + q_[i_][3]); s_ += __shfl_xor(s_, 16); s_ += __shfl_xor(s_, 32); \
        rs_[i_] = __builtin_amdgcn_rsqf(s_ * (1.0f / 1024.0f) + 1e-6f); } } while (0)
struct EpiGateUp {
    static constexpr bool PERM = true, AFTER_DRAIN = false;
    bf16_t* H; const float* rowss;
    __device__ __forceinline__ void operator()(const f32x4 (&acc)[2][2][4][2], const Unit& u, int wr, int wc, int fr, int fq) const {
        const int row0 = u.pm * BM + wr * 64 + fr; const int col0 = u.pn * HALF + wc * 32 + 8 * fq;
        float rs[8]; EPI_ROW_SCALES(rs, rowss, row0);
#pragma unroll
        for (int ai = 0; ai < 2; ++ai)
#pragma unroll
            for (int m = 0; m < 4; ++m) { const int row = row0 + ai * HALF + m * 16; const float r = rs[ai * 4 + m];
                float hv[8];
#pragma unroll
                for (int n = 0; n < 2; ++n)
#pragma unroll
                    for (int e = 0; e < 4; ++e) { const float g = acc[ai][0][m][n][e] * r, up = acc[ai][1][m][n][e] * r;
                        const float sg = g * __builtin_amdgcn_rcpf(1.0f + __builtin_amdgcn_exp2f(g * -1.4426950408889634f)); hv[n * 4 + e] = sg * up; }
                u32x4 w; w.x = cvt_pk_bf16(hv[0], hv[1]); w.y = cvt_pk_bf16(hv[2], hv[3]); w.z = cvt_pk_bf16(hv[4], hv[5]); w.w = cvt_pk_bf16(hv[6], hv[7]);
                *(u32x4*)(H + (size_t)row * 2816 + col0) = w; }
    }
};
struct EpiResid {
    static constexpr bool PERM = true, AFTER_DRAIN = false;
    typedef __attribute__((address_space(1))) float gf32; typedef __attribute__((address_space(1))) f32x4 gf32x4;
    const gf32* xin; gf32* xout; bf16_t* xb; float* rowss_next; float alpha;
    __device__ __forceinline__ void operator()(const f32x4 (&acc)[2][2][4][2], const Unit& u, int wr, int wc, int fr, int fq) const {
        const int row0 = u.pm * BM + wr * 64 + fr; const int col0 = u.pn * BM + wc * 32 + 8 * fq;
        f32x4 b0[8], b1[8];
#define EPR_LD(B, dst) do { _Pragma("unroll") for (int mm = 0; mm < 2; ++mm) _Pragma("unroll") for (int bj = 0; bj < 2; ++bj) { \
            const size_t off = (size_t)(row0 + ((B) >> 1) * HALF + (((B) & 1) * 2 + mm) * 16) * 1024 + col0 + bj * HALF; \
            dst[mm * 4 + bj * 2] = *(const gf32x4*)(xin + off); dst[mm * 4 + bj * 2 + 1] = *(const gf32x4*)(xin + off + 4); } } while (0)
#define EPR_ST(B, src) do { _Pragma("unroll") for (int mm = 0; mm < 2; ++mm) { const int ai = (B) >> 1, m = ((B) & 1) * 2 + mm; const int row = row0 + ai * HALF + m * 16; float ss = 0.f; \
            _Pragma("unroll") for (int bj = 0; bj < 2; ++bj) { const size_t off = (size_t)row * 1024 + col0 + bj * HALF; \
                const f32x4 v0 = src[mm * 4 + bj * 2] + acc[ai][bj][m][0] * alpha, v1 = src[mm * 4 + bj * 2 + 1] + acc[ai][bj][m][1] * alpha; \
                *(gf32x4*)(xout + off) = v0; *(gf32x4*)(xout + off + 4) = v1; \
                ss += (v0[0] * v0[0] + v0[1] * v0[1]) + (v0[2] * v0[2] + v0[3] * v0[3]) + (v1[0] * v1[0] + v1[1] * v1[1]) + (v1[2] * v1[2] + v1[3] * v1[3]); \
                u32x4 w; w.x = cvt_pk_bf16(v0[0], v0[1]); w.y = cvt_pk_bf16(v0[2], v0[3]); w.z = cvt_pk_bf16(v1[0], v1[1]); w.w = cvt_pk_bf16(v1[2], v1[3]); \
                *(u32x4*)(xb + off) = w; } \
            ss += __shfl_xor(ss, 16); ss += __shfl_xor(ss, 32); \
            if (fq == 0) rowss_next[(size_t)row * 16 + u.pn * 4 + wc] = ss; } } while (0)
        EPR_LD(0, b0); EPR_LD(1, b1); __builtin_amdgcn_sched_barrier(0);
        EPR_ST(0, b0); __builtin_amdgcn_sched_barrier(0); EPR_LD(2, b0); __builtin_amdgcn_sched_barrier(0);
        EPR_ST(1, b1); __builtin_amdgcn_sched_barrier(0); EPR_LD(3, b1); __builtin_amdgcn_sched_barrier(0);
        EPR_ST(2, b0); __builtin_amdgcn_sched_barrier(0);
        EPR_ST(3, b1);
#undef EPR_LD
#undef EPR_ST
    }
};
struct EpiQKVU {
    static constexpr bool PERM = true, AFTER_DRAIN = false;
    bf16_t* O; const float* rowss; const float* rope;
    __device__ __forceinline__ void operator()(const f32x4 (&acc)[2][2][4][2], const Unit& u, int wr, int wc, int fr, int fq) const {
        const int row0 = u.pm * BM + wr * 64 + fr; const int col0 = u.pn * BM + wc * 32 + 8 * fq; const int sec = u.pn >> 1;
        const int j0 = 16 * (wc & 1) + 4 * fq;
        float rs[8]; EPI_ROW_SCALES(rs, rowss, row0);
#pragma unroll
        for (int ai = 0; ai < 2; ++ai) {
            f32x4 cs[4][2];
#pragma unroll
            for (int m = 0; m < 4; ++m) { cs[m][0] = (f32x4){1.f, 0.f, 1.f, 0.f}; cs[m][1] = cs[m][0];
                if (sec < 2) { const f32x4* rp = (const f32x4*)(rope + ((size_t)(row0 + ai * HALF + m * 16) * 32 + j0) * 2); cs[m][0] = rp[0]; cs[m][1] = rp[1]; } }
#pragma unroll
            for (int m = 0; m < 4; ++m) { const int row = row0 + ai * HALF + m * 16; float r = rs[ai * 4 + m]; if (sec == 0) r *= 0.125f * 1.4426950408889634f;
                const f32x4 cs0 = cs[m][0], cs1 = cs[m][1];
#pragma unroll
                for (int bj = 0; bj < 2; ++bj) { const f32x4 v0 = acc[ai][bj][m][0] * r, v1 = acc[ai][bj][m][1] * r;
                    const float o0 = v0[0] * cs0[0] - v0[1] * cs0[1], o1 = v0[1] * cs0[0] + v0[0] * cs0[1];
                    const float o2 = v0[2] * cs0[2] - v0[3] * cs0[3], o3 = v0[3] * cs0[2] + v0[2] * cs0[3];
                    const float o4 = v1[0] * cs1[0] - v1[1] * cs1[1], o5 = v1[1] * cs1[0] + v1[0] * cs1[1];
                    const float o6 = v1[2] * cs1[2] - v1[3] * cs1[3], o7 = v1[3] * cs1[2] + v1[2] * cs1[3];
                    u32x4 w; w.x = cvt_pk_bf16(o0, o1); w.y = cvt_pk_bf16(o2, o3); w.z = cvt_pk_bf16(o4, o5); w.w = cvt_pk_bf16(o6, o7);
                    *(u32x4*)(O + (size_t)row * 2112 + col0 + bj * HALF) = w; } } }
    }
};

template <class Epi, class Sched, bool ALIGN_EPI = false, bool SP2 = false>
__device__ __forceinline__ void gemm_phase(PG8_LAS unsigned char* lds, const Gemm g, const Sched& S, const Epi& E) {
    int tid_ = threadIdx.x; asm volatile("" : "+v"(tid_));
    const int tid = tid_, wid = __builtin_amdgcn_readfirstlane(tid >> 6), lane = tid & 63, wr = wid >> 2, wc = wid & 3, fr = lane & 15, fq = lane >> 4;
    const int K = g.K, nt = K / BK;
    unsigned voffA[2], voffB[2];
#pragma unroll
    for (int i = 0; i < 2; ++i) { int R, C; stage_rc(tid * 16 + i * 8192, R, C); const int Rb = Epi::PERM ? ((R & ~31) + perm32(R & 31)) : R;
        voffA[i] = (unsigned)(R * K + C) * 2u; voffB[i] = (unsigned)(Rb * K + C) * 2u; }
    const size_t kstep = (size_t)(BK * 2);
    const size_t hstep = (size_t)HALF * K * 2;
    const size_t tstep = 2 * hstep;
    const unsigned ldsw = (unsigned)wid * 1024u;
    const int aoff = lds_byte(wr * 64 + fr, fq * 8), boff = lds_byte(wc * 32 + fr, fq * 8);
#define PG8_SA(b, h) (((b) * 2 + (h)) * HTB)
#define PG8_SB(b, h) ((4 + (b) * 2 + (h)) * HTB)
#define PG8_STAGE(bufoff, gbase, voff) do { _Pragma("unroll") for (int _i = 0; _i < 2; ++_i) \
        __builtin_amdgcn_global_load_lds((const unsigned*)((const char*)(gbase) + (voff)[_i]), (PG8_LAS unsigned*)(lds + (bufoff) + ldsw + _i * 8192), 16, 0, 0); } while (0)
#define PG8_LDA(dst, b, h) do { _Pragma("unroll") for (int m = 0; m < 4; ++m) _Pragma("unroll") for (int k = 0; k < 2; ++k) dst[m][k] = *(const PG8_LAS bf16x8*)(lds + PG8_SA(b, h) + aoff + m * 2048 + k * 1024); } while (0)
#define PG8_LDB(dst, b, h) do { _Pragma("unroll") for (int n = 0; n < 2; ++n) _Pragma("unroll") for (int k = 0; k < 2; ++k) dst[n][k] = *(const PG8_LAS bf16x8*)(lds + PG8_SB(b, h) + boff + n * 2048 + k * 1024); } while (0)
#define PG8_MMA(ai, bj, At, Bt) do { __builtin_amdgcn_s_setprio(1); _Pragma("unroll") for (int m = 0; m < 4; ++m) _Pragma("unroll") for (int n = 0; n < 2; ++n) _Pragma("unroll") for (int k = 0; k < 2; ++k) \
        acc[ai][bj][m][n] = __builtin_amdgcn_mfma_f32_16x16x32_bf16(Bt[n][k], At[m][k], acc[ai][bj][m][n], 0, 0, 0); __builtin_amdgcn_s_setprio(0); } while (0)
#define PG8_WAIT_V(n) asm volatile("s_waitcnt vmcnt(" #n ")" ::: "memory")
#define PG8_WAIT_L(n) asm volatile("s_waitcnt lgkmcnt(" #n ")" ::: "memory")
#define PG8_BAR __builtin_amdgcn_s_barrier()
#define PG8_SCHED __builtin_amdgcn_sched_barrier(0)
    Unit cur, nxt; int ui = 0;
    if (!S.next(0, cur)) return;
    f32x4 acc[2][2][4][2];
#pragma unroll
    for (int a = 0; a < 2; ++a)
#pragma unroll
        for (int b = 0; b < 2; ++b)
#pragma unroll
            for (int m = 0; m < 4; ++m)
#pragma unroll
                for (int n = 0; n < 2; ++n) acc[a][b][m][n] = (f32x4){0.f, 0.f, 0.f, 0.f};
    bf16x8 At[4][2], B0[2][2], B1[2][2];
    const char* cA = (const char*)g.A + (size_t)cur.pm * tstep; const char* cB = (const char*)g.Bt + (size_t)cur.pn * tstep;
    S.a_ready(cur);
    if constexpr (SP2) {
        PG8_STAGE(PG8_SB(0, 0), cB, voffB); PG8_STAGE(PG8_SB(0, 1), cB + hstep, voffB); PG8_STAGE(PG8_SA(0, 0), cA, voffA); PG8_STAGE(PG8_SA(0, 1), cA + hstep, voffA);
        if (wr == 1) PG8_BAR;
        PG8_WAIT_V(2); PG8_BAR;
        PG8_STAGE(PG8_SB(1, 0), cB + kstep, voffB); PG8_STAGE(PG8_SA(1, 0), cA + kstep, voffA); PG8_STAGE(PG8_SB(1, 1), cB + hstep + kstep, voffB);
        PG8_WAIT_V(6); PG8_BAR;
    } else {
        PG8_STAGE(PG8_SB(0, 0), cB, voffB); PG8_STAGE(PG8_SA(0, 0), cA, voffA); PG8_STAGE(PG8_SB(0, 1), cB + hstep, voffB); PG8_STAGE(PG8_SA(0, 1), cA + hstep, voffA);
        if (wr == 1) PG8_BAR;
        PG8_WAIT_V(4); PG8_BAR;
        PG8_STAGE(PG8_SB(1, 0), cB + kstep, voffB); PG8_STAGE(PG8_SA(1, 0), cA + kstep, voffA); PG8_STAGE(PG8_SB(1, 1), cB + hstep + kstep, voffB);
        PG8_WAIT_V(6); PG8_BAR;
    }
    for (;;) {
        const bool has_next = S.next(ui + 1, nxt);
        const char* nA = has_next ? (const char*)g.A + (size_t)nxt.pm * tstep : cA; const char* nB = has_next ? (const char*)g.Bt + (size_t)nxt.pn * tstep : cB;
        for (int t = 0; t < nt; t += 2) {
            const bool last = (t == nt - 2);
            const char* a1 = cA + (size_t)(t + 1) * kstep;
            const char* a2 = last ? nA : cA + (size_t)(t + 2) * kstep; const char* b2 = last ? nB : cB + (size_t)(t + 2) * kstep;
            const char* a3 = a2 + kstep; const char* b3 = b2 + kstep;
            if (last && has_next) S.a_ready(nxt);
            if constexpr (SP2) {
            PG8_LDB(B0, 0, 0); PG8_LDB(B1, 0, 1); PG8_SCHED; PG8_LDA(At, 0, 0); PG8_STAGE(PG8_SA(1, 1), a1 + hstep, voffA);
            PG8_WAIT_V(8); PG8_WAIT_L(0); PG8_BAR; PG8_MMA(0, 0, At, B0); PG8_MMA(0, 1, At, B1); PG8_BAR; PG8_SCHED;
            PG8_LDA(At, 0, 1); PG8_STAGE(PG8_SB(0, 0), b2, voffB); PG8_STAGE(PG8_SB(0, 1), b2 + hstep, voffB); PG8_STAGE(PG8_SA(0, 0), a2, voffA);
            PG8_WAIT_V(8); PG8_WAIT_L(0); PG8_BAR; PG8_MMA(1, 0, At, B0); PG8_MMA(1, 1, At, B1); PG8_BAR; PG8_SCHED;
            PG8_LDB(B0, 1, 0); PG8_LDB(B1, 1, 1); PG8_SCHED; PG8_LDA(At, 1, 0); PG8_STAGE(PG8_SA(0, 1), a2 + hstep, voffA);
            PG8_WAIT_V(8); PG8_WAIT_L(0); PG8_BAR; PG8_MMA(0, 0, At, B0); PG8_MMA(0, 1, At, B1); PG8_BAR; PG8_SCHED;
            PG8_LDA(At, 1, 1); PG8_STAGE(PG8_SB(1, 0), b3, voffB); PG8_STAGE(PG8_SB(1, 1), b3 + hstep, voffB); PG8_STAGE(PG8_SA(1, 0), a3, voffA);
            PG8_WAIT_V(8); PG8_WAIT_L(0); PG8_BAR; PG8_MMA(1, 0, At, B0); PG8_MMA(1, 1, At, B1); PG8_BAR; PG8_SCHED;
            } else {
            PG8_LDB(B0, 0, 0); PG8_SCHED; PG8_LDA(At, 0, 0); PG8_STAGE(PG8_SA(1, 1), a1 + hstep, voffA);
            PG8_WAIT_L(8); PG8_BAR; PG8_WAIT_L(0); PG8_MMA(0, 0, At, B0); PG8_BAR; PG8_SCHED;
            PG8_LDB(B1, 0, 1); PG8_STAGE(PG8_SB(0, 0), b2, voffB);
            PG8_BAR; PG8_WAIT_L(0); PG8_MMA(0, 1, At, B1); PG8_BAR;
            PG8_LDA(At, 0, 1); PG8_STAGE(PG8_SA(0, 0), a2, voffA);
            PG8_BAR; PG8_WAIT_L(0); PG8_MMA(1, 0, At, B0); PG8_BAR; PG8_SCHED;
            PG8_STAGE(PG8_SB(0, 1), b2 + hstep, voffB);
            PG8_WAIT_V(6); PG8_BAR; PG8_MMA(1, 1, At, B1); PG8_BAR;
            PG8_LDB(B0, 1, 0); PG8_SCHED; PG8_LDA(At, 1, 0); PG8_STAGE(PG8_SA(0, 1), a2 + hstep, voffA);
            PG8_WAIT_L(8); PG8_BAR; PG8_WAIT_L(0); PG8_MMA(0, 0, At, B0); PG8_BAR; PG8_SCHED;
            PG8_LDB(B1, 1, 1); PG8_STAGE(PG8_SB(1, 0), b3, voffB);
            PG8_BAR; PG8_WAIT_L(0); PG8_MMA(0, 1, At, B1); PG8_BAR;
            PG8_LDA(At, 1, 1); PG8_STAGE(PG8_SA(1, 0), a3, voffA);
            PG8_BAR; PG8_WAIT_L(0); PG8_MMA(1, 0, At, B0); PG8_BAR; PG8_SCHED;
            PG8_STAGE(PG8_SB(1, 1), b3 + hstep, voffB);
            PG8_WAIT_V(6); PG8_BAR; PG8_MMA(1, 1, At, B1); PG8_BAR;
            }
        }
        if constexpr (ALIGN_EPI) { if (wr == 0) PG8_BAR; }
        if constexpr (!Epi::AFTER_DRAIN) { E(acc, cur, wr, wc, fr, fq); S.done(cur); }
        if (!has_next) break;
#pragma unroll
        for (int a = 0; a < 2; ++a)
#pragma unroll
            for (int b = 0; b < 2; ++b)
#pragma unroll
                for (int m = 0; m < 4; ++m)
#pragma unroll
                    for (int n = 0; n < 2; ++n) acc[a][b][m][n] = (f32x4){0.f, 0.f, 0.f, 0.f};
        cur = nxt; cA = nA; cB = nB; ++ui;
        if constexpr (ALIGN_EPI) { if (wr == 1) PG8_BAR; }
    }
    PG8_WAIT_V(0);
    if constexpr (!ALIGN_EPI) { if (wr == 0) PG8_BAR; }
    PG8_BAR;
    if constexpr (Epi::AFTER_DRAIN) { E.fused(acc, cur, wr, wc, fr, fq, lds, wid, lane); S.done(cur); }
#undef PG8_SA
#undef PG8_SB
#undef PG8_STAGE
#undef PG8_LDA
#undef PG8_LDB
#undef PG8_MMA
#undef PG8_WAIT_V
#undef PG8_WAIT_L
#undef PG8_BAR
#undef PG8_SCHED
}
}

#ifndef PG8_SP2
#define PG8_SP2 true
#endif
#ifndef PG8_ALIGN
#define PG8_ALIGN true
#endif
#include <hip/hip_bf16.h>
#include <cmath>
namespace attn_body {
using bf16=__hip_bfloat16;
using bf16x8=__attribute__((ext_vector_type(8)))short;
using s16x4=__attribute__((ext_vector_type(4)))short;
using f32x16=__attribute__((ext_vector_type(16)))float;
using u32x4=__attribute__((ext_vector_type(4)))unsigned;
constexpr int BATCH=1,NHEAD=16,SEQ=16384,D=64,DM=2112,DMO=1024;
constexpr int NW=8,QBLK=32,QB=QBLK*NW,KVBLK=64,NQB=SEQ/QB;
constexpr int ATTN_PITCH=DM, ATTN_UNIT_ROWS=QB;
__device__ __forceinline__ int crow(int r,int hi){return (r&3)+8*(r>>2)+4*hi;}
#define SBAR() __builtin_amdgcn_sched_barrier(0)
__device__ __forceinline__ void cmask(f32x16&p0,f32x16&p1,int jb,int qrel,int hi){
  const float NEG=-INFINITY; int kb=64*jb+4*hi;
  #pragma unroll
  for(int r=0;r<16;++r){int kv=kb+(r&3)+8*(r>>2); if(kv>qrel)p0[r]=NEG; if(kv+32>qrel)p1[r]=NEG;}
}

constexpr int NSLOT=3, SLOTB=8192;
constexpr int NVSLOT=3, VSLOTB=16384;
constexpr int LDS_K=0, LDS_V=NSLOT*SLOTB, LDS_P=LDS_V+NVSLOT*VSLOTB, LDS_WS=LDS_P+NW*8192, WSF_STRIDE=64, LDS_BYTES=LDS_WS+NW*WSF_STRIDE*4;
constexpr float C2=0.125f*1.4426950408889634f;
__device__ __forceinline__ void glds16(const void*gsrc,unsigned lds_dst){unsigned keep;
  asm volatile("s_mov_b32 %0, m0\n\ts_mov_b32 m0, %2\n\ts_nop 0\n\tglobal_load_lds_dwordx4 %1, off\n\ts_mov_b32 m0, %0":"=&s"(keep):"v"(gsrc),"s"(lds_dst):"memory");}
__device__ __forceinline__ float max3f(float a,float b,float c){float r;asm("v_max3_f32 %0, %1, %2, %3":"=v"(r):"v"(a),"v"(b),"v"(c));return r;}
__device__ __forceinline__ float max2f(float a,float b){float r;asm("v_max_f32_e32 %0, %1, %2":"=v"(r):"v"(a),"v"(b));return r;}
__device__ __forceinline__ float fadd_s(float a,float b){float r;asm("v_add_f32_e32 %0, %1, %2":"=v"(r):"v"(a),"v"(b));return r;}
__device__ __forceinline__ float fsub_s(float a,float b){float r;asm("v_sub_f32_e32 %0, %1, %2":"=v"(r):"v"(a),"v"(b));return r;}
typedef float f32x2_t __attribute__((ext_vector_type(2))); typedef __bf16 bf16x2_t __attribute__((ext_vector_type(2)));
__device__ __forceinline__ unsigned cvtpk_s(float lo,float hi){f32x2_t v={lo,hi};bf16x2_t b=__builtin_convertvector(v,bf16x2_t);return __builtin_bit_cast(unsigned,b);}
#define WAIT_BAR(N) asm volatile("s_waitcnt vmcnt(" #N ") lgkmcnt(0)\n\ts_barrier":::"memory")

__device__ __forceinline__ void qkt(f32x16&p0,f32x16&p1,const char*Kslot,const bf16x8*qr,const f32x16&negm,int r32,int hi){
  const char*kb=Kslot+hi*1024+r32*16;
  #pragma unroll
  for(int d0=0;d0<4;++d0){
    const bf16x8 b0=*reinterpret_cast<const bf16x8*>(kb+d0*2048);
    const bf16x8 b1=*reinterpret_cast<const bf16x8*>(kb+d0*2048+512);
    if(d0==0){p0=__builtin_amdgcn_mfma_f32_32x32x16_bf16(b0,qr[0],negm,0,0,0);p1=__builtin_amdgcn_mfma_f32_32x32x16_bf16(b1,qr[0],negm,0,0,0);}
    else{p0=__builtin_amdgcn_mfma_f32_32x32x16_bf16(b0,qr[d0],p0,0,0,0);p1=__builtin_amdgcn_mfma_f32_32x32x16_bf16(b1,qr[d0],p1,0,0,0);}}
}
typedef __attribute__((address_space(3))) const char* lds_cptr;
typedef short v4i16_t __attribute__((ext_vector_type(4)));
__device__ __forceinline__ void kload8(bf16x8*kf,lds_cptr kp){
  kf[0]=*(const __attribute__((address_space(3))) bf16x8*)(kp);      kf[1]=*(const __attribute__((address_space(3))) bf16x8*)(kp+512);
  kf[2]=*(const __attribute__((address_space(3))) bf16x8*)(kp+2048); kf[3]=*(const __attribute__((address_space(3))) bf16x8*)(kp+2560);
  kf[4]=*(const __attribute__((address_space(3))) bf16x8*)(kp+4096); kf[5]=*(const __attribute__((address_space(3))) bf16x8*)(kp+4608);
  kf[6]=*(const __attribute__((address_space(3))) bf16x8*)(kp+6144); kf[7]=*(const __attribute__((address_space(3))) bf16x8*)(kp+6656);
}
__device__ __forceinline__ void kload2(bf16x8*kf,lds_cptr kp,int j){ kf[2*j]=*(const __attribute__((address_space(3))) bf16x8*)(kp+j*2048); kf[2*j+1]=*(const __attribute__((address_space(3))) bf16x8*)(kp+j*2048+512); }
__device__ __forceinline__ s16x4 vtr(lds_cptr p){ return __builtin_bit_cast(s16x4,__builtin_amdgcn_ds_read_tr16_b64_v4i16((__attribute__((address_space(3))) v4i16_t*)p)); }
__device__ __forceinline__ float rowmax(const f32x16&p0,const f32x16&p1){
  float a=max3f(p0[0],p0[1],p1[0]),b=max3f(p0[2],p0[3],p1[1]);a=max3f(a,p1[2],p1[3]);
  #pragma unroll
  for(int r=4;r<16;r+=4){a=max3f(a,p0[r],p0[r+1]);b=max3f(b,p0[r+2],p0[r+3]);a=max3f(a,p1[r],p1[r+1]);b=max3f(b,p1[r+2],p1[r+3]);}
  const float m=max2f(a,b);
  auto rr=__builtin_amdgcn_permlane32_swap(__float_as_uint(m),__float_as_uint(m),false,false);
  return max2f(__uint_as_float(rr[0]),__uint_as_float(rr[1]));
}
__device__ __forceinline__ void pv(f32x16*o,int vb,bf16x8 pa0,bf16x8 pa1,bf16x8 pa2,bf16x8 pa3){
  #pragma unroll
  for(int d0=0;d0<2;++d0){s16x4 lo[4],hi[4];
    #pragma unroll
    for(int ks=0;ks<4;++ks){
      asm volatile("ds_read_b64_tr_b16 %0,%1 offset:%c2":"=&v"(lo[ks]):"v"(vb),"i"(d0*4096+ks*1024):"memory");
      asm volatile("ds_read_b64_tr_b16 %0,%1 offset:%c2":"=&v"(hi[ks]):"v"(vb),"i"(d0*4096+ks*1024+512):"memory");}
    asm volatile("s_waitcnt lgkmcnt(0)":::"memory");SBAR();
    #define PK(k) (bf16x8){lo[k][0],lo[k][1],lo[k][2],lo[k][3],hi[k][0],hi[k][1],hi[k][2],hi[k][3]}
    o[d0]=__builtin_amdgcn_mfma_f32_32x32x16_bf16(pa0,PK(0),o[d0],0,0,0);
    o[d0]=__builtin_amdgcn_mfma_f32_32x32x16_bf16(pa1,PK(1),o[d0],0,0,0);
    o[d0]=__builtin_amdgcn_mfma_f32_32x32x16_bf16(pa2,PK(2),o[d0],0,0,0);
    o[d0]=__builtin_amdgcn_mfma_f32_32x32x16_bf16(pa3,PK(3),o[d0],0,0,0);
    #undef PK
  }
}

#ifndef ATTN_STORE16
#define ATTN_STORE16(p,v) (*(u32x4*)(p)=(v))
#endif
template<int THRL> __device__ __forceinline__ void attn_unit(int qb,const bf16*Q,const bf16*__restrict__ K,const bf16*__restrict__ V,bf16*O,char*shm){
  int tid_=threadIdx.x; asm volatile("":"+v"(tid_)); const int tid=tid_,lane=tid&63,r32=lane&31,hi=lane>>5; const int wid=__builtin_amdgcn_readfirstlane(tid>>6);
  const int q0=qb*QB;
  const unsigned lds0=(unsigned)(uintptr_t)shm;
  float*wsf=(float*)(shm+LDS_WS)+wid*WSF_STRIDE;
  const bf16*ksrc=K+(long)lane*DM+wid*8;
  const bf16*vsrc=V+(long)(16*(wid&3)+(lane>>2))*DM+(wid>>2)*32+(lane&3)*8;
  const unsigned kdst=lds0+LDS_K+wid*1024, vdst=lds0+LDS_V+wid*1024;
  #define DMA_K(t,s3) glds16(ksrc+(long)(t)*KVBLK*DM,(unsigned)__builtin_amdgcn_readfirstlane(kdst+(s3)*SLOTB))
  #define DMA_V(t,s3) do{ const unsigned vd_=(unsigned)__builtin_amdgcn_readfirstlane(vdst+(s3)*VSLOTB); glds16(vsrc+(long)(t)*KVBLK*DM,vd_); glds16(vsrc+(long)(t)*KVBLK*DM+64,(unsigned)__builtin_amdgcn_readfirstlane(vd_+8192)); }while(0)
  const lds_cptr shm3=(lds_cptr)shm;
  const int NT=(q0+QB)/KVBLK;
  DMA_K(0,0);DMA_V(0,0);DMA_K(1,1);DMA_V(1,1);
  int c0=0,c1=1,c2=2;
  #define ROT3() do{ const int x_=c0; c0=c1; c1=c2; c2=x_; }while(0)
  #define PKW(P,B) cvtpk_s(P[B],P[B+1])
  #define MX3(a,b,c) __builtin_fmaxf(__builtin_fmaxf((a),(b)),(c))
  const bf16*Qw=Q+(long)(q0+wid*QBLK)*DM;
  bf16x8 qr[4];
  #pragma unroll
  for(int d0=0;d0<4;++d0)qr[d0]=*reinterpret_cast<const bf16x8*>(&Qw[(long)r32*DM+d0*16+hi*8]);
  float mhat=0.f,l_reg=0.f; f32x16 negm=f32x16{};
  f32x16 o[4]; o[0]=f32x16{};o[1]=f32x16{};o[2]=f32x16{};o[3]=f32x16{};
  const int qrel=wid*QBLK+r32;
  const lds_cptr kp0=shm3+LDS_K+hi*1024+r32*16;
  const lds_cptr vp0=shm3+LDS_V+((lane>>4)&1)*32+(lane&3)*8+(4*hi+((lane&15)>>2))*64;
  WAIT_BAR(3);
  for(int t=0;t<NT;++t){
    if(t+2<NT){DMA_K(t+2,c2);DMA_V(t+2,c2);}
    bf16x8 kf[8]; kload8(kf,kp0+c0*SLOTB);
    SBAR();
    f32x16 C0,C1;
    {
      C0=__builtin_amdgcn_mfma_f32_32x32x16_bf16(kf[0],qr[0],negm,0,0,0); C1=__builtin_amdgcn_mfma_f32_32x32x16_bf16(kf[1],qr[0],negm,0,0,0);
      C0=__builtin_amdgcn_mfma_f32_32x32x16_bf16(kf[2],qr[1],C0,0,0,0);   C1=__builtin_amdgcn_mfma_f32_32x32x16_bf16(kf[3],qr[1],C1,0,0,0);
      C0=__builtin_amdgcn_mfma_f32_32x32x16_bf16(kf[4],qr[2],C0,0,0,0);   C1=__builtin_amdgcn_mfma_f32_32x32x16_bf16(kf[5],qr[2],C1,0,0,0);
      C0=__builtin_amdgcn_mfma_f32_32x32x16_bf16(kf[6],qr[3],C0,0,0,0);   C1=__builtin_amdgcn_mfma_f32_32x32x16_bf16(kf[7],qr[3],C1,0,0,0); }
    SBAR();
    const lds_cptr vp_=vp0+c0*VSLOTB; s16x4 vl_[8],vh_[8];
    #pragma unroll
    for(int k2=0;k2<2;++k2)
      #pragma unroll
      for(int d_=0;d_<4;++d_){ vl_[d_*2+k2]=vtr(vp_+(d_*4096+k2*1024)); vh_[d_*2+k2]=vtr(vp_+(d_*4096+k2*1024+512)); }
    SBAR();
    { const int jb_=t-(NT-4); if(jb_>=0)cmask(C0,C1,jb_,qrel,hi); }
    float a=MX3(C0[0],C0[1],C1[0]),b=MX3(C0[2],C0[3],C1[1]); a=MX3(a,C1[2],C1[3]);
    #pragma unroll
    for(int r=4;r<16;r+=4){a=MX3(a,C0[r],C0[r+1]);b=MX3(b,C0[r+2],C0[r+3]);a=MX3(a,C1[r],C1[r+1]);b=MX3(b,C1[r+2],C1[r+3]);}
    float rm=__builtin_fmaxf(a,b); { auto rr=__builtin_amdgcn_permlane32_swap(__float_as_uint(rm),__float_as_uint(rm),false,false); rm=__builtin_fmaxf(__uint_as_float(rr[0]),__uint_as_float(rr[1])); }
    if(t==0 || __any(rm>(float)THRL)){
      const float dl=(t==0)?rm:__builtin_fmaxf(rm,0.f); mhat+=dl;
      #pragma unroll
      for(int r=0;r<16;++r){C0[r]-=dl;C1[r]-=dl;}
      #pragma unroll
      for(int r=0;r<16;++r)negm[r]=-mhat;
      if(t!=0){ const float f=__builtin_amdgcn_exp2f(-dl); l_reg*=f; if(hi==0)wsf[r32]=f; asm volatile("s_waitcnt lgkmcnt(0)":::"memory");
        #pragma unroll
        for(int d_=0;d_<4;++d_)
          #pragma unroll
          for(int r=0;r<16;++r)o[d_][r]*=wsf[crow(r,hi)]; } }
    #pragma unroll
    for(int r=0;r<16;++r){C0[r]=__builtin_amdgcn_exp2f(C0[r]);C1[r]=__builtin_amdgcn_exp2f(C1[r]);}
    { float s0=C0[0]+C0[1],s1=C1[0]+C1[1];
      #pragma unroll
      for(int r=2;r<16;++r){s0+=C0[r];s1+=C1[r];}
      l_reg+=s0+s1; }
    const u32x4 pw0=(u32x4){PKW(C0,0),PKW(C0,2),PKW(C0,4),PKW(C0,6)},pw1=(u32x4){PKW(C0,8),PKW(C0,10),PKW(C0,12),PKW(C0,14)},pw2=(u32x4){PKW(C1,0),PKW(C1,2),PKW(C1,4),PKW(C1,6)},pw3=(u32x4){PKW(C1,8),PKW(C1,10),PKW(C1,12),PKW(C1,14)};
    SBAR();
    #define VFRAG(L_,H_,i_) (bf16x8){L_[i_][0],L_[i_][1],L_[i_][2],L_[i_][3],H_[i_][0],H_[i_][1],H_[i_][2],H_[i_][3]}
    s16x4 w2l_[4],w2h_[4],w3l_[4],w3h_[4];
    #pragma unroll
    for(int d_=0;d_<4;++d_){ w2l_[d_]=vtr(vp_+(d_*4096+2*1024)); w2h_[d_]=vtr(vp_+(d_*4096+2*1024+512)); }
    SBAR();
    #pragma unroll
    for(int d_=0;d_<4;++d_){ o[d_]=__builtin_amdgcn_mfma_f32_32x32x16_bf16(__builtin_bit_cast(bf16x8,pw0),VFRAG(vl_,vh_,d_*2),o[d_],0,0,0); }
    SBAR();
    #pragma unroll
    for(int d_=0;d_<4;++d_){ w3l_[d_]=vtr(vp_+(d_*4096+3*1024)); w3h_[d_]=vtr(vp_+(d_*4096+3*1024+512)); }
    SBAR();
    #pragma unroll
    for(int d_=0;d_<4;++d_){ o[d_]=__builtin_amdgcn_mfma_f32_32x32x16_bf16(__builtin_bit_cast(bf16x8,pw1),VFRAG(vl_,vh_,d_*2+1),o[d_],0,0,0); }
    #pragma unroll
    for(int d_=0;d_<4;++d_){ o[d_]=__builtin_amdgcn_mfma_f32_32x32x16_bf16(__builtin_bit_cast(bf16x8,pw2),VFRAG(w2l_,w2h_,d_),o[d_],0,0,0); }
    #pragma unroll
    for(int d_=0;d_<4;++d_){ o[d_]=__builtin_amdgcn_mfma_f32_32x32x16_bf16(__builtin_bit_cast(bf16x8,pw3),VFRAG(w3l_,w3h_,d_),o[d_],0,0,0); }
    SBAR();
    #undef VFRAG
    if(t+2<NT){WAIT_BAR(3);}else{WAIT_BAR(0);}
    ROT3();
  }
  { auto rr=__builtin_amdgcn_permlane32_swap(__float_as_uint(l_reg),__float_as_uint(l_reg),false,false); l_reg=__uint_as_float(rr[0])+__uint_as_float(rr[1]); }
  if(hi==0)wsf[32+r32]=l_reg; asm volatile("s_waitcnt lgkmcnt(0)":::"memory");
  bf16*Ow=O+(long)(q0+wid*QBLK)*DMO;
  { bf16*stg=(bf16*)(shm+LDS_P)+wid*4096;
    #pragma unroll
    for(int r=0;r<16;++r){const int orow=crow(r,hi); const float rl=__builtin_amdgcn_rcpf(wsf[32+orow]);
      #pragma unroll
      for(int d0=0;d0<4;++d0)stg[orow*128+d0*32+r32]=__float2bfloat16(o[d0][r]*rl);}
    asm volatile("s_waitcnt lgkmcnt(0)":::"memory");
    #pragma unroll
    for(int i=0;i<8;++i){const int row=i*4+(lane>>4),ch=lane&15; const u32x4 v=*(const u32x4*)(stg+row*128+ch*8); ATTN_STORE16(Ow+(long)row*DMO+ch*8,v);} }
  asm volatile("s_waitcnt lgkmcnt(0)\n\ts_barrier":::"memory");
  #undef DMA_K
  #undef DMA_V
  #undef ROT3
  #undef PKW
  #undef MX3
}
constexpr int ATTN_LDS_BYTES=LDS_BYTES;
struct AttnTensors { const bf16* Q; const bf16* K; const bf16* V; bf16* O; };
struct AttnUnit { int hc; int qb; };
struct StaticOrder {
  int vcu, G, bx;
  __device__ __forceinline__ StaticOrder(int grid,int block):vcu((grid%8==0)?(block%8)*(grid/8)+block/8:block),G(grid),bx(block){}
  __device__ __forceinline__ bool next(int i,AttnUnit&u)const{
    if(G==256){ if(i>=2)return false; const int s=vcu&31; u.hc=vcu>>5; u.qb=(i==0)?63-s:s; return true; }
    const int idx=i*G+bx; if(idx>=8*NQB)return false; u.hc=idx&7; u.qb=NQB-1-(idx>>3); return true; }
};
template<class Sched,int THRL=8> __device__ __forceinline__ void attn_phase(char*lds,const AttnTensors&T,const Sched&S){
  AttnUnit u;
  for(int i=0;S.next(i,u);++i){ const int h=u.hc>>1,c=u.hc&1;
    attn_unit<THRL>(u.qb,T.Q+h*128+c*64,T.K+h*128+c*64,T.V+h*128,T.O+u.hc*128,lds); }
}
#undef SBAR
#undef WAIT_BAR
}
constexpr int NWAVES = 8;
constexpr int M = 16384, D = 1024, FF = 2816, NGU = 2 * FF, NIN = 2048, DEPTH = 4;
constexpr size_t MiB = 1u << 20;
constexpr size_t WS_ROWSS = 1 * MiB;
constexpr size_t WS_ROPE = 2 * MiB;
constexpr size_t WS_XB = 8 * MiB;
constexpr size_t WS_H = 40 * MiB;
constexpr size_t WS_QKVU = 40 * MiB;
constexpr size_t WS_OBUF = 108 * MiB;
constexpr size_t WS_CAT = 140 * MiB;
constexpr size_t WS_W = 172 * MiB;
constexpr size_t OFF_GU1 = 0, OFF_DN1 = 11 * MiB, OFF_IN = 16 * MiB + 512 * 1024, OFF_OUT = 20 * MiB + 512 * 1024, OFF_GU2 = 22 * MiB + 512 * 1024, OFF_DN2 = 33 * MiB + 512 * 1024, W_LAYER = 39 * MiB;
constexpr size_t WS_END = WS_W + DEPTH * W_LAYER;
static_assert(attn_body::ATTN_LDS_BYTES <= 147392 && (size_t)NGU * D * 2 == 11 * MiB && (size_t)D * FF * 2 == 5 * MiB + 512 * 1024 && WS_H + (size_t)M * FF * 2 <= WS_CAT && WS_ROWSS + 16 * (size_t)M * 4 <= WS_ROPE && WS_ROPE + (size_t)M * 64 * 4 <= WS_XB, "ws map");
constexpr int LDS_BYTES = 147456;

#define LAS __attribute__((address_space(3)))
typedef unsigned short bf16;
typedef unsigned v4u __attribute__((ext_vector_type(4)));
typedef unsigned v2u __attribute__((ext_vector_type(2)));
typedef float f32x4 __attribute__((ext_vector_type(4)));
#define LDS_WAIT() asm volatile("s_waitcnt lgkmcnt(0)" ::: "memory")
__device__ __forceinline__ unsigned f2bf(float f) { unsigned u = __builtin_bit_cast(unsigned, f); return (u + 0x7fffu + ((u >> 16) & 1u)) >> 16; }
__device__ __forceinline__ unsigned pk2(float lo, float hi) { return f2bf(lo) | (f2bf(hi) << 16); }
__device__ __forceinline__ float bflo(unsigned w) { return __builtin_bit_cast(float, w << 16); }
__device__ __forceinline__ float bfhi(unsigned w) { return __builtin_bit_cast(float, w & 0xffff0000u); }
__device__ __forceinline__ float wave_sum(float v) {
#pragma unroll
    for (int o = 1; o < 64; o <<= 1) v += __shfl_xor(v, o);
    return v;
}
struct TrDesc { const float* W; const float* gk; bf16* WT; int N, k0, n0, Kd, rbase, rstride; };
__device__ __forceinline__ void tr_load(const TrDesc& d, int lane, f32x4 (&v)[8]) {
    const int kblk = lane & 7, n4 = lane >> 3;
    const float* src = d.W + (size_t)(d.k0 + 8 * kblk) * d.N + d.n0 + 4 * n4;
#pragma unroll
    for (int i = 0; i < 8; ++i) v[i] = __builtin_nontemporal_load((const f32x4*)(src + (size_t)i * d.N));
}
__device__ __forceinline__ void tr_store(const TrDesc& d, int lane, f32x4 (&v)[8]) {
    const int kblk = lane & 7, n4 = lane >> 3;
    if (d.gk) { const f32x4 g0 = *(const f32x4*)(d.gk + d.k0 + 8 * kblk), g1 = *(const f32x4*)(d.gk + d.k0 + 8 * kblk + 4);
#pragma unroll
        for (int i = 0; i < 4; ++i) { v[i] = v[i] * g0[i]; v[4 + i] = v[4 + i] * g1[i]; } }
#pragma unroll
    for (int e = 0; e < 4; ++e) { v4u o; o.x = pk2(v[0][e], v[1][e]); o.y = pk2(v[2][e], v[3][e]); o.z = pk2(v[4][e], v[5][e]); o.w = pk2(v[6][e], v[7][e]);
        *(v4u*)(d.WT + (size_t)(d.rbase + (4 * n4 + e) * d.rstride) * d.Kd + d.k0 + 8 * kblk) = o; }
}

#define XB_TMO      128
#define XB_XCNT(j)  (256  + 64 * (j))
#define XB_XSUB(j)  (1280 + 64 * (j))
#define XB_XGEN(j)  (2304 + 64 * (j))
#define XB_TOP      3328
#define XB_TOPGEN   3392
#define XCD_BAR_WORDS 3456
#define XB_SPIN_CAP (1u << 18)

__device__ __forceinline__ unsigned xb_ld(unsigned* p)              { return __hip_atomic_load(p, __ATOMIC_RELAXED, __HIP_MEMORY_SCOPE_AGENT); }
__device__ __forceinline__ unsigned xb_add(unsigned* p, unsigned v) { return __hip_atomic_fetch_add(p, v, __ATOMIC_RELAXED, __HIP_MEMORY_SCOPE_AGENT); }
__device__ __forceinline__ unsigned xb_xcc_id() { return (unsigned)__builtin_amdgcn_s_getreg((3 << 11) | 20) & 0xFu; }
#define XB_SPIN(cond, bar) do { unsigned _sp = 0; while (cond) { __builtin_amdgcn_s_sleep(1); \
    if ((++_sp & 255u) == 0u) { if (xb_ld(&(bar)[XB_TMO])) break; if (_sp > XB_SPIN_CAP) { atomicAdd(&(bar)[XB_TMO], 1u); break; } } } } while (0)

struct XcdBarrier {
    unsigned* bar; unsigned x;
    volatile LAS unsigned* st;
};

__device__ __forceinline__ XcdBarrier xcd_barrier_post(unsigned* bar, volatile LAS unsigned* st) {
    XcdBarrier b; b.bar = bar; b.x = xb_xcc_id(); b.st = st;
    if (threadIdx.x == 0) (void)xb_add(&bar[XB_XCNT(b.x)], 1u);
    return b;
}
__device__ __forceinline__ void xcd_barrier_complete(unsigned* bar, unsigned x, unsigned& nloc, unsigned& nx) {
    const unsigned G = gridDim.x * gridDim.y * gridDim.z;
    unsigned sum, cnt, mine, sp = 0u;
    for (;;) {
        sum = 0u; cnt = 0u; mine = 0u;
#pragma unroll
        for (unsigned j = 0; j < 16; ++j) { const unsigned c = xb_ld(&bar[XB_XCNT(j)]); sum += c; cnt += (c > 0u) ? 1u : 0u; mine = (j == x) ? c : mine; }
        if (sum == G) break;
        __builtin_amdgcn_s_sleep(1);
        if ((++sp & 255u) == 0u) { if (xb_ld(&bar[XB_TMO])) break; if (sp > XB_SPIN_CAP) { atomicAdd(&bar[XB_TMO], 1u); break; } }
    }
    nloc = mine > 0u ? mine : 1u; nx = cnt > 0u ? cnt : 1u;
}

__device__ __forceinline__ void xcd_barrier(const XcdBarrier& b) {
    asm volatile("s_waitcnt vmcnt(0)" ::: "memory");
    __syncthreads();
    if (threadIdx.x == 0) {
        unsigned* bar = b.bar;
        __builtin_amdgcn_s_waitcnt(0);
        unsigned nloc = b.st[0], nx = b.st[1];
        if (nloc == 0u) { xcd_barrier_complete(bar, b.x, nloc, nx); b.st[0] = nloc; b.st[1] = nx; }
        const unsigned old = xb_add(&bar[XB_XSUB(b.x)], 1u);
        const unsigned gen = old / nloc;
        if (old + 1u == (gen + 1u) * nloc) {
            __builtin_amdgcn_fence(__ATOMIC_RELEASE, "agent");
            asm volatile("s_waitcnt vmcnt(0)" ::: "memory");
            const unsigned og = xb_add(&bar[XB_TOP], 1u);
            const unsigned tg = og / nx;
            if (og + 1u == (tg + 1u) * nx) xb_add(&bar[XB_TOPGEN], 1u);
            else XB_SPIN(xb_ld(&bar[XB_TOPGEN]) == tg, bar);
            __builtin_amdgcn_fence(__ATOMIC_ACQUIRE, "agent");
            xb_add(&bar[XB_XGEN(b.x)], 1u);
            asm volatile("s_waitcnt vmcnt(0)" ::: "memory");
        } else {
            XB_SPIN(xb_ld(&bar[XB_XGEN(b.x)]) == gen, bar);
            __builtin_amdgcn_fence(__ATOMIC_ACQUIRE, "agent");
            asm volatile("s_waitcnt vmcnt(0)" ::: "memory");
        }
    }
    __syncthreads();
}

struct Args { const float* in[20]; float* out; unsigned char* wsp; };
typedef __attribute__((address_space(1))) unsigned char* gptr_t;
__device__ __forceinline__ gptr_t fresh_ptr(unsigned char* p) { asm volatile("" : "+s"(p)); return (gptr_t)p; }

__global__ void __launch_bounds__(NWAVES * 64, 2) hymba_fwd(Args args) {
    extern __shared__ __attribute__((aligned(16))) unsigned char lds[];
    LAS unsigned char* L = (LAS unsigned char*)lds;
    const int tid = threadIdx.x, lane = tid & 63, wave = __builtin_amdgcn_readfirstlane(tid >> 6);
    const int G = gridDim.x, bx = blockIdx.x;
    const int gw = bx * NWAVES + wave, NGW = G * NWAVES;
    const int gtid = bx * (NWAVES * 64) + tid, NT = G * NWAVES * 64;
#define ws (fresh_ptr(args.wsp))
#define rowss ((float*)(unsigned char*)(ws + WS_ROWSS))
#define rope ((float*)(unsigned char*)(ws + WS_ROPE))
#define XB ((bf16*)(unsigned char*)(ws + WS_XB))
#define HB ((bf16*)(unsigned char*)(ws + WS_H))
#define QKVU ((bf16*)(unsigned char*)(ws + WS_QKVU))
#define OBUF ((bf16*)(unsigned char*)(ws + WS_OBUF))
#define CAT ((bf16*)(unsigned char*)(ws + WS_CAT))
#define xout ((float*)(unsigned char*)fresh_ptr((unsigned char*)args.out))
    { volatile LAS unsigned* st0 = (volatile LAS unsigned*)(L + 147392); if (tid < 2) st0[tid] = 0u; }
    __syncthreads();
    const XcdBarrier gbar = xcd_barrier_post((unsigned*)args.wsp, (volatile LAS unsigned*)(L + 147392));

    {
        constexpr int IT_G = 16 * 88, IT_D = 44 * 32, IT_IN = 16 * 64, IT_OUT = 8 * 32, IT_LAYER = 4 * IT_G + 2 * IT_D + IT_IN + IT_OUT;
        static_assert(IT_G == IT_D, "item decode");
#define TR_DECODE(d_, it_) do { const int l = (it_) / IT_LAYER; int r = (it_) % IT_LAYER; unsigned char* wlc_ = (unsigned char*)(ws + WS_W + (size_t)l * W_LAYER); \
            if (r < 6 * IT_G) { \
                const int f = r / (3 * IT_G), q = r % (3 * IT_G), kind = q / IT_G, i = q % IT_G; \
                if (kind < 2) { const int kb = i / 88, nb = i % 88, n0 = 32 * nb; \
                    d_ = TrDesc{args.in[(f ? 16 : 2) + kind] + (size_t)l * D * FF, args.in[f ? 15 : 1] + l * D, (bf16*)(wlc_ + (f ? OFF_GU2 : OFF_GU1)), FF, 64 * kb, n0, D, (n0 >> 7) * 256 + kind * 128 + (n0 & 127), 1}; } \
                else { const int kb = i / 32, nb = i % 32; \
                    d_ = TrDesc{args.in[f ? 18 : 4] + (size_t)l * FF * D, nullptr, (bf16*)(wlc_ + (f ? OFF_DN2 : OFF_DN1)), D, 64 * kb, 32 * nb, FF, 32 * nb, 1}; } \
            } else { r -= 6 * IT_G; \
                if (r < IT_IN) { const int kb = r / 64, nb = r % 64, n0 = 32 * nb; int rbase = n0, rstride = 1; \
                    if (n0 < 1024) { const int d0 = n0 & 63; rbase = (n0 - d0) + (d0 ? 1 : 0); rstride = 2; } \
                    d_ = TrDesc{args.in[6] + (size_t)l * D * NIN, args.in[5] + l * D, (bf16*)(wlc_ + OFF_IN), NIN, 64 * kb, n0, D, rbase, rstride}; } \
                else { r -= IT_IN; const int kb = r / 32, nb = r % 32; \
                    d_ = TrDesc{args.in[14] + (size_t)l * D * D, nullptr, (bf16*)(wlc_ + OFF_OUT), D, 64 * kb, 32 * nb, D, 32 * nb, 1}; } \
            } } while (0)
        if (gw < DEPTH * IT_LAYER) { int it = gw; TrDesc d0; TR_DECODE(d0, it); f32x4 va[8]; tr_load(d0, lane, va);
            for (;;) { const int itn = it + NGW; const bool has = itn < DEPTH * IT_LAYER; TrDesc d1 = d0; f32x4 vb[8];
#pragma unroll
                for (int i = 0; i < 8; ++i) vb[i] = (f32x4){0.f, 0.f, 0.f, 0.f};
                if (has) { TR_DECODE(d1, itn); tr_load(d1, lane, vb); }
                tr_store(d0, lane, va); if (!has) break;
                d0 = d1; it = itn;
#pragma unroll
                for (int i = 0; i < 8; ++i) va[i] = vb[i]; } }
#undef TR_DECODE
        for (int it = gw; it < DEPTH * 1024; it += NGW) {
            const int l = it >> 10, r = it & 1023, g = r >> 8, cb = (r >> 4) & 15, nb = r & 15, c0 = cb * 8, n = nb * 64 + lane;
            const float* pw = args.in[12] + ((size_t)(l * 4 + g) * 128 + c0) * 128; const float* ps = args.in[13] + l * 512 + g * 128;
            const float* wo = args.in[14] + (size_t)l * D * D + (size_t)(512 + g * 128) * D + n;
            float a[8];
#pragma unroll
            for (int j = 0; j < 8; ++j) a[j] = 0.f;
            for (int e = 0; e < 128; ++e) { const float w = wo[(size_t)e * D] * ps[e];
#pragma unroll
                for (int j = 0; j < 8; ++j) a[j] += pw[j * 128 + e] * w; }
            v4u o; o.x = pk2(a[0], a[1]); o.y = pk2(a[2], a[3]); o.z = pk2(a[4], a[5]); o.w = pk2(a[6], a[7]);
            *(v4u*)((bf16*)(unsigned char*)(ws + WS_W + (size_t)l * W_LAYER + OFF_OUT) + (size_t)n * D + 512 + g * 128 + c0) = o;
        }
        for (int i = gtid; i < M * 32; i += NT) { const int s = i >> 5, j = i & 31; const float inv = (float)pow(10000.0, -(double)j / 32.0); const float ang = (float)s * inv;
            const double a = (double)ang; rope[2 * i] = (float)cos(a); rope[2 * i + 1] = (float)sin(a); }
        for (int m = gw; m < M; m += NGW) { const f32x4* xr = (const f32x4*)(args.in[0] + (size_t)m * D) + lane; f32x4 v[4]; float s = 0.f;
#pragma unroll
            for (int j = 0; j < 4; ++j) { v[j] = xr[64 * j]; s += (v[j].x * v[j].x + v[j].y * v[j].y) + (v[j].z * v[j].z + v[j].w * v[j].w); }
            s = wave_sum(s); if (lane < 16) rowss[(size_t)m * 16 + lane] = (lane == 0) ? s : 0.f;
            v2u* o8 = (v2u*)(XB + (size_t)m * D) + lane;
#pragma unroll
            for (int j = 0; j < 4; ++j) { v2u w; w.x = pk2(v[j].x, v[j].y); w.y = pk2(v[j].z, v[j].w); o8[64 * j] = w; } }
    }
    cg::this_grid().sync();


    for (int step = 0; step < 3 * DEPTH; ++step) {
        const int l = step / 3, kind = step % 3;
#define wl ((unsigned char*)(ws + WS_W + (size_t)l * W_LAYER))
        if (kind != 1) {
            const int f = kind >> 1;
            { pg8::Gemm g{XB, (const bf16*)(wl + (f ? OFF_GU2 : OFF_GU1)), M, NGU, D}; pg8::StaticOrder S; S.init(M, NGU, G, bx);
              pg8::EpiGateUp E{HB, rowss};
              pg8::gemm_phase<pg8::EpiGateUp, pg8::StaticOrder, PG8_ALIGN, PG8_SP2>(L, g, S, E); }
            xcd_barrier(gbar);
            { pg8::Gemm g{HB, (const bf16*)(wl + (f ? OFF_DN2 : OFF_DN1)), M, D, FF}; pg8::StaticOrder S; S.init(M, D, G, bx);
              pg8::EpiResid E{(const pg8::EpiResid::gf32*)fresh_ptr((unsigned char*)((step == 0) ? args.in[0] : args.out)), (pg8::EpiResid::gf32*)fresh_ptr((unsigned char*)args.out), XB, rowss, 0.5f};
              pg8::gemm_phase<pg8::EpiResid, pg8::StaticOrder, PG8_ALIGN, PG8_SP2>(L, g, S, E); }
            xcd_barrier(gbar);
        } else {
            { pg8::Gemm g{XB, (const bf16*)(wl + OFF_IN), M, NIN, D}; pg8::StaticOrder S; S.init(M, NIN, G, bx);
              pg8::EpiQKVU E{QKVU, rowss, rope};
              pg8::gemm_phase<pg8::EpiQKVU, pg8::StaticOrder, PG8_ALIGN, PG8_SP2>(L, g, S, E); }
            xcd_barrier(gbar);
            { const attn_body::AttnTensors AT{(const attn_body::bf16*)QKVU, (const attn_body::bf16*)(QKVU + 512), (const attn_body::bf16*)(QKVU + 1024), (attn_body::bf16*)OBUF};
              const attn_body::StaticOrder S(G, bx);
              attn_body::attn_phase<attn_body::StaticOrder>((char*)lds, AT, S); }
            xcd_barrier(gbar);
            {
                const float li = 0.8f - 0.6f * expf(-0.3f * (float)l);
                const float s1 = wave_sum(args.in[7][l * 64 + lane] * args.in[8][l * 64 + lane]), s2 = wave_sum(args.in[9][l * 64 + lane] * args.in[10][l * 64 + lane]);
                const float lam = expf(s1) - expf(s2) + li;
                const int hd = lane >> 4, j0 = (lane & 15) * 8;
                float gn[8];
#pragma unroll
                for (int j = 0; j < 8; ++j) gn[j] = args.in[11][l * 128 + j0 + j] * (1.0f - li);
                const int win = 2 << hd;
                for (int mc = gw; mc < M / 8; mc += NGW) { float wsum[8];
                  for (int mr = 0; mr < 8; ++mr) { const int m = mc * 8 + mr;
                    const v4u a = *(const v4u*)(OBUF + (size_t)m * 1024 + hd * 256 + j0), b = *(const v4u*)(OBUF + (size_t)m * 1024 + hd * 256 + 128 + j0);
                    float o[8];
                    o[0] = bflo(a.x) - lam * bflo(b.x); o[1] = bfhi(a.x) - lam * bfhi(b.x); o[2] = bflo(a.y) - lam * bflo(b.y); o[3] = bfhi(a.y) - lam * bfhi(b.y);
                    o[4] = bflo(a.z) - lam * bflo(b.z); o[5] = bfhi(a.z) - lam * bfhi(b.z); o[6] = bflo(a.w) - lam * bflo(b.w); o[7] = bfhi(a.w) - lam * bfhi(b.w);
                    float ss = 0.f;
#pragma unroll
                    for (int j = 0; j < 8; ++j) ss += o[j] * o[j];
                    ss += __shfl_xor(ss, 1); ss += __shfl_xor(ss, 2); ss += __shfl_xor(ss, 4); ss += __shfl_xor(ss, 8);
                    const float rr = __builtin_amdgcn_rsqf(ss * (1.0f / 128.0f) + 1e-6f);
                    v4u w; w.x = pk2(o[0] * rr * gn[0], o[1] * rr * gn[1]); w.y = pk2(o[2] * rr * gn[2], o[3] * rr * gn[3]); w.z = pk2(o[4] * rr * gn[4], o[5] * rr * gn[5]); w.w = pk2(o[6] * rr * gn[6], o[7] * rr * gn[7]);
                    *(v4u*)(CAT + (size_t)m * 1024 + hd * 128 + j0) = w;
                    const bf16* up = QKVU + (size_t)m * 2112 + 1536 + hd * 128 + j0;
                    const v4u u0 = *(const v4u*)up;
                    const float us[8] = {bflo(u0.x), bfhi(u0.x), bflo(u0.y), bfhi(u0.y), bflo(u0.z), bfhi(u0.z), bflo(u0.w), bfhi(u0.w)};
                    float sm[8];
                    if (mr == 0) {
                        v4u ut[15]; float wt[15];
#pragma unroll
                        for (int j = 0; j < 8; ++j) sm[j] = us[j];
#pragma unroll
                        for (int t = 1; t < 16; ++t) { const bool ok = (t < win) && (m - t >= 0); ut[t - 1] = *(const v4u*)(up - (size_t)(ok ? t : 0) * 2112); wt[t - 1] = ok ? 1.0f : 0.0f; }
#pragma unroll
                        for (int t = 0; t < 15; ++t) { const float w = wt[t];
                            sm[0] += w * bflo(ut[t].x); sm[1] += w * bfhi(ut[t].x); sm[2] += w * bflo(ut[t].y); sm[3] += w * bfhi(ut[t].y); sm[4] += w * bflo(ut[t].z); sm[5] += w * bfhi(ut[t].z); sm[6] += w * bflo(ut[t].w); sm[7] += w * bfhi(ut[t].w); }
                    } else {
                        const bool dr = (m - win >= 0); const v4u ud = *(const v4u*)(up - (size_t)(dr ? win : 0) * 2112); const float wd = dr ? 1.0f : 0.0f;
                        sm[0] = wsum[0] + us[0] - wd * bflo(ud.x); sm[1] = wsum[1] + us[1] - wd * bfhi(ud.x); sm[2] = wsum[2] + us[2] - wd * bflo(ud.y); sm[3] = wsum[3] + us[3] - wd * bfhi(ud.y);
                        sm[4] = wsum[4] + us[4] - wd * bflo(ud.z); sm[5] = wsum[5] + us[5] - wd * bfhi(ud.z); sm[6] = wsum[6] + us[6] - wd * bflo(ud.w); sm[7] = wsum[7] + us[7] - wd * bfhi(ud.w);
                    }
#pragma unroll
                    for (int j = 0; j < 8; ++j) wsum[j] = sm[j];
                    const float ic = 1.0f / (float)((m + 1 < win) ? (m + 1) : win);
                    v4u d; d.x = pk2(sm[0] * ic - us[0], sm[1] * ic - us[1]); d.y = pk2(sm[2] * ic - us[2], sm[3] * ic - us[3]); d.z = pk2(sm[4] * ic - us[4], sm[5] * ic - us[5]); d.w = pk2(sm[6] * ic - us[6], sm[7] * ic - us[7]);
                    *(v4u*)(CAT + (size_t)m * 1024 + 512 + hd * 128 + j0) = d;
                  }
                }
            }
            xcd_barrier(gbar);
            { pg8::Gemm g{CAT, (const bf16*)(wl + OFF_OUT), M, D, D}; pg8::StaticOrder S; S.init(M, D, G, bx);
              pg8::EpiResid E{(const pg8::EpiResid::gf32*)fresh_ptr((unsigned char*)args.out), (pg8::EpiResid::gf32*)fresh_ptr((unsigned char*)args.out), XB, rowss, 1.0f};
              pg8::gemm_phase<pg8::EpiResid, pg8::StaticOrder, PG8_ALIGN, PG8_SP2>(L, g, S, E); }
            xcd_barrier(gbar);
        }
    }
    for (int m = gw; m < M; m += NGW) { f32x4* xr = (f32x4*)(xout + (size_t)m * D) + lane; const f32x4* gr = (const f32x4*)args.in[19] + lane;
        const float r = pg8::rs_from_ss(rowss + (size_t)m * 16);
#pragma unroll
        for (int j = 0; j < 4; ++j) { const f32x4 v = xr[64 * j], gg = gr[64 * j]; xr[64 * j] = v * r * gg; } }
}

#undef wl
#undef ws
#undef rowss
#undef rope
#undef XB
#undef HB
#undef QKVU
#undef OBUF
#undef CAT
#undef xout
extern "C" void kernel_launch(void* const* d_in, const int* in_sizes, int n_in, void* d_out, int out_size, void* d_ws, size_t ws_size, hipStream_t stream) {
    static int grid_blocks = 0;
    if (grid_blocks == 0) {
        if (n_in != 20 || out_size != M * D || ws_size < WS_END) { fprintf(stderr, "kernel_launch: unexpected shapes (n_in %d out %d ws %zu, need %zu)\n", n_in, out_size, ws_size, (size_t)WS_END); grid_blocks = -1; return; }
        int dev = 0, cus = 0, per_cu = 0;
        (void)hipGetDevice(&dev); (void)hipDeviceGetAttribute(&cus, hipDeviceAttributeMultiprocessorCount, dev);
        if (hipFuncSetAttribute((const void*)hymba_fwd, hipFuncAttributeMaxDynamicSharedMemorySize, LDS_BYTES) != hipSuccess) { fprintf(stderr, "kernel_launch: hipFuncSetAttribute failed\n"); grid_blocks = -1; return; }
        if (hipOccupancyMaxActiveBlocksPerMultiprocessor(&per_cu, (const void*)hymba_fwd, NWAVES * 64, LDS_BYTES) != hipSuccess || per_cu < 1) { fprintf(stderr, "kernel_launch: occupancy query says %d\n", per_cu); per_cu = 1; }
        (void)hipGetLastError();
        grid_blocks = cus * per_cu;
    }
    if (grid_blocks < 0) return;
    if (hipMemsetAsync(d_ws, 0, 65536, stream) != hipSuccess) { fprintf(stderr, "kernel_launch: memset failed\n"); return; }
    Args a{};
    for (int i = 0; i < 20; ++i) a.in[i] = (const float*)d_in[i];
    a.out = (float*)d_out; a.wsp = (unsigned char*)d_ws;
    void* kargs[] = {&a};
    hipError_t e = hipLaunchCooperativeKernel((const void*)hymba_fwd, dim3(grid_blocks), dim3(NWAVES * 64), kargs, LDS_BYTES, stream);
    if (e != hipSuccess) fprintf(stderr, "cooperative launch failed: %s (grid %d)\n", hipGetErrorString(e), grid_blocks);
}
```

```cpp
#include <hip/hip_runtime.h>
#include <hip/hip_cooperative_groups.h>
#include <cstdio>
#include <cstdint>
namespace cg = cooperative_groups;
namespace pg8 {
#define PG8_LAS __attribute__((address_space(3)))
typedef unsigned short bf16_t;
typedef short bf16x8 __attribute__((ext_vector_type(8)));
typedef float f32x4 __attribute__((ext_vector_type(4)));
typedef unsigned u32x4 __attribute__((ext_vector_type(4)));
constexpr int BM = 256, BK = 64, HALF = 128, HTB = HALF * BK * 2  , STAGE_BYTES = 8 * HTB, NXCD = 8, WGM = 8;

__host__ __device__ __forceinline__ int lds_byte(int r, int c) { const int st = (r >> 4) * 2 + (c >> 5), rr = r & 15, cc = c & 31, ob = rr * 64 + cc * 2; return st * 1024 + (ob ^ (((ob >> 9) & 1) << 5)); }
__host__ __device__ __forceinline__ void stage_rc(int b, int& R, int& C) { const int st = b / 1024, sb = b % 1024, swz = sb ^ (((sb >> 9) & 1) << 5); R = (st >> 1) * 16 + swz / 64; C = (st & 1) * 32 + (swz % 64) / 2; }
__host__ __device__ __forceinline__ int perm32(int rho) { const int n = rho >> 4, i = rho & 15; return 8 * (i >> 2) + 4 * n + (i & 3); }

struct Unit { int pm, pn; };
struct Gemm { const bf16_t* A; const bf16_t* Bt; int M, N, K; };

struct StaticOrder {
    int nM, nN, nwg, G, c;
    __host__ __device__ void init(int M, int N, int G_, int c_) { nM = M / BM; nN = N / BM; nwg = nM * nN; G = G_; c = c_; }
    __host__ __device__ bool next(int i, Unit& u) const {
        const long L = (long)i * G + c; if (L >= nwg) return false;
        int wgid = (int)L; { const int q = nwg / NXCD, r = nwg % NXCD, xcd = wgid % NXCD, off = wgid / NXCD; wgid = (xcd < r ? xcd * (q + 1) : r * (q + 1) + (xcd - r) * q) + off; }
        const int nig = WGM * nN, gid = wgid / nig, fm = gid * WGM, gsz = (nM - fm) < WGM ? (nM - fm) : WGM;
        u.pm = fm + ((wgid % nig) % gsz); u.pn = (wgid % nig) / gsz; return true;
    }
    __device__ __forceinline__ void a_ready(const Unit&) const {}
    __device__ __forceinline__ void done(const Unit&) const {}
};

__device__ __forceinline__ unsigned cvt_pk_bf16(float lo, float hi) { unsigned r; asm volatile("v_cvt_pk_bf16_f32 %0, %1, %2" : "=v"(r) : "v"(lo), "v"(hi)); return r; }
typedef float f32x2 __attribute__((ext_vector_type(2)));
__device__ __forceinline__ f32x2 gelu_pk(f32x2 v) {
    const f32x2 av = __builtin_elementwise_abs(v), d = av * 0.2316418882f + 1.0f;
    f32x2 t; t.x = __builtin_amdgcn_rcpf(d.x); t.y = __builtin_amdgcn_rcpf(d.y);
    f32x2 q = t * 0.5307027145f + (-0.7265760135f); q = q * t + 0.7107068705f; q = q * t + (-0.142248368f); q = q * t + 0.127414796f; q = q * t;
    const f32x2 s = (v * v) * (-0.72134752044f);
    f32x2 e; e.x = __builtin_amdgcn_exp2f(s.x); e.y = __builtin_amdgcn_exp2f(s.y);
    const f32x2 m = v * (q * e), r = v - m;
    f32x2 o; o.x = v.x < 0.f ? m.x : r.x; o.y = v.y < 0.f ? m.y : r.y; return o;
}

template <int ACT  > struct EpiBf16 {
    static constexpr bool PERM = true, AFTER_DRAIN = false; static_assert(ACT == 0 || ACT == 1, "EpiBf16: ACT is 0 (none) or 1 (gelu_pk)");
    bf16_t* O; int ldc; const float* bias; int split_cols; size_t split_stride; float scale0;
    __device__ __forceinline__ void operator()(const f32x4 (&acc)[2][2][4][2], const Unit& u, int wr, int wc, int fr, int fq) const {
        const int row0 = u.pm * BM + wr * 64 + fr; int colt = u.pn * BM; bf16_t* base = O;
        float sc = 1.f; if (split_cols) { const int t = colt / split_cols; base += (size_t)t * split_stride; colt -= t * split_cols; if (t == 0) sc = scale0; }
        const int col0 = colt + wc * 32 + 8 * fq, bcol0 = u.pn * BM + wc * 32 + 8 * fq;
        f32x4 bv[2][2];
#pragma unroll
        for (int bj = 0; bj < 2; ++bj)
#pragma unroll
            for (int n = 0; n < 2; ++n) bv[bj][n] = bias ? *(const f32x4*)(bias + bcol0 + bj * HALF + 4 * n) : (f32x4){0.f, 0.f, 0.f, 0.f};
#pragma unroll
        for (int ai = 0; ai < 2; ++ai)
#pragma unroll
            for (int m = 0; m < 4; ++m) { bf16_t* rowp = base + (size_t)(row0 + ai * HALF + m * 16) * ldc + col0;
#pragma unroll
                for (int bj = 0; bj < 2; ++bj) { f32x4 v0 = acc[ai][bj][m][0] + bv[bj][0], v1 = acc[ai][bj][m][1] + bv[bj][1];
                    if (ACT == 1) { f32x2 a = gelu_pk((f32x2){v0[0], v0[1]}), b = gelu_pk((f32x2){v0[2], v0[3]}), c = gelu_pk((f32x2){v1[0], v1[1]}), d = gelu_pk((f32x2){v1[2], v1[3]});
                        v0 = (f32x4){a.x, a.y, b.x, b.y}; v1 = (f32x4){c.x, c.y, d.x, d.y}; }
                    v0 = v0 * sc; v1 = v1 * sc; u32x4 w; w.x = cvt_pk_bf16(v0[0], v0[1]); w.y = cvt_pk_bf16(v0[2], v0[3]); w.z = cvt_pk_bf16(v1[0], v1[1]); w.w = cvt_pk_bf16(v1[2], v1[3]);
                    *(u32x4*)(rowp + bj * HALF) = w; } }
    }
};
__device__ __forceinline__ float rs_from_ss(const float* p) { const f32x4 a = ((const f32x4*)p)[0], b = ((const f32x4*)p)[1], c = ((const f32x4*)p)[2], d = ((const f32x4*)p)[3];
    const float ss = (((a[0] + a[1]) + (a[2] + a[3])) + ((b[0] + b[1]) + (b[2] + b[3]))) + (((c[0] + c[1]) + (c[2] + c[3])) + ((d[0] + d[1]) + (d[2] + d[3])));
    return __builtin_amdgcn_rsqf(ss * (1.0f / 1024.0f) + 1e-6f); }
__device__ __forceinline__ float sum_fq4(float s) {
    { auto rr = __builtin_amdgcn_permlane16_swap(__float_as_uint(s), __float_as_uint(s), false, false); s = __uint_as_float(rr[0]) + __uint_as_float(rr[1]); }
    { auto rr = __builtin_amdgcn_permlane32_swap(__float_as_uint(s), __float_as_uint(s), false, false); s = __uint_as_float(rr[0]) + __uint_as_float(rr[1]); }
    return s; }
#define EPI_ROW_SCALES(rs_, rowss_, row0_) do { f32x4 q_[8]; \
    _Pragma("unroll") for (int i_ = 0; i_ < 8; ++i_) q_[i_] = *(const f32x4*)((rowss_) + (size_t)((row0_) + (i_ >> 2) * HALF + (i_ & 3) * 16) * 16 + fq * 4); \
    _Pragma("unroll") for (int i_ = 0; i_ < 8; ++i_) { float s_ = sum_fq4((q_[i_][0] + q_[i_][1]) + (q_[i_][2] + q_[i_][3])); \
        rs_[i_] = __builtin_amdgcn_rsqf(s_ * (1.0f / 1024.0f) + 1e-6f); } } while (0)
struct EpiGateUp {
    static constexpr bool PERM = true, AFTER_DRAIN = false;
    bf16_t* H; const float* rowss;
    __device__ __forceinline__ void operator()(const f32x4 (&acc)[2][2][4][2], const Unit& u, int wr, int wc, int fr, int fq) const {
        const int row0 = u.pm * BM + wr * 64 + fr; const int col0 = u.pn * HALF + wc * 32 + 8 * fq;
        float rs[8]; EPI_ROW_SCALES(rs, rowss, row0);
#pragma unroll
        for (int ai = 0; ai < 2; ++ai)
#pragma unroll
            for (int m = 0; m < 4; ++m) { const int row = row0 + ai * HALF + m * 16; const float r = rs[ai * 4 + m];
                float hv[8];
#pragma unroll
                for (int n = 0; n < 2; ++n)
#pragma unroll
                    for (int e = 0; e < 4; ++e) { const float g = acc[ai][0][m][n][e] * r, up = acc[ai][1][m][n][e] * r;
                        const float sg = g * __builtin_amdgcn_rcpf(1.0f + __builtin_amdgcn_exp2f(g * -1.4426950408889634f)); hv[n * 4 + e] = sg * up; }
                u32x4 w; w.x = cvt_pk_bf16(hv[0], hv[1]); w.y = cvt_pk_bf16(hv[2], hv[3]); w.z = cvt_pk_bf16(hv[4], hv[5]); w.w = cvt_pk_bf16(hv[6], hv[7]);
                *(u32x4*)(H + (size_t)row * 2816 + col0) = w; }
    }
};
struct EpiResidBf {
    static constexpr bool PERM = true, AFTER_DRAIN = false;
    typedef __attribute__((address_space(1))) u32x4 gu32x4; typedef unsigned u32x2 __attribute__((ext_vector_type(2))); typedef __attribute__((address_space(1))) u32x2 gu32x2;
    __attribute__((address_space(1))) bf16_t* xb; __attribute__((address_space(1))) unsigned char* xl; float* rowss_next; float alpha;
    __device__ __forceinline__ void operator()(const f32x4 (&acc)[2][2][4][2], const Unit& u, int wr, int wc, int fr, int fq) const {
        const int row0 = u.pm * BM + wr * 64 + fr; const int col0 = u.pn * BM + wc * 32 + 8 * fq;
        u32x4 xa[4][2]; u32x2 la[4][2];
#define EPB_LD(ai_) do { _Pragma("unroll") for (int m = 0; m < 4; ++m) _Pragma("unroll") for (int bj = 0; bj < 2; ++bj) { const size_t off = (size_t)(row0 + (ai_) * HALF + m * 16) * 1024 + col0 + bj * HALF; \
            xa[m][bj] = *(const gu32x4*)(xb + off); la[m][bj] = *(const gu32x2*)(xl + off); } } while (0)
#define EPB_ST(ai_) do { _Pragma("unroll") for (int m = 0; m < 4; ++m) { const int row = row0 + (ai_) * HALF + m * 16; float ss = 0.f; \
            _Pragma("unroll") for (int bj = 0; bj < 2; ++bj) { const u32x4 x = xa[m][bj]; const u32x2 lw = la[m][bj]; const size_t off = (size_t)row * 1024 + col0 + bj * HALF; \
                const f32x2 l0 = __builtin_amdgcn_cvt_pk_f32_bf8((int)lw.x, false), l1 = __builtin_amdgcn_cvt_pk_f32_bf8((int)lw.x, true), l2 = __builtin_amdgcn_cvt_pk_f32_bf8((int)lw.y, false), l3 = __builtin_amdgcn_cvt_pk_f32_bf8((int)lw.y, true); \
                const f32x4 a0 = (f32x4){__builtin_bit_cast(float, x.x << 16) + l0.x, __builtin_bit_cast(float, x.x & 0xffff0000u) + l0.y, __builtin_bit_cast(float, x.y << 16) + l1.x, __builtin_bit_cast(float, x.y & 0xffff0000u) + l1.y}; \
                const f32x4 a1 = (f32x4){__builtin_bit_cast(float, x.z << 16) + l2.x, __builtin_bit_cast(float, x.z & 0xffff0000u) + l2.y, __builtin_bit_cast(float, x.w << 16) + l3.x, __builtin_bit_cast(float, x.w & 0xffff0000u) + l3.y}; \
                const f32x4 v0 = a0 + acc[ai_][bj][m][0] * alpha, v1 = a1 + acc[ai_][bj][m][1] * alpha; \
                ss += (v0[0] * v0[0] + v0[1] * v0[1]) + (v0[2] * v0[2] + v0[3] * v0[3]) + (v1[0] * v1[0] + v1[1] * v1[1]) + (v1[2] * v1[2] + v1[3] * v1[3]); \
                u32x4 w; w.x = cvt_pk_bf16(v0[0], v0[1]); w.y = cvt_pk_bf16(v0[2], v0[3]); w.z = cvt_pk_bf16(v1[0], v1[1]); w.w = cvt_pk_bf16(v1[2], v1[3]); \
                *(gu32x4*)(xb + off) = w; \
                int e0 = __builtin_amdgcn_cvt_pk_bf8_f32(v0[0] - __builtin_bit_cast(float, w.x << 16), v0[1] - __builtin_bit_cast(float, w.x & 0xffff0000u), 0, false); \
                e0 = __builtin_amdgcn_cvt_pk_bf8_f32(v0[2] - __builtin_bit_cast(float, w.y << 16), v0[3] - __builtin_bit_cast(float, w.y & 0xffff0000u), e0, true); \
                int e1 = __builtin_amdgcn_cvt_pk_bf8_f32(v1[0] - __builtin_bit_cast(float, w.z << 16), v1[1] - __builtin_bit_cast(float, w.z & 0xffff0000u), 0, false); \
                e1 = __builtin_amdgcn_cvt_pk_bf8_f32(v1[2] - __builtin_bit_cast(float, w.w << 16), v1[3] - __builtin_bit_cast(float, w.w & 0xffff0000u), e1, true); \
                *(gu32x2*)(xl + off) = (u32x2){(unsigned)e0, (unsigned)e1}; } \
            ss = sum_fq4(ss); \
            if (fq == 0) rowss_next[(size_t)row * 16 + u.pn * 4 + wc] = ss; } } while (0)
        EPB_LD(0); __builtin_amdgcn_sched_barrier(0);
        EPB_ST(0); __builtin_amdgcn_sched_barrier(0);
        EPB_LD(1); __builtin_amdgcn_sched_barrier(0);
        EPB_ST(1);
#undef EPB_LD
#undef EPB_ST
    }
};
struct EpiQKVU {
    static constexpr bool PERM = true, AFTER_DRAIN = false;
    bf16_t* O; const float* rowss; const float* rope;
    __device__ __forceinline__ void operator()(const f32x4 (&acc)[2][2][4][2], const Unit& u, int wr, int wc, int fr, int fq) const {
        const int row0 = u.pm * BM + wr * 64 + fr; const int col0 = u.pn * BM + wc * 32 + 8 * fq; const int sec = u.pn >> 1;
        const int j0 = 16 * (wc & 1) + 4 * fq;
        float rs[8]; EPI_ROW_SCALES(rs, rowss, row0);
#pragma unroll
        for (int ai = 0; ai < 2; ++ai) {
            f32x4 cs[4][2];
#pragma unroll
            for (int m = 0; m < 4; ++m) { cs[m][0] = (f32x4){1.f, 0.f, 1.f, 0.f}; cs[m][1] = cs[m][0];
                if (sec < 2) { const f32x4* rp = (const f32x4*)(rope + ((size_t)(row0 + ai * HALF + m * 16) * 32 + j0) * 2); cs[m][0] = rp[0]; cs[m][1] = rp[1]; } }
#pragma unroll
            for (int m = 0; m < 4; ++m) { const int row = row0 + ai * HALF + m * 16; float r = rs[ai * 4 + m]; if (sec == 0) r *= 0.125f * 1.4426950408889634f;
                const f32x4 cs0 = cs[m][0], cs1 = cs[m][1];
#pragma unroll
                for (int bj = 0; bj < 2; ++bj) { const f32x4 v0 = acc[ai][bj][m][0] * r, v1 = acc[ai][bj][m][1] * r;
                    const float o0 = v0[0] * cs0[0] - v0[1] * cs0[1], o1 = v0[1] * cs0[0] + v0[0] * cs0[1];
                    const float o2 = v0[2] * cs0[2] - v0[3] * cs0[3], o3 = v0[3] * cs0[2] + v0[2] * cs0[3];
                    const float o4 = v1[0] * cs1[0] - v1[1] * cs1[1], o5 = v1[1] * cs1[0] + v1[0] * cs1[1];
                    const float o6 = v1[2] * cs1[2] - v1[3] * cs1[3], o7 = v1[3] * cs1[2] + v1[2] * cs1[3];
                    u32x4 w; w.x = cvt_pk_bf16(o0, o1); w.y = cvt_pk_bf16(o2, o3); w.z = cvt_pk_bf16(o4, o5); w.w = cvt_pk_bf16(o6, o7);
                    *(u32x4*)(O + (size_t)row * 2112 + col0 + bj * HALF) = w; } } }
    }
};

template <class Epi, class Sched, bool ALIGN_EPI = false, bool SP2 = false>
__device__ __forceinline__ void gemm_phase(PG8_LAS unsigned char* lds, const Gemm g, const Sched& S, const Epi& E) {
    int tid_ = threadIdx.x; asm volatile("" : "+v"(tid_));
    const int tid = tid_, wid = __builtin_amdgcn_readfirstlane(tid >> 6), lane = tid & 63, wr = wid >> 2, wc = wid & 3, fr = lane & 15, fq = lane >> 4;
    const int K = g.K, nt = K / BK;
    unsigned voffA[2], voffB[2];
#pragma unroll
    for (int i = 0; i < 2; ++i) { int R, C; stage_rc(tid * 16 + i * 8192, R, C); const int Rb = Epi::PERM ? ((R & ~31) + perm32(R & 31)) : R;
        voffA[i] = (unsigned)(R * K + C) * 2u; voffB[i] = (unsigned)(Rb * K + C) * 2u; }
    const size_t kstep = (size_t)(BK * 2);
    const size_t hstep = (size_t)HALF * K * 2;
    const size_t tstep = 2 * hstep;
    const unsigned ldsw = (unsigned)wid * 1024u;
    const int aoff = lds_byte(wr * 64 + fr, fq * 8), boff = lds_byte(wc * 32 + fr, fq * 8);
#define PG8_SA(b, h) (((b) * 2 + (h)) * HTB)
#define PG8_SB(b, h) ((4 + (b) * 2 + (h)) * HTB)
#define PG8_STAGE(bufoff, gbase, voff) do { _Pragma("unroll") for (int _i = 0; _i < 2; ++_i) \
        __builtin_amdgcn_global_load_lds((const unsigned*)((const char*)(gbase) + (voff)[_i]), (PG8_LAS unsigned*)(lds + (bufoff) + ldsw + _i * 8192), 16, 0, 0); } while (0)
#define PG8_LDA(dst, b, h) do { _Pragma("unroll") for (int m = 0; m < 4; ++m) _Pragma("unroll") for (int k = 0; k < 2; ++k) dst[m][k] = *(const PG8_LAS bf16x8*)(lds + PG8_SA(b, h) + aoff + m * 2048 + k * 1024); } while (0)
#define PG8_LDB(dst, b, h) do { _Pragma("unroll") for (int n = 0; n < 2; ++n) _Pragma("unroll") for (int k = 0; k < 2; ++k) dst[n][k] = *(const PG8_LAS bf16x8*)(lds + PG8_SB(b, h) + boff + n * 2048 + k * 1024); } while (0)
#define PG8_MMA(ai, bj, At, Bt) do { __builtin_amdgcn_s_setprio(1); _Pragma("unroll") for (int m = 0; m < 4; ++m) _Pragma("unroll") for (int n = 0; n < 2; ++n) _Pragma("unroll") for (int k = 0; k < 2; ++k) \
        acc[ai][bj][m][n] = __builtin_amdgcn_mfma_f32_16x16x32_bf16(Bt[n][k], At[m][k], acc[ai][bj][m][n], 0, 0, 0); __builtin_amdgcn_s_setprio(0); } while (0)
#define PG8_WAIT_V(n) asm volatile("s_waitcnt vmcnt(" #n ")" ::: "memory")
#define PG8_WAIT_L(n) asm volatile("s_waitcnt lgkmcnt(" #n ")" ::: "memory")
#define PG8_BAR __builtin_amdgcn_s_barrier()
#define PG8_SCHED __builtin_amdgcn_sched_barrier(0)
    Unit cur, nxt; int ui = 0;
    if (!S.next(0, cur)) return;
    f32x4 acc[2][2][4][2];
#pragma unroll
    for (int a = 0; a < 2; ++a)
#pragma unroll
        for (int b = 0; b < 2; ++b)
#pragma unroll
            for (int m = 0; m < 4; ++m)
#pragma unroll
                for (int n = 0; n < 2; ++n) acc[a][b][m][n] = (f32x4){0.f, 0.f, 0.f, 0.f};
    bf16x8 At[4][2], B0[2][2], B1[2][2];
    const char* cA = (const char*)g.A + (size_t)cur.pm * tstep; const char* cB = (const char*)g.Bt + (size_t)cur.pn * tstep;
    S.a_ready(cur);
    if constexpr (SP2) {
        PG8_STAGE(PG8_SB(0, 0), cB, voffB); PG8_STAGE(PG8_SB(0, 1), cB + hstep, voffB); PG8_STAGE(PG8_SA(0, 0), cA, voffA); PG8_STAGE(PG8_SA(0, 1), cA + hstep, voffA);
        if (wr == 1) PG8_BAR;
        PG8_WAIT_V(2); PG8_BAR;
        PG8_STAGE(PG8_SB(1, 0), cB + kstep, voffB); PG8_STAGE(PG8_SA(1, 0), cA + kstep, voffA); PG8_STAGE(PG8_SB(1, 1), cB + hstep + kstep, voffB);
        PG8_WAIT_V(6); PG8_BAR;
    } else {
        PG8_STAGE(PG8_SB(0, 0), cB, voffB); PG8_STAGE(PG8_SA(0, 0), cA, voffA); PG8_STAGE(PG8_SB(0, 1), cB + hstep, voffB); PG8_STAGE(PG8_SA(0, 1), cA + hstep, voffA);
        if (wr == 1) PG8_BAR;
        PG8_WAIT_V(4); PG8_BAR;
        PG8_STAGE(PG8_SB(1, 0), cB + kstep, voffB); PG8_STAGE(PG8_SA(1, 0), cA + kstep, voffA); PG8_STAGE(PG8_SB(1, 1), cB + hstep + kstep, voffB);
        PG8_WAIT_V(6); PG8_BAR;
    }
    for (;;) {
        const bool has_next = S.next(ui + 1, nxt);
        const char* nA = has_next ? (const char*)g.A + (size_t)nxt.pm * tstep : cA; const char* nB = has_next ? (const char*)g.Bt + (size_t)nxt.pn * tstep : cB;
        for (int t = 0; t < nt; t += 2) {
            const bool last = (t == nt - 2);
            const char* a1 = cA + (size_t)(t + 1) * kstep;
            const char* a2 = last ? nA : cA + (size_t)(t + 2) * kstep; const char* b2 = last ? nB : cB + (size_t)(t + 2) * kstep;
            const char* a3 = a2 + kstep; const char* b3 = b2 + kstep;
            if (last && has_next) S.a_ready(nxt);
            if constexpr (SP2) {
            PG8_LDB(B0, 0, 0); PG8_LDB(B1, 0, 1); PG8_SCHED; PG8_LDA(At, 0, 0); PG8_STAGE(PG8_SA(1, 1), a1 + hstep, voffA);
            PG8_WAIT_V(8); PG8_WAIT_L(0); PG8_BAR; PG8_MMA(0, 0, At, B0); PG8_MMA(0, 1, At, B1); PG8_BAR; PG8_SCHED;
            PG8_LDA(At, 0, 1); PG8_STAGE(PG8_SB(0, 0), b2, voffB); PG8_STAGE(PG8_SB(0, 1), b2 + hstep, voffB); PG8_STAGE(PG8_SA(0, 0), a2, voffA);
            PG8_WAIT_V(8); PG8_WAIT_L(0); PG8_BAR; PG8_MMA(1, 0, At, B0); PG8_MMA(1, 1, At, B1); PG8_BAR; PG8_SCHED;
            PG8_LDB(B0, 1, 0); PG8_LDB(B1, 1, 1); PG8_SCHED; PG8_LDA(At, 1, 0); PG8_STAGE(PG8_SA(0, 1), a2 + hstep, voffA);
            PG8_WAIT_V(8); PG8_WAIT_L(0); PG8_BAR; PG8_MMA(0, 0, At, B0); PG8_MMA(0, 1, At, B1); PG8_BAR; PG8_SCHED;
            PG8_LDA(At, 1, 1); PG8_STAGE(PG8_SB(1, 0), b3, voffB); PG8_STAGE(PG8_SB(1, 1), b3 + hstep, voffB); PG8_STAGE(PG8_SA(1, 0), a3, voffA);
            PG8_WAIT_V(8); PG8_WAIT_L(0); PG8_BAR; PG8_MMA(1, 0, At, B0); PG8_MMA(1, 1, At, B1); PG8_BAR; PG8_SCHED;
            } else {
            PG8_LDB(B0, 0, 0); PG8_SCHED; PG8_LDA(At, 0, 0); PG8_STAGE(PG8_SA(1, 1), a1 + hstep, voffA);
            PG8_WAIT_L(8); PG8_BAR; PG8_WAIT_L(0); PG8_MMA(0, 0, At, B0); PG8_BAR; PG8_SCHED;
            PG8_LDB(B1, 0, 1); PG8_STAGE(PG8_SB(0, 0), b2, voffB);
            PG8_BAR; PG8_WAIT_L(0); PG8_MMA(0, 1, At, B1); PG8_BAR;
            PG8_LDA(At, 0, 1); PG8_STAGE(PG8_SA(0, 0), a2, voffA);
            PG8_BAR; PG8_WAIT_L(0); PG8_MMA(1, 0, At, B0); PG8_BAR; PG8_SCHED;
            PG8_STAGE(PG8_SB(0, 1), b2 + hstep, voffB);
            PG8_WAIT_V(6); PG8_BAR; PG8_MMA(1, 1, At, B1); PG8_BAR;
            PG8_LDB(B0, 1, 0); PG8_SCHED; PG8_LDA(At, 1, 0); PG8_STAGE(PG8_SA(0, 1), a2 + hstep, voffA);
            PG8_WAIT_L(8); PG8_BAR; PG8_WAIT_L(0); PG8_MMA(0, 0, At, B0); PG8_BAR; PG8_SCHED;
            PG8_LDB(B1, 1, 1); PG8_STAGE(PG8_SB(1, 0), b3, voffB);
            PG8_BAR; PG8_WAIT_L(0); PG8_MMA(0, 1, At, B1); PG8_BAR;
            PG8_LDA(At, 1, 1); PG8_STAGE(PG8_SA(1, 0), a3, voffA);
            PG8_BAR; PG8_WAIT_L(0); PG8_MMA(1, 0, At, B0); PG8_BAR; PG8_SCHED;
            PG8_STAGE(PG8_SB(1, 1), b3 + hstep, voffB);
            PG8_WAIT_V(6); PG8_BAR; PG8_MMA(1, 1, At, B1); PG8_BAR;
            }
        }
        if constexpr (ALIGN_EPI) { if (wr == 0) PG8_BAR; }
        if constexpr (!Epi::AFTER_DRAIN) { E(acc, cur, wr, wc, fr, fq); S.done(cur); }
        if (!has_next) break;
#pragma unroll
        for (int a = 0; a < 2; ++a)
#pragma unroll
            for (int b = 0; b < 2; ++b)
#pragma unroll
                for (int m = 0; m < 4; ++m)
#pragma unroll
                    for (int n = 0; n < 2; ++n) acc[a][b][m][n] = (f32x4){0.f, 0.f, 0.f, 0.f};
        cur = nxt; cA = nA; cB = nB; ++ui;
        if constexpr (ALIGN_EPI) { if (wr == 1) PG8_BAR; }
    }
    PG8_WAIT_V(0);
    if constexpr (!ALIGN_EPI) { if (wr == 0) PG8_BAR; }
    PG8_BAR;
    if constexpr (Epi::AFTER_DRAIN) { E.fused(acc, cur, wr, wc, fr, fq, lds, wid, lane); S.done(cur); }
#undef PG8_SA
#undef PG8_SB
#undef PG8_STAGE
#undef PG8_LDA
#undef PG8_LDB
#undef PG8_MMA
#undef PG8_WAIT_V
#undef PG8_WAIT_L
#undef PG8_BAR
#undef PG8_SCHED
}
}

#ifndef PG8_SP2
#define PG8_SP2 true
#endif
#ifndef PG8_ALIGN
#define PG8_ALIGN true
#endif
#include <hip/hip_bf16.h>
#include <cmath>
namespace attn_body {
using bf16=__hip_bfloat16;
using bf16x8=__attribute__((ext_vector_type(8)))short;
using s16x4=__attribute__((ext_vector_type(4)))short;
using f32x16=__attribute__((ext_vector_type(16)))float;
using u32x4=__attribute__((ext_vector_type(4)))unsigned;
constexpr int BATCH=1,NHEAD=16,SEQ=16384,D=64,DM=2112,DMO=1024;
constexpr int NW=8,QBLK=32,QB=QBLK*NW,KVBLK=64,NQB=SEQ/QB;
constexpr int ATTN_PITCH=DM, ATTN_UNIT_ROWS=QB;
__device__ __forceinline__ int crow(int r,int hi){return (r&3)+8*(r>>2)+4*hi;}
#define SBAR() __builtin_amdgcn_sched_barrier(0)
__device__ __forceinline__ void cmask(f32x16&p0,f32x16&p1,int jb,int qrel,int hi){
  const float NEG=-INFINITY; int kb=64*jb+4*hi;
  #pragma unroll
  for(int r=0;r<16;++r){int kv=kb+(r&3)+8*(r>>2); if(kv>qrel)p0[r]=NEG; if(kv+32>qrel)p1[r]=NEG;}
}

constexpr int NSLOT=3, SLOTB=8192;
constexpr int NVSLOT=3, VSLOTB=16384;
constexpr int LDS_K=0, LDS_V=NSLOT*SLOTB, LDS_P=LDS_V+NVSLOT*VSLOTB, LDS_WS=LDS_P+NW*8192, WSF_STRIDE=64, LDS_BYTES=LDS_WS+NW*WSF_STRIDE*4;
constexpr float C2=0.125f*1.4426950408889634f;
__device__ __forceinline__ void glds16(const void*gsrc,unsigned lds_dst){unsigned keep;
  asm volatile("s_mov_b32 %0, m0\n\ts_mov_b32 m0, %2\n\ts_nop 0\n\tglobal_load_lds_dwordx4 %1, off\n\ts_mov_b32 m0, %0":"=&s"(keep):"v"(gsrc),"s"(lds_dst):"memory");}
__device__ __forceinline__ float max3f(float a,float b,float c){float r;asm("v_max3_f32 %0, %1, %2, %3":"=v"(r):"v"(a),"v"(b),"v"(c));return r;}
__device__ __forceinline__ float max2f(float a,float b){float r;asm("v_max_f32_e32 %0, %1, %2":"=v"(r):"v"(a),"v"(b));return r;}
__device__ __forceinline__ float fadd_s(float a,float b){float r;asm("v_add_f32_e32 %0, %1, %2":"=v"(r):"v"(a),"v"(b));return r;}
__device__ __forceinline__ float fsub_s(float a,float b){float r;asm("v_sub_f32_e32 %0, %1, %2":"=v"(r):"v"(a),"v"(b));return r;}
typedef float f32x2_t __attribute__((ext_vector_type(2))); typedef __bf16 bf16x2_t __attribute__((ext_vector_type(2)));
__device__ __forceinline__ unsigned cvtpk_s(float lo,float hi){f32x2_t v={lo,hi};bf16x2_t b=__builtin_convertvector(v,bf16x2_t);return __builtin_bit_cast(unsigned,b);}
#define WAIT_BAR(N) asm volatile("s_waitcnt vmcnt(" #N ") lgkmcnt(0)\n\ts_barrier":::"memory")

__device__ __forceinline__ void qkt(f32x16&p0,f32x16&p1,const char*Kslot,const bf16x8*qr,const f32x16&negm,int r32,int hi){
  const char*kb=Kslot+hi*1024+r32*16;
  #pragma unroll
  for(int d0=0;d0<4;++d0){
    const bf16x8 b0=*reinterpret_cast<const bf16x8*>(kb+d0*2048);
    const bf16x8 b1=*reinterpret_cast<const bf16x8*>(kb+d0*2048+512);
    if(d0==0){p0=__builtin_amdgcn_mfma_f32_32x32x16_bf16(b0,qr[0],negm,0,0,0);p1=__builtin_amdgcn_mfma_f32_32x32x16_bf16(b1,qr[0],negm,0,0,0);}
    else{p0=__builtin_amdgcn_mfma_f32_32x32x16_bf16(b0,qr[d0],p0,0,0,0);p1=__builtin_amdgcn_mfma_f32_32x32x16_bf16(b1,qr[d0],p1,0,0,0);}}
}
typedef __attribute__((address_space(3))) const char* lds_cptr;
typedef short v4i16_t __attribute__((ext_vector_type(4)));
__device__ __forceinline__ void kload8(bf16x8*kf,lds_cptr kp){
  kf[0]=*(const __attribute__((address_space(3))) bf16x8*)(kp);      kf[1]=*(const __attribute__((address_space(3))) bf16x8*)(kp+512);
  kf[2]=*(const __attribute__((address_space(3))) bf16x8*)(kp+2048); kf[3]=*(const __attribute__((address_space(3))) bf16x8*)(kp+2560);
  kf[4]=*(const __attribute__((address_space(3))) bf16x8*)(kp+4096); kf[5]=*(const __attribute__((address_space(3))) bf16x8*)(kp+4608);
  kf[6]=*(const __attribute__((address_space(3))) bf16x8*)(kp+6144); kf[7]=*(const __attribute__((address_space(3))) bf16x8*)(kp+6656);
}
__device__ __forceinline__ void kload2(bf16x8*kf,lds_cptr kp,int j){ kf[2*j]=*(const __attribute__((address_space(3))) bf16x8*)(kp+j*2048); kf[2*j+1]=*(const __attribute__((address_space(3))) bf16x8*)(kp+j*2048+512); }
__device__ __forceinline__ s16x4 vtr(lds_cptr p){ return __builtin_bit_cast(s16x4,__builtin_amdgcn_ds_read_tr16_b64_v4i16((__attribute__((address_space(3))) v4i16_t*)p)); }
__device__ __forceinline__ float rowmax(const f32x16&p0,const f32x16&p1){
  float a=max3f(p0[0],p0[1],p1[0]),b=max3f(p0[2],p0[3],p1[1]);a=max3f(a,p1[2],p1[3]);
  #pragma unroll
  for(int r=4;r<16;r+=4){a=max3f(a,p0[r],p0[r+1]);b=max3f(b,p0[r+2],p0[r+3]);a=max3f(a,p1[r],p1[r+1]);b=max3f(b,p1[r+2],p1[r+3]);}
  const float m=max2f(a,b);
  auto rr=__builtin_amdgcn_permlane32_swap(__float_as_uint(m),__float_as_uint(m),false,false);
  return max2f(__uint_as_float(rr[0]),__uint_as_float(rr[1]));
}
__device__ __forceinline__ void pv(f32x16*o,int vb,bf16x8 pa0,bf16x8 pa1,bf16x8 pa2,bf16x8 pa3){
  #pragma unroll
  for(int d0=0;d0<2;++d0){s16x4 lo[4],hi[4];
    #pragma unroll
    for(int ks=0;ks<4;++ks){
      asm volatile("ds_read_b64_tr_b16 %0,%1 offset:%c2":"=&v"(lo[ks]):"v"(vb),"i"(d0*4096+ks*1024):"memory");
      asm volatile("ds_read_b64_tr_b16 %0,%1 offset:%c2":"=&v"(hi[ks]):"v"(vb),"i"(d0*4096+ks*1024+512):"memory");}
    asm volatile("s_waitcnt lgkmcnt(0)":::"memory");SBAR();
    #define PK(k) (bf16x8){lo[k][0],lo[k][1],lo[k][2],lo[k][3],hi[k][0],hi[k][1],hi[k][2],hi[k][3]}
    o[d0]=__builtin_amdgcn_mfma_f32_32x32x16_bf16(pa0,PK(0),o[d0],0,0,0);
    o[d0]=__builtin_amdgcn_mfma_f32_32x32x16_bf16(pa1,PK(1),o[d0],0,0,0);
    o[d0]=__builtin_amdgcn_mfma_f32_32x32x16_bf16(pa2,PK(2),o[d0],0,0,0);
    o[d0]=__builtin_amdgcn_mfma_f32_32x32x16_bf16(pa3,PK(3),o[d0],0,0,0);
    #undef PK
  }
}

#ifndef ATTN_STORE16
#define ATTN_STORE16(p,v) (*(u32x4*)(p)=(v))
#endif
template<int THRL> __device__ __forceinline__ void attn_unit(int qb,const bf16*Q,const bf16*__restrict__ K,const bf16*__restrict__ V,bf16*O,char*shm){
  int tid_=threadIdx.x; asm volatile("":"+v"(tid_)); const int tid=tid_,lane=tid&63,r32=lane&31,hi=lane>>5; const int wid=__builtin_amdgcn_readfirstlane(tid>>6);
  const int q0=qb*QB;
  const unsigned lds0=(unsigned)(uintptr_t)shm;
  float*wsf=(float*)(shm+LDS_WS)+wid*WSF_STRIDE;
  const bf16*ksrc=K+(long)lane*DM+wid*8;
  const bf16*vsrc=V+(long)(16*(wid&3)+(lane>>2))*DM+(wid>>2)*32+(lane&3)*8;
  const unsigned kdst=lds0+LDS_K+wid*1024, vdst=lds0+LDS_V+wid*1024;
  #define DMA_K(t,s3) glds16(ksrc+(long)(t)*KVBLK*DM,(unsigned)__builtin_amdgcn_readfirstlane(kdst+(s3)*SLOTB))
  #define DMA_V(t,s3) do{ const unsigned vd_=(unsigned)__builtin_amdgcn_readfirstlane(vdst+(s3)*VSLOTB); glds16(vsrc+(long)(t)*KVBLK*DM,vd_); glds16(vsrc+(long)(t)*KVBLK*DM+64,(unsigned)__builtin_amdgcn_readfirstlane(vd_+8192)); }while(0)
  const lds_cptr shm3=(lds_cptr)shm;
  const int NT=(q0+QB)/KVBLK;
  DMA_K(0,0);DMA_V(0,0);DMA_K(1,1);DMA_V(1,1);
  int c0=0,c1=1,c2=2;
  #define ROT3() do{ const int x_=c0; c0=c1; c1=c2; c2=x_; }while(0)
  #define PKW(P,B) cvtpk_s(P[B],P[B+1])
  #define MX3(a,b,c) __builtin_fmaxf(__builtin_fmaxf((a),(b)),(c))
  const bf16*Qw=Q+(long)(q0+wid*QBLK)*DM;
  bf16x8 qr[4];
  #pragma unroll
  for(int d0=0;d0<4;++d0)qr[d0]=*reinterpret_cast<const bf16x8*>(&Qw[(long)r32*DM+d0*16+hi*8]);
  float mhat=0.f,l_reg=0.f; f32x16 negm=f32x16{};
  f32x16 o[4]; o[0]=f32x16{};o[1]=f32x16{};o[2]=f32x16{};o[3]=f32x16{};
  const int qrel=wid*QBLK+r32;
  const lds_cptr kp0=shm3+LDS_K+hi*1024+r32*16;
  const lds_cptr vp0=shm3+LDS_V+((lane>>4)&1)*32+(lane&3)*8+(4*hi+((lane&15)>>2))*64;
  WAIT_BAR(3);
  for(int t=0;t<NT;++t){
    if(t+2<NT){DMA_K(t+2,c2);DMA_V(t+2,c2);}
    bf16x8 kf[8]; kload8(kf,kp0+c0*SLOTB);
    SBAR();
    f32x16 C0,C1;
    {
      C0=__builtin_amdgcn_mfma_f32_32x32x16_bf16(kf[0],qr[0],negm,0,0,0); C1=__builtin_amdgcn_mfma_f32_32x32x16_bf16(kf[1],qr[0],negm,0,0,0);
      C0=__builtin_amdgcn_mfma_f32_32x32x16_bf16(kf[2],qr[1],C0,0,0,0);   C1=__builtin_amdgcn_mfma_f32_32x32x16_bf16(kf[3],qr[1],C1,0,0,0);
      C0=__builtin_amdgcn_mfma_f32_32x32x16_bf16(kf[4],qr[2],C0,0,0,0);   C1=__builtin_amdgcn_mfma_f32_32x32x16_bf16(kf[5],qr[2],C1,0,0,0);
      C0=__builtin_amdgcn_mfma_f32_32x32x16_bf16(kf[6],qr[3],C0,0,0,0);   C1=__builtin_amdgcn_mfma_f32_32x32x16_bf16(kf[7],qr[3],C1,0,0,0); }
    SBAR();
    const lds_cptr vp_=vp0+c0*VSLOTB; s16x4 vl_[8],vh_[8];
    #pragma unroll
    for(int k2=0;k2<2;++k2)
      #pragma unroll
      for(int d_=0;d_<4;++d_){ vl_[d_*2+k2]=vtr(vp_+(d_*4096+k2*1024)); vh_[d_*2+k2]=vtr(vp_+(d_*4096+k2*1024+512)); }
    SBAR();
    { const int jb_=t-(NT-4); if(jb_>=0)cmask(C0,C1,jb_,qrel,hi); }
    float a=MX3(C0[0],C0[1],C1[0]),b=MX3(C0[2],C0[3],C1[1]); a=MX3(a,C1[2],C1[3]);
    #pragma unroll
    for(int r=4;r<16;r+=4){a=MX3(a,C0[r],C0[r+1]);b=MX3(b,C0[r+2],C0[r+3]);a=MX3(a,C1[r],C1[r+1]);b=MX3(b,C1[r+2],C1[r+3]);}
    float rm=__builtin_fmaxf(a,b); { auto rr=__builtin_amdgcn_permlane32_swap(__float_as_uint(rm),__float_as_uint(rm),false,false); rm=__builtin_fmaxf(__uint_as_float(rr[0]),__uint_as_float(rr[1])); }
    if(t==0 || __any(rm>(float)THRL)){
      const float dl=(t==0)?rm:__builtin_fmaxf(rm,0.f); mhat+=dl;
      #pragma unroll
      for(int r=0;r<16;++r){C0[r]-=dl;C1[r]-=dl;}
      #pragma unroll
      for(int r=0;r<16;++r)negm[r]=-mhat;
      if(t!=0){ const float f=__builtin_amdgcn_exp2f(-dl); l_reg*=f; if(hi==0)wsf[r32]=f; asm volatile("s_waitcnt lgkmcnt(0)":::"memory");
        #pragma unroll
        for(int d_=0;d_<4;++d_)
          #pragma unroll
          for(int r=0;r<16;++r)o[d_][r]*=wsf[crow(r,hi)]; } }
    #pragma unroll
    for(int r=0;r<16;++r){C0[r]=__builtin_amdgcn_exp2f(C0[r]);C1[r]=__builtin_amdgcn_exp2f(C1[r]);}
    { float s0=C0[0]+C0[1],s1=C1[0]+C1[1];
      #pragma unroll
      for(int r=2;r<16;++r){s0+=C0[r];s1+=C1[r];}
      l_reg+=s0+s1; }
    const u32x4 pw0=(u32x4){PKW(C0,0),PKW(C0,2),PKW(C0,4),PKW(C0,6)},pw1=(u32x4){PKW(C0,8),PKW(C0,10),PKW(C0,12),PKW(C0,14)},pw2=(u32x4){PKW(C1,0),PKW(C1,2),PKW(C1,4),PKW(C1,6)},pw3=(u32x4){PKW(C1,8),PKW(C1,10),PKW(C1,12),PKW(C1,14)};
    SBAR();
    #define VFRAG(L_,H_,i_) (bf16x8){L_[i_][0],L_[i_][1],L_[i_][2],L_[i_][3],H_[i_][0],H_[i_][1],H_[i_][2],H_[i_][3]}
    s16x4 w2l_[4],w2h_[4],w3l_[4],w3h_[4];
    #pragma unroll
    for(int d_=0;d_<4;++d_){ w2l_[d_]=vtr(vp_+(d_*4096+2*1024)); w2h_[d_]=vtr(vp_+(d_*4096+2*1024+512)); }
    SBAR();
    #pragma unroll
    for(int d_=0;d_<4;++d_){ o[d_]=__builtin_amdgcn_mfma_f32_32x32x16_bf16(__builtin_bit_cast(bf16x8,pw0),VFRAG(vl_,vh_,d_*2),o[d_],0,0,0); }
    SBAR();
    #pragma unroll
    for(int d_=0;d_<4;++d_){ w3l_[d_]=vtr(vp_+(d_*4096+3*1024)); w3h_[d_]=vtr(vp_+(d_*4096+3*1024+512)); }
    SBAR();
    #pragma unroll
    for(int d_=0;d_<4;++d_){ o[d_]=__builtin_amdgcn_mfma_f32_32x32x16_bf16(__builtin_bit_cast(bf16x8,pw1),VFRAG(vl_,vh_,d_*2+1),o[d_],0,0,0); }
    #pragma unroll
    for(int d_=0;d_<4;++d_){ o[d_]=__builtin_amdgcn_mfma_f32_32x32x16_bf16(__builtin_bit_cast(bf16x8,pw2),VFRAG(w2l_,w2h_,d_),o[d_],0,0,0); }
    #pragma unroll
    for(int d_=0;d_<4;++d_){ o[d_]=__builtin_amdgcn_mfma_f32_32x32x16_bf16(__builtin_bit_cast(bf16x8,pw3),VFRAG(w3l_,w3h_,d_),o[d_],0,0,0); }
    SBAR();
    #undef VFRAG
    if(t+2<NT){WAIT_BAR(3);}else{WAIT_BAR(0);}
    ROT3();
  }
  { auto rr=__builtin_amdgcn_permlane32_swap(__float_as_uint(l_reg),__float_as_uint(l_reg),false,false); l_reg=__uint_as_float(rr[0])+__uint_as_float(rr[1]); }
  if(hi==0)wsf[32+r32]=l_reg; asm volatile("s_waitcnt lgkmcnt(0)":::"memory");
  bf16*Ow=O+(long)(q0+wid*QBLK)*DMO;
  { bf16*stg=(bf16*)(shm+LDS_P)+wid*4096;
    #pragma unroll
    for(int r=0;r<16;++r){const int orow=crow(r,hi); const float rl=__builtin_amdgcn_rcpf(wsf[32+orow]);
      #pragma unroll
      for(int d0=0;d0<4;++d0)stg[orow*128+d0*32+r32]=__float2bfloat16(o[d0][r]*rl);}
    asm volatile("s_waitcnt lgkmcnt(0)":::"memory");
    #pragma unroll
    for(int i=0;i<8;++i){const int row=i*4+(lane>>4),ch=lane&15; const u32x4 v=*(const u32x4*)(stg+row*128+ch*8); ATTN_STORE16(Ow+(long)row*DMO+ch*8,v);} }
  asm volatile("s_waitcnt lgkmcnt(0)\n\ts_barrier":::"memory");
  #undef DMA_K
  #undef DMA_V
  #undef ROT3
  #undef PKW
  #undef MX3
}
constexpr int ATTN_LDS_BYTES=LDS_BYTES;
struct AttnTensors { const bf16* Q; const bf16* K; const bf16* V; bf16* O; };
struct AttnUnit { int hc; int qb; };
struct StaticOrder {
  int vcu, G, bx;
  __device__ __forceinline__ StaticOrder(int grid,int block):vcu((grid%8==0)?(block%8)*(grid/8)+block/8:block),G(grid),bx(block){}
  __device__ __forceinline__ bool next(int i,AttnUnit&u)const{
    if(G==256){ if(i>=2)return false; const int s=vcu&31; u.hc=vcu>>5; u.qb=(i==0)?63-s:s; return true; }
    const int idx=i*G+bx; if(idx>=8*NQB)return false; u.hc=idx&7; u.qb=NQB-1-(idx>>3); return true; }
};
template<class Sched,int THRL=8> __device__ __forceinline__ void attn_phase(char*lds,const AttnTensors&T,const Sched&S){
  AttnUnit u;
  for(int i=0;S.next(i,u);++i){ const int h=u.hc>>1,c=u.hc&1;
    attn_unit<THRL>(u.qb,T.Q+h*128+c*64,T.K+h*128+c*64,T.V+h*128,T.O+u.hc*128,lds); }
}
#undef SBAR
#undef WAIT_BAR
}
constexpr int NWAVES = 8;
constexpr int M = 16384, D = 1024, FF = 2816, NGU = 2 * FF, NIN = 2048, DEPTH = 4;
constexpr size_t MiB = 1u << 20;
constexpr size_t WS_ROWSS = 1 * MiB;
constexpr size_t WS_ROPE = 2 * MiB;
constexpr size_t WS_XB = 8 * MiB;
constexpr size_t WS_H = 40 * MiB;
constexpr size_t WS_QKVU = 40 * MiB;
constexpr size_t WS_OBUF = 108 * MiB;
constexpr size_t WS_CAT = 140 * MiB;
constexpr size_t WS_W = 172 * MiB;
constexpr size_t OFF_GU1 = 0, OFF_DN1 = 11 * MiB, OFF_IN = 16 * MiB + 512 * 1024, OFF_OUT = 20 * MiB + 512 * 1024, OFF_GU2 = 22 * MiB + 512 * 1024, OFF_DN2 = 33 * MiB + 512 * 1024, W_LAYER = 39 * MiB;
constexpr size_t WS_XL = WS_W + DEPTH * W_LAYER;
constexpr size_t WS_END = WS_XL + (size_t)M * D;
static_assert(attn_body::ATTN_LDS_BYTES <= 147392 && (size_t)NGU * D * 2 == 11 * MiB && (size_t)D * FF * 2 == 5 * MiB + 512 * 1024 && WS_H + (size_t)M * FF * 2 <= WS_CAT && WS_ROWSS + 16 * (size_t)M * 4 <= WS_ROPE && WS_ROPE + (size_t)M * 64 * 4 <= WS_XB, "ws map");
constexpr int LDS_BYTES = 147456;

#define LAS __attribute__((address_space(3)))
typedef unsigned short bf16;
typedef unsigned v4u __attribute__((ext_vector_type(4)));
typedef unsigned v2u __attribute__((ext_vector_type(2)));
typedef float f32x4 __attribute__((ext_vector_type(4)));
#define LDS_WAIT() asm volatile("s_waitcnt lgkmcnt(0)" ::: "memory")
__device__ __forceinline__ unsigned f2bf(float f) { unsigned u = __builtin_bit_cast(unsigned, f); return (u + 0x7fffu + ((u >> 16) & 1u)) >> 16; }
__device__ __forceinline__ unsigned pk2(float lo, float hi) { return f2bf(lo) | (f2bf(hi) << 16); }
__device__ __forceinline__ float bflo(unsigned w) { return __builtin_bit_cast(float, w << 16); }
__device__ __forceinline__ float bfhi(unsigned w) { return __builtin_bit_cast(float, w & 0xffff0000u); }
__device__ __forceinline__ float wave_sum(float v) {
#pragma unroll
    for (int o = 1; o < 64; o <<= 1) v += __shfl_xor(v, o);
    return v;
}
struct TrDesc { const float* W; const float* gk; bf16* WT; int N, k0, n0, Kd, rbase, rstride; };
__device__ __forceinline__ void tr_load(const TrDesc& d, int lane, f32x4 (&v)[8]) {
    const int kblk = lane & 7, n4 = lane >> 3;
    const float* src = d.W + (size_t)(d.k0 + 8 * kblk) * d.N + d.n0 + 4 * n4;
#pragma unroll
    for (int i = 0; i < 8; ++i) v[i] = __builtin_nontemporal_load((const f32x4*)(src + (size_t)i * d.N));
}
__device__ __forceinline__ void tr_store(const TrDesc& d, int lane, f32x4 (&v)[8]) {
    const int kblk = lane & 7, n4 = lane >> 3;
    if (d.gk) { const f32x4 g0 = *(const f32x4*)(d.gk + d.k0 + 8 * kblk), g1 = *(const f32x4*)(d.gk + d.k0 + 8 * kblk + 4);
#pragma unroll
        for (int i = 0; i < 4; ++i) { v[i] = v[i] * g0[i]; v[4 + i] = v[4 + i] * g1[i]; } }
#pragma unroll
    for (int e = 0; e < 4; ++e) { v4u o; o.x = pk2(v[0][e], v[1][e]); o.y = pk2(v[2][e], v[3][e]); o.z = pk2(v[4][e], v[5][e]); o.w = pk2(v[6][e], v[7][e]);
        *(v4u*)(d.WT + (size_t)(d.rbase + (4 * n4 + e) * d.rstride) * d.Kd + d.k0 + 8 * kblk) = o; }
}

#define XB_TMO      128
#define XB_XCNT(j)  (256  + 64 * (j))
#define XB_XSUB(j)  (1280 + 64 * (j))
#define XB_XGEN(j)  (2304 + 64 * (j))
#define XB_TOP      3328
#define XB_TOPGEN   3392
#define XCD_BAR_WORDS 3456
#define XB_SPIN_CAP (1u << 18)

__device__ __forceinline__ unsigned xb_ld(unsigned* p)              { return __hip_atomic_load(p, __ATOMIC_RELAXED, __HIP_MEMORY_SCOPE_AGENT); }
__device__ __forceinline__ unsigned xb_add(unsigned* p, unsigned v) { return __hip_atomic_fetch_add(p, v, __ATOMIC_RELAXED, __HIP_MEMORY_SCOPE_AGENT); }
__device__ __forceinline__ unsigned xb_xcc_id() { return (unsigned)__builtin_amdgcn_s_getreg((3 << 11) | 20) & 0xFu; }
#define XB_SPIN(cond, bar) do { unsigned _sp = 0; while (cond) { __builtin_amdgcn_s_sleep(1); \
    if ((++_sp & 255u) == 0u) { if (xb_ld(&(bar)[XB_TMO])) break; if (_sp > XB_SPIN_CAP) { atomicAdd(&(bar)[XB_TMO], 1u); break; } } } } while (0)

struct XcdBarrier {
    unsigned* bar; unsigned x;
    volatile LAS unsigned* st;
};

__device__ __forceinline__ XcdBarrier xcd_barrier_post(unsigned* bar, volatile LAS unsigned* st) {
    XcdBarrier b; b.bar = bar; b.x = xb_xcc_id(); b.st = st;
    if (threadIdx.x == 0) (void)xb_add(&bar[XB_XCNT(b.x)], 1u);
    return b;
}
__device__ __forceinline__ void xcd_barrier_complete(unsigned* bar, unsigned x, unsigned& nloc, unsigned& nx) {
    const unsigned G = gridDim.x * gridDim.y * gridDim.z;
    unsigned sum, cnt, mine, sp = 0u;
    for (;;) {
        sum = 0u; cnt = 0u; mine = 0u;
#pragma unroll
        for (unsigned j = 0; j < 16; ++j) { const unsigned c = xb_ld(&bar[XB_XCNT(j)]); sum += c; cnt += (c > 0u) ? 1u : 0u; mine = (j == x) ? c : mine; }
        if (sum == G) break;
        __builtin_amdgcn_s_sleep(1);
        if ((++sp & 255u) == 0u) { if (xb_ld(&bar[XB_TMO])) break; if (sp > XB_SPIN_CAP) { atomicAdd(&bar[XB_TMO], 1u); break; } }
    }
    nloc = mine > 0u ? mine : 1u; nx = cnt > 0u ? cnt : 1u;
}

__device__ __forceinline__ void xcd_barrier(const XcdBarrier& b) {
    asm volatile("s_waitcnt vmcnt(0)" ::: "memory");
    __syncthreads();
    if (threadIdx.x == 0) {
        unsigned* bar = b.bar;
        __builtin_amdgcn_s_waitcnt(0);
        unsigned nloc = b.st[0], nx = b.st[1];
        if (nloc == 0u) { xcd_barrier_complete(bar, b.x, nloc, nx); b.st[0] = nloc; b.st[1] = nx; }
        const unsigned old = xb_add(&bar[XB_XSUB(b.x)], 1u);
        const unsigned gen = old / nloc;
        if (old + 1u == (gen + 1u) * nloc) {
            __builtin_amdgcn_fence(__ATOMIC_RELEASE, "agent");
            asm volatile("s_waitcnt vmcnt(0)" ::: "memory");
            const unsigned og = xb_add(&bar[XB_TOP], 1u);
            const unsigned tg = og / nx;
            if (og + 1u == (tg + 1u) * nx) xb_add(&bar[XB_TOPGEN], 1u);
            else XB_SPIN(xb_ld(&bar[XB_TOPGEN]) == tg, bar);
            __builtin_amdgcn_fence(__ATOMIC_ACQUIRE, "agent");
            xb_add(&bar[XB_XGEN(b.x)], 1u);
            asm volatile("s_waitcnt vmcnt(0)" ::: "memory");
        } else {
            XB_SPIN(xb_ld(&bar[XB_XGEN(b.x)]) == gen, bar);
            __builtin_amdgcn_fence(__ATOMIC_ACQUIRE, "agent");
            asm volatile("s_waitcnt vmcnt(0)" ::: "memory");
        }
    }
    __syncthreads();
}

struct Args { const float* in[20]; float* out; unsigned char* wsp; };
__device__ __forceinline__ int fresh_lane() { int l; asm volatile("v_mbcnt_lo_u32_b32 %0, -1, 0\n\tv_mbcnt_hi_u32_b32 %0, -1, %0" : "=v"(l)); return l; }
typedef __attribute__((address_space(1))) unsigned char* gptr_t;
__device__ __forceinline__ gptr_t fresh_ptr(unsigned char* p) { asm volatile("" : "+s"(p)); return (gptr_t)p; }

__global__ void __launch_bounds__(NWAVES * 64, 2) hymba_fwd(Args args) {
    extern __shared__ __attribute__((aligned(16))) unsigned char lds[];
    LAS unsigned char* L = (LAS unsigned char*)lds;
    const int tid = threadIdx.x, lane = tid & 63, wave = __builtin_amdgcn_readfirstlane(tid >> 6);
    const int G = gridDim.x, bx = blockIdx.x;
    const int gw = bx * NWAVES + wave, NGW = G * NWAVES;
    const int gtid = bx * (NWAVES * 64) + tid, NT = G * NWAVES * 64;
#define ws (fresh_ptr(args.wsp))
#define rowss ((float*)(unsigned char*)(ws + WS_ROWSS))
#define rope ((float*)(unsigned char*)(ws + WS_ROPE))
#define XB ((bf16*)(unsigned char*)(ws + WS_XB))
#define HB ((bf16*)(unsigned char*)(ws + WS_H))
#define QKVU ((bf16*)(unsigned char*)(ws + WS_QKVU))
#define OBUF ((bf16*)(unsigned char*)(ws + WS_OBUF))
#define CAT ((bf16*)(unsigned char*)(ws + WS_CAT))
#define xout ((float*)(unsigned char*)fresh_ptr((unsigned char*)args.out))
    { volatile LAS unsigned* st0 = (volatile LAS unsigned*)(L + 147392); if (tid < 2) st0[tid] = 0u; }
    __syncthreads();
    (void)xcd_barrier_post((unsigned*)args.wsp, (volatile LAS unsigned*)(L + 147392));

    {
        constexpr int IT_G = 16 * 88, IT_D = 44 * 32, IT_IN = 16 * 64, IT_OUT = 8 * 32, IT_LAYER = 4 * IT_G + 2 * IT_D + IT_IN + IT_OUT;
        static_assert(IT_G == IT_D, "item decode");
#define TR_DECODE(d_, it_) do { const int l = (it_) / IT_LAYER; int r = (it_) % IT_LAYER; unsigned char* wlc_ = (unsigned char*)(ws + WS_W + (size_t)l * W_LAYER); \
            if (r < 6 * IT_G) { \
                const int f = r / (3 * IT_G), q = r % (3 * IT_G), kind = q / IT_G, i = q % IT_G; \
                if (kind < 2) { const int kb = i / 88, nb = i % 88, n0 = 32 * nb; \
                    d_ = TrDesc{args.in[(f ? 16 : 2) + kind] + (size_t)l * D * FF, args.in[f ? 15 : 1] + l * D, (bf16*)(wlc_ + (f ? OFF_GU2 : OFF_GU1)), FF, 64 * kb, n0, D, (n0 >> 7) * 256 + kind * 128 + (n0 & 127), 1}; } \
                else { const int kb = i / 32, nb = i % 32; \
                    d_ = TrDesc{args.in[f ? 18 : 4] + (size_t)l * FF * D, nullptr, (bf16*)(wlc_ + (f ? OFF_DN2 : OFF_DN1)), D, 64 * kb, 32 * nb, FF, 32 * nb, 1}; } \
            } else { r -= 6 * IT_G; \
                if (r < IT_IN) { const int kb = r / 64, nb = r % 64, n0 = 32 * nb; int rbase = n0, rstride = 1; \
                    if (n0 < 1024) { const int d0 = n0 & 63; rbase = (n0 - d0) + (d0 ? 1 : 0); rstride = 2; } \
                    d_ = TrDesc{args.in[6] + (size_t)l * D * NIN, args.in[5] + l * D, (bf16*)(wlc_ + OFF_IN), NIN, 64 * kb, n0, D, rbase, rstride}; } \
                else { r -= IT_IN; const int kb = r / 32, nb = r % 32; \
                    d_ = TrDesc{args.in[14] + (size_t)l * D * D, nullptr, (bf16*)(wlc_ + OFF_OUT), D, 64 * kb, 32 * nb, D, 32 * nb, 1}; } \
            } } while (0)
        if (gw < DEPTH * IT_LAYER) { int it = gw; TrDesc d0; TR_DECODE(d0, it); f32x4 va[8]; tr_load(d0, lane, va);
            for (;;) { const int itn = it + NGW; const bool has = itn < DEPTH * IT_LAYER; TrDesc d1 = d0; f32x4 vb[8];
#pragma unroll
                for (int i = 0; i < 8; ++i) vb[i] = (f32x4){0.f, 0.f, 0.f, 0.f};
                if (has) { TR_DECODE(d1, itn); tr_load(d1, lane, vb); }
                tr_store(d0, lane, va); if (!has) break;
                d0 = d1; it = itn;
#pragma unroll
                for (int i = 0; i < 8; ++i) va[i] = vb[i]; } }
#undef TR_DECODE
        for (int it = gw; it < DEPTH * 1024; it += NGW) {
            const int l = it >> 10, r = it & 1023, g = r >> 8, cb = (r >> 4) & 15, nb = r & 15, c0 = cb * 8, n = nb * 64 + lane;
            const float* pw = args.in[12] + ((size_t)(l * 4 + g) * 128 + c0) * 128; const float* ps = args.in[13] + l * 512 + g * 128;
            const float* wo = args.in[14] + (size_t)l * D * D + (size_t)(512 + g * 128) * D + n;
            float a[8];
#pragma unroll
            for (int j = 0; j < 8; ++j) a[j] = 0.f;
            for (int e = 0; e < 128; ++e) { const float w = wo[(size_t)e * D] * ps[e];
#pragma unroll
                for (int j = 0; j < 8; ++j) a[j] += pw[j * 128 + e] * w; }
            v4u o; o.x = pk2(a[0], a[1]); o.y = pk2(a[2], a[3]); o.z = pk2(a[4], a[5]); o.w = pk2(a[6], a[7]);
            *(v4u*)((bf16*)(unsigned char*)(ws + WS_W + (size_t)l * W_LAYER + OFF_OUT) + (size_t)n * D + 512 + g * 128 + c0) = o;
        }
        for (int i = gtid; i < M * 32; i += NT) { const int s = i >> 5, j = i & 31; const float inv = (float)pow(10000.0, -(double)j / 32.0); const float ang = (float)s * inv;
            const double a = (double)ang; rope[2 * i] = (float)cos(a); rope[2 * i + 1] = (float)sin(a); }
        for (int m = gw; m < M; m += NGW) { const f32x4* xr = (const f32x4*)(args.in[0] + (size_t)m * D) + lane; f32x4 v[4]; float s = 0.f;
#pragma unroll
            for (int j = 0; j < 4; ++j) { v[j] = xr[64 * j]; s += (v[j].x * v[j].x + v[j].y * v[j].y) + (v[j].z * v[j].z + v[j].w * v[j].w); }
            s = wave_sum(s); if (lane < 16) rowss[(size_t)m * 16 + lane] = (lane == 0) ? s : 0.f;
            v2u* o8 = (v2u*)(XB + (size_t)m * D) + lane;
#pragma unroll
            for (int j = 0; j < 4; ++j) { v2u w; w.x = pk2(v[j].x, v[j].y); w.y = pk2(v[j].z, v[j].w); o8[64 * j] = w;
                int e = __builtin_amdgcn_cvt_pk_bf8_f32(v[j].x - bflo(w.x), v[j].y - bfhi(w.x), 0, false); e = __builtin_amdgcn_cvt_pk_bf8_f32(v[j].z - bflo(w.y), v[j].w - bfhi(w.y), e, true);
                ((unsigned*)(unsigned char*)(ws + WS_XL + (size_t)m * D))[lane + 64 * j] = (unsigned)e; } }
    }
    cg::this_grid().sync();


    for (int step = 0; step < 3 * DEPTH; ++step) {
        const int l = step / 3, kind = step % 3;
#define wl ((unsigned char*)(ws + WS_W + (size_t)l * W_LAYER))
        if (kind != 1) {
            const int f = kind >> 1;
            { pg8::Gemm g{XB, (const bf16*)(wl + (f ? OFF_GU2 : OFF_GU1)), M, NGU, D}; pg8::StaticOrder S; S.init(M, NGU, G, bx);
              pg8::EpiGateUp E{HB, rowss};
              pg8::gemm_phase<pg8::EpiGateUp, pg8::StaticOrder, PG8_ALIGN, PG8_SP2>(L, g, S, E); }
            xcd_barrier(XcdBarrier{(unsigned*)args.wsp, xb_xcc_id(), (volatile LAS unsigned*)(L + 147392)});
            { pg8::Gemm g{HB, (const bf16*)(wl + (f ? OFF_DN2 : OFF_DN1)), M, D, FF}; pg8::StaticOrder S; S.init(M, D, G, bx);
              pg8::EpiResidBf E{(__attribute__((address_space(1))) bf16*)(ws + WS_XB), (__attribute__((address_space(1))) unsigned char*)(ws + WS_XL), rowss, 0.5f};
              pg8::gemm_phase<pg8::EpiResidBf, pg8::StaticOrder, PG8_ALIGN, PG8_SP2>(L, g, S, E); }
            xcd_barrier(XcdBarrier{(unsigned*)args.wsp, xb_xcc_id(), (volatile LAS unsigned*)(L + 147392)});
        } else {
            { pg8::Gemm g{XB, (const bf16*)(wl + OFF_IN), M, NIN, D}; pg8::StaticOrder S; S.init(M, NIN, G, bx);
              pg8::EpiQKVU E{QKVU, rowss, rope};
              pg8::gemm_phase<pg8::EpiQKVU, pg8::StaticOrder, PG8_ALIGN, PG8_SP2>(L, g, S, E); }
            xcd_barrier(XcdBarrier{(unsigned*)args.wsp, xb_xcc_id(), (volatile LAS unsigned*)(L + 147392)});
            { const attn_body::AttnTensors AT{(const attn_body::bf16*)QKVU, (const attn_body::bf16*)(QKVU + 512), (const attn_body::bf16*)(QKVU + 1024), (attn_body::bf16*)OBUF};
              const attn_body::StaticOrder S(G, bx);
              attn_body::attn_phase<attn_body::StaticOrder>((char*)lds, AT, S); }
            xcd_barrier(XcdBarrier{(unsigned*)args.wsp, xb_xcc_id(), (volatile LAS unsigned*)(L + 147392)});
            {
                const int lane = fresh_lane();
                const float li = 0.8f - 0.6f * expf(-0.3f * (float)l);
                const float s1 = wave_sum(args.in[7][l * 64 + lane] * args.in[8][l * 64 + lane]), s2 = wave_sum(args.in[9][l * 64 + lane] * args.in[10][l * 64 + lane]);
                const float lam = expf(s1) - expf(s2) + li;
                const int hd = lane >> 4, j0 = (lane & 15) * 8;
                float gn[8];
#pragma unroll
                for (int j = 0; j < 8; ++j) gn[j] = args.in[11][l * 128 + j0 + j] * (1.0f - li);
                const int win = 2 << hd;
                for (int mc = gw; mc < M / 8; mc += NGW) { float wsum[8];
                  for (int mr = 0; mr < 8; ++mr) { const int m = mc * 8 + mr;
                    const v4u a = *(const v4u*)(OBUF + (size_t)m * 1024 + hd * 256 + j0), b = *(const v4u*)(OBUF + (size_t)m * 1024 + hd * 256 + 128 + j0);
                    float o[8];
                    o[0] = bflo(a.x) - lam * bflo(b.x); o[1] = bfhi(a.x) - lam * bfhi(b.x); o[2] = bflo(a.y) - lam * bflo(b.y); o[3] = bfhi(a.y) - lam * bfhi(b.y);
                    o[4] = bflo(a.z) - lam * bflo(b.z); o[5] = bfhi(a.z) - lam * bfhi(b.z); o[6] = bflo(a.w) - lam * bflo(b.w); o[7] = bfhi(a.w) - lam * bfhi(b.w);
                    float ss = 0.f;
#pragma unroll
                    for (int j = 0; j < 8; ++j) ss += o[j] * o[j];
                    ss += __shfl_xor(ss, 1); ss += __shfl_xor(ss, 2); ss += __shfl_xor(ss, 4); ss += __shfl_xor(ss, 8);
                    const float rr = __builtin_amdgcn_rsqf(ss * (1.0f / 128.0f) + 1e-6f);
                    v4u w; w.x = pk2(o[0] * rr * gn[0], o[1] * rr * gn[1]); w.y = pk2(o[2] * rr * gn[2], o[3] * rr * gn[3]); w.z = pk2(o[4] * rr * gn[4], o[5] * rr * gn[5]); w.w = pk2(o[6] * rr * gn[6], o[7] * rr * gn[7]);
                    *(v4u*)(CAT + (size_t)m * 1024 + hd * 128 + j0) = w;
                    const bf16* up = QKVU + (size_t)m * 2112 + 1536 + hd * 128 + j0;
                    const v4u u0 = *(const v4u*)up;
                    const float us[8] = {bflo(u0.x), bfhi(u0.x), bflo(u0.y), bfhi(u0.y), bflo(u0.z), bfhi(u0.z), bflo(u0.w), bfhi(u0.w)};
                    float sm[8];
                    if (mr == 0) {
                        v4u ut[15]; float wt[15];
#pragma unroll
                        for (int j = 0; j < 8; ++j) sm[j] = us[j];
#pragma unroll
                        for (int t = 1; t < 16; ++t) { const bool ok = (t < win) && (m - t >= 0); ut[t - 1] = *(const v4u*)(up - (size_t)(ok ? t : 0) * 2112); wt[t - 1] = ok ? 1.0f : 0.0f; }
#pragma unroll
                        for (int t = 0; t < 15; ++t) { const float w = wt[t];
                            sm[0] += w * bflo(ut[t].x); sm[1] += w * bfhi(ut[t].x); sm[2] += w * bflo(ut[t].y); sm[3] += w * bfhi(ut[t].y); sm[4] += w * bflo(ut[t].z); sm[5] += w * bfhi(ut[t].z); sm[6] += w * bflo(ut[t].w); sm[7] += w * bfhi(ut[t].w); }
                    } else {
                        const bool dr = (m - win >= 0); const v4u ud = *(const v4u*)(up - (size_t)(dr ? win : 0) * 2112); const float wd = dr ? 1.0f : 0.0f;
                        sm[0] = wsum[0] + us[0] - wd * bflo(ud.x); sm[1] = wsum[1] + us[1] - wd * bfhi(ud.x); sm[2] = wsum[2] + us[2] - wd * bflo(ud.y); sm[3] = wsum[3] + us[3] - wd * bfhi(ud.y);
                        sm[4] = wsum[4] + us[4] - wd * bflo(ud.z); sm[5] = wsum[5] + us[5] - wd * bfhi(ud.z); sm[6] = wsum[6] + us[6] - wd * bflo(ud.w); sm[7] = wsum[7] + us[7] - wd * bfhi(ud.w);
                    }
#pragma unroll
                    for (int j = 0; j < 8; ++j) wsum[j] = sm[j];
                    const float ic = 1.0f / (float)((m + 1 < win) ? (m + 1) : win);
                    v4u d; d.x = pk2(sm[0] * ic - us[0], sm[1] * ic - us[1]); d.y = pk2(sm[2] * ic - us[2], sm[3] * ic - us[3]); d.z = pk2(sm[4] * ic - us[4], sm[5] * ic - us[5]); d.w = pk2(sm[6] * ic - us[6], sm[7] * ic - us[7]);
                    *(v4u*)(CAT + (size_t)m * 1024 + 512 + hd * 128 + j0) = d;
                  }
                }
            }
            xcd_barrier(XcdBarrier{(unsigned*)args.wsp, xb_xcc_id(), (volatile LAS unsigned*)(L + 147392)});
            { pg8::Gemm g{CAT, (const bf16*)(wl + OFF_OUT), M, D, D}; pg8::StaticOrder S; S.init(M, D, G, bx);
              pg8::EpiResidBf E{(__attribute__((address_space(1))) bf16*)(ws + WS_XB), (__attribute__((address_space(1))) unsigned char*)(ws + WS_XL), rowss, 1.0f};
              pg8::gemm_phase<pg8::EpiResidBf, pg8::StaticOrder, PG8_ALIGN, PG8_SP2>(L, g, S, E); }
            xcd_barrier(XcdBarrier{(unsigned*)args.wsp, xb_xcc_id(), (volatile LAS unsigned*)(L + 147392)});
        }
    }
    { const int lane = fresh_lane();
    for (int m = gw; m < M; m += NGW) { const v2u* xr = (const v2u*)(XB + (size_t)m * D) + lane; f32x4* xo = (f32x4*)((float*)(unsigned char*)fresh_ptr((unsigned char*)args.out) + (size_t)m * D) + lane; const f32x4* gr = (const f32x4*)args.in[19] + lane;
        const float r = pg8::rs_from_ss(rowss + (size_t)m * 16);
#pragma unroll
        for (int j = 0; j < 4; ++j) { const v2u w = xr[64 * j]; const f32x4 gg = gr[64 * j]; const int e = (int)((const unsigned*)(unsigned char*)(ws + WS_XL + (size_t)m * D))[lane + 64 * j];
            const pg8::f32x2 la = __builtin_amdgcn_cvt_pk_f32_bf8(e, false), lb = __builtin_amdgcn_cvt_pk_f32_bf8(e, true);
            const f32x4 v = (f32x4){bflo(w.x) + la.x, bfhi(w.x) + la.y, bflo(w.y) + lb.x, bfhi(w.y) + lb.y}; xo[64 * j] = v * r * gg; } } }
}

#undef wl
#undef ws
#undef rowss
#undef rope
#undef XB
#undef HB
#undef QKVU
#undef OBUF
#undef CAT
#undef xout
extern "C" void kernel_launch(void* const* d_in, const int* in_sizes, int n_in, void* d_out, int out_size, void* d_ws, size_t ws_size, hipStream_t stream) {
    static int grid_blocks = 0;
    if (grid_blocks == 0) {
        if (n_in != 20 || out_size != M * D || ws_size < WS_END) { fprintf(stderr, "kernel_launch: unexpected shapes (n_in %d out %d ws %zu, need %zu)\n", n_in, out_size, ws_size, (size_t)WS_END); grid_blocks = -1; return; }
        int dev = 0, cus = 0, per_cu = 0;
        (void)hipGetDevice(&dev); (void)hipDeviceGetAttribute(&cus, hipDeviceAttributeMultiprocessorCount, dev);
        if (hipFuncSetAttribute((const void*)hymba_fwd, hipFuncAttributeMaxDynamicSharedMemorySize, LDS_BYTES) != hipSuccess) { fprintf(stderr, "kernel_launch: hipFuncSetAttribute failed\n"); grid_blocks = -1; return; }
        if (hipOccupancyMaxActiveBlocksPerMultiprocessor(&per_cu, (const void*)hymba_fwd, NWAVES * 64, LDS_BYTES) != hipSuccess || per_cu < 1) { fprintf(stderr, "kernel_launch: occupancy query says %d\n", per_cu); per_cu = 1; }
        (void)hipGetLastError();
        grid_blocks = cus * per_cu;
    }
    if (grid_blocks < 0) return;
    if (hipMemsetAsync(d_ws, 0, 65536, stream) != hipSuccess) { fprintf(stderr, "kernel_launch: memset failed\n"); return; }
    Args a{};
    for (int i = 0; i < 20; ++i) a.in[i] = (const float*)d_in[i];
    a.out = (float*)d_out; a.wsp = (unsigned char*)d_ws;
    void* kargs[] = {&a};
    hipError_t e = hipLaunchCooperativeKernel((const void*)hymba_fwd, dim3(grid_blocks), dim3(NWAVES * 64), kargs, LDS_BYTES, stream);
    if (e != hipSuccess) fprintf(stderr, "cooperative launch failed: %s (grid %d)\n", hipGetErrorString(e), grid_blocks);
}
```

```cpp
#include <hip/hip_runtime.h>
#include <hip/hip_cooperative_groups.h>
#include <cstdio>
#include <cstdint>
namespace cg = cooperative_groups;
namespace pg8 {
#define PG8_LAS __attribute__((address_space(3)))
typedef unsigned short bf16_t;
typedef short bf16x8 __attribute__((ext_vector_type(8)));
typedef float f32x4 __attribute__((ext_vector_type(4)));
typedef unsigned u32x4 __attribute__((ext_vector_type(4)));
constexpr int BM = 256, BK = 64, HALF = 128, HTB = HALF * BK * 2  , STAGE_BYTES = 8 * HTB, NXCD = 8, WGM = 8;

__host__ __device__ __forceinline__ int lds_byte(int r, int c) { const int st = (r >> 4) * 2 + (c >> 5), rr = r & 15, cc = c & 31, ob = rr * 64 + cc * 2; return st * 1024 + (ob ^ (((ob >> 9) & 1) << 5)); }
__host__ __device__ __forceinline__ void stage_rc(int b, int& R, int& C) { const int st = b / 1024, sb = b % 1024, swz = sb ^ (((sb >> 9) & 1) << 5); R = (st >> 1) * 16 + swz / 64; C = (st & 1) * 32 + (swz % 64) / 2; }
__host__ __device__ __forceinline__ int perm32(int rho) { const int n = rho >> 4, i = rho & 15; return 8 * (i >> 2) + 4 * n + (i & 3); }

struct Unit { int pm, pn; };
struct Gemm { const bf16_t* A; const bf16_t* Bt; int M, N, K; };

struct StaticOrder {
    int nM, nN, nwg, G, c;
    __host__ __device__ void init(int M, int N, int G_, int c_) { nM = M / BM; nN = N / BM; nwg = nM * nN; G = G_; c = c_; }
    __host__ __device__ bool next(int i, Unit& u) const {
        const long L = (long)i * G + c; if (L >= nwg) return false;
        int wgid = (int)L; { const int q = nwg / NXCD, r = nwg % NXCD, xcd = wgid % NXCD, off = wgid / NXCD; wgid = (xcd < r ? xcd * (q + 1) : r * (q + 1) + (xcd - r) * q) + off; }
        const int nig = WGM * nN, gid = wgid / nig, fm = gid * WGM, gsz = (nM - fm) < WGM ? (nM - fm) : WGM;
        u.pm = fm + ((wgid % nig) % gsz); u.pn = (wgid % nig) / gsz; return true;
    }
    __device__ __forceinline__ void a_ready(const Unit&) const {}
    __device__ __forceinline__ void done(const Unit&) const {}
};

__device__ __forceinline__ unsigned cvt_pk_bf16(float lo, float hi) { unsigned r; asm volatile("v_cvt_pk_bf16_f32 %0, %1, %2" : "=v"(r) : "v"(lo), "v"(hi)); return r; }
typedef float f32x2 __attribute__((ext_vector_type(2)));
__device__ __forceinline__ f32x2 gelu_pk(f32x2 v) {
    const f32x2 av = __builtin_elementwise_abs(v), d = av * 0.2316418882f + 1.0f;
    f32x2 t; t.x = __builtin_amdgcn_rcpf(d.x); t.y = __builtin_amdgcn_rcpf(d.y);
    f32x2 q = t * 0.5307027145f + (-0.7265760135f); q = q * t + 0.7107068705f; q = q * t + (-0.142248368f); q = q * t + 0.127414796f; q = q * t;
    const f32x2 s = (v * v) * (-0.72134752044f);
    f32x2 e; e.x = __builtin_amdgcn_exp2f(s.x); e.y = __builtin_amdgcn_exp2f(s.y);
    const f32x2 m = v * (q * e), r = v - m;
    f32x2 o; o.x = v.x < 0.f ? m.x : r.x; o.y = v.y < 0.f ? m.y : r.y; return o;
}

template <int ACT  > struct EpiBf16 {
    static constexpr bool PERM = true, AFTER_DRAIN = false; static_assert(ACT == 0 || ACT == 1, "EpiBf16: ACT is 0 (none) or 1 (gelu_pk)");
    bf16_t* O; int ldc; const float* bias; int split_cols; size_t split_stride; float scale0;
    __device__ __forceinline__ void operator()(const f32x4 (&acc)[2][2][4][2], const Unit& u, int wr, int wc, int fr, int fq) const {
        const int row0 = u.pm * BM + wr * 64 + fr; int colt = u.pn * BM; bf16_t* base = O;
        float sc = 1.f; if (split_cols) { const int t = colt / split_cols; base += (size_t)t * split_stride; colt -= t * split_cols; if (t == 0) sc = scale0; }
        const int col0 = colt + wc * 32 + 8 * fq, bcol0 = u.pn * BM + wc * 32 + 8 * fq;
        f32x4 bv[2][2];
#pragma unroll
        for (int bj = 0; bj < 2; ++bj)
#pragma unroll
            for (int n = 0; n < 2; ++n) bv[bj][n] = bias ? *(const f32x4*)(bias + bcol0 + bj * HALF + 4 * n) : (f32x4){0.f, 0.f, 0.f, 0.f};
#pragma unroll
        for (int ai = 0; ai < 2; ++ai)
#pragma unroll
            for (int m = 0; m < 4; ++m) { bf16_t* rowp = base + (size_t)(row0 + ai * HALF + m * 16) * ldc + col0;
#pragma unroll
                for (int bj = 0; bj < 2; ++bj) { f32x4 v0 = acc[ai][bj][m][0] + bv[bj][0], v1 = acc[ai][bj][m][1] + bv[bj][1];
                    if (ACT == 1) { f32x2 a = gelu_pk((f32x2){v0[0], v0[1]}), b = gelu_pk((f32x2){v0[2], v0[3]}), c = gelu_pk((f32x2){v1[0], v1[1]}), d = gelu_pk((f32x2){v1[2], v1[3]});
                        v0 = (f32x4){a.x, a.y, b.x, b.y}; v1 = (f32x4){c.x, c.y, d.x, d.y}; }
                    v0 = v0 * sc; v1 = v1 * sc; u32x4 w; w.x = cvt_pk_bf16(v0[0], v0[1]); w.y = cvt_pk_bf16(v0[2], v0[3]); w.z = cvt_pk_bf16(v1[0], v1[1]); w.w = cvt_pk_bf16(v1[2], v1[3]);
                    *(u32x4*)(rowp + bj * HALF) = w; } }
    }
};
__device__ __forceinline__ float rs_from_ss(const float* p) { const f32x4 a = ((const f32x4*)p)[0], b = ((const f32x4*)p)[1], c = ((const f32x4*)p)[2], d = ((const f32x4*)p)[3];
    const float ss = (((a[0] + a[1]) + (a[2] + a[3])) + ((b[0] + b[1]) + (b[2] + b[3]))) + (((c[0] + c[1]) + (c[2] + c[3])) + ((d[0] + d[1]) + (d[2] + d[3])));
    return __builtin_amdgcn_rsqf(ss * (1.0f / 1024.0f) + 1e-6f); }
__device__ __forceinline__ float sum_fq4(float s) {
    { auto rr = __builtin_amdgcn_permlane16_swap(__float_as_uint(s), __float_as_uint(s), false, false); s = __uint_as_float(rr[0]) + __uint_as_float(rr[1]); }
    { auto rr = __builtin_amdgcn_permlane32_swap(__float_as_uint(s), __float_as_uint(s), false, false); s = __uint_as_float(rr[0]) + __uint_as_float(rr[1]); }
    return s; }
#define EPI_ROW_SCALES(rs_, rowss_, row0_) do { f32x4 q_[8]; \
    _Pragma("unroll") for (int i_ = 0; i_ < 8; ++i_) q_[i_] = *(const f32x4*)((rowss_) + (size_t)((row0_) + (i_ >> 2) * HALF + (i_ & 3) * 16) * 16 + fq * 4); \
    _Pragma("unroll") for (int i_ = 0; i_ < 8; ++i_) { float s_ = sum_fq4((q_[i_][0] + q_[i_][1]) + (q_[i_][2] + q_[i_][3])); \
        rs_[i_] = __builtin_amdgcn_rsqf(s_ * (1.0f / 1024.0f) + 1e-6f); } } while (0)
struct EpiGateUp {
    static constexpr bool PERM = true, AFTER_DRAIN = false;
    bf16_t* H; const float* rowss; const PG8_LAS float* tab; int pm0;
    __device__ __forceinline__ void operator()(const f32x4 (&acc)[2][2][4][2], const Unit& u, int wr, int wc, int fr, int fq) const {
        const int row0 = u.pm * BM + wr * 64 + fr; const int col0 = u.pn * HALF + wc * 32 + 8 * fq;
        float rs[8];
        if (u.pm == pm0) {
#pragma unroll
            for (int i = 0; i < 8; ++i) rs[i] = tab[wr * 64 + fr + (i >> 2) * HALF + (i & 3) * 16]; }
        else EPI_ROW_SCALES(rs, rowss, row0);
#pragma unroll
        for (int ai = 0; ai < 2; ++ai)
#pragma unroll
            for (int m = 0; m < 4; ++m) { const int row = row0 + ai * HALF + m * 16; const float r = rs[ai * 4 + m];
                float hv[8];
#pragma unroll
                for (int n = 0; n < 2; ++n)
#pragma unroll
                    for (int e = 0; e < 4; ++e) { const float g = acc[ai][0][m][n][e] * r, up = acc[ai][1][m][n][e] * r;
                        const float sg = g * __builtin_amdgcn_rcpf(1.0f + __builtin_amdgcn_exp2f(g * -1.4426950408889634f)); hv[n * 4 + e] = sg * up; }
                u32x4 w; w.x = cvt_pk_bf16(hv[0], hv[1]); w.y = cvt_pk_bf16(hv[2], hv[3]); w.z = cvt_pk_bf16(hv[4], hv[5]); w.w = cvt_pk_bf16(hv[6], hv[7]);
                *(u32x4*)(H + (size_t)row * 2816 + col0) = w; }
    }
};
struct EpiResidBf {
    static constexpr bool PERM = true, AFTER_DRAIN = false;
    typedef __attribute__((address_space(1))) u32x4 gu32x4; typedef unsigned u32x2 __attribute__((ext_vector_type(2))); typedef __attribute__((address_space(1))) u32x2 gu32x2;
    __attribute__((address_space(1))) bf16_t* xb; __attribute__((address_space(1))) unsigned char* xl; float* rowss_next; float alpha;
    __device__ __forceinline__ void operator()(const f32x4 (&acc)[2][2][4][2], const Unit& u, int wr, int wc, int fr, int fq) const {
        const int row0 = u.pm * BM + wr * 64 + fr; const int col0 = u.pn * BM + wc * 32 + 8 * fq;
        u32x4 xa[4][2]; u32x2 la[4][2];
#define EPB_LD(ai_) do { _Pragma("unroll") for (int m = 0; m < 4; ++m) _Pragma("unroll") for (int bj = 0; bj < 2; ++bj) { const size_t off = (size_t)(row0 + (ai_) * HALF + m * 16) * 1024 + col0 + bj * HALF; \
            xa[m][bj] = *(const gu32x4*)(xb + off); la[m][bj] = *(const gu32x2*)(xl + off); } } while (0)
#define EPB_ST(ai_) do { _Pragma("unroll") for (int m = 0; m < 4; ++m) { const int row = row0 + (ai_) * HALF + m * 16; float ss = 0.f; \
            _Pragma("unroll") for (int bj = 0; bj < 2; ++bj) { const u32x4 x = xa[m][bj]; const u32x2 lw = la[m][bj]; const size_t off = (size_t)row * 1024 + col0 + bj * HALF; \
                const f32x2 l0 = __builtin_amdgcn_cvt_pk_f32_bf8((int)lw.x, false), l1 = __builtin_amdgcn_cvt_pk_f32_bf8((int)lw.x, true), l2 = __builtin_amdgcn_cvt_pk_f32_bf8((int)lw.y, false), l3 = __builtin_amdgcn_cvt_pk_f32_bf8((int)lw.y, true); \
                const f32x4 a0 = (f32x4){__builtin_bit_cast(float, x.x << 16) + l0.x, __builtin_bit_cast(float, x.x & 0xffff0000u) + l0.y, __builtin_bit_cast(float, x.y << 16) + l1.x, __builtin_bit_cast(float, x.y & 0xffff0000u) + l1.y}; \
                const f32x4 a1 = (f32x4){__builtin_bit_cast(float, x.z << 16) + l2.x, __builtin_bit_cast(float, x.z & 0xffff0000u) + l2.y, __builtin_bit_cast(float, x.w << 16) + l3.x, __builtin_bit_cast(float, x.w & 0xffff0000u) + l3.y}; \
                const f32x4 v0 = a0 + acc[ai_][bj][m][0] * alpha, v1 = a1 + acc[ai_][bj][m][1] * alpha; \
                ss += (v0[0] * v0[0] + v0[1] * v0[1]) + (v0[2] * v0[2] + v0[3] * v0[3]) + (v1[0] * v1[0] + v1[1] * v1[1]) + (v1[2] * v1[2] + v1[3] * v1[3]); \
                u32x4 w; w.x = cvt_pk_bf16(v0[0], v0[1]); w.y = cvt_pk_bf16(v0[2], v0[3]); w.z = cvt_pk_bf16(v1[0], v1[1]); w.w = cvt_pk_bf16(v1[2], v1[3]); \
                *(gu32x4*)(xb + off) = w; \
                int e0 = __builtin_amdgcn_cvt_pk_bf8_f32(v0[0] - __builtin_bit_cast(float, w.x << 16), v0[1] - __builtin_bit_cast(float, w.x & 0xffff0000u), 0, false); \
                e0 = __builtin_amdgcn_cvt_pk_bf8_f32(v0[2] - __builtin_bit_cast(float, w.y << 16), v0[3] - __builtin_bit_cast(float, w.y & 0xffff0000u), e0, true); \
                int e1 = __builtin_amdgcn_cvt_pk_bf8_f32(v1[0] - __builtin_bit_cast(float, w.z << 16), v1[1] - __builtin_bit_cast(float, w.z & 0xffff0000u), 0, false); \
                e1 = __builtin_amdgcn_cvt_pk_bf8_f32(v1[2] - __builtin_bit_cast(float, w.w << 16), v1[3] - __builtin_bit_cast(float, w.w & 0xffff0000u), e1, true); \
                *(gu32x2*)(xl + off) = (u32x2){(unsigned)e0, (unsigned)e1}; } \
            ss = sum_fq4(ss); \
            if (fq == 0) rowss_next[(size_t)row * 16 + u.pn * 4 + wc] = ss; } } while (0)
        EPB_LD(0); __builtin_amdgcn_sched_barrier(0);
        EPB_ST(0); __builtin_amdgcn_sched_barrier(0);
        EPB_LD(1); __builtin_amdgcn_sched_barrier(0);
        EPB_ST(1);
#undef EPB_LD
#undef EPB_ST
    }
};
struct EpiQKVU {
    static constexpr bool PERM = true, AFTER_DRAIN = false;
    bf16_t* O; const float* rowss; const float* rope; const PG8_LAS float* tab; int pm0;
    __device__ __forceinline__ void operator()(const f32x4 (&acc)[2][2][4][2], const Unit& u, int wr, int wc, int fr, int fq) const {
        const int row0 = u.pm * BM + wr * 64 + fr; const int col0 = u.pn * BM + wc * 32 + 8 * fq; const int sec = u.pn >> 1;
        const int j0 = 16 * (wc & 1) + 4 * fq;
        float rs[8];
        if (u.pm == pm0) {
#pragma unroll
            for (int i = 0; i < 8; ++i) rs[i] = tab[wr * 64 + fr + (i >> 2) * HALF + (i & 3) * 16]; }
        else EPI_ROW_SCALES(rs, rowss, row0);
#pragma unroll
        for (int ai = 0; ai < 2; ++ai) {
            f32x4 cs[4][2];
#pragma unroll
            for (int m = 0; m < 4; ++m) { cs[m][0] = (f32x4){1.f, 0.f, 1.f, 0.f}; cs[m][1] = cs[m][0];
                if (sec < 2) { const f32x4* rp = (const f32x4*)(rope + ((size_t)(row0 + ai * HALF + m * 16) * 32 + j0) * 2); cs[m][0] = rp[0]; cs[m][1] = rp[1]; } }
#pragma unroll
            for (int m = 0; m < 4; ++m) { const int row = row0 + ai * HALF + m * 16; float r = rs[ai * 4 + m]; if (sec == 0) r *= 0.125f * 1.4426950408889634f;
                const f32x4 cs0 = cs[m][0], cs1 = cs[m][1];
#pragma unroll
                for (int bj = 0; bj < 2; ++bj) { const f32x4 v0 = acc[ai][bj][m][0] * r, v1 = acc[ai][bj][m][1] * r;
                    const float o0 = v0[0] * cs0[0] - v0[1] * cs0[1], o1 = v0[1] * cs0[0] + v0[0] * cs0[1];
                    const float o2 = v0[2] * cs0[2] - v0[3] * cs0[3], o3 = v0[3] * cs0[2] + v0[2] * cs0[3];
                    const float o4 = v1[0] * cs1[0] - v1[1] * cs1[1], o5 = v1[1] * cs1[0] + v1[0] * cs1[1];
                    const float o6 = v1[2] * cs1[2] - v1[3] * cs1[3], o7 = v1[3] * cs1[2] + v1[2] * cs1[3];
                    u32x4 w; w.x = cvt_pk_bf16(o0, o1); w.y = cvt_pk_bf16(o2, o3); w.z = cvt_pk_bf16(o4, o5); w.w = cvt_pk_bf16(o6, o7);
                    *(u32x4*)(O + (size_t)row * 2112 + col0 + bj * HALF) = w; } } }
    }
};

template <class Epi, class Sched, bool ALIGN_EPI = false, bool SP2 = false>
__device__ __forceinline__ void gemm_phase(PG8_LAS unsigned char* lds, const Gemm g, const Sched& S, const Epi& E) {
    int tid_ = threadIdx.x; asm volatile("" : "+v"(tid_));
    const int tid = tid_, wid = __builtin_amdgcn_readfirstlane(tid >> 6), lane = tid & 63, wr = wid >> 2, wc = wid & 3, fr = lane & 15, fq = lane >> 4;
    const int K = g.K, nt = K / BK;
    unsigned voffA[2], voffB[2];
#pragma unroll
    for (int i = 0; i < 2; ++i) { int R, C; stage_rc(tid * 16 + i * 8192, R, C); const int Rb = Epi::PERM ? ((R & ~31) + perm32(R & 31)) : R;
        voffA[i] = (unsigned)(R * K + C) * 2u; voffB[i] = (unsigned)(Rb * K + C) * 2u; }
    const size_t kstep = (size_t)(BK * 2);
    const size_t hstep = (size_t)HALF * K * 2;
    const size_t tstep = 2 * hstep;
    const unsigned ldsw = (unsigned)wid * 1024u;
    const int aoff = lds_byte(wr * 64 + fr, fq * 8), boff = lds_byte(wc * 32 + fr, fq * 8);
#define PG8_SA(b, h) (((b) * 2 + (h)) * HTB)
#define PG8_SB(b, h) ((4 + (b) * 2 + (h)) * HTB)
#define PG8_STAGE(bufoff, gbase, voff) do { _Pragma("unroll") for (int _i = 0; _i < 2; ++_i) \
        __builtin_amdgcn_global_load_lds((const unsigned*)((const char*)(gbase) + (voff)[_i]), (PG8_LAS unsigned*)(lds + (bufoff) + ldsw + _i * 8192), 16, 0, 0); } while (0)
#define PG8_LDA(dst, b, h) do { _Pragma("unroll") for (int m = 0; m < 4; ++m) _Pragma("unroll") for (int k = 0; k < 2; ++k) dst[m][k] = *(const PG8_LAS bf16x8*)(lds + PG8_SA(b, h) + aoff + m * 2048 + k * 1024); } while (0)
#define PG8_LDB(dst, b, h) do { _Pragma("unroll") for (int n = 0; n < 2; ++n) _Pragma("unroll") for (int k = 0; k < 2; ++k) dst[n][k] = *(const PG8_LAS bf16x8*)(lds + PG8_SB(b, h) + boff + n * 2048 + k * 1024); } while (0)
#define PG8_MMA(ai, bj, At, Bt) do { __builtin_amdgcn_s_setprio(1); _Pragma("unroll") for (int m = 0; m < 4; ++m) _Pragma("unroll") for (int n = 0; n < 2; ++n) _Pragma("unroll") for (int k = 0; k < 2; ++k) \
        acc[ai][bj][m][n] = __builtin_amdgcn_mfma_f32_16x16x32_bf16(Bt[n][k], At[m][k], acc[ai][bj][m][n], 0, 0, 0); __builtin_amdgcn_s_setprio(0); } while (0)
#define PG8_WAIT_V(n) asm volatile("s_waitcnt vmcnt(" #n ")" ::: "memory")
#define PG8_WAIT_L(n) asm volatile("s_waitcnt lgkmcnt(" #n ")" ::: "memory")
#define PG8_BAR __builtin_amdgcn_s_barrier()
#define PG8_SCHED __builtin_amdgcn_sched_barrier(0)
    Unit cur, nxt; int ui = 0;
    if (!S.next(0, cur)) return;
    f32x4 acc[2][2][4][2];
#pragma unroll
    for (int a = 0; a < 2; ++a)
#pragma unroll
        for (int b = 0; b < 2; ++b)
#pragma unroll
            for (int m = 0; m < 4; ++m)
#pragma unroll
                for (int n = 0; n < 2; ++n) acc[a][b][m][n] = (f32x4){0.f, 0.f, 0.f, 0.f};
    bf16x8 At[4][2], B0[2][2], B1[2][2];
    const char* cA = (const char*)g.A + (size_t)cur.pm * tstep; const char* cB = (const char*)g.Bt + (size_t)cur.pn * tstep;
    S.a_ready(cur);
    if constexpr (SP2) {
        PG8_STAGE(PG8_SB(0, 0), cB, voffB); PG8_STAGE(PG8_SB(0, 1), cB + hstep, voffB); PG8_STAGE(PG8_SA(0, 0), cA, voffA); PG8_STAGE(PG8_SA(0, 1), cA + hstep, voffA);
        if (wr == 1) PG8_BAR;
        PG8_WAIT_V(2); PG8_BAR;
        PG8_STAGE(PG8_SB(1, 0), cB + kstep, voffB); PG8_STAGE(PG8_SA(1, 0), cA + kstep, voffA); PG8_STAGE(PG8_SB(1, 1), cB + hstep + kstep, voffB);
        PG8_WAIT_V(6); PG8_BAR;
    } else {
        PG8_STAGE(PG8_SB(0, 0), cB, voffB); PG8_STAGE(PG8_SA(0, 0), cA, voffA); PG8_STAGE(PG8_SB(0, 1), cB + hstep, voffB); PG8_STAGE(PG8_SA(0, 1), cA + hstep, voffA);
        if (wr == 1) PG8_BAR;
        PG8_WAIT_V(4); PG8_BAR;
        PG8_STAGE(PG8_SB(1, 0), cB + kstep, voffB); PG8_STAGE(PG8_SA(1, 0), cA + kstep, voffA); PG8_STAGE(PG8_SB(1, 1), cB + hstep + kstep, voffB);
        PG8_WAIT_V(6); PG8_BAR;
    }
    for (;;) {
        const bool has_next = S.next(ui + 1, nxt);
        const char* nA = has_next ? (const char*)g.A + (size_t)nxt.pm * tstep : cA; const char* nB = has_next ? (const char*)g.Bt + (size_t)nxt.pn * tstep : cB;
        for (int t = 0; t < nt; t += 2) {
            const bool last = (t == nt - 2);
            const char* a1 = cA + (size_t)(t + 1) * kstep;
            const char* a2 = last ? nA : cA + (size_t)(t + 2) * kstep; const char* b2 = last ? nB : cB + (size_t)(t + 2) * kstep;
            const char* a3 = a2 + kstep; const char* b3 = b2 + kstep;
            if (last && has_next) S.a_ready(nxt);
            if constexpr (SP2) {
            PG8_LDB(B0, 0, 0); PG8_LDB(B1, 0, 1); PG8_SCHED; PG8_LDA(At, 0, 0); PG8_STAGE(PG8_SA(1, 1), a1 + hstep, voffA);
            PG8_WAIT_V(8); PG8_WAIT_L(0); PG8_BAR; PG8_MMA(0, 0, At, B0); PG8_MMA(0, 1, At, B1); PG8_BAR; PG8_SCHED;
            PG8_LDA(At, 0, 1); PG8_STAGE(PG8_SB(0, 0), b2, voffB); PG8_STAGE(PG8_SB(0, 1), b2 + hstep, voffB); PG8_STAGE(PG8_SA(0, 0), a2, voffA);
            PG8_WAIT_V(8); PG8_WAIT_L(0); PG8_BAR; PG8_MMA(1, 0, At, B0); PG8_MMA(1, 1, At, B1); PG8_BAR; PG8_SCHED;
            PG8_LDB(B0, 1, 0); PG8_LDB(B1, 1, 1); PG8_SCHED; PG8_LDA(At, 1, 0); PG8_STAGE(PG8_SA(0, 1), a2 + hstep, voffA);
            PG8_WAIT_V(8); PG8_WAIT_L(0); PG8_BAR; PG8_MMA(0, 0, At, B0); PG8_MMA(0, 1, At, B1); PG8_BAR; PG8_SCHED;
            PG8_LDA(At, 1, 1); PG8_STAGE(PG8_SB(1, 0), b3, voffB); PG8_STAGE(PG8_SB(1, 1), b3 + hstep, voffB); PG8_STAGE(PG8_SA(1, 0), a3, voffA);
            PG8_WAIT_V(8); PG8_WAIT_L(0); PG8_BAR; PG8_MMA(1, 0, At, B0); PG8_MMA(1, 1, At, B1); PG8_BAR; PG8_SCHED;
            } else {
            PG8_LDB(B0, 0, 0); PG8_SCHED; PG8_LDA(At, 0, 0); PG8_STAGE(PG8_SA(1, 1), a1 + hstep, voffA);
            PG8_WAIT_L(8); PG8_BAR; PG8_WAIT_L(0); PG8_MMA(0, 0, At, B0); PG8_BAR; PG8_SCHED;
            PG8_LDB(B1, 0, 1); PG8_STAGE(PG8_SB(0, 0), b2, voffB);
            PG8_BAR; PG8_WAIT_L(0); PG8_MMA(0, 1, At, B1); PG8_BAR;
            PG8_LDA(At, 0, 1); PG8_STAGE(PG8_SA(0, 0), a2, voffA);
            PG8_BAR; PG8_WAIT_L(0); PG8_MMA(1, 0, At, B0); PG8_BAR; PG8_SCHED;
            PG8_STAGE(PG8_SB(0, 1), b2 + hstep, voffB);
            PG8_WAIT_V(6); PG8_BAR; PG8_MMA(1, 1, At, B1); PG8_BAR;
            PG8_LDB(B0, 1, 0); PG8_SCHED; PG8_LDA(At, 1, 0); PG8_STAGE(PG8_SA(0, 1), a2 + hstep, voffA);
            PG8_WAIT_L(8); PG8_BAR; PG8_WAIT_L(0); PG8_MMA(0, 0, At, B0); PG8_BAR; PG8_SCHED;
            PG8_LDB(B1, 1, 1); PG8_STAGE(PG8_SB(1, 0), b3, voffB);
            PG8_BAR; PG8_WAIT_L(0); PG8_MMA(0, 1, At, B1); PG8_BAR;
            PG8_LDA(At, 1, 1); PG8_STAGE(PG8_SA(1, 0), a3, voffA);
            PG8_BAR; PG8_WAIT_L(0); PG8_MMA(1, 0, At, B0); PG8_BAR; PG8_SCHED;
            PG8_STAGE(PG8_SB(1, 1), b3 + hstep, voffB);
            PG8_WAIT_V(6); PG8_BAR; PG8_MMA(1, 1, At, B1); PG8_BAR;
            }
        }
        if constexpr (ALIGN_EPI) { if (wr == 0) PG8_BAR; }
        if constexpr (!Epi::AFTER_DRAIN) { E(acc, cur, wr, wc, fr, fq); S.done(cur); }
        if (!has_next) break;
#pragma unroll
        for (int a = 0; a < 2; ++a)
#pragma unroll
            for (int b = 0; b < 2; ++b)
#pragma unroll
                for (int m = 0; m < 4; ++m)
#pragma unroll
                    for (int n = 0; n < 2; ++n) acc[a][b][m][n] = (f32x4){0.f, 0.f, 0.f, 0.f};
        cur = nxt; cA = nA; cB = nB; ++ui;
        if constexpr (ALIGN_EPI) { if (wr == 1) PG8_BAR; }
    }
    PG8_WAIT_V(0);
    if constexpr (!ALIGN_EPI) { if (wr == 0) PG8_BAR; }
    PG8_BAR;
    if constexpr (Epi::AFTER_DRAIN) { E.fused(acc, cur, wr, wc, fr, fq, lds, wid, lane); S.done(cur); }
#undef PG8_SA
#undef PG8_SB
#undef PG8_STAGE
#undef PG8_LDA
#undef PG8_LDB
#undef PG8_MMA
#undef PG8_WAIT_V
#undef PG8_WAIT_L
#undef PG8_BAR
#undef PG8_SCHED
}
}

#ifndef PG8_SP2
#define PG8_SP2 true
#endif
#ifndef PG8_ALIGN
#define PG8_ALIGN true
#endif
#include <hip/hip_bf16.h>
#include <cmath>
namespace attn_body {
using bf16=__hip_bfloat16;
using bf16x8=__attribute__((ext_vector_type(8)))short;
using s16x4=__attribute__((ext_vector_type(4)))short;
using f32x16=__attribute__((ext_vector_type(16)))float;
using u32x4=__attribute__((ext_vector_type(4)))unsigned;
constexpr int BATCH=1,NHEAD=16,SEQ=16384,D=64,DM=2112,DMO=1024;
constexpr int NW=8,QBLK=32,QB=QBLK*NW,KVBLK=64,NQB=SEQ/QB;
constexpr int ATTN_PITCH=DM, ATTN_UNIT_ROWS=QB;
__device__ __forceinline__ int crow(int r,int hi){return (r&3)+8*(r>>2)+4*hi;}
#define SBAR() __builtin_amdgcn_sched_barrier(0)
__device__ __forceinline__ void cmask(f32x16&p0,f32x16&p1,int jb,int qrel,int hi){
  const float NEG=-INFINITY; int kb=64*jb+4*hi;
  #pragma unroll
  for(int r=0;r<16;++r){int kv=kb+(r&3)+8*(r>>2); if(kv>qrel)p0[r]=NEG; if(kv+32>qrel)p1[r]=NEG;}
}

constexpr int NSLOT=3, SLOTB=8192;
constexpr int NVSLOT=3, VSLOTB=16384;
constexpr int LDS_K=0, LDS_V=NSLOT*SLOTB, LDS_P=LDS_V+NVSLOT*VSLOTB, LDS_WS=LDS_P+NW*8192, WSF_STRIDE=64, LDS_BYTES=LDS_WS+NW*WSF_STRIDE*4;
constexpr float C2=0.125f*1.4426950408889634f;
__device__ __forceinline__ void glds16(const void*gsrc,unsigned lds_dst){unsigned keep;
  asm volatile("s_mov_b32 %0, m0\n\ts_mov_b32 m0, %2\n\ts_nop 0\n\tglobal_load_lds_dwordx4 %1, off\n\ts_mov_b32 m0, %0":"=&s"(keep):"v"(gsrc),"s"(lds_dst):"memory");}
__device__ __forceinline__ float max3f(float a,float b,float c){float r;asm("v_max3_f32 %0, %1, %2, %3":"=v"(r):"v"(a),"v"(b),"v"(c));return r;}
__device__ __forceinline__ float max2f(float a,float b){float r;asm("v_max_f32_e32 %0, %1, %2":"=v"(r):"v"(a),"v"(b));return r;}
__device__ __forceinline__ float fadd_s(float a,float b){float r;asm("v_add_f32_e32 %0, %1, %2":"=v"(r):"v"(a),"v"(b));return r;}
__device__ __forceinline__ float fsub_s(float a,float b){float r;asm("v_sub_f32_e32 %0, %1, %2":"=v"(r):"v"(a),"v"(b));return r;}
typedef float f32x2_t __attribute__((ext_vector_type(2))); typedef __bf16 bf16x2_t __attribute__((ext_vector_type(2)));
__device__ __forceinline__ unsigned cvtpk_s(float lo,float hi){f32x2_t v={lo,hi};bf16x2_t b=__builtin_convertvector(v,bf16x2_t);return __builtin_bit_cast(unsigned,b);}
#define WAIT_BAR(N) asm volatile("s_waitcnt vmcnt(" #N ") lgkmcnt(0)\n\ts_barrier":::"memory")

__device__ __forceinline__ void qkt(f32x16&p0,f32x16&p1,const char*Kslot,const bf16x8*qr,const f32x16&negm,int r32,int hi){
  const char*kb=Kslot+hi*1024+r32*16;
  #pragma unroll
  for(int d0=0;d0<4;++d0){
    const bf16x8 b0=*reinterpret_cast<const bf16x8*>(kb+d0*2048);
    const bf16x8 b1=*reinterpret_cast<const bf16x8*>(kb+d0*2048+512);
    if(d0==0){p0=__builtin_amdgcn_mfma_f32_32x32x16_bf16(b0,qr[0],negm,0,0,0);p1=__builtin_amdgcn_mfma_f32_32x32x16_bf16(b1,qr[0],negm,0,0,0);}
    else{p0=__builtin_amdgcn_mfma_f32_32x32x16_bf16(b0,qr[d0],p0,0,0,0);p1=__builtin_amdgcn_mfma_f32_32x32x16_bf16(b1,qr[d0],p1,0,0,0);}}
}
typedef __attribute__((address_space(3))) const char* lds_cptr;
typedef short v4i16_t __attribute__((ext_vector_type(4)));
__device__ __forceinline__ void kload8(bf16x8*kf,lds_cptr kp){
  kf[0]=*(const __attribute__((address_space(3))) bf16x8*)(kp);      kf[1]=*(const __attribute__((address_space(3))) bf16x8*)(kp+512);
  kf[2]=*(const __attribute__((address_space(3))) bf16x8*)(kp+2048); kf[3]=*(const __attribute__((address_space(3))) bf16x8*)(kp+2560);
  kf[4]=*(const __attribute__((address_space(3))) bf16x8*)(kp+4096); kf[5]=*(const __attribute__((address_space(3))) bf16x8*)(kp+4608);
  kf[6]=*(const __attribute__((address_space(3))) bf16x8*)(kp+6144); kf[7]=*(const __attribute__((address_space(3))) bf16x8*)(kp+6656);
}
__device__ __forceinline__ void kload2(bf16x8*kf,lds_cptr kp,int j){ kf[2*j]=*(const __attribute__((address_space(3))) bf16x8*)(kp+j*2048); kf[2*j+1]=*(const __attribute__((address_space(3))) bf16x8*)(kp+j*2048+512); }
__device__ __forceinline__ s16x4 vtr(lds_cptr p){ return __builtin_bit_cast(s16x4,__builtin_amdgcn_ds_read_tr16_b64_v4i16((__attribute__((address_space(3))) v4i16_t*)p)); }
__device__ __forceinline__ float rowmax(const f32x16&p0,const f32x16&p1){
  float a=max3f(p0[0],p0[1],p1[0]),b=max3f(p0[2],p0[3],p1[1]);a=max3f(a,p1[2],p1[3]);
  #pragma unroll
  for(int r=4;r<16;r+=4){a=max3f(a,p0[r],p0[r+1]);b=max3f(b,p0[r+2],p0[r+3]);a=max3f(a,p1[r],p1[r+1]);b=max3f(b,p1[r+2],p1[r+3]);}
  const float m=max2f(a,b);
  auto rr=__builtin_amdgcn_permlane32_swap(__float_as_uint(m),__float_as_uint(m),false,false);
  return max2f(__uint_as_float(rr[0]),__uint_as_float(rr[1]));
}
__device__ __forceinline__ void pv(f32x16*o,int vb,bf16x8 pa0,bf16x8 pa1,bf16x8 pa2,bf16x8 pa3){
  #pragma unroll
  for(int d0=0;d0<2;++d0){s16x4 lo[4],hi[4];
    #pragma unroll
    for(int ks=0;ks<4;++ks){
      asm volatile("ds_read_b64_tr_b16 %0,%1 offset:%c2":"=&v"(lo[ks]):"v"(vb),"i"(d0*4096+ks*1024):"memory");
      asm volatile("ds_read_b64_tr_b16 %0,%1 offset:%c2":"=&v"(hi[ks]):"v"(vb),"i"(d0*4096+ks*1024+512):"memory");}
    asm volatile("s_waitcnt lgkmcnt(0)":::"memory");SBAR();
    #define PK(k) (bf16x8){lo[k][0],lo[k][1],lo[k][2],lo[k][3],hi[k][0],hi[k][1],hi[k][2],hi[k][3]}
    o[d0]=__builtin_amdgcn_mfma_f32_32x32x16_bf16(pa0,PK(0),o[d0],0,0,0);
    o[d0]=__builtin_amdgcn_mfma_f32_32x32x16_bf16(pa1,PK(1),o[d0],0,0,0);
    o[d0]=__builtin_amdgcn_mfma_f32_32x32x16_bf16(pa2,PK(2),o[d0],0,0,0);
    o[d0]=__builtin_amdgcn_mfma_f32_32x32x16_bf16(pa3,PK(3),o[d0],0,0,0);
    #undef PK
  }
}

#ifndef ATTN_STORE16
#define ATTN_STORE16(p,v) (*(u32x4*)(p)=(v))
#endif
template<int THRL> __device__ __forceinline__ void attn_unit(int qb,const bf16*Q,const bf16*__restrict__ K,const bf16*__restrict__ V,bf16*O,char*shm){
  int tid_=threadIdx.x; asm volatile("":"+v"(tid_)); const int tid=tid_,lane=tid&63,r32=lane&31,hi=lane>>5; const int wid=__builtin_amdgcn_readfirstlane(tid>>6);
  const int q0=qb*QB;
  const unsigned lds0=(unsigned)(uintptr_t)shm;
  float*wsf=(float*)(shm+LDS_WS)+wid*WSF_STRIDE;
  const bf16*ksrc=K+(long)lane*DM+wid*8;
  const bf16*vsrc=V+(long)(16*(wid&3)+(lane>>2))*DM+(wid>>2)*32+(lane&3)*8;
  const unsigned kdst=lds0+LDS_K+wid*1024, vdst=lds0+LDS_V+wid*1024;
  #define DMA_K(t,s3) glds16(ksrc+(long)(t)*KVBLK*DM,(unsigned)__builtin_amdgcn_readfirstlane(kdst+(s3)*SLOTB))
  #define DMA_V(t,s3) do{ const unsigned vd_=(unsigned)__builtin_amdgcn_readfirstlane(vdst+(s3)*VSLOTB); glds16(vsrc+(long)(t)*KVBLK*DM,vd_); glds16(vsrc+(long)(t)*KVBLK*DM+64,(unsigned)__builtin_amdgcn_readfirstlane(vd_+8192)); }while(0)
  const lds_cptr shm3=(lds_cptr)shm;
  const int NT=(q0+QB)/KVBLK;
  DMA_K(0,0);DMA_V(0,0);DMA_K(1,1);DMA_V(1,1);
  int c0=0,c1=1,c2=2;
  #define ROT3() do{ const int x_=c0; c0=c1; c1=c2; c2=x_; }while(0)
  #define PKW(P,B) cvtpk_s(P[B],P[B+1])
  #define MX3(a,b,c) __builtin_fmaxf(__builtin_fmaxf((a),(b)),(c))
  const bf16*Qw=Q+(long)(q0+wid*QBLK)*DM;
  bf16x8 qr[4];
  #pragma unroll
  for(int d0=0;d0<4;++d0)qr[d0]=*reinterpret_cast<const bf16x8*>(&Qw[(long)r32*DM+d0*16+hi*8]);
  float mhat=0.f,l_reg=0.f; f32x16 negm=f32x16{};
  f32x16 o[4]; o[0]=f32x16{};o[1]=f32x16{};o[2]=f32x16{};o[3]=f32x16{};
  const int qrel=wid*QBLK+r32;
  const lds_cptr kp0=shm3+LDS_K+hi*1024+r32*16;
  const lds_cptr vp0=shm3+LDS_V+((lane>>4)&1)*32+(lane&3)*8+(4*hi+((lane&15)>>2))*64;
  WAIT_BAR(3);
  for(int t=0;t<NT;++t){
    if(t+2<NT){DMA_K(t+2,c2);DMA_V(t+2,c2);}
    bf16x8 kf[8]; kload8(kf,kp0+c0*SLOTB);
    SBAR();
    f32x16 C0,C1;
    {
      C0=__builtin_amdgcn_mfma_f32_32x32x16_bf16(kf[0],qr[0],negm,0,0,0); C1=__builtin_amdgcn_mfma_f32_32x32x16_bf16(kf[1],qr[0],negm,0,0,0);
      C0=__builtin_amdgcn_mfma_f32_32x32x16_bf16(kf[2],qr[1],C0,0,0,0);   C1=__builtin_amdgcn_mfma_f32_32x32x16_bf16(kf[3],qr[1],C1,0,0,0);
      C0=__builtin_amdgcn_mfma_f32_32x32x16_bf16(kf[4],qr[2],C0,0,0,0);   C1=__builtin_amdgcn_mfma_f32_32x32x16_bf16(kf[5],qr[2],C1,0,0,0);
      C0=__builtin_amdgcn_mfma_f32_32x32x16_bf16(kf[6],qr[3],C0,0,0,0);   C1=__builtin_amdgcn_mfma_f32_32x32x16_bf16(kf[7],qr[3],C1,0,0,0); }
    SBAR();
    const lds_cptr vp_=vp0+c0*VSLOTB; s16x4 vl_[8],vh_[8];
    #pragma unroll
    for(int k2=0;k2<2;++k2)
      #pragma unroll
      for(int d_=0;d_<4;++d_){ vl_[d_*2+k2]=vtr(vp_+(d_*4096+k2*1024)); vh_[d_*2+k2]=vtr(vp_+(d_*4096+k2*1024+512)); }
    SBAR();
    { const int jb_=t-(NT-4); if(jb_>=0)cmask(C0,C1,jb_,qrel,hi); }
    float a=MX3(C0[0],C0[1],C1[0]),b=MX3(C0[2],C0[3],C1[1]); a=MX3(a,C1[2],C1[3]);
    #pragma unroll
    for(int r=4;r<16;r+=4){a=MX3(a,C0[r],C0[r+1]);b=MX3(b,C0[r+2],C0[r+3]);a=MX3(a,C1[r],C1[r+1]);b=MX3(b,C1[r+2],C1[r+3]);}
    float rm=__builtin_fmaxf(a,b); { auto rr=__builtin_amdgcn_permlane32_swap(__float_as_uint(rm),__float_as_uint(rm),false,false); rm=__builtin_fmaxf(__uint_as_float(rr[0]),__uint_as_float(rr[1])); }
    if(t==0 || __any(rm>(float)THRL)){
      const float dl=(t==0)?rm:__builtin_fmaxf(rm,0.f); mhat+=dl;
      #pragma unroll
      for(int r=0;r<16;++r){C0[r]-=dl;C1[r]-=dl;}
      #pragma unroll
      for(int r=0;r<16;++r)negm[r]=-mhat;
      if(t!=0){ const float f=__builtin_amdgcn_exp2f(-dl); l_reg*=f; if(hi==0)wsf[r32]=f; asm volatile("s_waitcnt lgkmcnt(0)":::"memory");
        #pragma unroll
        for(int d_=0;d_<4;++d_)
          #pragma unroll
          for(int r=0;r<16;++r)o[d_][r]*=wsf[crow(r,hi)]; } }
    #pragma unroll
    for(int r=0;r<16;++r){C0[r]=__builtin_amdgcn_exp2f(C0[r]);C1[r]=__builtin_amdgcn_exp2f(C1[r]);}
    { float s0=C0[0]+C0[1],s1=C1[0]+C1[1];
      #pragma unroll
      for(int r=2;r<16;++r){s0+=C0[r];s1+=C1[r];}
      l_reg+=s0+s1; }
    const u32x4 pw0=(u32x4){PKW(C0,0),PKW(C0,2),PKW(C0,4),PKW(C0,6)},pw1=(u32x4){PKW(C0,8),PKW(C0,10),PKW(C0,12),PKW(C0,14)},pw2=(u32x4){PKW(C1,0),PKW(C1,2),PKW(C1,4),PKW(C1,6)},pw3=(u32x4){PKW(C1,8),PKW(C1,10),PKW(C1,12),PKW(C1,14)};
    SBAR();
    #define VFRAG(L_,H_,i_) (bf16x8){L_[i_][0],L_[i_][1],L_[i_][2],L_[i_][3],H_[i_][0],H_[i_][1],H_[i_][2],H_[i_][3]}
    s16x4 w2l_[4],w2h_[4],w3l_[4],w3h_[4];
    #pragma unroll
    for(int d_=0;d_<4;++d_){ w2l_[d_]=vtr(vp_+(d_*4096+2*1024)); w2h_[d_]=vtr(vp_+(d_*4096+2*1024+512)); }
    SBAR();
    #pragma unroll
    for(int d_=0;d_<4;++d_){ o[d_]=__builtin_amdgcn_mfma_f32_32x32x16_bf16(__builtin_bit_cast(bf16x8,pw0),VFRAG(vl_,vh_,d_*2),o[d_],0,0,0); }
    SBAR();
    #pragma unroll
    for(int d_=0;d_<4;++d_){ w3l_[d_]=vtr(vp_+(d_*4096+3*1024)); w3h_[d_]=vtr(vp_+(d_*4096+3*1024+512)); }
    SBAR();
    #pragma unroll
    for(int d_=0;d_<4;++d_){ o[d_]=__builtin_amdgcn_mfma_f32_32x32x16_bf16(__builtin_bit_cast(bf16x8,pw1),VFRAG(vl_,vh_,d_*2+1),o[d_],0,0,0); }
    #pragma unroll
    for(int d_=0;d_<4;++d_){ o[d_]=__builtin_amdgcn_mfma_f32_32x32x16_bf16(__builtin_bit_cast(bf16x8,pw2),VFRAG(w2l_,w2h_,d_),o[d_],0,0,0); }
    #pragma unroll
    for(int d_=0;d_<4;++d_){ o[d_]=__builtin_amdgcn_mfma_f32_32x32x16_bf16(__builtin_bit_cast(bf16x8,pw3),VFRAG(w3l_,w3h_,d_),o[d_],0,0,0); }
    SBAR();
    #undef VFRAG
    if(t+2<NT){WAIT_BAR(3);}else{WAIT_BAR(0);}
    ROT3();
  }
  { auto rr=__builtin_amdgcn_permlane32_swap(__float_as_uint(l_reg),__float_as_uint(l_reg),false,false); l_reg=__uint_as_float(rr[0])+__uint_as_float(rr[1]); }
  if(hi==0)wsf[32+r32]=l_reg; asm volatile("s_waitcnt lgkmcnt(0)":::"memory");
  bf16*Ow=O+(long)(q0+wid*QBLK)*DMO;
  { bf16*stg=(bf16*)(shm+LDS_P)+wid*4096;
    #pragma unroll
    for(int r=0;r<16;++r){const int orow=crow(r,hi); const float rl=__builtin_amdgcn_rcpf(wsf[32+orow]);
      #pragma unroll
      for(int d0=0;d0<4;++d0)stg[orow*128+d0*32+r32]=__float2bfloat16(o[d0][r]*rl);}
    asm volatile("s_waitcnt lgkmcnt(0)":::"memory");
    #pragma unroll
    for(int i=0;i<8;++i){const int row=i*4+(lane>>4),ch=lane&15; const u32x4 v=*(const u32x4*)(stg+row*128+ch*8); ATTN_STORE16(Ow+(long)row*DMO+ch*8,v);} }
  asm volatile("s_waitcnt lgkmcnt(0)\n\ts_barrier":::"memory");
  #undef DMA_K
  #undef DMA_V
  #undef ROT3
  #undef PKW
  #undef MX3
}
constexpr int ATTN_LDS_BYTES=LDS_BYTES;
struct AttnTensors { const bf16* Q; const bf16* K; const bf16* V; bf16* O; };
struct AttnUnit { int hc; int qb; };
struct StaticOrder {
  int vcu, G, bx;
  __device__ __forceinline__ StaticOrder(int grid,int block):vcu((grid%8==0)?(block%8)*(grid/8)+block/8:block),G(grid),bx(block){}
  __device__ __forceinline__ bool next(int i,AttnUnit&u)const{
    if(G==256){ if(i>=2)return false; const int s=vcu&31; u.hc=vcu>>5; u.qb=(i==0)?63-s:s; return true; }
    const int idx=i*G+bx; if(idx>=8*NQB)return false; u.hc=idx&7; u.qb=NQB-1-(idx>>3); return true; }
};
template<class Sched,int THRL=8> __device__ __forceinline__ void attn_phase(char*lds,const AttnTensors&T,const Sched&S){
  AttnUnit u;
  for(int i=0;S.next(i,u);++i){ const int h=u.hc>>1,c=u.hc&1;
    attn_unit<THRL>(u.qb,T.Q+h*128+c*64,T.K+h*128+c*64,T.V+h*128,T.O+u.hc*128,lds); }
}
#undef SBAR
#undef WAIT_BAR
}
constexpr int NWAVES = 8;
constexpr int M = 16384, D = 1024, FF = 2816, NGU = 2 * FF, NIN = 2048, DEPTH = 4;
constexpr size_t MiB = 1u << 20;
constexpr size_t WS_ROWSS = 1 * MiB;
constexpr size_t WS_ROPE = 2 * MiB;
constexpr size_t WS_XB = 8 * MiB;
constexpr size_t WS_H = 40 * MiB;
constexpr size_t WS_QKVU = 40 * MiB;
constexpr size_t WS_OBUF = 108 * MiB;
constexpr size_t WS_CAT = 140 * MiB;
constexpr size_t WS_W = 172 * MiB;
constexpr size_t OFF_GU1 = 0, OFF_DN1 = 11 * MiB, OFF_IN = 16 * MiB + 512 * 1024, OFF_OUT = 20 * MiB + 512 * 1024, OFF_GU2 = 22 * MiB + 512 * 1024, OFF_DN2 = 33 * MiB + 512 * 1024, W_LAYER = 39 * MiB;
constexpr size_t WS_XL = WS_W + DEPTH * W_LAYER;
constexpr size_t WS_END = WS_XL + (size_t)M * D;
static_assert(attn_body::ATTN_LDS_BYTES <= 147392 && (size_t)NGU * D * 2 == 11 * MiB && (size_t)D * FF * 2 == 5 * MiB + 512 * 1024 && WS_H + (size_t)M * FF * 2 <= WS_CAT && WS_ROWSS + 16 * (size_t)M * 4 <= WS_ROPE && WS_ROPE + (size_t)M * 64 * 4 <= WS_XB, "ws map");
constexpr int LDS_BYTES = 147456;

#define LAS __attribute__((address_space(3)))
typedef unsigned short bf16;
typedef unsigned v4u __attribute__((ext_vector_type(4)));
typedef unsigned v2u __attribute__((ext_vector_type(2)));
typedef float f32x4 __attribute__((ext_vector_type(4)));
#define LDS_WAIT() asm volatile("s_waitcnt lgkmcnt(0)" ::: "memory")
__device__ __forceinline__ unsigned f2bf(float f) { unsigned u = __builtin_bit_cast(unsigned, f); return (u + 0x7fffu + ((u >> 16) & 1u)) >> 16; }
__device__ __forceinline__ unsigned pk2(float lo, float hi) { return f2bf(lo) | (f2bf(hi) << 16); }
__device__ __forceinline__ float bflo(unsigned w) { return __builtin_bit_cast(float, w << 16); }
__device__ __forceinline__ float bfhi(unsigned w) { return __builtin_bit_cast(float, w & 0xffff0000u); }
__device__ __forceinline__ float wave_sum(float v) {
#pragma unroll
    for (int o = 1; o < 64; o <<= 1) v += __shfl_xor(v, o);
    return v;
}
struct TrDesc { const float* W; const float* gk; bf16* WT; int N, k0, n0, Kd, rbase, rstride; };
__device__ __forceinline__ void tr_load(const TrDesc& d, int lane, f32x4 (&v)[8]) {
    const int kblk = lane & 7, n4 = lane >> 3;
    const float* src = d.W + (size_t)(d.k0 + 8 * kblk) * d.N + d.n0 + 4 * n4;
#pragma unroll
    for (int i = 0; i < 8; ++i) v[i] = __builtin_nontemporal_load((const f32x4*)(src + (size_t)i * d.N));
}
__device__ __forceinline__ void tr_store(const TrDesc& d, int lane, f32x4 (&v)[8]) {
    const int kblk = lane & 7, n4 = lane >> 3;
    if (d.gk) { const f32x4 g0 = *(const f32x4*)(d.gk + d.k0 + 8 * kblk), g1 = *(const f32x4*)(d.gk + d.k0 + 8 * kblk + 4);
#pragma unroll
        for (int i = 0; i < 4; ++i) { v[i] = v[i] * g0[i]; v[4 + i] = v[4 + i] * g1[i]; } }
#pragma unroll
    for (int e = 0; e < 4; ++e) { v4u o; o.x = pk2(v[0][e], v[1][e]); o.y = pk2(v[2][e], v[3][e]); o.z = pk2(v[4][e], v[5][e]); o.w = pk2(v[6][e], v[7][e]);
        *(v4u*)(d.WT + (size_t)(d.rbase + (4 * n4 + e) * d.rstride) * d.Kd + d.k0 + 8 * kblk) = o; }
}

#define XB_TMO      128
#define XB_XCNT(j)  (256  + 64 * (j))
#define XB_XSUB(j)  (1280 + 64 * (j))
#define XB_XGEN(j)  (2304 + 64 * (j))
#define XB_TOP      3328
#define XB_TOPGEN   3392
#define XCD_BAR_WORDS 3456
#define XB_SPIN_CAP (1u << 18)

__device__ __forceinline__ unsigned xb_ld(unsigned* p)              { return __hip_atomic_load(p, __ATOMIC_RELAXED, __HIP_MEMORY_SCOPE_AGENT); }
__device__ __forceinline__ unsigned xb_add(unsigned* p, unsigned v) { return __hip_atomic_fetch_add(p, v, __ATOMIC_RELAXED, __HIP_MEMORY_SCOPE_AGENT); }
__device__ __forceinline__ unsigned xb_xcc_id() { return (unsigned)__builtin_amdgcn_s_getreg((3 << 11) | 20) & 0xFu; }
#define XB_SPIN(cond, bar) do { unsigned _sp = 0; while (cond) { __builtin_amdgcn_s_sleep(1); \
    if ((++_sp & 255u) == 0u) { if (xb_ld(&(bar)[XB_TMO])) break; if (_sp > XB_SPIN_CAP) { atomicAdd(&(bar)[XB_TMO], 1u); break; } } } } while (0)

struct XcdBarrier {
    unsigned* bar; unsigned x;
    volatile LAS unsigned* st;
};

__device__ __forceinline__ XcdBarrier xcd_barrier_post(unsigned* bar, volatile LAS unsigned* st) {
    XcdBarrier b; b.bar = bar; b.x = xb_xcc_id(); b.st = st;
    if (threadIdx.x == 0) (void)xb_add(&bar[XB_XCNT(b.x)], 1u);
    return b;
}
__device__ __forceinline__ void xcd_barrier_complete(unsigned* bar, unsigned x, unsigned& nloc, unsigned& nx) {
    const unsigned G = gridDim.x * gridDim.y * gridDim.z;
    unsigned sum, cnt, mine, sp = 0u;
    for (;;) {
        sum = 0u; cnt = 0u; mine = 0u;
#pragma unroll
        for (unsigned j = 0; j < 16; ++j) { const unsigned c = xb_ld(&bar[XB_XCNT(j)]); sum += c; cnt += (c > 0u) ? 1u : 0u; mine = (j == x) ? c : mine; }
        if (sum == G) break;
        __builtin_amdgcn_s_sleep(1);
        if ((++sp & 255u) == 0u) { if (xb_ld(&bar[XB_TMO])) break; if (sp > XB_SPIN_CAP) { atomicAdd(&bar[XB_TMO], 1u); break; } }
    }
    nloc = mine > 0u ? mine : 1u; nx = cnt > 0u ? cnt : 1u;
}

__device__ __forceinline__ void xcd_barrier(const XcdBarrier& b) {
    asm volatile("s_waitcnt vmcnt(0)" ::: "memory");
    __syncthreads();
    if (threadIdx.x == 0) {
        unsigned* bar = b.bar;
        __builtin_amdgcn_s_waitcnt(0);
        unsigned nloc = b.st[0], nx = b.st[1];
        if (nloc == 0u) { xcd_barrier_complete(bar, b.x, nloc, nx); b.st[0] = nloc; b.st[1] = nx; }
        const unsigned old = xb_add(&bar[XB_XSUB(b.x)], 1u);
        const unsigned gen = old / nloc;
        if (old + 1u == (gen + 1u) * nloc) {
            __builtin_amdgcn_fence(__ATOMIC_RELEASE, "agent");
            asm volatile("s_waitcnt vmcnt(0)" ::: "memory");
            const unsigned og = xb_add(&bar[XB_TOP], 1u);
            const unsigned tg = og / nx;
            if (og + 1u == (tg + 1u) * nx) xb_add(&bar[XB_TOPGEN], 1u);
            else XB_SPIN(xb_ld(&bar[XB_TOPGEN]) == tg, bar);
            __builtin_amdgcn_fence(__ATOMIC_ACQUIRE, "agent");
            xb_add(&bar[XB_XGEN(b.x)], 1u);
            asm volatile("s_waitcnt vmcnt(0)" ::: "memory");
        } else {
            XB_SPIN(xb_ld(&bar[XB_XGEN(b.x)]) == gen, bar);
            __builtin_amdgcn_fence(__ATOMIC_ACQUIRE, "agent");
            asm volatile("s_waitcnt vmcnt(0)" ::: "memory");
        }
    }
    __syncthreads();
}

struct Args { const float* in[20]; float* out; unsigned char* wsp; };
__device__ __forceinline__ int fresh_lane() { int l; asm volatile("v_mbcnt_lo_u32_b32 %0, -1, 0\n\tv_mbcnt_hi_u32_b32 %0, -1, %0" : "=v"(l)); return l; }
typedef __attribute__((address_space(1))) unsigned char* gptr_t;
__device__ __forceinline__ gptr_t fresh_ptr(unsigned char* p) { asm volatile("" : "+s"(p)); return (gptr_t)p; }

__global__ void __launch_bounds__(NWAVES * 64, 2) hymba_fwd(Args args) {
    extern __shared__ __attribute__((aligned(16))) unsigned char lds[];
    LAS unsigned char* L = (LAS unsigned char*)lds;
    const int tid = threadIdx.x, lane = tid & 63, wave = __builtin_amdgcn_readfirstlane(tid >> 6);
    const int G = gridDim.x, bx = blockIdx.x;
    const int gw = bx * NWAVES + wave, NGW = G * NWAVES;
    const int gtid = bx * (NWAVES * 64) + tid, NT = G * NWAVES * 64;
#define ws (fresh_ptr(args.wsp))
#define rowss ((float*)(unsigned char*)(ws + WS_ROWSS))
#define rope ((float*)(unsigned char*)(ws + WS_ROPE))
#define XB ((bf16*)(unsigned char*)(ws + WS_XB))
#define HB ((bf16*)(unsigned char*)(ws + WS_H))
#define QKVU ((bf16*)(unsigned char*)(ws + WS_QKVU))
#define OBUF ((bf16*)(unsigned char*)(ws + WS_OBUF))
#define CAT ((bf16*)(unsigned char*)(ws + WS_CAT))
#define xout ((float*)(unsigned char*)fresh_ptr((unsigned char*)args.out))
    { volatile LAS unsigned* st0 = (volatile LAS unsigned*)(L + 147392); if (tid < 2) st0[tid] = 0u; }
    __syncthreads();
    (void)xcd_barrier_post((unsigned*)args.wsp, (volatile LAS unsigned*)(L + 147392));

    {
        constexpr int IT_G = 16 * 88, IT_D = 44 * 32, IT_IN = 16 * 64, IT_OUT = 8 * 32, IT_LAYER = 4 * IT_G + 2 * IT_D + IT_IN + IT_OUT;
        static_assert(IT_G == IT_D, "item decode");
#define TR_DECODE(d_, it_) do { const int l = (it_) / IT_LAYER; int r = (it_) % IT_LAYER; unsigned char* wlc_ = (unsigned char*)(ws + WS_W + (size_t)l * W_LAYER); \
            if (r < 6 * IT_G) { \
                const int f = r / (3 * IT_G), q = r % (3 * IT_G), kind = q / IT_G, i = q % IT_G; \
                if (kind < 2) { const int kb = i / 88, nb = i % 88, n0 = 32 * nb; \
                    d_ = TrDesc{args.in[(f ? 16 : 2) + kind] + (size_t)l * D * FF, args.in[f ? 15 : 1] + l * D, (bf16*)(wlc_ + (f ? OFF_GU2 : OFF_GU1)), FF, 64 * kb, n0, D, (n0 >> 7) * 256 + kind * 128 + (n0 & 127), 1}; } \
                else { const int kb = i / 32, nb = i % 32; \
                    d_ = TrDesc{args.in[f ? 18 : 4] + (size_t)l * FF * D, nullptr, (bf16*)(wlc_ + (f ? OFF_DN2 : OFF_DN1)), D, 64 * kb, 32 * nb, FF, 32 * nb, 1}; } \
            } else { r -= 6 * IT_G; \
                if (r < IT_IN) { const int kb = r / 64, nb = r % 64, n0 = 32 * nb; int rbase = n0, rstride = 1; \
                    if (n0 < 1024) { const int d0 = n0 & 63; rbase = (n0 - d0) + (d0 ? 1 : 0); rstride = 2; } \
                    d_ = TrDesc{args.in[6] + (size_t)l * D * NIN, args.in[5] + l * D, (bf16*)(wlc_ + OFF_IN), NIN, 64 * kb, n0, D, rbase, rstride}; } \
                else { r -= IT_IN; const int kb = r / 32, nb = r % 32; \
                    d_ = TrDesc{args.in[14] + (size_t)l * D * D, nullptr, (bf16*)(wlc_ + OFF_OUT), D, 64 * kb, 32 * nb, D, 32 * nb, 1}; } \
            } } while (0)
        if (gw < DEPTH * IT_LAYER) { int it = gw; TrDesc d0; TR_DECODE(d0, it); f32x4 va[8]; tr_load(d0, lane, va);
            for (;;) { const int itn = it + NGW; const bool has = itn < DEPTH * IT_LAYER; TrDesc d1 = d0; f32x4 vb[8];
#pragma unroll
                for (int i = 0; i < 8; ++i) vb[i] = (f32x4){0.f, 0.f, 0.f, 0.f};
                if (has) { TR_DECODE(d1, itn); tr_load(d1, lane, vb); }
                tr_store(d0, lane, va); if (!has) break;
                d0 = d1; it = itn;
#pragma unroll
                for (int i = 0; i < 8; ++i) va[i] = vb[i]; } }
#undef TR_DECODE
        for (int it = gw; it < DEPTH * 1024; it += NGW) {
            const int l = it >> 10, r = it & 1023, g = r >> 8, cb = (r >> 4) & 15, nb = r & 15, c0 = cb * 8, n = nb * 64 + lane;
            const float* pw = args.in[12] + ((size_t)(l * 4 + g) * 128 + c0) * 128; const float* ps = args.in[13] + l * 512 + g * 128;
            const float* wo = args.in[14] + (size_t)l * D * D + (size_t)(512 + g * 128) * D + n;
            float a[8];
#pragma unroll
            for (int j = 0; j < 8; ++j) a[j] = 0.f;
            for (int e = 0; e < 128; ++e) { const float w = wo[(size_t)e * D] * ps[e];
#pragma unroll
                for (int j = 0; j < 8; ++j) a[j] += pw[j * 128 + e] * w; }
            v4u o; o.x = pk2(a[0], a[1]); o.y = pk2(a[2], a[3]); o.z = pk2(a[4], a[5]); o.w = pk2(a[6], a[7]);
            *(v4u*)((bf16*)(unsigned char*)(ws + WS_W + (size_t)l * W_LAYER + OFF_OUT) + (size_t)n * D + 512 + g * 128 + c0) = o;
        }
        for (int i = gtid; i < M * 32; i += NT) { const int s = i >> 5, j = i & 31; const float inv = (float)pow(10000.0, -(double)j / 32.0); const float ang = (float)s * inv;
            const double a = (double)ang; rope[2 * i] = (float)cos(a); rope[2 * i + 1] = (float)sin(a); }
        for (int m = gw; m < M; m += NGW) { const f32x4* xr = (const f32x4*)(args.in[0] + (size_t)m * D) + lane; f32x4 v[4]; float s = 0.f;
#pragma unroll
            for (int j = 0; j < 4; ++j) { v[j] = xr[64 * j]; s += (v[j].x * v[j].x + v[j].y * v[j].y) + (v[j].z * v[j].z + v[j].w * v[j].w); }
            s = wave_sum(s); if (lane < 16) rowss[(size_t)m * 16 + lane] = (lane == 0) ? s : 0.f;
            v2u* o8 = (v2u*)(XB + (size_t)m * D) + lane;
#pragma unroll
            for (int j = 0; j < 4; ++j) { v2u w; w.x = pk2(v[j].x, v[j].y); w.y = pk2(v[j].z, v[j].w); o8[64 * j] = w;
                int e = __builtin_amdgcn_cvt_pk_bf8_f32(v[j].x - bflo(w.x), v[j].y - bfhi(w.x), 0, false); e = __builtin_amdgcn_cvt_pk_bf8_f32(v[j].z - bflo(w.y), v[j].w - bfhi(w.y), e, true);
                ((unsigned*)(unsigned char*)(ws + WS_XL + (size_t)m * D))[lane + 64 * j] = (unsigned)e; } }
    }
    cg::this_grid().sync();


    for (int step = 0; step < 3 * DEPTH; ++step) {
        const int l = step / 3, kind = step % 3;
#define wl ((unsigned char*)(ws + WS_W + (size_t)l * W_LAYER))
        if (kind != 1) {
            const int f = kind >> 1;
            { pg8::Gemm g{XB, (const bf16*)(wl + (f ? OFF_GU2 : OFF_GU1)), M, NGU, D}; pg8::StaticOrder S; S.init(M, NGU, G, bx);
              pg8::Unit u0; u0.pm = -1; u0.pn = 0; const bool any0 = S.next(0, u0);
              { int tt = threadIdx.x; asm volatile("" : "+v"(tt));
                if (any0 && tt < 256) ((LAS float*)(L + 131072))[tt] = pg8::rs_from_ss(rowss + (size_t)(u0.pm * 256 + tt) * 16); }
              __syncthreads();
              pg8::EpiGateUp E{HB, rowss, (const LAS float*)(L + 131072), any0 ? u0.pm : -1};
              pg8::gemm_phase<pg8::EpiGateUp, pg8::StaticOrder, PG8_ALIGN, PG8_SP2>(L, g, S, E); }
            xcd_barrier(XcdBarrier{(unsigned*)args.wsp, xb_xcc_id(), (volatile LAS unsigned*)(L + 147392)});
            { pg8::Gemm g{HB, (const bf16*)(wl + (f ? OFF_DN2 : OFF_DN1)), M, D, FF}; pg8::StaticOrder S; S.init(M, D, G, bx);
              pg8::EpiResidBf E{(__attribute__((address_space(1))) bf16*)(ws + WS_XB), (__attribute__((address_space(1))) unsigned char*)(ws + WS_XL), rowss, 0.5f};
              pg8::gemm_phase<pg8::EpiResidBf, pg8::StaticOrder, PG8_ALIGN, PG8_SP2>(L, g, S, E); }
            xcd_barrier(XcdBarrier{(unsigned*)args.wsp, xb_xcc_id(), (volatile LAS unsigned*)(L + 147392)});
        } else {
            { pg8::Gemm g{XB, (const bf16*)(wl + OFF_IN), M, NIN, D}; pg8::StaticOrder S; S.init(M, NIN, G, bx);
              pg8::Unit u0; u0.pm = -1; u0.pn = 0; const bool any0 = S.next(0, u0);
              { int tt = threadIdx.x; asm volatile("" : "+v"(tt));
                if (any0 && tt < 256) ((LAS float*)(L + 131072))[tt] = pg8::rs_from_ss(rowss + (size_t)(u0.pm * 256 + tt) * 16); }
              __syncthreads();
              pg8::EpiQKVU E{QKVU, rowss, rope, (const LAS float*)(L + 131072), any0 ? u0.pm : -1};
              pg8::gemm_phase<pg8::EpiQKVU, pg8::StaticOrder, PG8_ALIGN, PG8_SP2>(L, g, S, E); }
            xcd_barrier(XcdBarrier{(unsigned*)args.wsp, xb_xcc_id(), (volatile LAS unsigned*)(L + 147392)});
            { const attn_body::AttnTensors AT{(const attn_body::bf16*)QKVU, (const attn_body::bf16*)(QKVU + 512), (const attn_body::bf16*)(QKVU + 1024), (attn_body::bf16*)OBUF};
              const attn_body::StaticOrder S(G, bx);
              attn_body::attn_phase<attn_body::StaticOrder>((char*)lds, AT, S); }
            xcd_barrier(XcdBarrier{(unsigned*)args.wsp, xb_xcc_id(), (volatile LAS unsigned*)(L + 147392)});
            {
                const int lane = fresh_lane();
                const float li = 0.8f - 0.6f * expf(-0.3f * (float)l);
                const float s1 = wave_sum(args.in[7][l * 64 + lane] * args.in[8][l * 64 + lane]), s2 = wave_sum(args.in[9][l * 64 + lane] * args.in[10][l * 64 + lane]);
                const float lam = expf(s1) - expf(s2) + li;
                const int hd = lane >> 4, j0 = (lane & 15) * 8;
                float gn[8];
#pragma unroll
                for (int j = 0; j < 8; ++j) gn[j] = args.in[11][l * 128 + j0 + j] * (1.0f - li);
                const int win = 2 << hd;
                for (int mc = gw; mc < M / 8; mc += NGW) { float wsum[8];
                  for (int mr = 0; mr < 8; ++mr) { const int m = mc * 8 + mr;
                    const v4u a = *(const v4u*)(OBUF + (size_t)m * 1024 + hd * 256 + j0), b = *(const v4u*)(OBUF + (size_t)m * 1024 + hd * 256 + 128 + j0);
                    float o[8];
                    o[0] = bflo(a.x) - lam * bflo(b.x); o[1] = bfhi(a.x) - lam * bfhi(b.x); o[2] = bflo(a.y) - lam * bflo(b.y); o[3] = bfhi(a.y) - lam * bfhi(b.y);
                    o[4] = bflo(a.z) - lam * bflo(b.z); o[5] = bfhi(a.z) - lam * bfhi(b.z); o[6] = bflo(a.w) - lam * bflo(b.w); o[7] = bfhi(a.w) - lam * bfhi(b.w);
                    float ss = 0.f;
#pragma unroll
                    for (int j = 0; j < 8; ++j) ss += o[j] * o[j];
                    ss += __shfl_xor(ss, 1); ss += __shfl_xor(ss, 2); ss += __shfl_xor(ss, 4); ss += __shfl_xor(ss, 8);
                    const float rr = __builtin_amdgcn_rsqf(ss * (1.0f / 128.0f) + 1e-6f);
                    v4u w; w.x = pk2(o[0] * rr * gn[0], o[1] * rr * gn[1]); w.y = pk2(o[2] * rr * gn[2], o[3] * rr * gn[3]); w.z = pk2(o[4] * rr * gn[4], o[5] * rr * gn[5]); w.w = pk2(o[6] * rr * gn[6], o[7] * rr * gn[7]);
                    *(v4u*)(CAT + (size_t)m * 1024 + hd * 128 + j0) = w;
                    const bf16* up = QKVU + (size_t)m * 2112 + 1536 + hd * 128 + j0;
                    const v4u u0 = *(const v4u*)up;
                    const float us[8] = {bflo(u0.x), bfhi(u0.x), bflo(u0.y), bfhi(u0.y), bflo(u0.z), bfhi(u0.z), bflo(u0.w), bfhi(u0.w)};
                    float sm[8];
                    if (mr == 0) {
                        v4u ut[15]; float wt[15];
#pragma unroll
                        for (int j = 0; j < 8; ++j) sm[j] = us[j];
#pragma unroll
                        for (int t = 1; t < 16; ++t) { const bool ok = (t < win) && (m - t >= 0); ut[t - 1] = *(const v4u*)(up - (size_t)(ok ? t : 0) * 2112); wt[t - 1] = ok ? 1.0f : 0.0f; }
#pragma unroll
                        for (int t = 0; t < 15; ++t) { const float w = wt[t];
                            sm[0] += w * bflo(ut[t].x); sm[1] += w * bfhi(ut[t].x); sm[2] += w * bflo(ut[t].y); sm[3] += w * bfhi(ut[t].y); sm[4] += w * bflo(ut[t].z); sm[5] += w * bfhi(ut[t].z); sm[6] += w * bflo(ut[t].w); sm[7] += w * bfhi(ut[t].w); }
                    } else {
                        const bool dr = (m - win >= 0); const v4u ud = *(const v4u*)(up - (size_t)(dr ? win : 0) * 2112); const float wd = dr ? 1.0f : 0.0f;
                        sm[0] = wsum[0] + us[0] - wd * bflo(ud.x); sm[1] = wsum[1] + us[1] - wd * bfhi(ud.x); sm[2] = wsum[2] + us[2] - wd * bflo(ud.y); sm[3] = wsum[3] + us[3] - wd * bfhi(ud.y);
                        sm[4] = wsum[4] + us[4] - wd * bflo(ud.z); sm[5] = wsum[5] + us[5] - wd * bfhi(ud.z); sm[6] = wsum[6] + us[6] - wd * bflo(ud.w); sm[7] = wsum[7] + us[7] - wd * bfhi(ud.w);
                    }
#pragma unroll
                    for (int j = 0; j < 8; ++j) wsum[j] = sm[j];
                    const float ic = 1.0f / (float)((m + 1 < win) ? (m + 1) : win);
                    v4u d; d.x = pk2(sm[0] * ic - us[0], sm[1] * ic - us[1]); d.y = pk2(sm[2] * ic - us[2], sm[3] * ic - us[3]); d.z = pk2(sm[4] * ic - us[4], sm[5] * ic - us[5]); d.w = pk2(sm[6] * ic - us[6], sm[7] * ic - us[7]);
                    *(v4u*)(CAT + (size_t)m * 1024 + 512 + hd * 128 + j0) = d;
                  }
                }
            }
            xcd_barrier(XcdBarrier{(unsigned*)args.wsp, xb_xcc_id(), (volatile LAS unsigned*)(L + 147392)});
            { pg8::Gemm g{CAT, (const bf16*)(wl + OFF_OUT), M, D, D}; pg8::StaticOrder S; S.init(M, D, G, bx);
              pg8::EpiResidBf E{(__attribute__((address_space(1))) bf16*)(ws + WS_XB), (__attribute__((address_space(1))) unsigned char*)(ws + WS_XL), rowss, 1.0f};
              pg8::gemm_phase<pg8::EpiResidBf, pg8::StaticOrder, PG8_ALIGN, PG8_SP2>(L, g, S, E); }
            xcd_barrier(XcdBarrier{(unsigned*)args.wsp, xb_xcc_id(), (volatile LAS unsigned*)(L + 147392)});
        }
    }
    { const int lane = fresh_lane();
    for (int m = gw; m < M; m += NGW) { const v2u* xr = (const v2u*)(XB + (size_t)m * D) + lane; f32x4* xo = (f32x4*)((float*)(unsigned char*)fresh_ptr((unsigned char*)args.out) + (size_t)m * D) + lane; const f32x4* gr = (const f32x4*)args.in[19] + lane;
        const float r = pg8::rs_from_ss(rowss + (size_t)m * 16);
#pragma unroll
        for (int j = 0; j < 4; ++j) { const v2u w = xr[64 * j]; const f32x4 gg = gr[64 * j]; const int e = (int)((const unsigned*)(unsigned char*)(ws + WS_XL + (size_t)m * D))[lane + 64 * j];
            const pg8::f32x2 la = __builtin_amdgcn_cvt_pk_f32_bf8(e, false), lb = __builtin_amdgcn_cvt_pk_f32_bf8(e, true);
            const f32x4 v = (f32x4){bflo(w.x) + la.x, bfhi(w.x) + la.y, bflo(w.y) + lb.x, bfhi(w.y) + lb.y}; xo[64 * j] = v * r * gg; } } }
}

#undef wl
#undef ws
#undef rowss
#undef rope
#undef XB
#undef HB
#undef QKVU
#undef OBUF
#undef CAT
#undef xout
extern "C" void kernel_launch(void* const* d_in, const int* in_sizes, int n_in, void* d_out, int out_size, void* d_ws, size_t ws_size, hipStream_t stream) {
    static int grid_blocks = 0;
    if (grid_blocks == 0) {
        if (n_in != 20 || out_size != M * D || ws_size < WS_END) { fprintf(stderr, "kernel_launch: unexpected shapes (n_in %d out %d ws %zu, need %zu)\n", n_in, out_size, ws_size, (size_t)WS_END); grid_blocks = -1; return; }
        int dev = 0, cus = 0, per_cu = 0;
        (void)hipGetDevice(&dev); (void)hipDeviceGetAttribute(&cus, hipDeviceAttributeMultiprocessorCount, dev);
        if (hipFuncSetAttribute((const void*)hymba_fwd, hipFuncAttributeMaxDynamicSharedMemorySize, LDS_BYTES) != hipSuccess) { fprintf(stderr, "kernel_launch: hipFuncSetAttribute failed\n"); grid_blocks = -1; return; }
        if (hipOccupancyMaxActiveBlocksPerMultiprocessor(&per_cu, (const void*)hymba_fwd, NWAVES * 64, LDS_BYTES) != hipSuccess || per_cu < 1) { fprintf(stderr, "kernel_launch: occupancy query says %d\n", per_cu); per_cu = 1; }
        (void)hipGetLastError();
        grid_blocks = cus * per_cu;
    }
    if (grid_blocks < 0) return;
    if (hipMemsetAsync(d_ws, 0, 65536, stream) != hipSuccess) { fprintf(stderr, "kernel_launch: memset failed\n"); return; }
    Args a{};
    for (int i = 0; i < 20; ++i) a.in[i] = (const float*)d_in[i];
    a.out = (float*)d_out; a.wsp = (unsigned char*)d_ws;
    void* kargs[] = {&a};
    hipError_t e = hipLaunchCooperativeKernel((const void*)hymba_fwd, dim3(grid_blocks), dim3(NWAVES * 64), kargs, LDS_BYTES, stream);
    if (e != hipSuccess) fprintf(stderr, "cooperative launch failed: %s (grid %d)\n", hipGetErrorString(e), grid_blocks);
}
```

```cpp
#include <hip/hip_runtime.h>
#include <hip/hip_cooperative_groups.h>
#include <cstdio>
#include <cstdint>
namespace cg = cooperative_groups;
namespace pg8 {
#define PG8_LAS __attribute__((address_space(3)))
typedef unsigned short bf16_t;
typedef short bf16x8 __attribute__((ext_vector_type(8)));
typedef float f32x4 __attribute__((ext_vector_type(4)));
typedef unsigned u32x4 __attribute__((ext_vector_type(4)));
constexpr int BM = 256, BK = 64, HALF = 128, HTB = HALF * BK * 2  , STAGE_BYTES = 8 * HTB, NXCD = 8, WGM = 8;

__host__ __device__ __forceinline__ int lds_byte(int r, int c) { const int st = (r >> 4) * 2 + (c >> 5), rr = r & 15, cc = c & 31, ob = rr * 64 + cc * 2; return st * 1024 + (ob ^ (((ob >> 9) & 1) << 5)); }
__host__ __device__ __forceinline__ void stage_rc(int b, int& R, int& C) { const int st = b / 1024, sb = b % 1024, swz = sb ^ (((sb >> 9) & 1) << 5); R = (st >> 1) * 16 + swz / 64; C = (st & 1) * 32 + (swz % 64) / 2; }
__host__ __device__ __forceinline__ int perm32(int rho) { const int n = rho >> 4, i = rho & 15; return 8 * (i >> 2) + 4 * n + (i & 3); }

struct Unit { int pm, pn; };
struct Gemm { const bf16_t* A; const bf16_t* Bt; int M, N, K; };

struct StaticOrder {
    int nM, nN, nwg, G, c;
    __host__ __device__ void init(int M, int N, int G_, int c_) { nM = M / BM; nN = N / BM; nwg = nM * nN; G = G_; c = c_; }
    __host__ __device__ bool next(int i, Unit& u) const {
        const long L = (long)i * G + c; if (L >= nwg) return false;
        int wgid = (int)L; { const int q = nwg / NXCD, r = nwg % NXCD, xcd = wgid % NXCD, off = wgid / NXCD; wgid = (xcd < r ? xcd * (q + 1) : r * (q + 1) + (xcd - r) * q) + off; }
        const int nig = WGM * nN, gid = wgid / nig, fm = gid * WGM, gsz = (nM - fm) < WGM ? (nM - fm) : WGM;
        u.pm = fm + ((wgid % nig) % gsz); u.pn = (wgid % nig) / gsz; return true;
    }
    __device__ __forceinline__ void a_ready(const Unit&) const {}
    __device__ __forceinline__ void done(const Unit&) const {}
};

__device__ __forceinline__ unsigned cvt_pk_bf16(float lo, float hi) { unsigned r; asm volatile("v_cvt_pk_bf16_f32 %0, %1, %2" : "=v"(r) : "v"(lo), "v"(hi)); return r; }
typedef float f32x2 __attribute__((ext_vector_type(2)));
__device__ __forceinline__ f32x2 gelu_pk(f32x2 v) {
    const f32x2 av = __builtin_elementwise_abs(v), d = av * 0.2316418882f + 1.0f;
    f32x2 t; t.x = __builtin_amdgcn_rcpf(d.x); t.y = __builtin_amdgcn_rcpf(d.y);
    f32x2 q = t * 0.5307027145f + (-0.7265760135f); q = q * t + 0.7107068705f; q = q * t + (-0.142248368f); q = q * t + 0.127414796f; q = q * t;
    const f32x2 s = (v * v) * (-0.72134752044f);
    f32x2 e; e.x = __builtin_amdgcn_exp2f(s.x); e.y = __builtin_amdgcn_exp2f(s.y);
    const f32x2 m = v * (q * e), r = v - m;
    f32x2 o; o.x = v.x < 0.f ? m.x : r.x; o.y = v.y < 0.f ? m.y : r.y; return o;
}

template <int ACT  > struct EpiBf16 {
    static constexpr bool PERM = true, AFTER_DRAIN = false; static_assert(ACT == 0 || ACT == 1, "EpiBf16: ACT is 0 (none) or 1 (gelu_pk)");
    bf16_t* O; int ldc; const float* bias; int split_cols; size_t split_stride; float scale0;
    __device__ __forceinline__ void operator()(const f32x4 (&acc)[2][2][4][2], const Unit& u, int wr, int wc, int fr, int fq) const {
        const int row0 = u.pm * BM + wr * 64 + fr; int colt = u.pn * BM; bf16_t* base = O;
        float sc = 1.f; if (split_cols) { const int t = colt / split_cols; base += (size_t)t * split_stride; colt -= t * split_cols; if (t == 0) sc = scale0; }
        const int col0 = colt + wc * 32 + 8 * fq, bcol0 = u.pn * BM + wc * 32 + 8 * fq;
        f32x4 bv[2][2];
#pragma unroll
        for (int bj = 0; bj < 2; ++bj)
#pragma unroll
            for (int n = 0; n < 2; ++n) bv[bj][n] = bias ? *(const f32x4*)(bias + bcol0 + bj * HALF + 4 * n) : (f32x4){0.f, 0.f, 0.f, 0.f};
#pragma unroll
        for (int ai = 0; ai < 2; ++ai)
#pragma unroll
            for (int m = 0; m < 4; ++m) { bf16_t* rowp = base + (size_t)(row0 + ai * HALF + m * 16) * ldc + col0;
#pragma unroll
                for (int bj = 0; bj < 2; ++bj) { f32x4 v0 = acc[ai][bj][m][0] + bv[bj][0], v1 = acc[ai][bj][m][1] + bv[bj][1];
                    if (ACT == 1) { f32x2 a = gelu_pk((f32x2){v0[0], v0[1]}), b = gelu_pk((f32x2){v0[2], v0[3]}), c = gelu_pk((f32x2){v1[0], v1[1]}), d = gelu_pk((f32x2){v1[2], v1[3]});
                        v0 = (f32x4){a.x, a.y, b.x, b.y}; v1 = (f32x4){c.x, c.y, d.x, d.y}; }
                    v0 = v0 * sc; v1 = v1 * sc; u32x4 w; w.x = cvt_pk_bf16(v0[0], v0[1]); w.y = cvt_pk_bf16(v0[2], v0[3]); w.z = cvt_pk_bf16(v1[0], v1[1]); w.w = cvt_pk_bf16(v1[2], v1[3]);
                    *(u32x4*)(rowp + bj * HALF) = w; } }
    }
};
__device__ __forceinline__ float rs_from_ss(const float* p) { const f32x4 a = ((const f32x4*)p)[0], b = ((const f32x4*)p)[1], c = ((const f32x4*)p)[2], d = ((const f32x4*)p)[3];
    const float ss = (((a[0] + a[1]) + (a[2] + a[3])) + ((b[0] + b[1]) + (b[2] + b[3]))) + (((c[0] + c[1]) + (c[2] + c[3])) + ((d[0] + d[1]) + (d[2] + d[3])));
    return __builtin_amdgcn_rsqf(ss * (1.0f / 1024.0f) + 1e-6f); }
__device__ __forceinline__ float sum_fq4(float s) {
    { auto rr = __builtin_amdgcn_permlane16_swap(__float_as_uint(s), __float_as_uint(s), false, false); s = __uint_as_float(rr[0]) + __uint_as_float(rr[1]); }
    { auto rr = __builtin_amdgcn_permlane32_swap(__float_as_uint(s), __float_as_uint(s), false, false); s = __uint_as_float(rr[0]) + __uint_as_float(rr[1]); }
    return s; }
#define EPI_ROW_SCALES(rs_, rowss_, row0_) do { f32x4 q_[8]; \
    _Pragma("unroll") for (int i_ = 0; i_ < 8; ++i_) q_[i_] = *(const f32x4*)((rowss_) + (size_t)((row0_) + (i_ >> 2) * HALF + (i_ & 3) * 16) * 16 + fq * 4); \
    _Pragma("unroll") for (int i_ = 0; i_ < 8; ++i_) { float s_ = sum_fq4((q_[i_][0] + q_[i_][1]) + (q_[i_][2] + q_[i_][3])); \
        rs_[i_] = __builtin_amdgcn_rsqf(s_ * (1.0f / 1024.0f) + 1e-6f); } } while (0)
struct EpiGateUp {
    static constexpr bool PERM = true, AFTER_DRAIN = false;
    bf16_t* H; const float* rowss; const PG8_LAS float* tab; int pm0;
    __device__ __forceinline__ void operator()(const f32x4 (&acc)[2][2][4][2], const Unit& u, int wr, int wc, int fr, int fq) const {
        const int row0 = u.pm * BM + wr * 64 + fr; const int col0 = u.pn * HALF + wc * 32 + 8 * fq;
        float rs[8];
        if (u.pm == pm0) {
#pragma unroll
            for (int i = 0; i < 8; ++i) rs[i] = tab[wr * 64 + fr + (i >> 2) * HALF + (i & 3) * 16]; }
        else EPI_ROW_SCALES(rs, rowss, row0);
#pragma unroll
        for (int ai = 0; ai < 2; ++ai)
#pragma unroll
            for (int m = 0; m < 4; ++m) { const int row = row0 + ai * HALF + m * 16; const float r = rs[ai * 4 + m];
                float hv[8];
#pragma unroll
                for (int n = 0; n < 2; ++n)
#pragma unroll
                    for (int e = 0; e < 4; ++e) { const float g = acc[ai][0][m][n][e] * r, up = acc[ai][1][m][n][e] * r;
                        const float sg = g * __builtin_amdgcn_rcpf(1.0f + __builtin_amdgcn_exp2f(g * -1.4426950408889634f)); hv[n * 4 + e] = sg * up; }
                u32x4 w; w.x = cvt_pk_bf16(hv[0], hv[1]); w.y = cvt_pk_bf16(hv[2], hv[3]); w.z = cvt_pk_bf16(hv[4], hv[5]); w.w = cvt_pk_bf16(hv[6], hv[7]);
                *(u32x4*)(H + (size_t)row * 2816 + col0) = w; }
    }
};
struct EpiResidBf {
    static constexpr bool PERM = true, AFTER_DRAIN = false;
    typedef __attribute__((address_space(1))) u32x4 gu32x4; typedef unsigned u32x2 __attribute__((ext_vector_type(2))); typedef __attribute__((address_space(1))) u32x2 gu32x2;
    __attribute__((address_space(1))) bf16_t* xb; __attribute__((address_space(1))) unsigned char* xl; float* rowss_next; float alpha;
    __device__ __forceinline__ void operator()(const f32x4 (&acc)[2][2][4][2], const Unit& u, int wr, int wc, int fr, int fq) const {
        const int row0 = u.pm * BM + wr * 64 + fr; const int col0 = u.pn * BM + wc * 32 + 8 * fq;
        u32x4 xa[4][2]; u32x2 la[4][2];
#define EPB_LD(ai_) do { _Pragma("unroll") for (int m = 0; m < 4; ++m) _Pragma("unroll") for (int bj = 0; bj < 2; ++bj) { const size_t off = (size_t)(row0 + (ai_) * HALF + m * 16) * 1024 + col0 + bj * HALF; \
            xa[m][bj] = *(const gu32x4*)(xb + off); la[m][bj] = *(const gu32x2*)(xl + off); } } while (0)
#define EPB_ST(ai_) do { _Pragma("unroll") for (int m = 0; m < 4; ++m) { const int row = row0 + (ai_) * HALF + m * 16; float ss = 0.f; \
            _Pragma("unroll") for (int bj = 0; bj < 2; ++bj) { const u32x4 x = xa[m][bj]; const u32x2 lw = la[m][bj]; const size_t off = (size_t)row * 1024 + col0 + bj * HALF; \
                const f32x2 l0 = __builtin_amdgcn_cvt_pk_f32_bf8((int)lw.x, false), l1 = __builtin_amdgcn_cvt_pk_f32_bf8((int)lw.x, true), l2 = __builtin_amdgcn_cvt_pk_f32_bf8((int)lw.y, false), l3 = __builtin_amdgcn_cvt_pk_f32_bf8((int)lw.y, true); \
                const f32x4 a0 = (f32x4){__builtin_bit_cast(float, x.x << 16) + l0.x, __builtin_bit_cast(float, x.x & 0xffff0000u) + l0.y, __builtin_bit_cast(float, x.y << 16) + l1.x, __builtin_bit_cast(float, x.y & 0xffff0000u) + l1.y}; \
                const f32x4 a1 = (f32x4){__builtin_bit_cast(float, x.z << 16) + l2.x, __builtin_bit_cast(float, x.z & 0xffff0000u) + l2.y, __builtin_bit_cast(float, x.w << 16) + l3.x, __builtin_bit_cast(float, x.w & 0xffff0000u) + l3.y}; \
                const f32x4 v0 = a0 + acc[ai_][bj][m][0] * alpha, v1 = a1 + acc[ai_][bj][m][1] * alpha; \
                ss += (v0[0] * v0[0] + v0[1] * v0[1]) + (v0[2] * v0[2] + v0[3] * v0[3]) + (v1[0] * v1[0] + v1[1] * v1[1]) + (v1[2] * v1[2] + v1[3] * v1[3]); \
                u32x4 w; w.x = cvt_pk_bf16(v0[0], v0[1]); w.y = cvt_pk_bf16(v0[2], v0[3]); w.z = cvt_pk_bf16(v1[0], v1[1]); w.w = cvt_pk_bf16(v1[2], v1[3]); \
                *(gu32x4*)(xb + off) = w; \
                int e0 = __builtin_amdgcn_cvt_pk_bf8_f32(v0[0] - __builtin_bit_cast(float, w.x << 16), v0[1] - __builtin_bit_cast(float, w.x & 0xffff0000u), 0, false); \
                e0 = __builtin_amdgcn_cvt_pk_bf8_f32(v0[2] - __builtin_bit_cast(float, w.y << 16), v0[3] - __builtin_bit_cast(float, w.y & 0xffff0000u), e0, true); \
                int e1 = __builtin_amdgcn_cvt_pk_bf8_f32(v1[0] - __builtin_bit_cast(float, w.z << 16), v1[1] - __builtin_bit_cast(float, w.z & 0xffff0000u), 0, false); \
                e1 = __builtin_amdgcn_cvt_pk_bf8_f32(v1[2] - __builtin_bit_cast(float, w.w << 16), v1[3] - __builtin_bit_cast(float, w.w & 0xffff0000u), e1, true); \
                *(gu32x2*)(xl + off) = (u32x2){(unsigned)e0, (unsigned)e1}; } \
            ss = sum_fq4(ss); \
            if (fq == 0) rowss_next[(size_t)row * 16 + u.pn * 4 + wc] = ss; } } while (0)
        EPB_LD(0); __builtin_amdgcn_sched_barrier(0);
        EPB_ST(0); __builtin_amdgcn_sched_barrier(0);
        EPB_LD(1); __builtin_amdgcn_sched_barrier(0);
        EPB_ST(1);
#undef EPB_LD
#undef EPB_ST
    }
};
struct EpiQKVU {
    static constexpr bool PERM = true, AFTER_DRAIN = false;
    bf16_t* O; const float* rowss; const float* rope; const PG8_LAS float* tab; int pm0;
    __device__ __forceinline__ void operator()(const f32x4 (&acc)[2][2][4][2], const Unit& u, int wr, int wc, int fr, int fq) const {
        const int row0 = u.pm * BM + wr * 64 + fr; const int col0 = u.pn * BM + wc * 32 + 8 * fq; const int sec = u.pn >> 1;
        const int j0 = 16 * (wc & 1) + 4 * fq;
        float rs[8];
        if (u.pm == pm0) {
#pragma unroll
            for (int i = 0; i < 8; ++i) rs[i] = tab[wr * 64 + fr + (i >> 2) * HALF + (i & 3) * 16]; }
        else EPI_ROW_SCALES(rs, rowss, row0);
#pragma unroll
        for (int ai = 0; ai < 2; ++ai) {
            f32x4 cs[4][2];
#pragma unroll
            for (int m = 0; m < 4; ++m) { cs[m][0] = (f32x4){1.f, 0.f, 1.f, 0.f}; cs[m][1] = cs[m][0];
                if (sec < 2) { const f32x4* rp = (const f32x4*)(rope + ((size_t)(row0 + ai * HALF + m * 16) * 32 + j0) * 2); cs[m][0] = rp[0]; cs[m][1] = rp[1]; } }
#pragma unroll
            for (int m = 0; m < 4; ++m) { const int row = row0 + ai * HALF + m * 16; float r = rs[ai * 4 + m]; if (sec == 0) r *= 0.125f * 1.4426950408889634f;
                const f32x4 cs0 = cs[m][0], cs1 = cs[m][1];
#pragma unroll
                for (int bj = 0; bj < 2; ++bj) { const f32x4 v0 = acc[ai][bj][m][0] * r, v1 = acc[ai][bj][m][1] * r;
                    const float o0 = v0[0] * cs0[0] - v0[1] * cs0[1], o1 = v0[1] * cs0[0] + v0[0] * cs0[1];
                    const float o2 = v0[2] * cs0[2] - v0[3] * cs0[3], o3 = v0[3] * cs0[2] + v0[2] * cs0[3];
                    const float o4 = v1[0] * cs1[0] - v1[1] * cs1[1], o5 = v1[1] * cs1[0] + v1[0] * cs1[1];
                    const float o6 = v1[2] * cs1[2] - v1[3] * cs1[3], o7 = v1[3] * cs1[2] + v1[2] * cs1[3];
                    u32x4 w; w.x = cvt_pk_bf16(o0, o1); w.y = cvt_pk_bf16(o2, o3); w.z = cvt_pk_bf16(o4, o5); w.w = cvt_pk_bf16(o6, o7);
                    *(u32x4*)(O + (size_t)row * 2112 + col0 + bj * HALF) = w; } } }
    }
};

template <class Epi, class Sched, bool ALIGN_EPI = false, bool SP2 = false>
__device__ __forceinline__ void gemm_phase(PG8_LAS unsigned char* lds, const Gemm g, const Sched& S, const Epi& E) {
    int tid_ = threadIdx.x; asm volatile("" : "+v"(tid_));
    const int tid = tid_, wid = __builtin_amdgcn_readfirstlane(tid >> 6), lane = tid & 63, wr = wid >> 2, wc = wid & 3, fr = lane & 15, fq = lane >> 4;
    const int K = g.K, nt = K / BK;
    unsigned voffA[2], voffB[2];
#pragma unroll
    for (int i = 0; i < 2; ++i) { int R, C; stage_rc(tid * 16 + i * 8192, R, C); const int Rb = Epi::PERM ? ((R & ~31) + perm32(R & 31)) : R;
        voffA[i] = (unsigned)(R * K + C) * 2u; voffB[i] = (unsigned)(Rb * K + C) * 2u; }
    const size_t kstep = (size_t)(BK * 2);
    const size_t hstep = (size_t)HALF * K * 2;
    const size_t tstep = 2 * hstep;
    const unsigned ldsw = (unsigned)wid * 1024u;
    const int aoff = lds_byte(wr * 64 + fr, fq * 8), boff = lds_byte(wc * 32 + fr, fq * 8);
#define PG8_SA(b, h) (((b) * 2 + (h)) * HTB)
#define PG8_SB(b, h) ((4 + (b) * 2 + (h)) * HTB)
#define PG8_STAGE(bufoff, gbase, voff) do { _Pragma("unroll") for (int _i = 0; _i < 2; ++_i) \
        __builtin_amdgcn_global_load_lds((const unsigned*)((const char*)(gbase) + (voff)[_i]), (PG8_LAS unsigned*)(lds + (bufoff) + ldsw + _i * 8192), 16, 0, 0); } while (0)
#define PG8_LDA(dst, b, h) do { _Pragma("unroll") for (int m = 0; m < 4; ++m) _Pragma("unroll") for (int k = 0; k < 2; ++k) dst[m][k] = *(const PG8_LAS bf16x8*)(lds + PG8_SA(b, h) + aoff + m * 2048 + k * 1024); } while (0)
#define PG8_LDB(dst, b, h) do { _Pragma("unroll") for (int n = 0; n < 2; ++n) _Pragma("unroll") for (int k = 0; k < 2; ++k) dst[n][k] = *(const PG8_LAS bf16x8*)(lds + PG8_SB(b, h) + boff + n * 2048 + k * 1024); } while (0)
#define PG8_MMA(ai, bj, At, Bt) do { __builtin_amdgcn_s_setprio(1); _Pragma("unroll") for (int m = 0; m < 4; ++m) _Pragma("unroll") for (int n = 0; n < 2; ++n) _Pragma("unroll") for (int k = 0; k < 2; ++k) \
        acc[ai][bj][m][n] = __builtin_amdgcn_mfma_f32_16x16x32_bf16(Bt[n][k], At[m][k], acc[ai][bj][m][n], 0, 0, 0); __builtin_amdgcn_s_setprio(0); } while (0)
#define PG8_WAIT_V(n) asm volatile("s_waitcnt vmcnt(" #n ")" ::: "memory")
#define PG8_WAIT_L(n) asm volatile("s_waitcnt lgkmcnt(" #n ")" ::: "memory")
#define PG8_BAR __builtin_amdgcn_s_barrier()
#define PG8_SCHED __builtin_amdgcn_sched_barrier(0)
    Unit cur, nxt; int ui = 0;
    if (!S.next(0, cur)) return;
    f32x4 acc[2][2][4][2];
#pragma unroll
    for (int a = 0; a < 2; ++a)
#pragma unroll
        for (int b = 0; b < 2; ++b)
#pragma unroll
            for (int m = 0; m < 4; ++m)
#pragma unroll
                for (int n = 0; n < 2; ++n) acc[a][b][m][n] = (f32x4){0.f, 0.f, 0.f, 0.f};
    bf16x8 At[4][2], B0[2][2], B1[2][2];
    const char* cA = (const char*)g.A + (size_t)cur.pm * tstep; const char* cB = (const char*)g.Bt + (size_t)cur.pn * tstep;
    S.a_ready(cur);
    if constexpr (SP2) {
        PG8_STAGE(PG8_SB(0, 0), cB, voffB); PG8_STAGE(PG8_SB(0, 1), cB + hstep, voffB); PG8_STAGE(PG8_SA(0, 0), cA, voffA); PG8_STAGE(PG8_SA(0, 1), cA + hstep, voffA);
        if (wr == 1) PG8_BAR;
        PG8_WAIT_V(2); PG8_BAR;
        PG8_STAGE(PG8_SB(1, 0), cB + kstep, voffB); PG8_STAGE(PG8_SA(1, 0), cA + kstep, voffA); PG8_STAGE(PG8_SB(1, 1), cB + hstep + kstep, voffB);
        PG8_WAIT_V(6); PG8_BAR;
    } else {
        PG8_STAGE(PG8_SB(0, 0), cB, voffB); PG8_STAGE(PG8_SA(0, 0), cA, voffA); PG8_STAGE(PG8_SB(0, 1), cB + hstep, voffB); PG8_STAGE(PG8_SA(0, 1), cA + hstep, voffA);
        if (wr == 1) PG8_BAR;
        PG8_WAIT_V(4); PG8_BAR;
        PG8_STAGE(PG8_SB(1, 0), cB + kstep, voffB); PG8_STAGE(PG8_SA(1, 0), cA + kstep, voffA); PG8_STAGE(PG8_SB(1, 1), cB + hstep + kstep, voffB);
        PG8_WAIT_V(6); PG8_BAR;
    }
    for (;;) {
        const bool has_next = S.next(ui + 1, nxt);
        const char* nA = has_next ? (const char*)g.A + (size_t)nxt.pm * tstep : cA; const char* nB = has_next ? (const char*)g.Bt + (size_t)nxt.pn * tstep : cB;
        for (int t = 0; t < nt; t += 2) {
            const bool last = (t == nt - 2);
            const char* a1 = cA + (size_t)(t + 1) * kstep;
            const char* a2 = last ? nA : cA + (size_t)(t + 2) * kstep; const char* b2 = last ? nB : cB + (size_t)(t + 2) * kstep;
            const char* a3 = a2 + kstep; const char* b3 = b2 + kstep;
            if (last && has_next) S.a_ready(nxt);
            if constexpr (SP2) {
            PG8_LDB(B0, 0, 0); PG8_LDB(B1, 0, 1); PG8_SCHED; PG8_LDA(At, 0, 0); PG8_STAGE(PG8_SA(1, 1), a1 + hstep, voffA);
            PG8_WAIT_V(8); PG8_WAIT_L(0); PG8_BAR; PG8_MMA(0, 0, At, B0); PG8_MMA(0, 1, At, B1); PG8_BAR; PG8_SCHED;
            PG8_LDA(At, 0, 1); PG8_STAGE(PG8_SB(0, 0), b2, voffB); PG8_STAGE(PG8_SB(0, 1), b2 + hstep, voffB); PG8_STAGE(PG8_SA(0, 0), a2, voffA);
            PG8_WAIT_V(8); PG8_WAIT_L(0); PG8_BAR; PG8_MMA(1, 0, At, B0); PG8_MMA(1, 1, At, B1); PG8_BAR; PG8_SCHED;
            PG8_LDB(B0, 1, 0); PG8_LDB(B1, 1, 1); PG8_SCHED; PG8_LDA(At, 1, 0); PG8_STAGE(PG8_SA(0, 1), a2 + hstep, voffA);
            PG8_WAIT_V(8); PG8_WAIT_L(0); PG8_BAR; PG8_MMA(0, 0, At, B0); PG8_MMA(0, 1, At, B1); PG8_BAR; PG8_SCHED;
            PG8_LDA(At, 1, 1); PG8_STAGE(PG8_SB(1, 0), b3, voffB); PG8_STAGE(PG8_SB(1, 1), b3 + hstep, voffB); PG8_STAGE(PG8_SA(1, 0), a3, voffA);
            PG8_WAIT_V(8); PG8_WAIT_L(0); PG8_BAR; PG8_MMA(1, 0, At, B0); PG8_MMA(1, 1, At, B1); PG8_BAR; PG8_SCHED;
            } else {
            PG8_LDB(B0, 0, 0); PG8_SCHED; PG8_LDA(At, 0, 0); PG8_STAGE(PG8_SA(1, 1), a1 + hstep, voffA);
            PG8_WAIT_L(8); PG8_BAR; PG8_WAIT_L(0); PG8_MMA(0, 0, At, B0); PG8_BAR; PG8_SCHED;
            PG8_LDB(B1, 0, 1); PG8_STAGE(PG8_SB(0, 0), b2, voffB);
            PG8_BAR; PG8_WAIT_L(0); PG8_MMA(0, 1, At, B1); PG8_BAR;
            PG8_LDA(At, 0, 1); PG8_STAGE(PG8_SA(0, 0), a2, voffA);
            PG8_BAR; PG8_WAIT_L(0); PG8_MMA(1, 0, At, B0); PG8_BAR; PG8_SCHED;
            PG8_STAGE(PG8_SB(0, 1), b2 + hstep, voffB);
            PG8_WAIT_V(6); PG8_BAR; PG8_MMA(1, 1, At, B1); PG8_BAR;
            PG8_LDB(B0, 1, 0); PG8_SCHED; PG8_LDA(At, 1, 0); PG8_STAGE(PG8_SA(0, 1), a2 + hstep, voffA);
            PG8_WAIT_L(8); PG8_BAR; PG8_WAIT_L(0); PG8_MMA(0, 0, At, B0); PG8_BAR; PG8_SCHED;
            PG8_LDB(B1, 1, 1); PG8_STAGE(PG8_SB(1, 0), b3, voffB);
            PG8_BAR; PG8_WAIT_L(0); PG8_MMA(0, 1, At, B1); PG8_BAR;
            PG8_LDA(At, 1, 1); PG8_STAGE(PG8_SA(1, 0), a3, voffA);
            PG8_BAR; PG8_WAIT_L(0); PG8_MMA(1, 0, At, B0); PG8_BAR; PG8_SCHED;
            PG8_STAGE(PG8_SB(1, 1), b3 + hstep, voffB);
            PG8_WAIT_V(6); PG8_BAR; PG8_MMA(1, 1, At, B1); PG8_BAR;
            }
        }
        if constexpr (ALIGN_EPI) { if (wr == 0) PG8_BAR; }
        if constexpr (!Epi::AFTER_DRAIN) { E(acc, cur, wr, wc, fr, fq); S.done(cur); }
        if (!has_next) break;
#pragma unroll
        for (int a = 0; a < 2; ++a)
#pragma unroll
            for (int b = 0; b < 2; ++b)
#pragma unroll
                for (int m = 0; m < 4; ++m)
#pragma unroll
                    for (int n = 0; n < 2; ++n) acc[a][b][m][n] = (f32x4){0.f, 0.f, 0.f, 0.f};
        cur = nxt; cA = nA; cB = nB; ++ui;
        if constexpr (ALIGN_EPI) { if (wr == 1) PG8_BAR; }
    }
    PG8_WAIT_V(0);
    if constexpr (!ALIGN_EPI) { if (wr == 0) PG8_BAR; }
    PG8_BAR;
    if constexpr (Epi::AFTER_DRAIN) { E.fused(acc, cur, wr, wc, fr, fq, lds, wid, lane); S.done(cur); }
#undef PG8_SA
#undef PG8_SB
#undef PG8_STAGE
#undef PG8_LDA
#undef PG8_LDB
#undef PG8_MMA
#undef PG8_WAIT_V
#undef PG8_WAIT_L
#undef PG8_BAR
#undef PG8_SCHED
}
}

#ifndef PG8_SP2
#define PG8_SP2 true
#endif
#ifndef PG8_ALIGN
#define PG8_ALIGN true
#endif
#include <hip/hip_bf16.h>
#include <cmath>
namespace attn_body {
using bf16=__hip_bfloat16;
using bf16x8=__attribute__((ext_vector_type(8)))short;
using s16x4=__attribute__((ext_vector_type(4)))short;
using f32x16=__attribute__((ext_vector_type(16)))float;
using u32x4=__attribute__((ext_vector_type(4)))unsigned;
constexpr int BATCH=1,NHEAD=16,SEQ=16384,D=64,DM=2112,DMO=1024;
constexpr int NW=8,QBLK=32,QB=QBLK*NW,KVBLK=64,NQB=SEQ/QB;
constexpr int ATTN_PITCH=DM, ATTN_UNIT_ROWS=QB;
__device__ __forceinline__ int crow(int r,int hi){return (r&3)+8*(r>>2)+4*hi;}
#define SBAR() __builtin_amdgcn_sched_barrier(0)
__device__ __forceinline__ void cmask(f32x16&p0,f32x16&p1,int jb,int qrel,int hi){
  const float NEG=-INFINITY; int kb=64*jb+4*hi;
  #pragma unroll
  for(int r=0;r<16;++r){int kv=kb+(r&3)+8*(r>>2); if(kv>qrel)p0[r]=NEG; if(kv+32>qrel)p1[r]=NEG;}
}

constexpr int NSLOT=3, SLOTB=8192;
constexpr int NVSLOT=3, VSLOTB=16384;
constexpr int LDS_K=0, LDS_V=NSLOT*SLOTB, LDS_P=LDS_V+NVSLOT*VSLOTB, LDS_WS=LDS_P+NW*8192, WSF_STRIDE=64, LDS_BYTES=LDS_WS+NW*WSF_STRIDE*4;
constexpr float C2=0.125f*1.4426950408889634f;
__device__ __forceinline__ void glds16(const void*gsrc,unsigned lds_dst){unsigned keep;
  asm volatile("s_mov_b32 %0, m0\n\ts_mov_b32 m0, %2\n\ts_nop 0\n\tglobal_load_lds_dwordx4 %1, off\n\ts_mov_b32 m0, %0":"=&s"(keep):"v"(gsrc),"s"(lds_dst):"memory");}
__device__ __forceinline__ float max3f(float a,float b,float c){float r;asm("v_max3_f32 %0, %1, %2, %3":"=v"(r):"v"(a),"v"(b),"v"(c));return r;}
__device__ __forceinline__ float max2f(float a,float b){float r;asm("v_max_f32_e32 %0, %1, %2":"=v"(r):"v"(a),"v"(b));return r;}
__device__ __forceinline__ float fadd_s(float a,float b){float r;asm("v_add_f32_e32 %0, %1, %2":"=v"(r):"v"(a),"v"(b));return r;}
__device__ __forceinline__ float fsub_s(float a,float b){float r;asm("v_sub_f32_e32 %0, %1, %2":"=v"(r):"v"(a),"v"(b));return r;}
typedef float f32x2_t __attribute__((ext_vector_type(2))); typedef __bf16 bf16x2_t __attribute__((ext_vector_type(2)));
__device__ __forceinline__ unsigned cvtpk_s(float lo,float hi){f32x2_t v={lo,hi};bf16x2_t b=__builtin_convertvector(v,bf16x2_t);return __builtin_bit_cast(unsigned,b);}
#define WAIT_BAR(N) asm volatile("s_waitcnt vmcnt(" #N ") lgkmcnt(0)\n\ts_barrier":::"memory")

__device__ __forceinline__ void qkt(f32x16&p0,f32x16&p1,const char*Kslot,const bf16x8*qr,const f32x16&negm,int r32,int hi){
  const char*kb=Kslot+hi*1024+r32*16;
  #pragma unroll
  for(int d0=0;d0<4;++d0){
    const bf16x8 b0=*reinterpret_cast<const bf16x8*>(kb+d0*2048);
    const bf16x8 b1=*reinterpret_cast<const bf16x8*>(kb+d0*2048+512);
    if(d0==0){p0=__builtin_amdgcn_mfma_f32_32x32x16_bf16(b0,qr[0],negm,0,0,0);p1=__builtin_amdgcn_mfma_f32_32x32x16_bf16(b1,qr[0],negm,0,0,0);}
    else{p0=__builtin_amdgcn_mfma_f32_32x32x16_bf16(b0,qr[d0],p0,0,0,0);p1=__builtin_amdgcn_mfma_f32_32x32x16_bf16(b1,qr[d0],p1,0,0,0);}}
}
typedef __attribute__((address_space(3))) const char* lds_cptr;
typedef short v4i16_t __attribute__((ext_vector_type(4)));
__device__ __forceinline__ void kload8(bf16x8*kf,lds_cptr kp){
  kf[0]=*(const __attribute__((address_space(3))) bf16x8*)(kp);      kf[1]=*(const __attribute__((address_space(3))) bf16x8*)(kp+512);
  kf[2]=*(const __attribute__((address_space(3))) bf16x8*)(kp+2048); kf[3]=*(const __attribute__((address_space(3))) bf16x8*)(kp+2560);
  kf[4]=*(const __attribute__((address_space(3))) bf16x8*)(kp+4096); kf[5]=*(const __attribute__((address_space(3))) bf16x8*)(kp+4608);
  kf[6]=*(const __attribute__((address_space(3))) bf16x8*)(kp+6144); kf[7]=*(const __attribute__((address_space(3))) bf16x8*)(kp+6656);
}
__device__ __forceinline__ void kload2(bf16x8*kf,lds_cptr kp,int j){ kf[2*j]=*(const __attribute__((address_space(3))) bf16x8*)(kp+j*2048); kf[2*j+1]=*(const __attribute__((address_space(3))) bf16x8*)(kp+j*2048+512); }
__device__ __forceinline__ s16x4 vtr(lds_cptr p){ return __builtin_bit_cast(s16x4,__builtin_amdgcn_ds_read_tr16_b64_v4i16((__attribute__((address_space(3))) v4i16_t*)p)); }
__device__ __forceinline__ float rowmax(const f32x16&p0,const f32x16&p1){
  float a=max3f(p0[0],p0[1],p1[0]),b=max3f(p0[2],p0[3],p1[1]);a=max3f(a,p1[2],p1[3]);
  #pragma unroll
  for(int r=4;r<16;r+=4){a=max3f(a,p0[r],p0[r+1]);b=max3f(b,p0[r+2],p0[r+3]);a=max3f(a,p1[r],p1[r+1]);b=max3f(b,p1[r+2],p1[r+3]);}
  const float m=max2f(a,b);
  auto rr=__builtin_amdgcn_permlane32_swap(__float_as_uint(m),__float_as_uint(m),false,false);
  return max2f(__uint_as_float(rr[0]),__uint_as_float(rr[1]));
}
__device__ __forceinline__ void pv(f32x16*o,int vb,bf16x8 pa0,bf16x8 pa1,bf16x8 pa2,bf16x8 pa3){
  #pragma unroll
  for(int d0=0;d0<2;++d0){s16x4 lo[4],hi[4];
    #pragma unroll
    for(int ks=0;ks<4;++ks){
      asm volatile("ds_read_b64_tr_b16 %0,%1 offset:%c2":"=&v"(lo[ks]):"v"(vb),"i"(d0*4096+ks*1024):"memory");
      asm volatile("ds_read_b64_tr_b16 %0,%1 offset:%c2":"=&v"(hi[ks]):"v"(vb),"i"(d0*4096+ks*1024+512):"memory");}
    asm volatile("s_waitcnt lgkmcnt(0)":::"memory");SBAR();
    #define PK(k) (bf16x8){lo[k][0],lo[k][1],lo[k][2],lo[k][3],hi[k][0],hi[k][1],hi[k][2],hi[k][3]}
    o[d0]=__builtin_amdgcn_mfma_f32_32x32x16_bf16(pa0,PK(0),o[d0],0,0,0);
    o[d0]=__builtin_amdgcn_mfma_f32_32x32x16_bf16(pa1,PK(1),o[d0],0,0,0);
    o[d0]=__builtin_amdgcn_mfma_f32_32x32x16_bf16(pa2,PK(2),o[d0],0,0,0);
    o[d0]=__builtin_amdgcn_mfma_f32_32x32x16_bf16(pa3,PK(3),o[d0],0,0,0);
    #undef PK
  }
}

#ifndef ATTN_STORE16
#define ATTN_STORE16(p,v) (*(u32x4*)(p)=(v))
#endif
template<int THRL> __device__ __forceinline__ void attn_unit(int qb,const bf16*Q,const bf16*__restrict__ K,const bf16*__restrict__ V,bf16*O,char*shm){
  int tid_=threadIdx.x; asm volatile("":"+v"(tid_)); const int tid=tid_,lane=tid&63,r32=lane&31,hi=lane>>5; const int wid=__builtin_amdgcn_readfirstlane(tid>>6);
  const int q0=qb*QB;
  const unsigned lds0=(unsigned)(uintptr_t)shm;
  float*wsf=(float*)(shm+LDS_WS)+wid*WSF_STRIDE;
  const bf16*ksrc=K+(long)lane*DM+wid*8;
  const bf16*vsrc=V+(long)(16*(wid&3)+(lane>>2))*DM+(wid>>2)*32+(lane&3)*8;
  const unsigned kdst=lds0+LDS_K+wid*1024, vdst=lds0+LDS_V+wid*1024;
  #define DMA_K(t,s3) glds16(ksrc+(long)(t)*KVBLK*DM,(unsigned)__builtin_amdgcn_readfirstlane(kdst+(s3)*SLOTB))
  #define DMA_V(t,s3) do{ const unsigned vd_=(unsigned)__builtin_amdgcn_readfirstlane(vdst+(s3)*VSLOTB); glds16(vsrc+(long)(t)*KVBLK*DM,vd_); glds16(vsrc+(long)(t)*KVBLK*DM+64,(unsigned)__builtin_amdgcn_readfirstlane(vd_+8192)); }while(0)
  const lds_cptr shm3=(lds_cptr)shm;
  const int NT=(q0+QB)/KVBLK;
  DMA_K(0,0);DMA_V(0,0);DMA_K(1,1);DMA_V(1,1);
  int c0=0,c1=1,c2=2;
  #define ROT3() do{ const int x_=c0; c0=c1; c1=c2; c2=x_; }while(0)
  #define PKW(P,B) cvtpk_s(P[B],P[B+1])
  #define MX3(a,b,c) __builtin_fmaxf(__builtin_fmaxf((a),(b)),(c))
  const bf16*Qw=Q+(long)(q0+wid*QBLK)*DM;
  bf16x8 qr[4];
  #pragma unroll
  for(int d0=0;d0<4;++d0)qr[d0]=*reinterpret_cast<const bf16x8*>(&Qw[(long)r32*DM+d0*16+hi*8]);
  float mhat=0.f,l_reg=0.f; f32x16 negm=f32x16{};
  f32x16 o[4]; o[0]=f32x16{};o[1]=f32x16{};o[2]=f32x16{};o[3]=f32x16{};
  const int qrel=wid*QBLK+r32;
  const lds_cptr kp0=shm3+LDS_K+hi*1024+r32*16;
  const lds_cptr vp0=shm3+LDS_V+((lane>>4)&1)*32+(lane&3)*8+(4*hi+((lane&15)>>2))*64;
  WAIT_BAR(3);
  for(int t=0;t<NT;++t){
    if(t+2<NT){DMA_K(t+2,c2);DMA_V(t+2,c2);}
    bf16x8 kf[8]; kload8(kf,kp0+c0*SLOTB);
    SBAR();
    f32x16 C0,C1;
    {
      C0=__builtin_amdgcn_mfma_f32_32x32x16_bf16(kf[0],qr[0],negm,0,0,0); C1=__builtin_amdgcn_mfma_f32_32x32x16_bf16(kf[1],qr[0],negm,0,0,0);
      C0=__builtin_amdgcn_mfma_f32_32x32x16_bf16(kf[2],qr[1],C0,0,0,0);   C1=__builtin_amdgcn_mfma_f32_32x32x16_bf16(kf[3],qr[1],C1,0,0,0);
      C0=__builtin_amdgcn_mfma_f32_32x32x16_bf16(kf[4],qr[2],C0,0,0,0);   C1=__builtin_amdgcn_mfma_f32_32x32x16_bf16(kf[5],qr[2],C1,0,0,0);
      C0=__builtin_amdgcn_mfma_f32_32x32x16_bf16(kf[6],qr[3],C0,0,0,0);   C1=__builtin_amdgcn_mfma_f32_32x32x16_bf16(kf[7],qr[3],C1,0,0,0); }
    SBAR();
    const lds_cptr vp_=vp0+c0*VSLOTB; s16x4 vl_[8],vh_[8];
    #pragma unroll
    for(int k2=0;k2<2;++k2)
      #pragma unroll
      for(int d_=0;d_<4;++d_){ vl_[d_*2+k2]=vtr(vp_+(d_*4096+k2*1024)); vh_[d_*2+k2]=vtr(vp_+(d_*4096+k2*1024+512)); }
    SBAR();
    { const int jb_=t-(NT-4); if(jb_>=0)cmask(C0,C1,jb_,qrel,hi); }
    float a=MX3(C0[0],C0[1],C1[0]),b=MX3(C0[2],C0[3],C1[1]); a=MX3(a,C1[2],C1[3]);
    #pragma unroll
    for(int r=4;r<16;r+=4){a=MX3(a,C0[r],C0[r+1]);b=MX3(b,C0[r+2],C0[r+3]);a=MX3(a,C1[r],C1[r+1]);b=MX3(b,C1[r+2],C1[r+3]);}
    float rm=__builtin_fmaxf(a,b); { auto rr=__builtin_amdgcn_permlane32_swap(__float_as_uint(rm),__float_as_uint(rm),false,false); rm=__builtin_fmaxf(__uint_as_float(rr[0]),__uint_as_float(rr[1])); }
    if(t==0 || __any(rm>(float)THRL)){
      const float dl=(t==0)?rm:__builtin_fmaxf(rm,0.f); mhat+=dl;
      #pragma unroll
      for(int r=0;r<16;++r){C0[r]-=dl;C1[r]-=dl;}
      #pragma unroll
      for(int r=0;r<16;++r)negm[r]=-mhat;
      if(t!=0){ const float f=__builtin_amdgcn_exp2f(-dl); l_reg*=f; if(hi==0)wsf[r32]=f; asm volatile("s_waitcnt lgkmcnt(0)":::"memory");
        #pragma unroll
        for(int d_=0;d_<4;++d_)
          #pragma unroll
          for(int r=0;r<16;++r)o[d_][r]*=wsf[crow(r,hi)]; } }
    #pragma unroll
    for(int r=0;r<16;++r){C0[r]=__builtin_amdgcn_exp2f(C0[r]);C1[r]=__builtin_amdgcn_exp2f(C1[r]);}
    { float s0=C0[0]+C0[1],s1=C1[0]+C1[1];
      #pragma unroll
      for(int r=2;r<16;++r){s0+=C0[r];s1+=C1[r];}
      l_reg+=s0+s1; }
    const u32x4 pw0=(u32x4){PKW(C0,0),PKW(C0,2),PKW(C0,4),PKW(C0,6)},pw1=(u32x4){PKW(C0,8),PKW(C0,10),PKW(C0,12),PKW(C0,14)},pw2=(u32x4){PKW(C1,0),PKW(C1,2),PKW(C1,4),PKW(C1,6)},pw3=(u32x4){PKW(C1,8),PKW(C1,10),PKW(C1,12),PKW(C1,14)};
    SBAR();
    #define VFRAG(L_,H_,i_) (bf16x8){L_[i_][0],L_[i_][1],L_[i_][2],L_[i_][3],H_[i_][0],H_[i_][1],H_[i_][2],H_[i_][3]}
    s16x4 w2l_[4],w2h_[4],w3l_[4],w3h_[4];
    #pragma unroll
    for(int d_=0;d_<4;++d_){ w2l_[d_]=vtr(vp_+(d_*4096+2*1024)); w2h_[d_]=vtr(vp_+(d_*4096+2*1024+512)); }
    SBAR();
    #pragma unroll
    for(int d_=0;d_<4;++d_){ o[d_]=__builtin_amdgcn_mfma_f32_32x32x16_bf16(__builtin_bit_cast(bf16x8,pw0),VFRAG(vl_,vh_,d_*2),o[d_],0,0,0); }
    SBAR();
    #pragma unroll
    for(int d_=0;d_<4;++d_){ w3l_[d_]=vtr(vp_+(d_*4096+3*1024)); w3h_[d_]=vtr(vp_+(d_*4096+3*1024+512)); }
    SBAR();
    #pragma unroll
    for(int d_=0;d_<4;++d_){ o[d_]=__builtin_amdgcn_mfma_f32_32x32x16_bf16(__builtin_bit_cast(bf16x8,pw1),VFRAG(vl_,vh_,d_*2+1),o[d_],0,0,0); }
    #pragma unroll
    for(int d_=0;d_<4;++d_){ o[d_]=__builtin_amdgcn_mfma_f32_32x32x16_bf16(__builtin_bit_cast(bf16x8,pw2),VFRAG(w2l_,w2h_,d_),o[d_],0,0,0); }
    #pragma unroll
    for(int d_=0;d_<4;++d_){ o[d_]=__builtin_amdgcn_mfma_f32_32x32x16_bf16(__builtin_bit_cast(bf16x8,pw3),VFRAG(w3l_,w3h_,d_),o[d_],0,0,0); }
    SBAR();
    #undef VFRAG
    if(t+2<NT){WAIT_BAR(3);}else{WAIT_BAR(0);}
    ROT3();
  }
  { auto rr=__builtin_amdgcn_permlane32_swap(__float_as_uint(l_reg),__float_as_uint(l_reg),false,false); l_reg=__uint_as_float(rr[0])+__uint_as_float(rr[1]); }
  if(hi==0)wsf[32+r32]=l_reg; asm volatile("s_waitcnt lgkmcnt(0)":::"memory");
  bf16*Ow=O+(long)(q0+wid*QBLK)*DMO;
  { bf16*stg=(bf16*)(shm+LDS_P)+wid*4096;
    #pragma unroll
    for(int r=0;r<16;++r){const int orow=crow(r,hi); const float rl=__builtin_amdgcn_rcpf(wsf[32+orow]);
      #pragma unroll
      for(int d0=0;d0<4;++d0)stg[orow*128+d0*32+r32]=__float2bfloat16(o[d0][r]*rl);}
    asm volatile("s_waitcnt lgkmcnt(0)":::"memory");
    #pragma unroll
    for(int i=0;i<8;++i){const int row=i*4+(lane>>4),ch=lane&15; const u32x4 v=*(const u32x4*)(stg+row*128+ch*8); ATTN_STORE16(Ow+(long)row*DMO+ch*8,v);} }
  asm volatile("s_waitcnt lgkmcnt(0)\n\ts_barrier":::"memory");
  #undef DMA_K
  #undef DMA_V
  #undef ROT3
  #undef PKW
  #undef MX3
}
constexpr int ATTN_LDS_BYTES=LDS_BYTES;
struct AttnTensors { const bf16* Q; const bf16* K; const bf16* V; bf16* O; };
struct AttnUnit { int hc; int qb; };
struct StaticOrder {
  int vcu, G, bx;
  __device__ __forceinline__ StaticOrder(int grid,int block):vcu((grid%8==0)?(block%8)*(grid/8)+block/8:block),G(grid),bx(block){}
  __device__ __forceinline__ bool next(int i,AttnUnit&u)const{
    if(G==256){ if(i>=2)return false; const int s=vcu&31; u.hc=vcu>>5; u.qb=(i==0)?63-s:s; return true; }
    const int idx=i*G+bx; if(idx>=8*NQB)return false; u.hc=idx&7; u.qb=NQB-1-(idx>>3); return true; }
};
template<class Sched,int THRL=8> __device__ __forceinline__ void attn_phase(char*lds,const AttnTensors&T,const Sched&S){
  AttnUnit u;
  for(int i=0;S.next(i,u);++i){ const int h=u.hc>>1,c=u.hc&1;
    attn_unit<THRL>(u.qb,T.Q+h*128+c*64,T.K+h*128+c*64,T.V+h*128,T.O+u.hc*128,lds); }
}
#undef SBAR
#undef WAIT_BAR
}
constexpr int NWAVES = 8;
constexpr int M = 16384, D = 1024, FF = 2816, NGU = 2 * FF, NIN = 2048, DEPTH = 4;
constexpr size_t MiB = 1u << 20;
constexpr size_t WS_ROWSS = 1 * MiB;
constexpr size_t WS_ROPE = 2 * MiB;
constexpr size_t WS_XB = 8 * MiB;
constexpr size_t WS_H = 40 * MiB;
constexpr size_t WS_QKVU = 40 * MiB;
constexpr size_t WS_OBUF = 108 * MiB;
constexpr size_t WS_CAT = 140 * MiB;
constexpr size_t WS_W = 172 * MiB;
constexpr size_t OFF_GU1 = 0, OFF_DN1 = 11 * MiB, OFF_IN = 16 * MiB + 512 * 1024, OFF_OUT = 20 * MiB + 512 * 1024, OFF_GU2 = 22 * MiB + 512 * 1024, OFF_DN2 = 33 * MiB + 512 * 1024, W_LAYER = 39 * MiB;
constexpr size_t WS_XL = WS_W + DEPTH * W_LAYER;
constexpr size_t WS_END = WS_XL + (size_t)M * D;
static_assert(attn_body::ATTN_LDS_BYTES <= 147392 && (size_t)NGU * D * 2 == 11 * MiB && (size_t)D * FF * 2 == 5 * MiB + 512 * 1024 && WS_H + (size_t)M * FF * 2 <= WS_CAT && WS_ROWSS + 16 * (size_t)M * 4 <= WS_ROPE && WS_ROPE + (size_t)M * 64 * 4 <= WS_XB, "ws map");
constexpr int LDS_BYTES = 147456;

#define LAS __attribute__((address_space(3)))
typedef unsigned short bf16;
typedef unsigned v4u __attribute__((ext_vector_type(4)));
typedef unsigned v2u __attribute__((ext_vector_type(2)));
typedef float f32x4 __attribute__((ext_vector_type(4)));
#define LDS_WAIT() asm volatile("s_waitcnt lgkmcnt(0)" ::: "memory")
__device__ __forceinline__ unsigned f2bf(float f) { unsigned u = __builtin_bit_cast(unsigned, f); return (u + 0x7fffu + ((u >> 16) & 1u)) >> 16; }
__device__ __forceinline__ unsigned pk2(float lo, float hi) { return f2bf(lo) | (f2bf(hi) << 16); }
__device__ __forceinline__ float bflo(unsigned w) { return __builtin_bit_cast(float, w << 16); }
__device__ __forceinline__ float bfhi(unsigned w) { return __builtin_bit_cast(float, w & 0xffff0000u); }
__device__ __forceinline__ float wave_sum(float v) {
#pragma unroll
    for (int o = 1; o < 64; o <<= 1) v += __shfl_xor(v, o);
    return v;
}
struct TrDesc { const float* W; const float* gk; bf16* WT; int N, k0, n0, Kd, rbase, rstride; };
__device__ __forceinline__ void tr_load(const TrDesc& d, int lane, f32x4 (&v)[8]) {
    const int kblk = lane & 7, n4 = lane >> 3;
    const float* src = d.W + (size_t)(d.k0 + 8 * kblk) * d.N + d.n0 + 4 * n4;
#pragma unroll
    for (int i = 0; i < 8; ++i) v[i] = __builtin_nontemporal_load((const f32x4*)(src + (size_t)i * d.N));
}
__device__ __forceinline__ void tr_store(const TrDesc& d, int lane, f32x4 (&v)[8]) {
    const int kblk = lane & 7, n4 = lane >> 3;
    if (d.gk) { const f32x4 g0 = *(const f32x4*)(d.gk + d.k0 + 8 * kblk), g1 = *(const f32x4*)(d.gk + d.k0 + 8 * kblk + 4);
#pragma unroll
        for (int i = 0; i < 4; ++i) { v[i] = v[i] * g0[i]; v[4 + i] = v[4 + i] * g1[i]; } }
#pragma unroll
    for (int e = 0; e < 4; ++e) { v4u o; o.x = pk2(v[0][e], v[1][e]); o.y = pk2(v[2][e], v[3][e]); o.z = pk2(v[4][e], v[5][e]); o.w = pk2(v[6][e], v[7][e]);
        *(v4u*)(d.WT + (size_t)(d.rbase + (4 * n4 + e) * d.rstride) * d.Kd + d.k0 + 8 * kblk) = o; }
}

#define XB_TMO      128
#define XB_XCNT(j)  (256  + 64 * (j))
#define XB_XSUB(j)  (1280 + 64 * (j))
#define XB_XGEN(j)  (2304 + 64 * (j))
#define XB_TOP      3328
#define XB_TOPGEN   3392
#define XCD_BAR_WORDS 3456
#define XB_SPIN_CAP (1u << 18)

__device__ __forceinline__ unsigned xb_ld(unsigned* p)              { return __hip_atomic_load(p, __ATOMIC_RELAXED, __HIP_MEMORY_SCOPE_AGENT); }
__device__ __forceinline__ unsigned xb_add(unsigned* p, unsigned v) { return __hip_atomic_fetch_add(p, v, __ATOMIC_RELAXED, __HIP_MEMORY_SCOPE_AGENT); }
__device__ __forceinline__ unsigned xb_xcc_id() { return (unsigned)__builtin_amdgcn_s_getreg((3 << 11) | 20) & 0xFu; }
#define XB_SPIN(cond, bar) do { unsigned _sp = 0; while (cond) { __builtin_amdgcn_s_sleep(1); \
    if ((++_sp & 255u) == 0u) { if (xb_ld(&(bar)[XB_TMO])) break; if (_sp > XB_SPIN_CAP) { atomicAdd(&(bar)[XB_TMO], 1u); break; } } } } while (0)

struct XcdBarrier {
    unsigned* bar; unsigned x;
    volatile LAS unsigned* st;
};

__device__ __forceinline__ XcdBarrier xcd_barrier_post(unsigned* bar, volatile LAS unsigned* st) {
    XcdBarrier b; b.bar = bar; b.x = xb_xcc_id(); b.st = st;
    if (threadIdx.x == 0) (void)xb_add(&bar[XB_XCNT(b.x)], 1u);
    return b;
}
__device__ __forceinline__ void xcd_barrier_complete(unsigned* bar, unsigned x, unsigned& nloc, unsigned& nx) {
    const unsigned G = gridDim.x * gridDim.y * gridDim.z;
    unsigned sum, cnt, mine, sp = 0u;
    for (;;) {
        sum = 0u; cnt = 0u; mine = 0u;
#pragma unroll
        for (unsigned j = 0; j < 16; ++j) { const unsigned c = xb_ld(&bar[XB_XCNT(j)]); sum += c; cnt += (c > 0u) ? 1u : 0u; mine = (j == x) ? c : mine; }
        if (sum == G) break;
        __builtin_amdgcn_s_sleep(1);
        if ((++sp & 255u) == 0u) { if (xb_ld(&bar[XB_TMO])) break; if (sp > XB_SPIN_CAP) { atomicAdd(&bar[XB_TMO], 1u); break; } }
    }
    nloc = mine > 0u ? mine : 1u; nx = cnt > 0u ? cnt : 1u;
}

__device__ __forceinline__ void xcd_barrier(const XcdBarrier& b) {
    asm volatile("s_waitcnt vmcnt(0)" ::: "memory");
    __syncthreads();
    if (threadIdx.x == 0) {
        unsigned* bar = b.bar;
        __builtin_amdgcn_s_waitcnt(0);
        unsigned nloc = b.st[0], nx = b.st[1];
        if (nloc == 0u) { xcd_barrier_complete(bar, b.x, nloc, nx); b.st[0] = nloc; b.st[1] = nx; }
        const unsigned old = xb_add(&bar[XB_XSUB(b.x)], 1u);
        const unsigned gen = old / nloc;
        if (old + 1u == (gen + 1u) * nloc) {
            __builtin_amdgcn_fence(__ATOMIC_RELEASE, "agent");
            asm volatile("s_waitcnt vmcnt(0)" ::: "memory");
            const unsigned og = xb_add(&bar[XB_TOP], 1u);
            const unsigned tg = og / nx;
            if (og + 1u == (tg + 1u) * nx) xb_add(&bar[XB_TOPGEN], 1u);
            else XB_SPIN(xb_ld(&bar[XB_TOPGEN]) == tg, bar);
            __builtin_amdgcn_fence(__ATOMIC_ACQUIRE, "agent");
            xb_add(&bar[XB_XGEN(b.x)], 1u);
            asm volatile("s_waitcnt vmcnt(0)" ::: "memory");
        } else {
            XB_SPIN(xb_ld(&bar[XB_XGEN(b.x)]) == gen, bar);
            __builtin_amdgcn_fence(__ATOMIC_ACQUIRE, "agent");
            asm volatile("s_waitcnt vmcnt(0)" ::: "memory");
        }
    }
    __syncthreads();
}

struct Args { const float* in[20]; float* out; unsigned char* wsp; };
__device__ __forceinline__ int fresh_lane() { int l; asm volatile("v_mbcnt_lo_u32_b32 %0, -1, 0\n\tv_mbcnt_hi_u32_b32 %0, -1, %0" : "=v"(l)); return l; }
typedef __attribute__((address_space(1))) unsigned char* gptr_t;
__device__ __forceinline__ gptr_t fresh_ptr(unsigned char* p) { asm volatile("" : "+s"(p)); return (gptr_t)p; }

__global__ void __launch_bounds__(NWAVES * 64, 2) hymba_fwd(Args args) {
    extern __shared__ __attribute__((aligned(16))) unsigned char lds[];
    LAS unsigned char* L = (LAS unsigned char*)lds;
    const int tid = threadIdx.x, lane = tid & 63, wave = __builtin_amdgcn_readfirstlane(tid >> 6);
    const int G = gridDim.x, bx = blockIdx.x;
    const int gw = bx * NWAVES + wave, NGW = G * NWAVES;
    const int gtid = bx * (NWAVES * 64) + tid, NT = G * NWAVES * 64;
#define ws (fresh_ptr(args.wsp))
#define rowss ((float*)(unsigned char*)(ws + WS_ROWSS))
#define rope ((float*)(unsigned char*)(ws + WS_ROPE))
#define XB ((bf16*)(unsigned char*)(ws + WS_XB))
#define HB ((bf16*)(unsigned char*)(ws + WS_H))
#define QKVU ((bf16*)(unsigned char*)(ws + WS_QKVU))
#define OBUF ((bf16*)(unsigned char*)(ws + WS_OBUF))
#define CAT ((bf16*)(unsigned char*)(ws + WS_CAT))
#define xout ((float*)(unsigned char*)fresh_ptr((unsigned char*)args.out))
    { volatile LAS unsigned* st0 = (volatile LAS unsigned*)(L + 147392); if (tid < 2) st0[tid] = 0u; }
    __syncthreads();
    (void)xcd_barrier_post((unsigned*)args.wsp, (volatile LAS unsigned*)(L + 147392));

    {
        constexpr int IT_G = 16 * 88, IT_D = 44 * 32, IT_IN = 16 * 64, IT_OUT = 8 * 32, IT_LAYER = 4 * IT_G + 2 * IT_D + IT_IN + IT_OUT;
        static_assert(IT_G == IT_D, "item decode");
#define TR_DECODE(d_, it_) do { const int l = (it_) / IT_LAYER; int r = (it_) % IT_LAYER; unsigned char* wlc_ = (unsigned char*)(ws + WS_W + (size_t)l * W_LAYER); \
            if (r < 6 * IT_G) { \
                const int f = r / (3 * IT_G), q = r % (3 * IT_G), kind = q / IT_G, i = q % IT_G; \
                if (kind < 2) { const int kb = i / 88, nb = i % 88, n0 = 32 * nb; \
                    d_ = TrDesc{args.in[(f ? 16 : 2) + kind] + (size_t)l * D * FF, args.in[f ? 15 : 1] + l * D, (bf16*)(wlc_ + (f ? OFF_GU2 : OFF_GU1)), FF, 64 * kb, n0, D, (n0 >> 7) * 256 + kind * 128 + (n0 & 127), 1}; } \
                else { const int kb = i / 32, nb = i % 32; \
                    d_ = TrDesc{args.in[f ? 18 : 4] + (size_t)l * FF * D, nullptr, (bf16*)(wlc_ + (f ? OFF_DN2 : OFF_DN1)), D, 64 * kb, 32 * nb, FF, 32 * nb, 1}; } \
            } else { r -= 6 * IT_G; \
                if (r < IT_IN) { const int kb = r / 64, nb = r % 64, n0 = 32 * nb; int rbase = n0, rstride = 1; \
                    if (n0 < 1024) { const int d0 = n0 & 63; rbase = (n0 - d0) + (d0 ? 1 : 0); rstride = 2; } \
                    d_ = TrDesc{args.in[6] + (size_t)l * D * NIN, args.in[5] + l * D, (bf16*)(wlc_ + OFF_IN), NIN, 64 * kb, n0, D, rbase, rstride}; } \
                else { r -= IT_IN; const int kb = r / 32, nb = r % 32; \
                    d_ = TrDesc{args.in[14] + (size_t)l * D * D, nullptr, (bf16*)(wlc_ + OFF_OUT), D, 64 * kb, 32 * nb, D, 32 * nb, 1}; } \
            } } while (0)
        if (gw < DEPTH * IT_LAYER) { int it = gw; TrDesc d0; TR_DECODE(d0, it); f32x4 va[8]; tr_load(d0, lane, va);
            for (;;) { const int itn = it + NGW; const bool has = itn < DEPTH * IT_LAYER; TrDesc d1 = d0; f32x4 vb[8];
#pragma unroll
                for (int i = 0; i < 8; ++i) vb[i] = (f32x4){0.f, 0.f, 0.f, 0.f};
                if (has) { TR_DECODE(d1, itn); tr_load(d1, lane, vb); }
                tr_store(d0, lane, va); if (!has) break;
                d0 = d1; it = itn;
#pragma unroll
                for (int i = 0; i < 8; ++i) va[i] = vb[i]; } }
#undef TR_DECODE
        for (int it = gw; it < DEPTH * 1024; it += NGW) {
            const int l = it >> 10, r = it & 1023, g = r >> 8, cb = (r >> 4) & 15, nb = r & 15, c0 = cb * 8, n = nb * 64 + lane;
            const float* pw = args.in[12] + ((size_t)(l * 4 + g) * 128 + c0) * 128; const float* ps = args.in[13] + l * 512 + g * 128;
            const float* wo = args.in[14] + (size_t)l * D * D + (size_t)(512 + g * 128) * D + n;
            float a[8];
#pragma unroll
            for (int j = 0; j < 8; ++j) a[j] = 0.f;
#pragma unroll 16
            for (int e = 0; e < 128; ++e) { const float w = wo[(size_t)e * D] * ps[e];
#pragma unroll
                for (int j = 0; j < 8; ++j) a[j] += pw[j * 128 + e] * w; }
            v4u o; o.x = pk2(a[0], a[1]); o.y = pk2(a[2], a[3]); o.z = pk2(a[4], a[5]); o.w = pk2(a[6], a[7]);
            *(v4u*)((bf16*)(unsigned char*)(ws + WS_W + (size_t)l * W_LAYER + OFF_OUT) + (size_t)n * D + 512 + g * 128 + c0) = o;
        }
        for (int i = gtid; i < M * 32; i += NT) { const int s = i >> 5, j = i & 31; const float inv = (float)pow(10000.0, -(double)j / 32.0); const float ang = (float)s * inv;
            const double a = (double)ang; rope[2 * i] = (float)cos(a); rope[2 * i + 1] = (float)sin(a); }
        for (int m = gw; m < M; m += NGW) { const f32x4* xr = (const f32x4*)(args.in[0] + (size_t)m * D) + lane; f32x4 v[4]; float s = 0.f;
#pragma unroll
            for (int j = 0; j < 4; ++j) { v[j] = xr[64 * j]; s += (v[j].x * v[j].x + v[j].y * v[j].y) + (v[j].z * v[j].z + v[j].w * v[j].w); }
            s = wave_sum(s); if (lane < 16) rowss[(size_t)m * 16 + lane] = (lane == 0) ? s : 0.f;
            v2u* o8 = (v2u*)(XB + (size_t)m * D) + lane;
#pragma unroll
            for (int j = 0; j < 4; ++j) { v2u w; w.x = pk2(v[j].x, v[j].y); w.y = pk2(v[j].z, v[j].w); o8[64 * j] = w;
                int e = __builtin_amdgcn_cvt_pk_bf8_f32(v[j].x - bflo(w.x), v[j].y - bfhi(w.x), 0, false); e = __builtin_amdgcn_cvt_pk_bf8_f32(v[j].z - bflo(w.y), v[j].w - bfhi(w.y), e, true);
                ((unsigned*)(unsigned char*)(ws + WS_XL + (size_t)m * D))[lane + 64 * j] = (unsigned)e; } }
    }
    cg::this_grid().sync();


    for (int step = 0; step < 3 * DEPTH; ++step) {
        const int l = step / 3, kind = step % 3;
#define wl ((unsigned char*)(ws + WS_W + (size_t)l * W_LAYER))
        if (kind != 1) {
            const int f = kind >> 1;
            { pg8::Gemm g{XB, (const bf16*)(wl + (f ? OFF_GU2 : OFF_GU1)), M, NGU, D}; pg8::StaticOrder S; S.init(M, NGU, G, bx);
              pg8::Unit u0; u0.pm = -1; u0.pn = 0; const bool any0 = S.next(0, u0);
              { int tt = threadIdx.x; asm volatile("" : "+v"(tt));
                if (any0 && tt < 256) ((LAS float*)(L + 131072))[tt] = pg8::rs_from_ss(rowss + (size_t)(u0.pm * 256 + tt) * 16); }
              __syncthreads();
              pg8::EpiGateUp E{HB, rowss, (const LAS float*)(L + 131072), any0 ? u0.pm : -1};
              pg8::gemm_phase<pg8::EpiGateUp, pg8::StaticOrder, PG8_ALIGN, PG8_SP2>(L, g, S, E); }
            xcd_barrier(XcdBarrier{(unsigned*)args.wsp, xb_xcc_id(), (volatile LAS unsigned*)(L + 147392)});
            { pg8::Gemm g{HB, (const bf16*)(wl + (f ? OFF_DN2 : OFF_DN1)), M, D, FF}; pg8::StaticOrder S; S.init(M, D, G, bx);
              pg8::EpiResidBf E{(__attribute__((address_space(1))) bf16*)(ws + WS_XB), (__attribute__((address_space(1))) unsigned char*)(ws + WS_XL), rowss, 0.5f};
              pg8::gemm_phase<pg8::EpiResidBf, pg8::StaticOrder, PG8_ALIGN, PG8_SP2>(L, g, S, E); }
            xcd_barrier(XcdBarrier{(unsigned*)args.wsp, xb_xcc_id(), (volatile LAS unsigned*)(L + 147392)});
        } else {
            { pg8::Gemm g{XB, (const bf16*)(wl + OFF_IN), M, NIN, D}; pg8::StaticOrder S; S.init(M, NIN, G, bx);
              pg8::Unit u0; u0.pm = -1; u0.pn = 0; const bool any0 = S.next(0, u0);
              { int tt = threadIdx.x; asm volatile("" : "+v"(tt));
                if (any0 && tt < 256) ((LAS float*)(L + 131072))[tt] = pg8::rs_from_ss(rowss + (size_t)(u0.pm * 256 + tt) * 16); }
              __syncthreads();
              pg8::EpiQKVU E{QKVU, rowss, rope, (const LAS float*)(L + 131072), any0 ? u0.pm : -1};
              pg8::gemm_phase<pg8::EpiQKVU, pg8::StaticOrder, PG8_ALIGN, PG8_SP2>(L, g, S, E); }
            xcd_barrier(XcdBarrier{(unsigned*)args.wsp, xb_xcc_id(), (volatile LAS unsigned*)(L + 147392)});
            { const attn_body::AttnTensors AT{(const attn_body::bf16*)QKVU, (const attn_body::bf16*)(QKVU + 512), (const attn_body::bf16*)(QKVU + 1024), (attn_body::bf16*)OBUF};
              const attn_body::StaticOrder S(G, bx);
              attn_body::attn_phase<attn_body::StaticOrder>((char*)lds, AT, S); }
            xcd_barrier(XcdBarrier{(unsigned*)args.wsp, xb_xcc_id(), (volatile LAS unsigned*)(L + 147392)});
            {
                const int lane = fresh_lane();
                const float li = 0.8f - 0.6f * expf(-0.3f * (float)l);
                const float s1 = wave_sum(args.in[7][l * 64 + lane] * args.in[8][l * 64 + lane]), s2 = wave_sum(args.in[9][l * 64 + lane] * args.in[10][l * 64 + lane]);
                const float lam = expf(s1) - expf(s2) + li;
                const int hd = lane >> 4, j0 = (lane & 15) * 8;
                float gn[8];
#pragma unroll
                for (int j = 0; j < 8; ++j) gn[j] = args.in[11][l * 128 + j0 + j] * (1.0f - li);
                const int win = 2 << hd;
                for (int mc = gw; mc < M / 8; mc += NGW) { float wsum[8];
                  for (int mr = 0; mr < 8; ++mr) { const int m = mc * 8 + mr;
                    const v4u a = *(const v4u*)(OBUF + (size_t)m * 1024 + hd * 256 + j0), b = *(const v4u*)(OBUF + (size_t)m * 1024 + hd * 256 + 128 + j0);
                    float o[8];
                    o[0] = bflo(a.x) - lam * bflo(b.x); o[1] = bfhi(a.x) - lam * bfhi(b.x); o[2] = bflo(a.y) - lam * bflo(b.y); o[3] = bfhi(a.y) - lam * bfhi(b.y);
                    o[4] = bflo(a.z) - lam * bflo(b.z); o[5] = bfhi(a.z) - lam * bfhi(b.z); o[6] = bflo(a.w) - lam * bflo(b.w); o[7] = bfhi(a.w) - lam * bfhi(b.w);
                    float ss = 0.f;
#pragma unroll
                    for (int j = 0; j < 8; ++j) ss += o[j] * o[j];
                    ss += __shfl_xor(ss, 1); ss += __shfl_xor(ss, 2); ss += __shfl_xor(ss, 4); ss += __shfl_xor(ss, 8);
                    const float rr = __builtin_amdgcn_rsqf(ss * (1.0f / 128.0f) + 1e-6f);
                    v4u w; w.x = pk2(o[0] * rr * gn[0], o[1] * rr * gn[1]); w.y = pk2(o[2] * rr * gn[2], o[3] * rr * gn[3]); w.z = pk2(o[4] * rr * gn[4], o[5] * rr * gn[5]); w.w = pk2(o[6] * rr * gn[6], o[7] * rr * gn[7]);
                    *(v4u*)(CAT + (size_t)m * 1024 + hd * 128 + j0) = w;
                    const bf16* up = QKVU + (size_t)m * 2112 + 1536 + hd * 128 + j0;
                    const v4u u0 = *(const v4u*)up;
                    const float us[8] = {bflo(u0.x), bfhi(u0.x), bflo(u0.y), bfhi(u0.y), bflo(u0.z), bfhi(u0.z), bflo(u0.w), bfhi(u0.w)};
                    float sm[8];
                    if (mr == 0) {
                        v4u ut[15]; float wt[15];
#pragma unroll
                        for (int j = 0; j < 8; ++j) sm[j] = us[j];
#pragma unroll
                        for (int t = 1; t < 16; ++t) { const bool ok = (t < win) && (m - t >= 0); ut[t - 1] = *(const v4u*)(up - (size_t)(ok ? t : 0) * 2112); wt[t - 1] = ok ? 1.0f : 0.0f; }
#pragma unroll
                        for (int t = 0; t < 15; ++t) { const float w = wt[t];
                            sm[0] += w * bflo(ut[t].x); sm[1] += w * bfhi(ut[t].x); sm[2] += w * bflo(ut[t].y); sm[3] += w * bfhi(ut[t].y); sm[4] += w * bflo(ut[t].z); sm[5] += w * bfhi(ut[t].z); sm[6] += w * bflo(ut[t].w); sm[7] += w * bfhi(ut[t].w); }
                    } else {
                        const bool dr = (m - win >= 0); const v4u ud = *(const v4u*)(up - (size_t)(dr ? win : 0) * 2112); const float wd = dr ? 1.0f : 0.0f;
                        sm[0] = wsum[0] + us[0] - wd * bflo(ud.x); sm[1] = wsum[1] + us[1] - wd * bfhi(ud.x); sm[2] = wsum[2] + us[2] - wd * bflo(ud.y); sm[3] = wsum[3] + us[3] - wd * bfhi(ud.y);
                        sm[4] = wsum[4] + us[4] - wd * bflo(ud.z); sm[5] = wsum[5] + us[5] - wd * bfhi(ud.z); sm[6] = wsum[6] + us[6] - wd * bflo(ud.w); sm[7] = wsum[7] + us[7] - wd * bfhi(ud.w);
                    }
#pragma unroll
                    for (int j = 0; j < 8; ++j) wsum[j] = sm[j];
                    const float ic = 1.0f / (float)((m + 1 < win) ? (m + 1) : win);
                    v4u d; d.x = pk2(sm[0] * ic - us[0], sm[1] * ic - us[1]); d.y = pk2(sm[2] * ic - us[2], sm[3] * ic - us[3]); d.z = pk2(sm[4] * ic - us[4], sm[5] * ic - us[5]); d.w = pk2(sm[6] * ic - us[6], sm[7] * ic - us[7]);
                    *(v4u*)(CAT + (size_t)m * 1024 + 512 + hd * 128 + j0) = d;
                  }
                }
            }
            xcd_barrier(XcdBarrier{(unsigned*)args.wsp, xb_xcc_id(), (volatile LAS unsigned*)(L + 147392)});
            { pg8::Gemm g{CAT, (const bf16*)(wl + OFF_OUT), M, D, D}; pg8::StaticOrder S; S.init(M, D, G, bx);
              pg8::EpiResidBf E{(__attribute__((address_space(1))) bf16*)(ws + WS_XB), (__attribute__((address_space(1))) unsigned char*)(ws + WS_XL), rowss, 1.0f};
              pg8::gemm_phase<pg8::EpiResidBf, pg8::StaticOrder, PG8_ALIGN, PG8_SP2>(L, g, S, E); }
            xcd_barrier(XcdBarrier{(unsigned*)args.wsp, xb_xcc_id(), (volatile LAS unsigned*)(L + 147392)});
        }
    }
    { const int lane = fresh_lane();
    for (int m = gw; m < M; m += NGW) { const v2u* xr = (const v2u*)(XB + (size_t)m * D) + lane; f32x4* xo = (f32x4*)((float*)(unsigned char*)fresh_ptr((unsigned char*)args.out) + (size_t)m * D) + lane; const f32x4* gr = (const f32x4*)args.in[19] + lane;
        const float r = pg8::rs_from_ss(rowss + (size_t)m * 16);
#pragma unroll
        for (int j = 0; j < 4; ++j) { const v2u w = xr[64 * j]; const f32x4 gg = gr[64 * j]; const int e = (int)((const unsigned*)(unsigned char*)(ws + WS_XL + (size_t)m * D))[lane + 64 * j];
            const pg8::f32x2 la = __builtin_amdgcn_cvt_pk_f32_bf8(e, false), lb = __builtin_amdgcn_cvt_pk_f32_bf8(e, true);
            const f32x4 v = (f32x4){bflo(w.x) + la.x, bfhi(w.x) + la.y, bflo(w.y) + lb.x, bfhi(w.y) + lb.y}; xo[64 * j] = v * r * gg; } } }
}

#undef wl
#undef ws
#undef rowss
#undef rope
#undef XB
#undef HB
#undef QKVU
#undef OBUF
#undef CAT
#undef xout
extern "C" void kernel_launch(void* const* d_in, const int* in_sizes, int n_in, void* d_out, int out_size, void* d_ws, size_t ws_size, hipStream_t stream) {
    static int grid_blocks = 0;
    if (grid_blocks == 0) {
        if (n_in != 20 || out_size != M * D || ws_size < WS_END) { fprintf(stderr, "kernel_launch: unexpected shapes (n_in %d out %d ws %zu, need %zu)\n", n_in, out_size, ws_size, (size_t)WS_END); grid_blocks = -1; return; }
        int dev = 0, cus = 0, per_cu = 0;
        (void)hipGetDevice(&dev); (void)hipDeviceGetAttribute(&cus, hipDeviceAttributeMultiprocessorCount, dev);
        if (hipFuncSetAttribute((const void*)hymba_fwd, hipFuncAttributeMaxDynamicSharedMemorySize, LDS_BYTES) != hipSuccess) { fprintf(stderr, "kernel_launch: hipFuncSetAttribute failed\n"); grid_blocks = -1; return; }
        if (hipOccupancyMaxActiveBlocksPerMultiprocessor(&per_cu, (const void*)hymba_fwd, NWAVES * 64, LDS_BYTES) != hipSuccess || per_cu < 1) { fprintf(stderr, "kernel_launch: occupancy query says %d\n", per_cu); per_cu = 1; }
        (void)hipGetLastError();
        grid_blocks = cus * per_cu;
    }
    if (grid_blocks < 0) return;
    if (hipMemsetAsync(d_ws, 0, 65536, stream) != hipSuccess) { fprintf(stderr, "kernel_launch: memset failed\n"); return; }
    Args a{};
    for (int i = 0; i < 20; ++i) a.in[i] = (const float*)d_in[i];
    a.out = (float*)d_out; a.wsp = (unsigned char*)d_ws;
    void* kargs[] = {&a};
    hipError_t e = hipLaunchCooperativeKernel((const void*)hymba_fwd, dim3(grid_blocks), dim3(NWAVES * 64), kargs, LDS_BYTES, stream);
    if (e != hipSuccess) fprintf(stderr, "cooperative launch failed: %s (grid %d)\n", hipGetErrorString(e), grid_blocks);
}
```

```cpp
#include <hip/hip_runtime.h>
#include <hip/hip_cooperative_groups.h>
#include <cstdio>
#include <cstdint>
namespace cg = cooperative_groups;
namespace pg8 {
#define PG8_LAS __attribute__((address_space(3)))
typedef unsigned short bf16_t;
typedef short bf16x8 __attribute__((ext_vector_type(8)));
typedef float f32x4 __attribute__((ext_vector_type(4)));
typedef unsigned u32x4 __attribute__((ext_vector_type(4)));
constexpr int BM = 256, BK = 64, HALF = 128, HTB = HALF * BK * 2  , STAGE_BYTES = 8 * HTB, NXCD = 8, WGM = 8;

__host__ __device__ __forceinline__ int lds_byte(int r, int c) { const int st = (r >> 4) * 2 + (c >> 5), rr = r & 15, cc = c & 31, ob = rr * 64 + cc * 2; return st * 1024 + (ob ^ (((ob >> 9) & 1) << 5)); }
__host__ __device__ __forceinline__ void stage_rc(int b, int& R, int& C) { const int st = b / 1024, sb = b % 1024, swz = sb ^ (((sb >> 9) & 1) << 5); R = (st >> 1) * 16 + swz / 64; C = (st & 1) * 32 + (swz % 64) / 2; }
__host__ __device__ __forceinline__ int perm32(int rho) { const int n = rho >> 4, i = rho & 15; return 8 * (i >> 2) + 4 * n + (i & 3); }

struct Unit { int pm, pn; };
struct Gemm { const bf16_t* A; const bf16_t* Bt; int M, N, K; };

struct StaticOrder {
    int nM, nN, nwg, G, c;
    __host__ __device__ void init(int M, int N, int G_, int c_) { nM = M / BM; nN = N / BM; nwg = nM * nN; G = G_; c = c_; }
    __host__ __device__ bool next(int i, Unit& u) const {
        const long L = (long)i * G + c; if (L >= nwg) return false;
        int wgid = (int)L; { const int q = nwg / NXCD, r = nwg % NXCD, xcd = wgid % NXCD, off = wgid / NXCD; wgid = (xcd < r ? xcd * (q + 1) : r * (q + 1) + (xcd - r) * q) + off; }
        const int nig = WGM * nN, gid = wgid / nig, fm = gid * WGM, gsz = (nM - fm) < WGM ? (nM - fm) : WGM;
        u.pm = fm + ((wgid % nig) % gsz); u.pn = (wgid % nig) / gsz; return true;
    }
    __device__ __forceinline__ void a_ready(const Unit&) const {}
    __device__ __forceinline__ void done(const Unit&) const {}
};

__device__ __forceinline__ unsigned cvt_pk_bf16(float lo, float hi) { unsigned r; asm volatile("v_cvt_pk_bf16_f32 %0, %1, %2" : "=v"(r) : "v"(lo), "v"(hi)); return r; }
typedef float f32x2 __attribute__((ext_vector_type(2)));
__device__ __forceinline__ f32x2 gelu_pk(f32x2 v) {
    const f32x2 av = __builtin_elementwise_abs(v), d = av * 0.2316418882f + 1.0f;
    f32x2 t; t.x = __builtin_amdgcn_rcpf(d.x); t.y = __builtin_amdgcn_rcpf(d.y);
    f32x2 q = t * 0.5307027145f + (-0.7265760135f); q = q * t + 0.7107068705f; q = q * t + (-0.142248368f); q = q * t + 0.127414796f; q = q * t;
    const f32x2 s = (v * v) * (-0.72134752044f);
    f32x2 e; e.x = __builtin_amdgcn_exp2f(s.x); e.y = __builtin_amdgcn_exp2f(s.y);
    const f32x2 m = v * (q * e), r = v - m;
    f32x2 o; o.x = v.x < 0.f ? m.x : r.x; o.y = v.y < 0.f ? m.y : r.y; return o;
}

template <int ACT  > struct EpiBf16 {
    static constexpr bool PERM = true, AFTER_DRAIN = false; static_assert(ACT == 0 || ACT == 1, "EpiBf16: ACT is 0 (none) or 1 (gelu_pk)");
    bf16_t* O; int ldc; const float* bias; int split_cols; size_t split_stride; float scale0;
    __device__ __forceinline__ void operator()(const f32x4 (&acc)[2][2][4][2], const Unit& u, int wr, int wc, int fr, int fq) const {
        const int row0 = u.pm * BM + wr * 64 + fr; int colt = u.pn * BM; bf16_t* base = O;
        float sc = 1.f; if (split_cols) { const int t = colt / split_cols; base += (size_t)t * split_stride; colt -= t * split_cols; if (t == 0) sc = scale0; }
        const int col0 = colt + wc * 32 + 8 * fq, bcol0 = u.pn * BM + wc * 32 + 8 * fq;
        f32x4 bv[2][2];
#pragma unroll
        for (int bj = 0; bj < 2; ++bj)
#pragma unroll
            for (int n = 0; n < 2; ++n) bv[bj][n] = bias ? *(const f32x4*)(bias + bcol0 + bj * HALF + 4 * n) : (f32x4){0.f, 0.f, 0.f, 0.f};
#pragma unroll
        for (int ai = 0; ai < 2; ++ai)
#pragma unroll
            for (int m = 0; m < 4; ++m) { bf16_t* rowp = base + (size_t)(row0 + ai * HALF + m * 16) * ldc + col0;
#pragma unroll
                for (int bj = 0; bj < 2; ++bj) { f32x4 v0 = acc[ai][bj][m][0] + bv[bj][0], v1 = acc[ai][bj][m][1] + bv[bj][1];
                    if (ACT == 1) { f32x2 a = gelu_pk((f32x2){v0[0], v0[1]}), b = gelu_pk((f32x2){v0[2], v0[3]}), c = gelu_pk((f32x2){v1[0], v1[1]}), d = gelu_pk((f32x2){v1[2], v1[3]});
                        v0 = (f32x4){a.x, a.y, b.x, b.y}; v1 = (f32x4){c.x, c.y, d.x, d.y}; }
                    v0 = v0 * sc; v1 = v1 * sc; u32x4 w; w.x = cvt_pk_bf16(v0[0], v0[1]); w.y = cvt_pk_bf16(v0[2], v0[3]); w.z = cvt_pk_bf16(v1[0], v1[1]); w.w = cvt_pk_bf16(v1[2], v1[3]);
                    *(u32x4*)(rowp + bj * HALF) = w; } }
    }
};
__device__ __forceinline__ float rs_from_ss(const float* p) { const f32x4 a = ((const f32x4*)p)[0], b = ((const f32x4*)p)[1], c = ((const f32x4*)p)[2], d = ((const f32x4*)p)[3];
    const float ss = (((a[0] + a[1]) + (a[2] + a[3])) + ((b[0] + b[1]) + (b[2] + b[3]))) + (((c[0] + c[1]) + (c[2] + c[3])) + ((d[0] + d[1]) + (d[2] + d[3])));
    return __builtin_amdgcn_rsqf(ss * (1.0f / 1024.0f) + 1e-6f); }
__device__ __forceinline__ float sum_fq4(float s) {
    { auto rr = __builtin_amdgcn_permlane16_swap(__float_as_uint(s), __float_as_uint(s), false, false); s = __uint_as_float(rr[0]) + __uint_as_float(rr[1]); }
    { auto rr = __builtin_amdgcn_permlane32_swap(__float_as_uint(s), __float_as_uint(s), false, false); s = __uint_as_float(rr[0]) + __uint_as_float(rr[1]); }
    return s; }
#define EPI_ROW_SCALES(rs_, rowss_, row0_) do { f32x4 q_[8]; \
    _Pragma("unroll") for (int i_ = 0; i_ < 8; ++i_) q_[i_] = *(const f32x4*)((rowss_) + (size_t)((row0_) + (i_ >> 2) * HALF + (i_ & 3) * 16) * 16 + fq * 4); \
    _Pragma("unroll") for (int i_ = 0; i_ < 8; ++i_) { float s_ = sum_fq4((q_[i_][0] + q_[i_][1]) + (q_[i_][2] + q_[i_][3])); \
        rs_[i_] = __builtin_amdgcn_rsqf(s_ * (1.0f / 1024.0f) + 1e-6f); } } while (0)
struct EpiGateUp {
    static constexpr bool PERM = true, AFTER_DRAIN = false;
    bf16_t* H; const float* rowss; const PG8_LAS float* tab; int pm0;
    __device__ __forceinline__ void operator()(const f32x4 (&acc)[2][2][4][2], const Unit& u, int wr, int wc, int fr, int fq) const {
        const int row0 = u.pm * BM + wr * 64 + fr; const int col0 = u.pn * HALF + wc * 32 + 8 * fq;
        float rs[8];
        if (u.pm == pm0) {
#pragma unroll
            for (int i = 0; i < 8; ++i) rs[i] = tab[wr * 64 + fr + (i >> 2) * HALF + (i & 3) * 16]; }
        else EPI_ROW_SCALES(rs, rowss, row0);
#pragma unroll
        for (int ai = 0; ai < 2; ++ai)
#pragma unroll
            for (int m = 0; m < 4; ++m) { const int row = row0 + ai * HALF + m * 16; const float r = rs[ai * 4 + m];
                float hv[8];
#pragma unroll
                for (int n = 0; n < 2; ++n)
#pragma unroll
                    for (int e = 0; e < 4; ++e) { const float g = acc[ai][0][m][n][e] * r, up = acc[ai][1][m][n][e] * r;
                        const float sg = g * __builtin_amdgcn_rcpf(1.0f + __builtin_amdgcn_exp2f(g * -1.4426950408889634f)); hv[n * 4 + e] = sg * up; }
                u32x4 w; w.x = cvt_pk_bf16(hv[0], hv[1]); w.y = cvt_pk_bf16(hv[2], hv[3]); w.z = cvt_pk_bf16(hv[4], hv[5]); w.w = cvt_pk_bf16(hv[6], hv[7]);
                *(u32x4*)(H + (size_t)row * 2816 + col0) = w; }
    }
};
struct EpiResidBf {
    static constexpr bool PERM = true, AFTER_DRAIN = false;
    typedef __attribute__((address_space(1))) u32x4 gu32x4; typedef unsigned u32x2 __attribute__((ext_vector_type(2))); typedef __attribute__((address_space(1))) u32x2 gu32x2;
    __attribute__((address_space(1))) bf16_t* xb; __attribute__((address_space(1))) unsigned char* xl; float* rowss_next; float alpha;
    __device__ __forceinline__ void operator()(const f32x4 (&acc)[2][2][4][2], const Unit& u, int wr, int wc, int fr, int fq) const {
        const int row0 = u.pm * BM + wr * 64 + fr; const int col0 = u.pn * BM + wc * 32 + 8 * fq;
        u32x4 xa[4][2]; u32x2 la[4][2];
#define EPB_LD(ai_) do { _Pragma("unroll") for (int m = 0; m < 4; ++m) _Pragma("unroll") for (int bj = 0; bj < 2; ++bj) { const size_t off = (size_t)(row0 + (ai_) * HALF + m * 16) * 1024 + col0 + bj * HALF; \
            xa[m][bj] = *(const gu32x4*)(xb + off); la[m][bj] = *(const gu32x2*)(xl + off); } } while (0)
#define EPB_ST(ai_) do { _Pragma("unroll") for (int m = 0; m < 4; ++m) { const int row = row0 + (ai_) * HALF + m * 16; float ss = 0.f; \
            _Pragma("unroll") for (int bj = 0; bj < 2; ++bj) { const u32x4 x = xa[m][bj]; const u32x2 lw = la[m][bj]; const size_t off = (size_t)row * 1024 + col0 + bj * HALF; \
                const f32x2 l0 = __builtin_amdgcn_cvt_pk_f32_bf8((int)lw.x, false), l1 = __builtin_amdgcn_cvt_pk_f32_bf8((int)lw.x, true), l2 = __builtin_amdgcn_cvt_pk_f32_bf8((int)lw.y, false), l3 = __builtin_amdgcn_cvt_pk_f32_bf8((int)lw.y, true); \
                const f32x4 a0 = (f32x4){__builtin_bit_cast(float, x.x << 16) + l0.x, __builtin_bit_cast(float, x.x & 0xffff0000u) + l0.y, __builtin_bit_cast(float, x.y << 16) + l1.x, __builtin_bit_cast(float, x.y & 0xffff0000u) + l1.y}; \
                const f32x4 a1 = (f32x4){__builtin_bit_cast(float, x.z << 16) + l2.x, __builtin_bit_cast(float, x.z & 0xffff0000u) + l2.y, __builtin_bit_cast(float, x.w << 16) + l3.x, __builtin_bit_cast(float, x.w & 0xffff0000u) + l3.y}; \
                const f32x4 v0 = a0 + acc[ai_][bj][m][0] * alpha, v1 = a1 + acc[ai_][bj][m][1] * alpha; \
                ss += (v0[0] * v0[0] + v0[1] * v0[1]) + (v0[2] * v0[2] + v0[3] * v0[3]) + (v1[0] * v1[0] + v1[1] * v1[1]) + (v1[2] * v1[2] + v1[3] * v1[3]); \
                u32x4 w; w.x = cvt_pk_bf16(v0[0], v0[1]); w.y = cvt_pk_bf16(v0[2], v0[3]); w.z = cvt_pk_bf16(v1[0], v1[1]); w.w = cvt_pk_bf16(v1[2], v1[3]); \
                *(gu32x4*)(xb + off) = w; \
                int e0 = __builtin_amdgcn_cvt_pk_bf8_f32(v0[0] - __builtin_bit_cast(float, w.x << 16), v0[1] - __builtin_bit_cast(float, w.x & 0xffff0000u), 0, false); \
                e0 = __builtin_amdgcn_cvt_pk_bf8_f32(v0[2] - __builtin_bit_cast(float, w.y << 16), v0[3] - __builtin_bit_cast(float, w.y & 0xffff0000u), e0, true); \
                int e1 = __builtin_amdgcn_cvt_pk_bf8_f32(v1[0] - __builtin_bit_cast(float, w.z << 16), v1[1] - __builtin_bit_cast(float, w.z & 0xffff0000u), 0, false); \
                e1 = __builtin_amdgcn_cvt_pk_bf8_f32(v1[2] - __builtin_bit_cast(float, w.w << 16), v1[3] - __builtin_bit_cast(float, w.w & 0xffff0000u), e1, true); \
                *(gu32x2*)(xl + off) = (u32x2){(unsigned)e0, (unsigned)e1}; } \
            ss = sum_fq4(ss); \
            if (fq == 0) rowss_next[(size_t)row * 16 + u.pn * 4 + wc] = ss; } } while (0)
        EPB_LD(0); __builtin_amdgcn_sched_barrier(0);
        EPB_ST(0); __builtin_amdgcn_sched_barrier(0);
        EPB_LD(1); __builtin_amdgcn_sched_barrier(0);
        EPB_ST(1);
#undef EPB_LD
#undef EPB_ST
    }
};
struct EpiQKVU {
    static constexpr bool PERM = true, AFTER_DRAIN = false;
    bf16_t* O; const float* rowss; const float* rope; const PG8_LAS float* tab; int pm0;
    __device__ __forceinline__ void operator()(const f32x4 (&acc)[2][2][4][2], const Unit& u, int wr, int wc, int fr, int fq) const {
        const int row0 = u.pm * BM + wr * 64 + fr; const int col0 = u.pn * BM + wc * 32 + 8 * fq; const int sec = u.pn >> 1;
        const int j0 = 16 * (wc & 1) + 4 * fq;
        float rs[8];
        if (u.pm == pm0) {
#pragma unroll
            for (int i = 0; i < 8; ++i) rs[i] = tab[wr * 64 + fr + (i >> 2) * HALF + (i & 3) * 16]; }
        else EPI_ROW_SCALES(rs, rowss, row0);
#pragma unroll
        for (int ai = 0; ai < 2; ++ai) {
            f32x4 cs[4][2];
#pragma unroll
            for (int m = 0; m < 4; ++m) { cs[m][0] = (f32x4){1.f, 0.f, 1.f, 0.f}; cs[m][1] = cs[m][0];
                if (sec < 2) { const f32x4* rp = (const f32x4*)(rope + ((size_t)(row0 + ai * HALF + m * 16) * 32 + j0) * 2); cs[m][0] = rp[0]; cs[m][1] = rp[1]; } }
#pragma unroll
            for (int m = 0; m < 4; ++m) { const int row = row0 + ai * HALF + m * 16; float r = rs[ai * 4 + m]; if (sec == 0) r *= 0.125f * 1.4426950408889634f;
                const f32x4 cs0 = cs[m][0], cs1 = cs[m][1];
#pragma unroll
                for (int bj = 0; bj < 2; ++bj) { const f32x4 v0 = acc[ai][bj][m][0] * r, v1 = acc[ai][bj][m][1] * r;
                    const float o0 = v0[0] * cs0[0] - v0[1] * cs0[1], o1 = v0[1] * cs0[0] + v0[0] * cs0[1];
                    const float o2 = v0[2] * cs0[2] - v0[3] * cs0[3], o3 = v0[3] * cs0[2] + v0[2] * cs0[3];
                    const float o4 = v1[0] * cs1[0] - v1[1] * cs1[1], o5 = v1[1] * cs1[0] + v1[0] * cs1[1];
                    const float o6 = v1[2] * cs1[2] - v1[3] * cs1[3], o7 = v1[3] * cs1[2] + v1[2] * cs1[3];
                    u32x4 w; w.x = cvt_pk_bf16(o0, o1); w.y = cvt_pk_bf16(o2, o3); w.z = cvt_pk_bf16(o4, o5); w.w = cvt_pk_bf16(o6, o7);
                    *(u32x4*)(O + (size_t)row * 2112 + col0 + bj * HALF) = w; } } }
    }
};

template <class Epi, class Sched, bool ALIGN_EPI = false, bool SP2 = false>
__device__ __forceinline__ void gemm_phase(PG8_LAS unsigned char* lds, const Gemm g, const Sched& S, const Epi& E) {
    int tid_ = threadIdx.x; asm volatile("" : "+v"(tid_));
    const int tid = tid_, wid = __builtin_amdgcn_readfirstlane(tid >> 6), lane = tid & 63, wr = wid >> 2, wc = wid & 3, fr = lane & 15, fq = lane >> 4;
    const int K = g.K, nt = K / BK;
    unsigned voffA[2], voffB[2];
#pragma unroll
    for (int i = 0; i < 2; ++i) { int R, C; stage_rc(tid * 16 + i * 8192, R, C); const int Rb = Epi::PERM ? ((R & ~31) + perm32(R & 31)) : R;
        voffA[i] = (unsigned)(R * K + C) * 2u; voffB[i] = (unsigned)(Rb * K + C) * 2u; }
    const size_t kstep = (size_t)(BK * 2);
    const size_t hstep = (size_t)HALF * K * 2;
    const size_t tstep = 2 * hstep;
    const unsigned ldsw = (unsigned)wid * 1024u;
    const int aoff = lds_byte(wr * 64 + fr, fq * 8), boff = lds_byte(wc * 32 + fr, fq * 8);
#define PG8_SA(b, h) (((b) * 2 + (h)) * HTB)
#define PG8_SB(b, h) ((4 + (b) * 2 + (h)) * HTB)
#define PG8_STAGE(bufoff, gbase, voff) do { _Pragma("unroll") for (int _i = 0; _i < 2; ++_i) \
        __builtin_amdgcn_global_load_lds((const unsigned*)((const char*)(gbase) + (voff)[_i]), (PG8_LAS unsigned*)(lds + (bufoff) + ldsw + _i * 8192), 16, 0, 0); } while (0)
#define PG8_LDA(dst, b, h) do { _Pragma("unroll") for (int m = 0; m < 4; ++m) _Pragma("unroll") for (int k = 0; k < 2; ++k) dst[m][k] = *(const PG8_LAS bf16x8*)(lds + PG8_SA(b, h) + aoff + m * 2048 + k * 1024); } while (0)
#define PG8_LDB(dst, b, h) do { _Pragma("unroll") for (int n = 0; n < 2; ++n) _Pragma("unroll") for (int k = 0; k < 2; ++k) dst[n][k] = *(const PG8_LAS bf16x8*)(lds + PG8_SB(b, h) + boff + n * 2048 + k * 1024); } while (0)
#define PG8_MMA(ai, bj, At, Bt) do { __builtin_amdgcn_s_setprio(1); _Pragma("unroll") for (int m = 0; m < 4; ++m) _Pragma("unroll") for (int n = 0; n < 2; ++n) _Pragma("unroll") for (int k = 0; k < 2; ++k) \
        acc[ai][bj][m][n] = __builtin_amdgcn_mfma_f32_16x16x32_bf16(Bt[n][k], At[m][k], acc[ai][bj][m][n], 0, 0, 0); __builtin_amdgcn_s_setprio(0); } while (0)
#define PG8_WAIT_V(n) asm volatile("s_waitcnt vmcnt(" #n ")" ::: "memory")
#define PG8_WAIT_L(n) asm volatile("s_waitcnt lgkmcnt(" #n ")" ::: "memory")
#define PG8_BAR __builtin_amdgcn_s_barrier()
#define PG8_SCHED __builtin_amdgcn_sched_barrier(0)
    Unit cur, nxt; int ui = 0;
    if (!S.next(0, cur)) return;
    f32x4 acc[2][2][4][2];
#pragma unroll
    for (int a = 0; a < 2; ++a)
#pragma unroll
        for (int b = 0; b < 2; ++b)
#pragma unroll
            for (int m = 0; m < 4; ++m)
#pragma unroll
                for (int n = 0; n < 2; ++n) acc[a][b][m][n] = (f32x4){0.f, 0.f, 0.f, 0.f};
    bf16x8 At[4][2], B0[2][2], B1[2][2];
    const char* cA = (const char*)g.A + (size_t)cur.pm * tstep; const char* cB = (const char*)g.Bt + (size_t)cur.pn * tstep;
    S.a_ready(cur);
    if constexpr (SP2) {
        PG8_STAGE(PG8_SB(0, 0), cB, voffB); PG8_STAGE(PG8_SB(0, 1), cB + hstep, voffB); PG8_STAGE(PG8_SA(0, 0), cA, voffA); PG8_STAGE(PG8_SA(0, 1), cA + hstep, voffA);
        if (wr == 1) PG8_BAR;
        PG8_WAIT_V(2); PG8_BAR;
        PG8_STAGE(PG8_SB(1, 0), cB + kstep, voffB); PG8_STAGE(PG8_SA(1, 0), cA + kstep, voffA); PG8_STAGE(PG8_SB(1, 1), cB + hstep + kstep, voffB);
        PG8_WAIT_V(6); PG8_BAR;
    } else {
        PG8_STAGE(PG8_SB(0, 0), cB, voffB); PG8_STAGE(PG8_SA(0, 0), cA, voffA); PG8_STAGE(PG8_SB(0, 1), cB + hstep, voffB); PG8_STAGE(PG8_SA(0, 1), cA + hstep, voffA);
        if (wr == 1) PG8_BAR;
        PG8_WAIT_V(4); PG8_BAR;
        PG8_STAGE(PG8_SB(1, 0), cB + kstep, voffB); PG8_STAGE(PG8_SA(1, 0), cA + kstep, voffA); PG8_STAGE(PG8_SB(1, 1), cB + hstep + kstep, voffB);
        PG8_WAIT_V(6); PG8_BAR;
    }
    for (;;) {
        const bool has_next = S.next(ui + 1, nxt);
        const char* nA = has_next ? (const char*)g.A + (size_t)nxt.pm * tstep : cA; const char* nB = has_next ? (const char*)g.Bt + (size_t)nxt.pn * tstep : cB;
        for (int t = 0; t < nt; t += 2) {
            const bool last = (t == nt - 2);
            const char* a1 = cA + (size_t)(t + 1) * kstep;
            const char* a2 = last ? nA : cA + (size_t)(t + 2) * kstep; const char* b2 = last ? nB : cB + (size_t)(t + 2) * kstep;
            const char* a3 = a2 + kstep; const char* b3 = b2 + kstep;
            if (last && has_next) S.a_ready(nxt);
            if constexpr (SP2) {
            PG8_LDB(B0, 0, 0); PG8_LDB(B1, 0, 1); PG8_SCHED; PG8_LDA(At, 0, 0); PG8_STAGE(PG8_SA(1, 1), a1 + hstep, voffA);
            PG8_WAIT_V(8); PG8_WAIT_L(0); PG8_BAR; PG8_MMA(0, 0, At, B0); PG8_MMA(0, 1, At, B1); PG8_BAR; PG8_SCHED;
            PG8_LDA(At, 0, 1); PG8_STAGE(PG8_SB(0, 0), b2, voffB); PG8_STAGE(PG8_SB(0, 1), b2 + hstep, voffB); PG8_STAGE(PG8_SA(0, 0), a2, voffA);
            PG8_WAIT_V(8); PG8_WAIT_L(0); PG8_BAR; PG8_MMA(1, 0, At, B0); PG8_MMA(1, 1, At, B1); PG8_BAR; PG8_SCHED;
            PG8_LDB(B0, 1, 0); PG8_LDB(B1, 1, 1); PG8_SCHED; PG8_LDA(At, 1, 0); PG8_STAGE(PG8_SA(0, 1), a2 + hstep, voffA);
            PG8_WAIT_V(8); PG8_WAIT_L(0); PG8_BAR; PG8_MMA(0, 0, At, B0); PG8_MMA(0, 1, At, B1); PG8_BAR; PG8_SCHED;
            PG8_LDA(At, 1, 1); PG8_STAGE(PG8_SB(1, 0), b3, voffB); PG8_STAGE(PG8_SB(1, 1), b3 + hstep, voffB); PG8_STAGE(PG8_SA(1, 0), a3, voffA);
            PG8_WAIT_V(8); PG8_WAIT_L(0); PG8_BAR; PG8_MMA(1, 0, At, B0); PG8_MMA(1, 1, At, B1); PG8_BAR; PG8_SCHED;
            } else {
            PG8_LDB(B0, 0, 0); PG8_SCHED; PG8_LDA(At, 0, 0); PG8_STAGE(PG8_SA(1, 1), a1 + hstep, voffA);
            PG8_WAIT_L(8); PG8_BAR; PG8_WAIT_L(0); PG8_MMA(0, 0, At, B0); PG8_BAR; PG8_SCHED;
            PG8_LDB(B1, 0, 1); PG8_STAGE(PG8_SB(0, 0), b2, voffB);
            PG8_BAR; PG8_WAIT_L(0); PG8_MMA(0, 1, At, B1); PG8_BAR;
            PG8_LDA(At, 0, 1); PG8_STAGE(PG8_SA(0, 0), a2, voffA);
            PG8_BAR; PG8_WAIT_L(0); PG8_MMA(1, 0, At, B0); PG8_BAR; PG8_SCHED;
            PG8_STAGE(PG8_SB(0, 1), b2 + hstep, voffB);
            PG8_WAIT_V(6); PG8_BAR; PG8_MMA(1, 1, At, B1); PG8_BAR;
            PG8_LDB(B0, 1, 0); PG8_SCHED; PG8_LDA(At, 1, 0); PG8_STAGE(PG8_SA(0, 1), a2 + hstep, voffA);
            PG8_WAIT_L(8); PG8_BAR; PG8_WAIT_L(0); PG8_MMA(0, 0, At, B0); PG8_BAR; PG8_SCHED;
            PG8_LDB(B1, 1, 1); PG8_STAGE(PG8_SB(1, 0), b3, voffB);
            PG8_BAR; PG8_WAIT_L(0); PG8_MMA(0, 1, At, B1); PG8_BAR;
            PG8_LDA(At, 1, 1); PG8_STAGE(PG8_SA(1, 0), a3, voffA);
            PG8_BAR; PG8_WAIT_L(0); PG8_MMA(1, 0, At, B0); PG8_BAR; PG8_SCHED;
            PG8_STAGE(PG8_SB(1, 1), b3 + hstep, voffB);
            PG8_WAIT_V(6); PG8_BAR; PG8_MMA(1, 1, At, B1); PG8_BAR;
            }
        }
        if constexpr (ALIGN_EPI) { if (wr == 0) PG8_BAR; }
        if constexpr (!Epi::AFTER_DRAIN) { E(acc, cur, wr, wc, fr, fq); S.done(cur); }
        if (!has_next) break;
#pragma unroll
        for (int a = 0; a < 2; ++a)
#pragma unroll
            for (int b = 0; b < 2; ++b)
#pragma unroll
                for (int m = 0; m < 4; ++m)
#pragma unroll
                    for (int n = 0; n < 2; ++n) acc[a][b][m][n] = (f32x4){0.f, 0.f, 0.f, 0.f};
        cur = nxt; cA = nA; cB = nB; ++ui;
        if constexpr (ALIGN_EPI) { if (wr == 1) PG8_BAR; }
    }
    PG8_WAIT_V(0);
    if constexpr (!ALIGN_EPI) { if (wr == 0) PG8_BAR; }
    PG8_BAR;
    if constexpr (Epi::AFTER_DRAIN) { E.fused(acc, cur, wr, wc, fr, fq, lds, wid, lane); S.done(cur); }
#undef PG8_SA
#undef PG8_SB
#undef PG8_STAGE
#undef PG8_LDA
#undef PG8_LDB
#undef PG8_MMA
#undef PG8_WAIT_V
#undef PG8_WAIT_L
#undef PG8_BAR
#undef PG8_SCHED
}
}

#ifndef PG8_SP2
#define PG8_SP2 true
#endif
#ifndef PG8_ALIGN
#define PG8_ALIGN true
#endif
#include <hip/hip_bf16.h>
#include <cmath>
namespace attn_body {
using bf16=__hip_bfloat16;
using bf16x8=__attribute__((ext_vector_type(8)))short;
using s16x4=__attribute__((ext_vector_type(4)))short;
using f32x16=__attribute__((ext_vector_type(16)))float;
using u32x4=__attribute__((ext_vector_type(4)))unsigned;
constexpr int BATCH=1,NHEAD=16,SEQ=16384,D=64,DM=2112,DMO=1024;
constexpr int NW=8,QBLK=32,QB=QBLK*NW,KVBLK=64,NQB=SEQ/QB;
constexpr int ATTN_PITCH=DM, ATTN_UNIT_ROWS=QB;
__device__ __forceinline__ int crow(int r,int hi){return (r&3)+8*(r>>2)+4*hi;}
#define SBAR() __builtin_amdgcn_sched_barrier(0)
__device__ __forceinline__ void cmask(f32x16&p0,f32x16&p1,int jb,int qrel,int hi){
  const float NEG=-INFINITY; int kb=64*jb+4*hi;
  #pragma unroll
  for(int r=0;r<16;++r){int kv=kb+(r&3)+8*(r>>2); if(kv>qrel)p0[r]=NEG; if(kv+32>qrel)p1[r]=NEG;}
}

constexpr int NSLOT=3, SLOTB=8192;
constexpr int NVSLOT=3, VSLOTB=16384;
constexpr int LDS_K=0, LDS_V=NSLOT*SLOTB, LDS_P=LDS_V+NVSLOT*VSLOTB, LDS_WS=LDS_P+NW*8192, WSF_STRIDE=64, LDS_BYTES=LDS_WS+NW*WSF_STRIDE*4;
constexpr float C2=0.125f*1.4426950408889634f;
__device__ __forceinline__ void glds16(const void*gsrc,unsigned lds_dst){unsigned keep;
  asm volatile("s_mov_b32 %0, m0\n\ts_mov_b32 m0, %2\n\ts_nop 0\n\tglobal_load_lds_dwordx4 %1, off\n\ts_mov_b32 m0, %0":"=&s"(keep):"v"(gsrc),"s"(lds_dst):"memory");}
__device__ __forceinline__ float max3f(float a,float b,float c){float r;asm("v_max3_f32 %0, %1, %2, %3":"=v"(r):"v"(a),"v"(b),"v"(c));return r;}
__device__ __forceinline__ float max2f(float a,float b){float r;asm("v_max_f32_e32 %0, %1, %2":"=v"(r):"v"(a),"v"(b));return r;}
__device__ __forceinline__ float fadd_s(float a,float b){float r;asm("v_add_f32_e32 %0, %1, %2":"=v"(r):"v"(a),"v"(b));return r;}
__device__ __forceinline__ float fsub_s(float a,float b){float r;asm("v_sub_f32_e32 %0, %1, %2":"=v"(r):"v"(a),"v"(b));return r;}
typedef float f32x2_t __attribute__((ext_vector_type(2))); typedef __bf16 bf16x2_t __attribute__((ext_vector_type(2)));
__device__ __forceinline__ unsigned cvtpk_s(float lo,float hi){f32x2_t v={lo,hi};bf16x2_t b=__builtin_convertvector(v,bf16x2_t);return __builtin_bit_cast(unsigned,b);}
#define WAIT_BAR(N) asm volatile("s_waitcnt vmcnt(" #N ") lgkmcnt(0)\n\ts_barrier":::"memory")

__device__ __forceinline__ void qkt(f32x16&p0,f32x16&p1,const char*Kslot,const bf16x8*qr,const f32x16&negm,int r32,int hi){
  const char*kb=Kslot+hi*1024+r32*16;
  #pragma unroll
  for(int d0=0;d0<4;++d0){
    const bf16x8 b0=*reinterpret_cast<const bf16x8*>(kb+d0*2048);
    const bf16x8 b1=*reinterpret_cast<const bf16x8*>(kb+d0*2048+512);
    if(d0==0){p0=__builtin_amdgcn_mfma_f32_32x32x16_bf16(b0,qr[0],negm,0,0,0);p1=__builtin_amdgcn_mfma_f32_32x32x16_bf16(b1,qr[0],negm,0,0,0);}
    else{p0=__builtin_amdgcn_mfma_f32_32x32x16_bf16(b0,qr[d0],p0,0,0,0);p1=__builtin_amdgcn_mfma_f32_32x32x16_bf16(b1,qr[d0],p1,0,0,0);}}
}
typedef __attribute__((address_space(3))) const char* lds_cptr;
typedef short v4i16_t __attribute__((ext_vector_type(4)));
__device__ __forceinline__ void kload8(bf16x8*kf,lds_cptr kp){
  kf[0]=*(const __attribute__((address_space(3))) bf16x8*)(kp);      kf[1]=*(const __attribute__((address_space(3))) bf16x8*)(kp+512);
  kf[2]=*(const __attribute__((address_space(3))) bf16x8*)(kp+2048); kf[3]=*(const __attribute__((address_space(3))) bf16x8*)(kp+2560);
  kf[4]=*(const __attribute__((address_space(3))) bf16x8*)(kp+4096); kf[5]=*(const __attribute__((address_space(3))) bf16x8*)(kp+4608);
  kf[6]=*(const __attribute__((address_space(3))) bf16x8*)(kp+6144); kf[7]=*(const __attribute__((address_space(3))) bf16x8*)(kp+6656);
}
__device__ __forceinline__ void kload2(bf16x8*kf,lds_cptr kp,int j){ kf[2*j]=*(const __attribute__((address_space(3))) bf16x8*)(kp+j*2048); kf[2*j+1]=*(const __attribute__((address_space(3))) bf16x8*)(kp+j*2048+512); }
__device__ __forceinline__ s16x4 vtr(lds_cptr p){ return __builtin_bit_cast(s16x4,__builtin_amdgcn_ds_read_tr16_b64_v4i16((__attribute__((address_space(3))) v4i16_t*)p)); }
__device__ __forceinline__ float rowmax(const f32x16&p0,const f32x16&p1){
  float a=max3f(p0[0],p0[1],p1[0]),b=max3f(p0[2],p0[3],p1[1]);a=max3f(a,p1[2],p1[3]);
  #pragma unroll
  for(int r=4;r<16;r+=4){a=max3f(a,p0[r],p0[r+1]);b=max3f(b,p0[r+2],p0[r+3]);a=max3f(a,p1[r],p1[r+1]);b=max3f(b,p1[r+2],p1[r+3]);}
  const float m=max2f(a,b);
  auto rr=__builtin_amdgcn_permlane32_swap(__float_as_uint(m),__float_as_uint(m),false,false);
  return max2f(__uint_as_float(rr[0]),__uint_as_float(rr[1]));
}
__device__ __forceinline__ void pv(f32x16*o,int vb,bf16x8 pa0,bf16x8 pa1,bf16x8 pa2,bf16x8 pa3){
  #pragma unroll
  for(int d0=0;d0<2;++d0){s16x4 lo[4],hi[4];
    #pragma unroll
    for(int ks=0;ks<4;++ks){
      asm volatile("ds_read_b64_tr_b16 %0,%1 offset:%c2":"=&v"(lo[ks]):"v"(vb),"i"(d0*4096+ks*1024):"memory");
      asm volatile("ds_read_b64_tr_b16 %0,%1 offset:%c2":"=&v"(hi[ks]):"v"(vb),"i"(d0*4096+ks*1024+512):"memory");}
    asm volatile("s_waitcnt lgkmcnt(0)":::"memory");SBAR();
    #define PK(k) (bf16x8){lo[k][0],lo[k][1],lo[k][2],lo[k][3],hi[k][0],hi[k][1],hi[k][2],hi[k][3]}
    o[d0]=__builtin_amdgcn_mfma_f32_32x32x16_bf16(pa0,PK(0),o[d0],0,0,0);
    o[d0]=__builtin_amdgcn_mfma_f32_32x32x16_bf16(pa1,PK(1),o[d0],0,0,0);
    o[d0]=__builtin_amdgcn_mfma_f32_32x32x16_bf16(pa2,PK(2),o[d0],0,0,0);
    o[d0]=__builtin_amdgcn_mfma_f32_32x32x16_bf16(pa3,PK(3),o[d0],0,0,0);
    #undef PK
  }
}

#ifndef ATTN_STORE16
#define ATTN_STORE16(p,v) (*(u32x4*)(p)=(v))
#endif
template<int THRL> __device__ __forceinline__ void attn_unit(int qb,const bf16*Q,const bf16*__restrict__ K,const bf16*__restrict__ V,bf16*O,char*shm){
  int tid_=threadIdx.x; asm volatile("":"+v"(tid_)); const int tid=tid_,lane=tid&63,r32=lane&31,hi=lane>>5; const int wid=__builtin_amdgcn_readfirstlane(tid>>6);
  const int q0=qb*QB;
  const unsigned lds0=(unsigned)(uintptr_t)shm;
  float*wsf=(float*)(shm+LDS_WS)+wid*WSF_STRIDE;
  const bf16*ksrc=K+(long)lane*DM+wid*8;
  const bf16*vsrc=V+(long)(16*(wid&3)+(lane>>2))*DM+(wid>>2)*32+(lane&3)*8;
  const unsigned kdst=lds0+LDS_K+wid*1024, vdst=lds0+LDS_V+wid*1024;
  #define DMA_K(t,s3) glds16(ksrc+(long)(t)*KVBLK*DM,(unsigned)__builtin_amdgcn_readfirstlane(kdst+(s3)*SLOTB))
  #define DMA_V(t,s3) do{ const unsigned vd_=(unsigned)__builtin_amdgcn_readfirstlane(vdst+(s3)*VSLOTB); glds16(vsrc+(long)(t)*KVBLK*DM,vd_); glds16(vsrc+(long)(t)*KVBLK*DM+64,(unsigned)__builtin_amdgcn_readfirstlane(vd_+8192)); }while(0)
  const lds_cptr shm3=(lds_cptr)shm;
  const int NT=(q0+QB)/KVBLK;
  DMA_K(0,0);DMA_V(0,0);DMA_K(1,1);DMA_V(1,1);
  int c0=0,c1=1,c2=2;
  #define ROT3() do{ const int x_=c0; c0=c1; c1=c2; c2=x_; }while(0)
  #define PKW(P,B) cvtpk_s(P[B],P[B+1])
  #define MX3(a,b,c) __builtin_fmaxf(__builtin_fmaxf((a),(b)),(c))
  const bf16*Qw=Q+(long)(q0+wid*QBLK)*DM;
  bf16x8 qr[4];
  #pragma unroll
  for(int d0=0;d0<4;++d0)qr[d0]=*reinterpret_cast<const bf16x8*>(&Qw[(long)r32*DM+d0*16+hi*8]);
  float mhat=0.f,l_reg=0.f; f32x16 negm=f32x16{};
  f32x16 o[4]; o[0]=f32x16{};o[1]=f32x16{};o[2]=f32x16{};o[3]=f32x16{};
  const int qrel=wid*QBLK+r32;
  const lds_cptr kp0=shm3+LDS_K+hi*1024+r32*16;
  const lds_cptr vp0=shm3+LDS_V+((lane>>4)&1)*32+(lane&3)*8+(4*hi+((lane&15)>>2))*64;
  WAIT_BAR(3);
  for(int t=0;t<NT;++t){
    if(t+2<NT){DMA_K(t+2,c2);DMA_V(t+2,c2);}
    bf16x8 kf[8]; kload8(kf,kp0+c0*SLOTB);
    SBAR();
    f32x16 C0,C1;
    {
      C0=__builtin_amdgcn_mfma_f32_32x32x16_bf16(kf[0],qr[0],negm,0,0,0); C1=__builtin_amdgcn_mfma_f32_32x32x16_bf16(kf[1],qr[0],negm,0,0,0);
      C0=__builtin_amdgcn_mfma_f32_32x32x16_bf16(kf[2],qr[1],C0,0,0,0);   C1=__builtin_amdgcn_mfma_f32_32x32x16_bf16(kf[3],qr[1],C1,0,0,0);
      C0=__builtin_amdgcn_mfma_f32_32x32x16_bf16(kf[4],qr[2],C0,0,0,0);   C1=__builtin_amdgcn_mfma_f32_32x32x16_bf16(kf[5],qr[2],C1,0,0,0);
      C0=__builtin_amdgcn_mfma_f32_32x32x16_bf16(kf[6],qr[3],C0,0,0,0);   C1=__builtin_amdgcn_mfma_f32_32x32x16_bf16(kf[7],qr[3],C1,0,0,0); }
    SBAR();
    const lds_cptr vp_=vp0+c0*VSLOTB; s16x4 vl_[8],vh_[8];
    #pragma unroll
    for(int k2=0;k2<2;++k2)
      #pragma unroll
      for(int d_=0;d_<4;++d_){ vl_[d_*2+k2]=vtr(vp_+(d_*4096+k2*1024)); vh_[d_*2+k2]=vtr(vp_+(d_*4096+k2*1024+512)); }
    SBAR();
    { const int jb_=t-(NT-4); if(jb_>=0)cmask(C0,C1,jb_,qrel,hi); }
    float a=MX3(C0[0],C0[1],C1[0]),b=MX3(C0[2],C0[3],C1[1]); a=MX3(a,C1[2],C1[3]);
    #pragma unroll
    for(int r=4;r<16;r+=4){a=MX3(a,C0[r],C0[r+1]);b=MX3(b,C0[r+2],C0[r+3]);a=MX3(a,C1[r],C1[r+1]);b=MX3(b,C1[r+2],C1[r+3]);}
    float rm=__builtin_fmaxf(a,b); { auto rr=__builtin_amdgcn_permlane32_swap(__float_as_uint(rm),__float_as_uint(rm),false,false); rm=__builtin_fmaxf(__uint_as_float(rr[0]),__uint_as_float(rr[1])); }
    if(t==0 || __any(rm>(float)THRL)){
      const float dl=(t==0)?rm:__builtin_fmaxf(rm,0.f); mhat+=dl;
      #pragma unroll
      for(int r=0;r<16;++r){C0[r]-=dl;C1[r]-=dl;}
      #pragma unroll
      for(int r=0;r<16;++r)negm[r]=-mhat;
      if(t!=0){ const float f=__builtin_amdgcn_exp2f(-dl); l_reg*=f; if(hi==0)wsf[r32]=f; asm volatile("s_waitcnt lgkmcnt(0)":::"memory");
        #pragma unroll
        for(int d_=0;d_<4;++d_)
          #pragma unroll
          for(int r=0;r<16;++r)o[d_][r]*=wsf[crow(r,hi)]; } }
    #pragma unroll
    for(int r=0;r<16;++r){C0[r]=__builtin_amdgcn_exp2f(C0[r]);C1[r]=__builtin_amdgcn_exp2f(C1[r]);}
    { float s0=C0[0]+C0[1],s1=C1[0]+C1[1];
      #pragma unroll
      for(int r=2;r<16;++r){s0+=C0[r];s1+=C1[r];}
      l_reg+=s0+s1; }
    const u32x4 pw0=(u32x4){PKW(C0,0),PKW(C0,2),PKW(C0,4),PKW(C0,6)},pw1=(u32x4){PKW(C0,8),PKW(C0,10),PKW(C0,12),PKW(C0,14)},pw2=(u32x4){PKW(C1,0),PKW(C1,2),PKW(C1,4),PKW(C1,6)},pw3=(u32x4){PKW(C1,8),PKW(C1,10),PKW(C1,12),PKW(C1,14)};
    SBAR();
    #define VFRAG(L_,H_,i_) (bf16x8){L_[i_][0],L_[i_][1],L_[i_][2],L_[i_][3],H_[i_][0],H_[i_][1],H_[i_][2],H_[i_][3]}
    s16x4 w2l_[4],w2h_[4],w3l_[4],w3h_[4];
    #pragma unroll
    for(int d_=0;d_<4;++d_){ w2l_[d_]=vtr(vp_+(d_*4096+2*1024)); w2h_[d_]=vtr(vp_+(d_*4096+2*1024+512)); }
    SBAR();
    #pragma unroll
    for(int d_=0;d_<4;++d_){ o[d_]=__builtin_amdgcn_mfma_f32_32x32x16_bf16(__builtin_bit_cast(bf16x8,pw0),VFRAG(vl_,vh_,d_*2),o[d_],0,0,0); }
    SBAR();
    #pragma unroll
    for(int d_=0;d_<4;++d_){ w3l_[d_]=vtr(vp_+(d_*4096+3*1024)); w3h_[d_]=vtr(vp_+(d_*4096+3*1024+512)); }
    SBAR();
    #pragma unroll
    for(int d_=0;d_<4;++d_){ o[d_]=__builtin_amdgcn_mfma_f32_32x32x16_bf16(__builtin_bit_cast(bf16x8,pw1),VFRAG(vl_,vh_,d_*2+1),o[d_],0,0,0); }
    #pragma unroll
    for(int d_=0;d_<4;++d_){ o[d_]=__builtin_amdgcn_mfma_f32_32x32x16_bf16(__builtin_bit_cast(bf16x8,pw2),VFRAG(w2l_,w2h_,d_),o[d_],0,0,0); }
    #pragma unroll
    for(int d_=0;d_<4;++d_){ o[d_]=__builtin_amdgcn_mfma_f32_32x32x16_bf16(__builtin_bit_cast(bf16x8,pw3),VFRAG(w3l_,w3h_,d_),o[d_],0,0,0); }
    SBAR();
    #undef VFRAG
    if(t+2<NT){WAIT_BAR(3);}else{WAIT_BAR(0);}
    ROT3();
  }
  { auto rr=__builtin_amdgcn_permlane32_swap(__float_as_uint(l_reg),__float_as_uint(l_reg),false,false); l_reg=__uint_as_float(rr[0])+__uint_as_float(rr[1]); }
  if(hi==0)wsf[32+r32]=l_reg; asm volatile("s_waitcnt lgkmcnt(0)":::"memory");
  bf16*Ow=O+(long)(q0+wid*QBLK)*DMO;
  { bf16*stg=(bf16*)(shm+LDS_P)+wid*4096;
    #pragma unroll
    for(int r=0;r<16;++r){const int orow=crow(r,hi); const float rl=__builtin_amdgcn_rcpf(wsf[32+orow]);
      #pragma unroll
      for(int d0=0;d0<4;++d0)stg[orow*128+d0*32+r32]=__float2bfloat16(o[d0][r]*rl);}
    asm volatile("s_waitcnt lgkmcnt(0)":::"memory");
    #pragma unroll
    for(int i=0;i<8;++i){const int row=i*4+(lane>>4),ch=lane&15; const u32x4 v=*(const u32x4*)(stg+row*128+ch*8); ATTN_STORE16(Ow+(long)row*DMO+ch*8,v);} }
  asm volatile("s_waitcnt lgkmcnt(0)\n\ts_barrier":::"memory");
  #undef DMA_K
  #undef DMA_V
  #undef ROT3
  #undef PKW
  #undef MX3
}
constexpr int ATTN_LDS_BYTES=LDS_BYTES;
struct AttnTensors { const bf16* Q; const bf16* K; const bf16* V; bf16* O; };
struct AttnUnit { int hc; int qb; };
struct StaticOrder {
  int vcu, G, bx;
  __device__ __forceinline__ StaticOrder(int grid,int block):vcu((grid%8==0)?(block%8)*(grid/8)+block/8:block),G(grid),bx(block){}
  __device__ __forceinline__ bool next(int i,AttnUnit&u)const{
    if(G==256){ if(i>=2)return false; const int s=vcu&31; u.hc=vcu>>5; u.qb=(i==0)?63-s:s; return true; }
    const int idx=i*G+bx; if(idx>=8*NQB)return false; u.hc=idx&7; u.qb=NQB-1-(idx>>3); return true; }
};
template<class Sched,int THRL=8> __device__ __forceinline__ void attn_phase(char*lds,const AttnTensors&T,const Sched&S){
  AttnUnit u;
  for(int i=0;S.next(i,u);++i){ const int h=u.hc>>1,c=u.hc&1;
    attn_unit<THRL>(u.qb,T.Q+h*128+c*64,T.K+h*128+c*64,T.V+h*128,T.O+u.hc*128,lds); }
}
#undef SBAR
#undef WAIT_BAR
}
constexpr int NWAVES = 8;
constexpr int M = 16384, D = 1024, FF = 2816, NGU = 2 * FF, NIN = 2048, DEPTH = 4;
constexpr size_t MiB = 1u << 20;
constexpr size_t WS_ROWSS = 1 * MiB;
constexpr size_t WS_ROPE = 2 * MiB;
constexpr size_t WS_XB = 8 * MiB;
constexpr size_t WS_H = 40 * MiB;
constexpr size_t WS_QKVU = 40 * MiB;
constexpr size_t WS_OBUF = 108 * MiB;
constexpr size_t WS_CAT = 140 * MiB;
constexpr size_t WS_W = 172 * MiB;
constexpr size_t OFF_GU1 = 0, OFF_DN1 = 11 * MiB, OFF_IN = 16 * MiB + 512 * 1024, OFF_OUT = 20 * MiB + 512 * 1024, OFF_GU2 = 22 * MiB + 512 * 1024, OFF_DN2 = 33 * MiB + 512 * 1024, W_LAYER = 39 * MiB;
constexpr size_t WS_XL = WS_W + DEPTH * W_LAYER;
constexpr size_t WS_END = WS_XL + (size_t)M * D;
static_assert(attn_body::ATTN_LDS_BYTES <= 147392 && (size_t)NGU * D * 2 == 11 * MiB && (size_t)D * FF * 2 == 5 * MiB + 512 * 1024 && WS_H + (size_t)M * FF * 2 <= WS_CAT && WS_ROWSS + 16 * (size_t)M * 4 <= WS_ROPE && WS_ROPE + (size_t)M * 64 * 4 <= WS_XB, "ws map");
constexpr int LDS_BYTES = 147456;

#define LAS __attribute__((address_space(3)))
typedef unsigned short bf16;
typedef unsigned v4u __attribute__((ext_vector_type(4)));
typedef unsigned v2u __attribute__((ext_vector_type(2)));
typedef float f32x4 __attribute__((ext_vector_type(4)));
#define LDS_WAIT() asm volatile("s_waitcnt lgkmcnt(0)" ::: "memory")
__device__ __forceinline__ unsigned f2bf(float f) { unsigned u = __builtin_bit_cast(unsigned, f); return (u + 0x7fffu + ((u >> 16) & 1u)) >> 16; }
__device__ __forceinline__ unsigned pk2(float lo, float hi) { return f2bf(lo) | (f2bf(hi) << 16); }
__device__ __forceinline__ float bflo(unsigned w) { return __builtin_bit_cast(float, w << 16); }
__device__ __forceinline__ float bfhi(unsigned w) { return __builtin_bit_cast(float, w & 0xffff0000u); }
__device__ __forceinline__ float wave_sum(float v) {
#pragma unroll
    for (int o = 1; o < 64; o <<= 1) v += __shfl_xor(v, o);
    return v;
}
struct TrDesc { const float* W; const float* gk; bf16* WT; int N, k0, n0, Kd, rbase, rstride; };
__device__ __forceinline__ void tr_load(const TrDesc& d, int lane, f32x4 (&v)[8]) {
    const int kblk = lane & 7, n4 = lane >> 3;
    const float* src = d.W + (size_t)(d.k0 + 8 * kblk) * d.N + d.n0 + 4 * n4;
#pragma unroll
    for (int i = 0; i < 8; ++i) v[i] = __builtin_nontemporal_load((const f32x4*)(src + (size_t)i * d.N));
}
__device__ __forceinline__ void tr_store(const TrDesc& d, int lane, f32x4 (&v)[8]) {
    const int kblk = lane & 7, n4 = lane >> 3;
    if (d.gk) { const f32x4 g0 = *(const f32x4*)(d.gk + d.k0 + 8 * kblk), g1 = *(const f32x4*)(d.gk + d.k0 + 8 * kblk + 4);
#pragma unroll
        for (int i = 0; i < 4; ++i) { v[i] = v[i] * g0[i]; v[4 + i] = v[4 + i] * g1[i]; } }
#pragma unroll
    for (int e = 0; e < 4; ++e) { v4u o; o.x = pk2(v[0][e], v[1][e]); o.y = pk2(v[2][e], v[3][e]); o.z = pk2(v[4][e], v[5][e]); o.w = pk2(v[6][e], v[7][e]);
        *(v4u*)(d.WT + (size_t)(d.rbase + (4 * n4 + e) * d.rstride) * d.Kd + d.k0 + 8 * kblk) = o; }
}

#define XB_TMO      128
#define XB_XCNT(j)  (256  + 64 * (j))
#define XB_XSUB(j)  (1280 + 64 * (j))
#define XB_XGEN(j)  (2304 + 64 * (j))
#define XB_TOP      3328
#define XB_TOPGEN   3392
#define XCD_BAR_WORDS 3456
#define XB_SPIN_CAP (1u << 18)

__device__ __forceinline__ unsigned xb_ld(unsigned* p)              { return __hip_atomic_load(p, __ATOMIC_RELAXED, __HIP_MEMORY_SCOPE_AGENT); }
__device__ __forceinline__ unsigned xb_add(unsigned* p, unsigned v) { return __hip_atomic_fetch_add(p, v, __ATOMIC_RELAXED, __HIP_MEMORY_SCOPE_AGENT); }
__device__ __forceinline__ unsigned xb_xcc_id() { return (unsigned)__builtin_amdgcn_s_getreg((3 << 11) | 20) & 0xFu; }
#define XB_SPIN(cond, bar) do { unsigned _sp = 0; while (cond) { __builtin_amdgcn_s_sleep(1); \
    if ((++_sp & 255u) == 0u) { if (xb_ld(&(bar)[XB_TMO])) break; if (_sp > XB_SPIN_CAP) { atomicAdd(&(bar)[XB_TMO], 1u); break; } } } } while (0)

struct XcdBarrier {
    unsigned* bar; unsigned x;
    volatile LAS unsigned* st;
};

__device__ __forceinline__ XcdBarrier xcd_barrier_post(unsigned* bar, volatile LAS unsigned* st) {
    XcdBarrier b; b.bar = bar; b.x = xb_xcc_id(); b.st = st;
    if (threadIdx.x == 0) (void)xb_add(&bar[XB_XCNT(b.x)], 1u);
    return b;
}
__device__ __forceinline__ void xcd_barrier_complete(unsigned* bar, unsigned x, unsigned& nloc, unsigned& nx) {
    const unsigned G = gridDim.x * gridDim.y * gridDim.z;
    unsigned sum, cnt, mine, sp = 0u;
    for (;;) {
        sum = 0u; cnt = 0u; mine = 0u;
#pragma unroll
        for (unsigned j = 0; j < 16; ++j) { const unsigned c = xb_ld(&bar[XB_XCNT(j)]); sum += c; cnt += (c > 0u) ? 1u : 0u; mine = (j == x) ? c : mine; }
        if (sum == G) break;
        __builtin_amdgcn_s_sleep(1);
        if ((++sp & 255u) == 0u) { if (xb_ld(&bar[XB_TMO])) break; if (sp > XB_SPIN_CAP) { atomicAdd(&bar[XB_TMO], 1u); break; } }
    }
    nloc = mine > 0u ? mine : 1u; nx = cnt > 0u ? cnt : 1u;
}

__device__ __forceinline__ void xcd_barrier(const XcdBarrier& b) {
    asm volatile("s_waitcnt vmcnt(0)" ::: "memory");
    __syncthreads();
    if (threadIdx.x == 0) {
        unsigned* bar = b.bar;
        __builtin_amdgcn_s_waitcnt(0);
        unsigned nloc = b.st[0], nx = b.st[1];
        if (nloc == 0u) { xcd_barrier_complete(bar, b.x, nloc, nx); b.st[0] = nloc; b.st[1] = nx; }
        const unsigned old = xb_add(&bar[XB_XSUB(b.x)], 1u);
        const unsigned gen = old / nloc;
        if (old + 1u == (gen + 1u) * nloc) {
            __builtin_amdgcn_fence(__ATOMIC_RELEASE, "agent");
            asm volatile("s_waitcnt vmcnt(0)" ::: "memory");
            const unsigned og = xb_add(&bar[XB_TOP], 1u);
            const unsigned tg = og / nx;
            if (og + 1u == (tg + 1u) * nx) xb_add(&bar[XB_TOPGEN], 1u);
            else XB_SPIN(xb_ld(&bar[XB_TOPGEN]) == tg, bar);
            __builtin_amdgcn_fence(__ATOMIC_ACQUIRE, "agent");
            xb_add(&bar[XB_XGEN(b.x)], 1u);
            asm volatile("s_waitcnt vmcnt(0)" ::: "memory");
        } else {
            XB_SPIN(xb_ld(&bar[XB_XGEN(b.x)]) == gen, bar);
            __builtin_amdgcn_fence(__ATOMIC_ACQUIRE, "agent");
            asm volatile("s_waitcnt vmcnt(0)" ::: "memory");
        }
    }
    __syncthreads();
}

struct Args { const float* in[20]; float* out; unsigned char* wsp; };
__device__ __forceinline__ int fresh_lane() { int l; asm volatile("v_mbcnt_lo_u32_b32 %0, -1, 0\n\tv_mbcnt_hi_u32_b32 %0, -1, %0" : "=v"(l)); return l; }
typedef __attribute__((address_space(1))) unsigned char* gptr_t;
__device__ __forceinline__ gptr_t fresh_ptr(unsigned char* p) { asm volatile("" : "+s"(p)); return (gptr_t)p; }

__global__ void __launch_bounds__(NWAVES * 64, 2) hymba_fwd(Args args) {
    extern __shared__ __attribute__((aligned(16))) unsigned char lds[];
    LAS unsigned char* L = (LAS unsigned char*)lds;
    const int tid = threadIdx.x, lane = tid & 63, wave = __builtin_amdgcn_readfirstlane(tid >> 6);
    const int G = gridDim.x, bx = blockIdx.x;
    const int gw = bx * NWAVES + wave, NGW = G * NWAVES;
    const int gtid = bx * (NWAVES * 64) + tid, NT = G * NWAVES * 64;
#define ws (fresh_ptr(args.wsp))
#define rowss ((float*)(unsigned char*)(ws + WS_ROWSS))
#define rope ((float*)(unsigned char*)(ws + WS_ROPE))
#define XB ((bf16*)(unsigned char*)(ws + WS_XB))
#define HB ((bf16*)(unsigned char*)(ws + WS_H))
#define QKVU ((bf16*)(unsigned char*)(ws + WS_QKVU))
#define OBUF ((bf16*)(unsigned char*)(ws + WS_OBUF))
#define CAT ((bf16*)(unsigned char*)(ws + WS_CAT))
#define xout ((float*)(unsigned char*)fresh_ptr((unsigned char*)args.out))
    { volatile LAS unsigned* st0 = (volatile LAS unsigned*)(L + 147392); if (tid < 2) st0[tid] = 0u; }
    __syncthreads();
    (void)xcd_barrier_post((unsigned*)args.wsp, (volatile LAS unsigned*)(L + 147392));

    {
        constexpr int IT_G = 16 * 88, IT_D = 44 * 32, IT_IN = 16 * 64, IT_OUT = 8 * 32, IT_LAYER = 4 * IT_G + 2 * IT_D + IT_IN + IT_OUT;
        static_assert(IT_G == IT_D, "item decode");
#define TR_DECODE(d_, it_) do { const int l = (it_) / IT_LAYER; int r = (it_) % IT_LAYER; unsigned char* wlc_ = (unsigned char*)(ws + WS_W + (size_t)l * W_LAYER); \
            if (r < 6 * IT_G) { \
                const int f = r / (3 * IT_G), q = r % (3 * IT_G), kind = q / IT_G, i = q % IT_G; \
                if (kind < 2) { const int kb = i / 88, nb = i % 88, n0 = 32 * nb; \
                    d_ = TrDesc{args.in[(f ? 16 : 2) + kind] + (size_t)l * D * FF, args.in[f ? 15 : 1] + l * D, (bf16*)(wlc_ + (f ? OFF_GU2 : OFF_GU1)), FF, 64 * kb, n0, D, (n0 >> 7) * 256 + kind * 128 + (n0 & 127), 1}; } \
                else { const int kb = i / 32, nb = i % 32; \
                    d_ = TrDesc{args.in[f ? 18 : 4] + (size_t)l * FF * D, nullptr, (bf16*)(wlc_ + (f ? OFF_DN2 : OFF_DN1)), D, 64 * kb, 32 * nb, FF, 32 * nb, 1}; } \
            } else { r -= 6 * IT_G; \
                if (r < IT_IN) { const int kb = r / 64, nb = r % 64, n0 = 32 * nb; int rbase = n0, rstride = 1; \
                    if (n0 < 1024) { const int d0 = n0 & 63; rbase = (n0 - d0) + (d0 ? 1 : 0); rstride = 2; } \
                    d_ = TrDesc{args.in[6] + (size_t)l * D * NIN, args.in[5] + l * D, (bf16*)(wlc_ + OFF_IN), NIN, 64 * kb, n0, D, rbase, rstride}; } \
                else { r -= IT_IN; const int kb = r / 32, nb = r % 32; \
                    d_ = TrDesc{args.in[14] + (size_t)l * D * D, nullptr, (bf16*)(wlc_ + OFF_OUT), D, 64 * kb, 32 * nb, D, 32 * nb, 1}; } \
            } } while (0)
        if (gw < DEPTH * IT_LAYER) { int it = gw; TrDesc d0; TR_DECODE(d0, it); f32x4 va[8]; tr_load(d0, lane, va);
            for (;;) { const int itn = it + NGW; const bool has = itn < DEPTH * IT_LAYER; TrDesc d1 = d0; f32x4 vb[8];
#pragma unroll
                for (int i = 0; i < 8; ++i) vb[i] = (f32x4){0.f, 0.f, 0.f, 0.f};
                if (has) { TR_DECODE(d1, itn); tr_load(d1, lane, vb); }
                tr_store(d0, lane, va); if (!has) break;
                d0 = d1; it = itn;
#pragma unroll
                for (int i = 0; i < 8; ++i) va[i] = vb[i]; } }
#undef TR_DECODE
        for (int it = gw; it < DEPTH * 1024; it += NGW) {
            const int l = it >> 10, r = it & 1023, g = r >> 8, cb = (r >> 4) & 15, nb = r & 15, c0 = cb * 8, n = nb * 64 + lane;
            const float* pw = args.in[12] + ((size_t)(l * 4 + g) * 128 + c0) * 128; const float* ps = args.in[13] + l * 512 + g * 128;
            const float* wo = args.in[14] + (size_t)l * D * D + (size_t)(512 + g * 128) * D + n;
            float a[8];
#pragma unroll
            for (int j = 0; j < 8; ++j) a[j] = 0.f;
#pragma unroll 16
            for (int e = 0; e < 128; ++e) { const float w = wo[(size_t)e * D] * ps[e];
#pragma unroll
                for (int j = 0; j < 8; ++j) a[j] += pw[j * 128 + e] * w; }
            v4u o; o.x = pk2(a[0], a[1]); o.y = pk2(a[2], a[3]); o.z = pk2(a[4], a[5]); o.w = pk2(a[6], a[7]);
            *(v4u*)((bf16*)(unsigned char*)(ws + WS_W + (size_t)l * W_LAYER + OFF_OUT) + (size_t)n * D + 512 + g * 128 + c0) = o;
        }
        for (int i = gtid; i < M * 32; i += NT) { const int s = i >> 5, j = i & 31; const float inv = (float)pow(10000.0, -(double)j / 32.0); const float ang = (float)s * inv;
            const double a = (double)ang; rope[2 * i] = (float)cos(a); rope[2 * i + 1] = (float)sin(a); }
        if (gw < M) { int m = gw; f32x4 v[4];
            { const f32x4* xr = (const f32x4*)(args.in[0] + (size_t)m * D) + lane;
#pragma unroll
              for (int j = 0; j < 4; ++j) v[j] = __builtin_nontemporal_load(xr + 64 * j); }
            for (;;) { const int mn = m + NGW; const bool has = mn < M; f32x4 vn[4];
#pragma unroll
                for (int j = 0; j < 4; ++j) vn[j] = (f32x4){0.f, 0.f, 0.f, 0.f};
                if (has) { const f32x4* xr = (const f32x4*)(args.in[0] + (size_t)mn * D) + lane;
#pragma unroll
                    for (int j = 0; j < 4; ++j) vn[j] = __builtin_nontemporal_load(xr + 64 * j); }
                float s = 0.f;
#pragma unroll
                for (int j = 0; j < 4; ++j) s += (v[j].x * v[j].x + v[j].y * v[j].y) + (v[j].z * v[j].z + v[j].w * v[j].w);
                s = wave_sum(s); if (lane < 16) rowss[(size_t)m * 16 + lane] = (lane == 0) ? s : 0.f;
                v2u* o8 = (v2u*)(XB + (size_t)m * D) + lane;
#pragma unroll
                for (int j = 0; j < 4; ++j) { v2u w; w.x = pk2(v[j].x, v[j].y); w.y = pk2(v[j].z, v[j].w); o8[64 * j] = w;
                    int e = __builtin_amdgcn_cvt_pk_bf8_f32(v[j].x - bflo(w.x), v[j].y - bfhi(w.x), 0, false); e = __builtin_amdgcn_cvt_pk_bf8_f32(v[j].z - bflo(w.y), v[j].w - bfhi(w.y), e, true);
                    ((unsigned*)(unsigned char*)(ws + WS_XL + (size_t)m * D))[lane + 64 * j] = (unsigned)e; }
                if (!has) break; m = mn;
#pragma unroll
                for (int j = 0; j < 4; ++j) v[j] = vn[j]; } }
    }
    cg::this_grid().sync();


    for (int step = 0; step < 3 * DEPTH; ++step) {
        const int l = step / 3, kind = step % 3;
#define wl ((unsigned char*)(ws + WS_W + (size_t)l * W_LAYER))
        if (kind != 1) {
            const int f = kind >> 1;
            { pg8::Gemm g{XB, (const bf16*)(wl + (f ? OFF_GU2 : OFF_GU1)), M, NGU, D}; pg8::StaticOrder S; S.init(M, NGU, G, bx);
              pg8::Unit u0; u0.pm = -1; u0.pn = 0; const bool any0 = S.next(0, u0);
              { int tt = threadIdx.x; asm volatile("" : "+v"(tt));
                if (any0 && tt < 256) ((LAS float*)(L + 131072))[tt] = pg8::rs_from_ss(rowss + (size_t)(u0.pm * 256 + tt) * 16); }
              __syncthreads();
              pg8::EpiGateUp E{HB, rowss, (const LAS float*)(L + 131072), any0 ? u0.pm : -1};
              pg8::gemm_phase<pg8::EpiGateUp, pg8::StaticOrder, PG8_ALIGN, PG8_SP2>(L, g, S, E); }
            xcd_barrier(XcdBarrier{(unsigned*)args.wsp, xb_xcc_id(), (volatile LAS unsigned*)(L + 147392)});
            { pg8::Gemm g{HB, (const bf16*)(wl + (f ? OFF_DN2 : OFF_DN1)), M, D, FF}; pg8::StaticOrder S; S.init(M, D, G, bx);
              pg8::EpiResidBf E{(__attribute__((address_space(1))) bf16*)(ws + WS_XB), (__attribute__((address_space(1))) unsigned char*)(ws + WS_XL), rowss, 0.5f};
              pg8::gemm_phase<pg8::EpiResidBf, pg8::StaticOrder, PG8_ALIGN, PG8_SP2>(L, g, S, E); }
            xcd_barrier(XcdBarrier{(unsigned*)args.wsp, xb_xcc_id(), (volatile LAS unsigned*)(L + 147392)});
        } else {
            { pg8::Gemm g{XB, (const bf16*)(wl + OFF_IN), M, NIN, D}; pg8::StaticOrder S; S.init(M, NIN, G, bx);
              pg8::Unit u0; u0.pm = -1; u0.pn = 0; const bool any0 = S.next(0, u0);
              { int tt = threadIdx.x; asm volatile("" : "+v"(tt));
                if (any0 && tt < 256) ((LAS float*)(L + 131072))[tt] = pg8::rs_from_ss(rowss + (size_t)(u0.pm * 256 + tt) * 16); }
              __syncthreads();
              pg8::EpiQKVU E{QKVU, rowss, rope, (const LAS float*)(L + 131072), any0 ? u0.pm : -1};
              pg8::gemm_phase<pg8::EpiQKVU, pg8::StaticOrder, PG8_ALIGN, PG8_SP2>(L, g, S, E); }
            xcd_barrier(XcdBarrier{(unsigned*)args.wsp, xb_xcc_id(), (volatile LAS unsigned*)(L + 147392)});
            { const attn_body::AttnTensors AT{(const attn_body::bf16*)QKVU, (const attn_body::bf16*)(QKVU + 512), (const attn_body::bf16*)(QKVU + 1024), (attn_body::bf16*)OBUF};
              const attn_body::StaticOrder S(G, bx);
              attn_body::attn_phase<attn_body::StaticOrder>((char*)lds, AT, S); }
            xcd_barrier(XcdBarrier{(unsigned*)args.wsp, xb_xcc_id(), (volatile LAS unsigned*)(L + 147392)});
            {
                const int lane = fresh_lane();
                const float li = 0.8f - 0.6f * expf(-0.3f * (float)l);
                const float s1 = wave_sum(args.in[7][l * 64 + lane] * args.in[8][l * 64 + lane]), s2 = wave_sum(args.in[9][l * 64 + lane] * args.in[10][l * 64 + lane]);
                const float lam = expf(s1) - expf(s2) + li;
                const int hd = lane >> 4, j0 = (lane & 15) * 8;
                float gn[8];
#pragma unroll
                for (int j = 0; j < 8; ++j) gn[j] = args.in[11][l * 128 + j0 + j] * (1.0f - li);
                const int win = 2 << hd;
                for (int mc = gw; mc < M / 8; mc += NGW) { float wsum[8];
                  for (int mr = 0; mr < 8; ++mr) { const int m = mc * 8 + mr;
                    const v4u a = *(const v4u*)(OBUF + (size_t)m * 1024 + hd * 256 + j0), b = *(const v4u*)(OBUF + (size_t)m * 1024 + hd * 256 + 128 + j0);
                    float o[8];
                    o[0] = bflo(a.x) - lam * bflo(b.x); o[1] = bfhi(a.x) - lam * bfhi(b.x); o[2] = bflo(a.y) - lam * bflo(b.y); o[3] = bfhi(a.y) - lam * bfhi(b.y);
                    o[4] = bflo(a.z) - lam * bflo(b.z); o[5] = bfhi(a.z) - lam * bfhi(b.z); o[6] = bflo(a.w) - lam * bflo(b.w); o[7] = bfhi(a.w) - lam * bfhi(b.w);
                    float ss = 0.f;
#pragma unroll
                    for (int j = 0; j < 8; ++j) ss += o[j] * o[j];
                    ss += __shfl_xor(ss, 1); ss += __shfl_xor(ss, 2); ss += __shfl_xor(ss, 4); ss += __shfl_xor(ss, 8);
                    const float rr = __builtin_amdgcn_rsqf(ss * (1.0f / 128.0f) + 1e-6f);
                    v4u w; w.x = pk2(o[0] * rr * gn[0], o[1] * rr * gn[1]); w.y = pk2(o[2] * rr * gn[2], o[3] * rr * gn[3]); w.z = pk2(o[4] * rr * gn[4], o[5] * rr * gn[5]); w.w = pk2(o[6] * rr * gn[6], o[7] * rr * gn[7]);
                    *(v4u*)(CAT + (size_t)m * 1024 + hd * 128 + j0) = w;
                    const bf16* up = QKVU + (size_t)m * 2112 + 1536 + hd * 128 + j0;
                    const v4u u0 = *(const v4u*)up;
                    const float us[8] = {bflo(u0.x), bfhi(u0.x), bflo(u0.y), bfhi(u0.y), bflo(u0.z), bfhi(u0.z), bflo(u0.w), bfhi(u0.w)};
                    float sm[8];
                    if (mr == 0) {
                        v4u ut[15]; float wt[15];
#pragma unroll
                        for (int j = 0; j < 8; ++j) sm[j] = us[j];
#pragma unroll
                        for (int t = 1; t < 16; ++t) { const bool ok = (t < win) && (m - t >= 0); ut[t - 1] = *(const v4u*)(up - (size_t)(ok ? t : 0) * 2112); wt[t - 1] = ok ? 1.0f : 0.0f; }
#pragma unroll
                        for (int t = 0; t < 15; ++t) { const float w = wt[t];
                            sm[0] += w * bflo(ut[t].x); sm[1] += w * bfhi(ut[t].x); sm[2] += w * bflo(ut[t].y); sm[3] += w * bfhi(ut[t].y); sm[4] += w * bflo(ut[t].z); sm[5] += w * bfhi(ut[t].z); sm[6] += w * bflo(ut[t].w); sm[7] += w * bfhi(ut[t].w); }
                    } else {
                        const bool dr = (m - win >= 0); const v4u ud = *(const v4u*)(up - (size_t)(dr ? win : 0) * 2112); const float wd = dr ? 1.0f : 0.0f;
                        sm[0] = wsum[0] + us[0] - wd * bflo(ud.x); sm[1] = wsum[1] + us[1] - wd * bfhi(ud.x); sm[2] = wsum[2] + us[2] - wd * bflo(ud.y); sm[3] = wsum[3] + us[3] - wd * bfhi(ud.y);
                        sm[4] = wsum[4] + us[4] - wd * bflo(ud.z); sm[5] = wsum[5] + us[5] - wd * bfhi(ud.z); sm[6] = wsum[6] + us[6] - wd * bflo(ud.w); sm[7] = wsum[7] + us[7] - wd * bfhi(ud.w);
                    }
#pragma unroll
                    for (int j = 0; j < 8; ++j) wsum[j] = sm[j];
                    const float ic = 1.0f / (float)((m + 1 < win) ? (m + 1) : win);
                    v4u d; d.x = pk2(sm[0] * ic - us[0], sm[1] * ic - us[1]); d.y = pk2(sm[2] * ic - us[2], sm[3] * ic - us[3]); d.z = pk2(sm[4] * ic - us[4], sm[5] * ic - us[5]); d.w = pk2(sm[6] * ic - us[6], sm[7] * ic - us[7]);
                    *(v4u*)(CAT + (size_t)m * 1024 + 512 + hd * 128 + j0) = d;
                  }
                }
            }
            xcd_barrier(XcdBarrier{(unsigned*)args.wsp, xb_xcc_id(), (volatile LAS unsigned*)(L + 147392)});
            { pg8::Gemm g{CAT, (const bf16*)(wl + OFF_OUT), M, D, D}; pg8::StaticOrder S; S.init(M, D, G, bx);
              pg8::EpiResidBf E{(__attribute__((address_space(1))) bf16*)(ws + WS_XB), (__attribute__((address_space(1))) unsigned char*)(ws + WS_XL), rowss, 1.0f};
              pg8::gemm_phase<pg8::EpiResidBf, pg8::StaticOrder, PG8_ALIGN, PG8_SP2>(L, g, S, E); }
            xcd_barrier(XcdBarrier{(unsigned*)args.wsp, xb_xcc_id(), (volatile LAS unsigned*)(L + 147392)});
        }
    }
    { const int lane = fresh_lane();
    for (int m = gw; m < M; m += NGW) { const v2u* xr = (const v2u*)(XB + (size_t)m * D) + lane; f32x4* xo = (f32x4*)((float*)(unsigned char*)fresh_ptr((unsigned char*)args.out) + (size_t)m * D) + lane; const f32x4* gr = (const f32x4*)args.in[19] + lane;
        const float r = pg8::rs_from_ss(rowss + (size_t)m * 16);
#pragma unroll
        for (int j = 0; j < 4; ++j) { const v2u w = xr[64 * j]; const f32x4 gg = gr[64 * j]; const int e = (int)((const unsigned*)(unsigned char*)(ws + WS_XL + (size_t)m * D))[lane + 64 * j];
            const pg8::f32x2 la = __builtin_amdgcn_cvt_pk_f32_bf8(e, false), lb = __builtin_amdgcn_cvt_pk_f32_bf8(e, true);
            const f32x4 v = (f32x4){bflo(w.x) + la.x, bfhi(w.x) + la.y, bflo(w.y) + lb.x, bfhi(w.y) + lb.y}; xo[64 * j] = v * r * gg; } } }
}

#undef wl
#undef ws
#undef rowss
#undef rope
#undef XB
#undef HB
#undef QKVU
#undef OBUF
#undef CAT
#undef xout
extern "C" void kernel_launch(void* const* d_in, const int* in_sizes, int n_in, void* d_out, int out_size, void* d_ws, size_t ws_size, hipStream_t stream) {
    static int grid_blocks = 0;
    if (grid_blocks == 0) {
        if (n_in != 20 || out_size != M * D || ws_size < WS_END) { fprintf(stderr, "kernel_launch: unexpected shapes (n_in %d out %d ws %zu, need %zu)\n", n_in, out_size, ws_size, (size_t)WS_END); grid_blocks = -1; return; }
        int dev = 0, cus = 0, per_cu = 0;
        (void)hipGetDevice(&dev); (void)hipDeviceGetAttribute(&cus, hipDeviceAttributeMultiprocessorCount, dev);
        if (hipFuncSetAttribute((const void*)hymba_fwd, hipFuncAttributeMaxDynamicSharedMemorySize, LDS_BYTES) != hipSuccess) { fprintf(stderr, "kernel_launch: hipFuncSetAttribute failed\n"); grid_blocks = -1; return; }
        if (hipOccupancyMaxActiveBlocksPerMultiprocessor(&per_cu, (const void*)hymba_fwd, NWAVES * 64, LDS_BYTES) != hipSuccess || per_cu < 1) { fprintf(stderr, "kernel_launch: occupancy query says %d\n", per_cu); per_cu = 1; }
        (void)hipGetLastError();
        grid_blocks = cus * per_cu;
    }
    if (grid_blocks < 0) return;
    if (hipMemsetAsync(d_ws, 0, 65536, stream) != hipSuccess) { fprintf(stderr, "kernel_launch: memset failed\n"); return; }
    Args a{};
    for (int i = 0; i < 20; ++i) a.in[i] = (const float*)d_in[i];
    a.out = (float*)d_out; a.wsp = (unsigned char*)d_ws;
    void* kargs[] = {&a};
    hipError_t e = hipLaunchCooperativeKernel((const void*)hymba_fwd, dim3(grid_blocks), dim3(NWAVES * 64), kargs, LDS_BYTES, stream);
    if (e != hipSuccess) fprintf(stderr, "cooperative launch failed: %s (grid %d)\n", hipGetErrorString(e), grid_blocks);
}
```

```cpp
#include <hip/hip_runtime.h>
#include <hip/hip_cooperative_groups.h>
#include <cstdio>
#include <cstdint>
namespace cg = cooperative_groups;
namespace pg8 {
#define PG8_LAS __attribute__((address_space(3)))
typedef unsigned short bf16_t;
typedef short bf16x8 __attribute__((ext_vector_type(8)));
typedef float f32x4 __attribute__((ext_vector_type(4)));
typedef unsigned u32x4 __attribute__((ext_vector_type(4)));
constexpr int BM = 256, BK = 64, HALF = 128, HTB = HALF * BK * 2  , STAGE_BYTES = 8 * HTB, NXCD = 8, WGM = 8;

__host__ __device__ __forceinline__ int lds_byte(int r, int c) { const int st = (r >> 4) * 2 + (c >> 5), rr = r & 15, cc = c & 31, ob = rr * 64 + cc * 2; return st * 1024 + (ob ^ (((ob >> 9) & 1) << 5)); }
__host__ __device__ __forceinline__ void stage_rc(int b, int& R, int& C) { const int st = b / 1024, sb = b % 1024, swz = sb ^ (((sb >> 9) & 1) << 5); R = (st >> 1) * 16 + swz / 64; C = (st & 1) * 32 + (swz % 64) / 2; }
__host__ __device__ __forceinline__ int perm32(int rho) { const int n = rho >> 4, i = rho & 15; return 8 * (i >> 2) + 4 * n + (i & 3); }

struct Unit { int pm, pn; };
struct Gemm { const bf16_t* A; const bf16_t* Bt; int M, N, K; };

struct StaticOrder {
    int nM, nN, nwg, G, c;
    __host__ __device__ void init(int M, int N, int G_, int c_) { nM = M / BM; nN = N / BM; nwg = nM * nN; G = G_; c = c_; }
    __host__ __device__ bool next(int i, Unit& u) const {
        const long L = (long)i * G + c; if (L >= nwg) return false;
        int wgid = (int)L; { const int q = nwg / NXCD, r = nwg % NXCD, xcd = wgid % NXCD, off = wgid / NXCD; wgid = (xcd < r ? xcd * (q + 1) : r * (q + 1) + (xcd - r) * q) + off; }
        const int nig = WGM * nN, gid = wgid / nig, fm = gid * WGM, gsz = (nM - fm) < WGM ? (nM - fm) : WGM;
        u.pm = fm + ((wgid % nig) % gsz); u.pn = (wgid % nig) / gsz; return true;
    }
    __device__ __forceinline__ void a_ready(const Unit&) const {}
    __device__ __forceinline__ void done(const Unit&) const {}
};

__device__ __forceinline__ unsigned cvt_pk_bf16(float lo, float hi) { unsigned r; asm volatile("v_cvt_pk_bf16_f32 %0, %1, %2" : "=v"(r) : "v"(lo), "v"(hi)); return r; }
typedef float f32x2 __attribute__((ext_vector_type(2)));
__device__ __forceinline__ f32x2 gelu_pk(f32x2 v) {
    const f32x2 av = __builtin_elementwise_abs(v), d = av * 0.2316418882f + 1.0f;
    f32x2 t; t.x = __builtin_amdgcn_rcpf(d.x); t.y = __builtin_amdgcn_rcpf(d.y);
    f32x2 q = t * 0.5307027145f + (-0.7265760135f); q = q * t + 0.7107068705f; q = q * t + (-0.142248368f); q = q * t + 0.127414796f; q = q * t;
    const f32x2 s = (v * v) * (-0.72134752044f);
    f32x2 e; e.x = __builtin_amdgcn_exp2f(s.x); e.y = __builtin_amdgcn_exp2f(s.y);
    const f32x2 m = v * (q * e), r = v - m;
    f32x2 o; o.x = v.x < 0.f ? m.x : r.x; o.y = v.y < 0.f ? m.y : r.y; return o;
}

template <int ACT  > struct EpiBf16 {
    static constexpr bool PERM = true, AFTER_DRAIN = false; static_assert(ACT == 0 || ACT == 1, "EpiBf16: ACT is 0 (none) or 1 (gelu_pk)");
    bf16_t* O; int ldc; const float* bias; int split_cols; size_t split_stride; float scale0;
    __device__ __forceinline__ void operator()(const f32x4 (&acc)[2][2][4][2], const Unit& u, int wr, int wc, int fr, int fq) const {
        const int row0 = u.pm * BM + wr * 64 + fr; int colt = u.pn * BM; bf16_t* base = O;
        float sc = 1.f; if (split_cols) { const int t = colt / split_cols; base += (size_t)t * split_stride; colt -= t * split_cols; if (t == 0) sc = scale0; }
        const int col0 = colt + wc * 32 + 8 * fq, bcol0 = u.pn * BM + wc * 32 + 8 * fq;
        f32x4 bv[2][2];
#pragma unroll
        for (int bj = 0; bj < 2; ++bj)
#pragma unroll
            for (int n = 0; n < 2; ++n) bv[bj][n] = bias ? *(const f32x4*)(bias + bcol0 + bj * HALF + 4 * n) : (f32x4){0.f, 0.f, 0.f, 0.f};
#pragma unroll
        for (int ai = 0; ai < 2; ++ai)
#pragma unroll
            for (int m = 0; m < 4; ++m) { bf16_t* rowp = base + (size_t)(row0 + ai * HALF + m * 16) * ldc + col0;
#pragma unroll
                for (int bj = 0; bj < 2; ++bj) { f32x4 v0 = acc[ai][bj][m][0] + bv[bj][0], v1 = acc[ai][bj][m][1] + bv[bj][1];
                    if (ACT == 1) { f32x2 a = gelu_pk((f32x2){v0[0], v0[1]}), b = gelu_pk((f32x2){v0[2], v0[3]}), c = gelu_pk((f32x2){v1[0], v1[1]}), d = gelu_pk((f32x2){v1[2], v1[3]});
                        v0 = (f32x4){a.x, a.y, b.x, b.y}; v1 = (f32x4){c.x, c.y, d.x, d.y}; }
                    v0 = v0 * sc; v1 = v1 * sc; u32x4 w; w.x = cvt_pk_bf16(v0[0], v0[1]); w.y = cvt_pk_bf16(v0[2], v0[3]); w.z = cvt_pk_bf16(v1[0], v1[1]); w.w = cvt_pk_bf16(v1[2], v1[3]);
                    *(u32x4*)(rowp + bj * HALF) = w; } }
    }
};
__device__ __forceinline__ float rs_from_ss(const float* p) { const f32x4 a = ((const f32x4*)p)[0], b = ((const f32x4*)p)[1], c = ((const f32x4*)p)[2], d = ((const f32x4*)p)[3];
    const float ss = (((a[0] + a[1]) + (a[2] + a[3])) + ((b[0] + b[1]) + (b[2] + b[3]))) + (((c[0] + c[1]) + (c[2] + c[3])) + ((d[0] + d[1]) + (d[2] + d[3])));
    return __builtin_amdgcn_rsqf(ss * (1.0f / 1024.0f) + 1e-6f); }
__device__ __forceinline__ float sum_fq4(float s) {
    { auto rr = __builtin_amdgcn_permlane16_swap(__float_as_uint(s), __float_as_uint(s), false, false); s = __uint_as_float(rr[0]) + __uint_as_float(rr[1]); }
    { auto rr = __builtin_amdgcn_permlane32_swap(__float_as_uint(s), __float_as_uint(s), false, false); s = __uint_as_float(rr[0]) + __uint_as_float(rr[1]); }
    return s; }
#define EPI_ROW_SCALES(rs_, rowss_, row0_) do { f32x4 q_[8]; \
    _Pragma("unroll") for (int i_ = 0; i_ < 8; ++i_) q_[i_] = *(const f32x4*)((rowss_) + (size_t)((row0_) + (i_ >> 2) * HALF + (i_ & 3) * 16) * 16 + fq * 4); \
    _Pragma("unroll") for (int i_ = 0; i_ < 8; ++i_) { float s_ = sum_fq4((q_[i_][0] + q_[i_][1]) + (q_[i_][2] + q_[i_][3])); \
        rs_[i_] = __builtin_amdgcn_rsqf(s_ * (1.0f / 1024.0f) + 1e-6f); } } while (0)
struct EpiGateUp {
    static constexpr bool PERM = true, AFTER_DRAIN = false;
    bf16_t* H; const float* rowss; const PG8_LAS float* tab; int pm0;
    __device__ __forceinline__ void operator()(const f32x4 (&acc)[2][2][4][2], const Unit& u, int wr, int wc, int fr, int fq) const {
        const int row0 = u.pm * BM + wr * 64 + fr; const int col0 = u.pn * HALF + wc * 32 + 8 * fq;
        float rs[8];
        if (u.pm == pm0) {
#pragma unroll
            for (int i = 0; i < 8; ++i) rs[i] = tab[wr * 64 + fr + (i >> 2) * HALF + (i & 3) * 16]; }
        else EPI_ROW_SCALES(rs, rowss, row0);
#pragma unroll
        for (int ai = 0; ai < 2; ++ai)
#pragma unroll
            for (int m = 0; m < 4; ++m) { const int row = row0 + ai * HALF + m * 16; const float r = rs[ai * 4 + m];
                float hv[8];
#pragma unroll
                for (int n = 0; n < 2; ++n)
#pragma unroll
                    for (int e = 0; e < 4; ++e) { const float g = acc[ai][0][m][n][e] * r, up = acc[ai][1][m][n][e] * r;
                        const float sg = g * __builtin_amdgcn_rcpf(1.0f + __builtin_amdgcn_exp2f(g * -1.4426950408889634f)); hv[n * 4 + e] = sg * up; }
                u32x4 w; w.x = cvt_pk_bf16(hv[0], hv[1]); w.y = cvt_pk_bf16(hv[2], hv[3]); w.z = cvt_pk_bf16(hv[4], hv[5]); w.w = cvt_pk_bf16(hv[6], hv[7]);
                *(u32x4*)(H + (size_t)row * 2816 + col0) = w; }
    }
};
struct EpiResidBf {
    static constexpr bool PERM = true, AFTER_DRAIN = false;
    typedef __attribute__((address_space(1))) u32x4 gu32x4; typedef unsigned u32x2 __attribute__((ext_vector_type(2))); typedef __attribute__((address_space(1))) u32x2 gu32x2;
    __attribute__((address_space(1))) bf16_t* xb; __attribute__((address_space(1))) unsigned char* xl; float* rowss_next; float alpha;
    __device__ __forceinline__ void operator()(const f32x4 (&acc)[2][2][4][2], const Unit& u, int wr, int wc, int fr, int fq) const {
        const int row0 = u.pm * BM + wr * 64 + fr; const int col0 = u.pn * BM + wc * 32 + 8 * fq;
        u32x4 xa[4][2]; u32x2 la[4][2];
#define EPB_LD(ai_) do { _Pragma("unroll") for (int m = 0; m < 4; ++m) _Pragma("unroll") for (int bj = 0; bj < 2; ++bj) { const size_t off = (size_t)(row0 + (ai_) * HALF + m * 16) * 1024 + col0 + bj * HALF; \
            xa[m][bj] = *(const gu32x4*)(xb + off); la[m][bj] = *(const gu32x2*)(xl + off); } } while (0)
#define EPB_ST(ai_) do { _Pragma("unroll") for (int m = 0; m < 4; ++m) { const int row = row0 + (ai_) * HALF + m * 16; float ss = 0.f; \
            _Pragma("unroll") for (int bj = 0; bj < 2; ++bj) { const u32x4 x = xa[m][bj]; const u32x2 lw = la[m][bj]; const size_t off = (size_t)row * 1024 + col0 + bj * HALF; \
                const f32x2 l0 = __builtin_amdgcn_cvt_pk_f32_bf8((int)lw.x, false), l1 = __builtin_amdgcn_cvt_pk_f32_bf8((int)lw.x, true), l2 = __builtin_amdgcn_cvt_pk_f32_bf8((int)lw.y, false), l3 = __builtin_amdgcn_cvt_pk_f32_bf8((int)lw.y, true); \
                const f32x4 a0 = (f32x4){__builtin_bit_cast(float, x.x << 16) + l0.x, __builtin_bit_cast(float, x.x & 0xffff0000u) + l0.y, __builtin_bit_cast(float, x.y << 16) + l1.x, __builtin_bit_cast(float, x.y & 0xffff0000u) + l1.y}; \
                const f32x4 a1 = (f32x4){__builtin_bit_cast(float, x.z << 16) + l2.x, __builtin_bit_cast(float, x.z & 0xffff0000u) + l2.y, __builtin_bit_cast(float, x.w << 16) + l3.x, __builtin_bit_cast(float, x.w & 0xffff0000u) + l3.y}; \
                const f32x4 v0 = a0 + acc[ai_][bj][m][0] * alpha, v1 = a1 + acc[ai_][bj][m][1] * alpha; \
                ss += (v0[0] * v0[0] + v0[1] * v0[1]) + (v0[2] * v0[2] + v0[3] * v0[3]) + (v1[0] * v1[0] + v1[1] * v1[1]) + (v1[2] * v1[2] + v1[3] * v1[3]); \
                u32x4 w; w.x = cvt_pk_bf16(v0[0], v0[1]); w.y = cvt_pk_bf16(v0[2], v0[3]); w.z = cvt_pk_bf16(v1[0], v1[1]); w.w = cvt_pk_bf16(v1[2], v1[3]); \
                *(gu32x4*)(xb + off) = w; \
                int e0 = __builtin_amdgcn_cvt_pk_bf8_f32(v0[0] - __builtin_bit_cast(float, w.x << 16), v0[1] - __builtin_bit_cast(float, w.x & 0xffff0000u), 0, false); \
                e0 = __builtin_amdgcn_cvt_pk_bf8_f32(v0[2] - __builtin_bit_cast(float, w.y << 16), v0[3] - __builtin_bit_cast(float, w.y & 0xffff0000u), e0, true); \
                int e1 = __builtin_amdgcn_cvt_pk_bf8_f32(v1[0] - __builtin_bit_cast(float, w.z << 16), v1[1] - __builtin_bit_cast(float, w.z & 0xffff0000u), 0, false); \
                e1 = __builtin_amdgcn_cvt_pk_bf8_f32(v1[2] - __builtin_bit_cast(float, w.w << 16), v1[3] - __builtin_bit_cast(float, w.w & 0xffff0000u), e1, true); \
                *(gu32x2*)(xl + off) = (u32x2){(unsigned)e0, (unsigned)e1}; } \
            ss = sum_fq4(ss); \
            if (fq == 0) rowss_next[(size_t)row * 16 + u.pn * 4 + wc] = ss; } } while (0)
        EPB_LD(0); __builtin_amdgcn_sched_barrier(0);
        EPB_ST(0); __builtin_amdgcn_sched_barrier(0);
        EPB_LD(1); __builtin_amdgcn_sched_barrier(0);
        EPB_ST(1);
#undef EPB_LD
#undef EPB_ST
    }
};
struct EpiQKVU {
    static constexpr bool PERM = true, AFTER_DRAIN = false;
    bf16_t* O; const float* rowss; const float* rope; const PG8_LAS float* tab; int pm0;
    __device__ __forceinline__ void operator()(const f32x4 (&acc)[2][2][4][2], const Unit& u, int wr, int wc, int fr, int fq) const {
        const int row0 = u.pm * BM + wr * 64 + fr; const int col0 = u.pn * BM + wc * 32 + 8 * fq; const int sec = u.pn >> 1;
        const int j0 = 16 * (wc & 1) + 4 * fq;
        float rs[8];
        if (u.pm == pm0) {
#pragma unroll
            for (int i = 0; i < 8; ++i) rs[i] = tab[wr * 64 + fr + (i >> 2) * HALF + (i & 3) * 16]; }
        else EPI_ROW_SCALES(rs, rowss, row0);
#pragma unroll
        for (int ai = 0; ai < 2; ++ai) {
            f32x4 cs[4][2];
#pragma unroll
            for (int m = 0; m < 4; ++m) { cs[m][0] = (f32x4){1.f, 0.f, 1.f, 0.f}; cs[m][1] = cs[m][0];
                if (sec < 2) { const f32x4* rp = (const f32x4*)(rope + ((size_t)(row0 + ai * HALF + m * 16) * 32 + j0) * 2); cs[m][0] = rp[0]; cs[m][1] = rp[1]; } }
#pragma unroll
            for (int m = 0; m < 4; ++m) { const int row = row0 + ai * HALF + m * 16; float r = rs[ai * 4 + m]; if (sec == 0) r *= 0.125f * 1.4426950408889634f;
                const f32x4 cs0 = cs[m][0], cs1 = cs[m][1];
#pragma unroll
                for (int bj = 0; bj < 2; ++bj) { const f32x4 v0 = acc[ai][bj][m][0] * r, v1 = acc[ai][bj][m][1] * r;
                    const float o0 = v0[0] * cs0[0] - v0[1] * cs0[1], o1 = v0[1] * cs0[0] + v0[0] * cs0[1];
                    const float o2 = v0[2] * cs0[2] - v0[3] * cs0[3], o3 = v0[3] * cs0[2] + v0[2] * cs0[3];
                    const float o4 = v1[0] * cs1[0] - v1[1] * cs1[1], o5 = v1[1] * cs1[0] + v1[0] * cs1[1];
                    const float o6 = v1[2] * cs1[2] - v1[3] * cs1[3], o7 = v1[3] * cs1[2] + v1[2] * cs1[3];
                    u32x4 w; w.x = cvt_pk_bf16(o0, o1); w.y = cvt_pk_bf16(o2, o3); w.z = cvt_pk_bf16(o4, o5); w.w = cvt_pk_bf16(o6, o7);
                    *(u32x4*)(O + (size_t)row * 2112 + col0 + bj * HALF) = w; } } }
    }
};

template <class Epi, class Sched, bool ALIGN_EPI = false, bool SP2 = false>
__device__ __forceinline__ void gemm_phase(PG8_LAS unsigned char* lds, const Gemm g, const Sched& S, const Epi& E) {
    int tid_ = threadIdx.x; asm volatile("" : "+v"(tid_));
    const int tid = tid_, wid = __builtin_amdgcn_readfirstlane(tid >> 6), lane = tid & 63, wr = wid >> 2, wc = wid & 3, fr = lane & 15, fq = lane >> 4;
    const int K = g.K, nt = K / BK;
    unsigned voffA[2], voffB[2];
#pragma unroll
    for (int i = 0; i < 2; ++i) { int R, C; stage_rc(tid * 16 + i * 8192, R, C); const int Rb = Epi::PERM ? ((R & ~31) + perm32(R & 31)) : R;
        voffA[i] = (unsigned)(R * K + C) * 2u; voffB[i] = (unsigned)(Rb * K + C) * 2u; }
    const size_t kstep = (size_t)(BK * 2);
    const size_t hstep = (size_t)HALF * K * 2;
    const size_t tstep = 2 * hstep;
    const unsigned ldsw = (unsigned)wid * 1024u;
    const int aoff = lds_byte(wr * 64 + fr, fq * 8), boff = lds_byte(wc * 32 + fr, fq * 8);
#define PG8_SA(b, h) (((b) * 2 + (h)) * HTB)
#define PG8_SB(b, h) ((4 + (b) * 2 + (h)) * HTB)
#define PG8_STAGE(bufoff, gbase, voff) do { _Pragma("unroll") for (int _i = 0; _i < 2; ++_i) \
        __builtin_amdgcn_global_load_lds((const unsigned*)((const char*)(gbase) + (voff)[_i]), (PG8_LAS unsigned*)(lds + (bufoff) + ldsw + _i * 8192), 16, 0, 0); } while (0)
#define PG8_LDA(dst, b, h) do { _Pragma("unroll") for (int m = 0; m < 4; ++m) _Pragma("unroll") for (int k = 0; k < 2; ++k) dst[m][k] = *(const PG8_LAS bf16x8*)(lds + PG8_SA(b, h) + aoff + m * 2048 + k * 1024); } while (0)
#define PG8_LDB(dst, b, h) do { _Pragma("unroll") for (int n = 0; n < 2; ++n) _Pragma("unroll") for (int k = 0; k < 2; ++k) dst[n][k] = *(const PG8_LAS bf16x8*)(lds + PG8_SB(b, h) + boff + n * 2048 + k * 1024); } while (0)
#define PG8_MMA(ai, bj, At, Bt) do { __builtin_amdgcn_s_setprio(1); _Pragma("unroll") for (int m = 0; m < 4; ++m) _Pragma("unroll") for (int n = 0; n < 2; ++n) _Pragma("unroll") for (int k = 0; k < 2; ++k) \
        acc[ai][bj][m][n] = __builtin_amdgcn_mfma_f32_16x16x32_bf16(Bt[n][k], At[m][k], acc[ai][bj][m][n], 0, 0, 0); __builtin_amdgcn_s_setprio(0); } while (0)
#define PG8_WAIT_V(n) asm volatile("s_waitcnt vmcnt(" #n ")" ::: "memory")
#define PG8_WAIT_L(n) asm volatile("s_waitcnt lgkmcnt(" #n ")" ::: "memory")
#define PG8_BAR __builtin_amdgcn_s_barrier()
#define PG8_SCHED __builtin_amdgcn_sched_barrier(0)
    Unit cur, nxt; int ui = 0;
    if (!S.next(0, cur)) return;
    f32x4 acc[2][2][4][2];
#pragma unroll
    for (int a = 0; a < 2; ++a)
#pragma unroll
        for (int b = 0; b < 2; ++b)
#pragma unroll
            for (int m = 0; m < 4; ++m)
#pragma unroll
                for (int n = 0; n < 2; ++n) acc[a][b][m][n] = (f32x4){0.f, 0.f, 0.f, 0.f};
    bf16x8 At[4][2], B0[2][2], B1[2][2];
    const char* cA = (const char*)g.A + (size_t)cur.pm * tstep; const char* cB = (const char*)g.Bt + (size_t)cur.pn * tstep;
    S.a_ready(cur);
    if constexpr (SP2) {
        PG8_STAGE(PG8_SB(0, 0), cB, voffB); PG8_STAGE(PG8_SB(0, 1), cB + hstep, voffB); PG8_STAGE(PG8_SA(0, 0), cA, voffA); PG8_STAGE(PG8_SA(0, 1), cA + hstep, voffA);
        if (wr == 1) PG8_BAR;
        PG8_WAIT_V(2); PG8_BAR;
        PG8_STAGE(PG8_SB(1, 0), cB + kstep, voffB); PG8_STAGE(PG8_SA(1, 0), cA + kstep, voffA); PG8_STAGE(PG8_SB(1, 1), cB + hstep + kstep, voffB);
        PG8_WAIT_V(6); PG8_BAR;
    } else {
        PG8_STAGE(PG8_SB(0, 0), cB, voffB); PG8_STAGE(PG8_SA(0, 0), cA, voffA); PG8_STAGE(PG8_SB(0, 1), cB + hstep, voffB); PG8_STAGE(PG8_SA(0, 1), cA + hstep, voffA);
        if (wr == 1) PG8_BAR;
        PG8_WAIT_V(4); PG8_BAR;
        PG8_STAGE(PG8_SB(1, 0), cB + kstep, voffB); PG8_STAGE(PG8_SA(1, 0), cA + kstep, voffA); PG8_STAGE(PG8_SB(1, 1), cB + hstep + kstep, voffB);
        PG8_WAIT_V(6); PG8_BAR;
    }
    for (;;) {
        const bool has_next = S.next(ui + 1, nxt);
        const char* nA = has_next ? (const char*)g.A + (size_t)nxt.pm * tstep : cA; const char* nB = has_next ? (const char*)g.Bt + (size_t)nxt.pn * tstep : cB;
        for (int t = 0; t < nt; t += 2) {
            const bool last = (t == nt - 2);
            const char* a1 = cA + (size_t)(t + 1) * kstep;
            const char* a2 = last ? nA : cA + (size_t)(t + 2) * kstep; const char* b2 = last ? nB : cB + (size_t)(t + 2) * kstep;
            const char* a3 = a2 + kstep; const char* b3 = b2 + kstep;
            if (last && has_next) S.a_ready(nxt);
            if constexpr (SP2) {
            PG8_LDB(B0, 0, 0); PG8_LDB(B1, 0, 1); PG8_SCHED; PG8_LDA(At, 0, 0); PG8_STAGE(PG8_SA(1, 1), a1 + hstep, voffA);
            PG8_WAIT_V(8); PG8_WAIT_L(0); PG8_BAR; PG8_MMA(0, 0, At, B0); PG8_MMA(0, 1, At, B1); PG8_BAR; PG8_SCHED;
            PG8_LDA(At, 0, 1); PG8_STAGE(PG8_SB(0, 0), b2, voffB); PG8_STAGE(PG8_SB(0, 1), b2 + hstep, voffB); PG8_STAGE(PG8_SA(0, 0), a2, voffA);
            PG8_WAIT_V(8); PG8_WAIT_L(0); PG8_BAR; PG8_MMA(1, 0, At, B0); PG8_MMA(1, 1, At, B1); PG8_BAR; PG8_SCHED;
            PG8_LDB(B0, 1, 0); PG8_LDB(B1, 1, 1); PG8_SCHED; PG8_LDA(At, 1, 0); PG8_STAGE(PG8_SA(0, 1), a2 + hstep, voffA);
            PG8_WAIT_V(8); PG8_WAIT_L(0); PG8_BAR; PG8_MMA(0, 0, At, B0); PG8_MMA(0, 1, At, B1); PG8_BAR; PG8_SCHED;
            PG8_LDA(At, 1, 1); PG8_STAGE(PG8_SB(1, 0), b3, voffB); PG8_STAGE(PG8_SB(1, 1), b3 + hstep, voffB); PG8_STAGE(PG8_SA(1, 0), a3, voffA);
            PG8_WAIT_V(8); PG8_WAIT_L(0); PG8_BAR; PG8_MMA(1, 0, At, B0); PG8_MMA(1, 1, At, B1); PG8_BAR; PG8_SCHED;
            } else {
            PG8_LDB(B0, 0, 0); PG8_SCHED; PG8_LDA(At, 0, 0); PG8_STAGE(PG8_SA(1, 1), a1 + hstep, voffA);
            PG8_WAIT_L(8); PG8_BAR; PG8_WAIT_L(0); PG8_MMA(0, 0, At, B0); PG8_BAR; PG8_SCHED;
            PG8_LDB(B1, 0, 1); PG8_STAGE(PG8_SB(0, 0), b2, voffB);
            PG8_BAR; PG8_WAIT_L(0); PG8_MMA(0, 1, At, B1); PG8_BAR;
            PG8_LDA(At, 0, 1); PG8_STAGE(PG8_SA(0, 0), a2, voffA);
            PG8_BAR; PG8_WAIT_L(0); PG8_MMA(1, 0, At, B0); PG8_BAR; PG8_SCHED;
            PG8_STAGE(PG8_SB(0, 1), b2 + hstep, voffB);
            PG8_WAIT_V(6); PG8_BAR; PG8_MMA(1, 1, At, B1); PG8_BAR;
            PG8_LDB(B0, 1, 0); PG8_SCHED; PG8_LDA(At, 1, 0); PG8_STAGE(PG8_SA(0, 1), a2 + hstep, voffA);
            PG8_WAIT_L(8); PG8_BAR; PG8_WAIT_L(0); PG8_MMA(0, 0, At, B0); PG8_BAR; PG8_SCHED;
            PG8_LDB(B1, 1, 1); PG8_STAGE(PG8_SB(1, 0), b3, voffB);
            PG8_BAR; PG8_WAIT_L(0); PG8_MMA(0, 1, At, B1); PG8_BAR;
            PG8_LDA(At, 1, 1); PG8_STAGE(PG8_SA(1, 0), a3, voffA);
            PG8_BAR; PG8_WAIT_L(0); PG8_MMA(1, 0, At, B0); PG8_BAR; PG8_SCHED;
            PG8_STAGE(PG8_SB(1, 1), b3 + hstep, voffB);
            PG8_WAIT_V(6); PG8_BAR; PG8_MMA(1, 1, At, B1); PG8_BAR;
            }
        }
        if constexpr (ALIGN_EPI) { if (wr == 0) PG8_BAR; }
        if constexpr (!Epi::AFTER_DRAIN) { E(acc, cur, wr, wc, fr, fq); S.done(cur); }
        if (!has_next) break;
#pragma unroll
        for (int a = 0; a < 2; ++a)
#pragma unroll
            for (int b = 0; b < 2; ++b)
#pragma unroll
                for (int m = 0; m < 4; ++m)
#pragma unroll
                    for (int n = 0; n < 2; ++n) acc[a][b][m][n] = (f32x4){0.f, 0.f, 0.f, 0.f};
        cur = nxt; cA = nA; cB = nB; ++ui;
        if constexpr (ALIGN_EPI) { if (wr == 1) PG8_BAR; }
    }
    PG8_WAIT_V(0);
    if constexpr (!ALIGN_EPI) { if (wr == 0) PG8_BAR; }
    PG8_BAR;
    if constexpr (Epi::AFTER_DRAIN) { E.fused(acc, cur, wr, wc, fr, fq, lds, wid, lane); S.done(cur); }
#undef PG8_SA
#undef PG8_SB
#undef PG8_STAGE
#undef PG8_LDA
#undef PG8_LDB
#undef PG8_MMA
#undef PG8_WAIT_V
#undef PG8_WAIT_L
#undef PG8_BAR
#undef PG8_SCHED
}
}

#ifndef PG8_SP2
#define PG8_SP2 true
#endif
#ifndef PG8_ALIGN
#define PG8_ALIGN true
#endif
#include <hip/hip_bf16.h>
#include <cmath>
namespace attn_body {
using bf16=__hip_bfloat16;
using bf16x8=__attribute__((ext_vector_type(8)))short;
using s16x4=__attribute__((ext_vector_type(4)))short;
using f32x16=__attribute__((ext_vector_type(16)))float;
using u32x4=__attribute__((ext_vector_type(4)))unsigned;
constexpr int BATCH=1,NHEAD=16,SEQ=16384,D=64,DM=2112,DMO=1024;
constexpr int NW=8,QBLK=32,QB=QBLK*NW,KVBLK=64,NQB=SEQ/QB;
constexpr int ATTN_PITCH=DM, ATTN_UNIT_ROWS=QB;
__device__ __forceinline__ int crow(int r,int hi){return (r&3)+8*(r>>2)+4*hi;}
#define SBAR() __builtin_amdgcn_sched_barrier(0)
__device__ __forceinline__ void cmask(f32x16&p0,f32x16&p1,int jb,int qrel,int hi){
  const float NEG=-INFINITY; int kb=64*jb+4*hi;
  #pragma unroll
  for(int r=0;r<16;++r){int kv=kb+(r&3)+8*(r>>2); if(kv>qrel)p0[r]=NEG; if(kv+32>qrel)p1[r]=NEG;}
}

constexpr int NSLOT=3, SLOTB=8192;
constexpr int NVSLOT=3, VSLOTB=16384;
constexpr int LDS_K=0, LDS_V=NSLOT*SLOTB, LDS_P=LDS_V+NVSLOT*VSLOTB, LDS_WS=LDS_P+NW*8192, WSF_STRIDE=64, LDS_BYTES=LDS_WS+NW*WSF_STRIDE*4;
constexpr float C2=0.125f*1.4426950408889634f;
__device__ __forceinline__ void glds16(const void*gsrc,unsigned lds_dst){unsigned keep;
  asm volatile("s_mov_b32 %0, m0\n\ts_mov_b32 m0, %2\n\ts_nop 0\n\tglobal_load_lds_dwordx4 %1, off\n\ts_mov_b32 m0, %0":"=&s"(keep):"v"(gsrc),"s"(lds_dst):"memory");}
__device__ __forceinline__ float max3f(float a,float b,float c){float r;asm("v_max3_f32 %0, %1, %2, %3":"=v"(r):"v"(a),"v"(b),"v"(c));return r;}
__device__ __forceinline__ float max2f(float a,float b){float r;asm("v_max_f32_e32 %0, %1, %2":"=v"(r):"v"(a),"v"(b));return r;}
__device__ __forceinline__ float fadd_s(float a,float b){float r;asm("v_add_f32_e32 %0, %1, %2":"=v"(r):"v"(a),"v"(b));return r;}
__device__ __forceinline__ float fsub_s(float a,float b){float r;asm("v_sub_f32_e32 %0, %1, %2":"=v"(r):"v"(a),"v"(b));return r;}
typedef float f32x2_t __attribute__((ext_vector_type(2))); typedef __bf16 bf16x2_t __attribute__((ext_vector_type(2)));
__device__ __forceinline__ unsigned cvtpk_s(float lo,float hi){f32x2_t v={lo,hi};bf16x2_t b=__builtin_convertvector(v,bf16x2_t);return __builtin_bit_cast(unsigned,b);}
#define WAIT_BAR(N) asm volatile("s_waitcnt vmcnt(" #N ") lgkmcnt(0)\n\ts_barrier":::"memory")

__device__ __forceinline__ void qkt(f32x16&p0,f32x16&p1,const char*Kslot,const bf16x8*qr,const f32x16&negm,int r32,int hi){
  const char*kb=Kslot+hi*1024+r32*16;
  #pragma unroll
  for(int d0=0;d0<4;++d0){
    const bf16x8 b0=*reinterpret_cast<const bf16x8*>(kb+d0*2048);
    const bf16x8 b1=*reinterpret_cast<const bf16x8*>(kb+d0*2048+512);
    if(d0==0){p0=__builtin_amdgcn_mfma_f32_32x32x16_bf16(b0,qr[0],negm,0,0,0);p1=__builtin_amdgcn_mfma_f32_32x32x16_bf16(b1,qr[0],negm,0,0,0);}
    else{p0=__builtin_amdgcn_mfma_f32_32x32x16_bf16(b0,qr[d0],p0,0,0,0);p1=__builtin_amdgcn_mfma_f32_32x32x16_bf16(b1,qr[d0],p1,0,0,0);}}
}
typedef __attribute__((address_space(3))) const char* lds_cptr;
typedef short v4i16_t __attribute__((ext_vector_type(4)));
__device__ __forceinline__ void kload8(bf16x8*kf,lds_cptr kp){
  kf[0]=*(const __attribute__((address_space(3))) bf16x8*)(kp);      kf[1]=*(const __attribute__((address_space(3))) bf16x8*)(kp+512);
  kf[2]=*(const __attribute__((address_space(3))) bf16x8*)(kp+2048); kf[3]=*(const __attribute__((address_space(3))) bf16x8*)(kp+2560);
  kf[4]=*(const __attribute__((address_space(3))) bf16x8*)(kp+4096); kf[5]=*(const __attribute__((address_space(3))) bf16x8*)(kp+4608);
  kf[6]=*(const __attribute__((address_space(3))) bf16x8*)(kp+6144); kf[7]=*(const __attribute__((address_space(3))) bf16x8*)(kp+6656);
}
__device__ __forceinline__ void kload2(bf16x8*kf,lds_cptr kp,int j){ kf[2*j]=*(const __attribute__((address_space(3))) bf16x8*)(kp+j*2048); kf[2*j+1]=*(const __attribute__((address_space(3))) bf16x8*)(kp+j*2048+512); }
__device__ __forceinline__ s16x4 vtr(lds_cptr p){ return __builtin_bit_cast(s16x4,__builtin_amdgcn_ds_read_tr16_b64_v4i16((__attribute__((address_space(3))) v4i16_t*)p)); }
__device__ __forceinline__ float rowmax(const f32x16&p0,const f32x16&p1){
  float a=max3f(p0[0],p0[1],p1[0]),b=max3f(p0[2],p0[3],p1[1]);a=max3f(a,p1[2],p1[3]);
  #pragma unroll
  for(int r=4;r<16;r+=4){a=max3f(a,p0[r],p0[r+1]);b=max3f(b,p0[r+2],p0[r+3]);a=max3f(a,p1[r],p1[r+1]);b=max3f(b,p1[r+2],p1[r+3]);}
  const float m=max2f(a,b);
  auto rr=__builtin_amdgcn_permlane32_swap(__float_as_uint(m),__float_as_uint(m),false,false);
  return max2f(__uint_as_float(rr[0]),__uint_as_float(rr[1]));
}
__device__ __forceinline__ void pv(f32x16*o,int vb,bf16x8 pa0,bf16x8 pa1,bf16x8 pa2,bf16x8 pa3){
  #pragma unroll
  for(int d0=0;d0<2;++d0){s16x4 lo[4],hi[4];
    #pragma unroll
    for(int ks=0;ks<4;++ks){
      asm volatile("ds_read_b64_tr_b16 %0,%1 offset:%c2":"=&v"(lo[ks]):"v"(vb),"i"(d0*4096+ks*1024):"memory");
      asm volatile("ds_read_b64_tr_b16 %0,%1 offset:%c2":"=&v"(hi[ks]):"v"(vb),"i"(d0*4096+ks*1024+512):"memory");}
    asm volatile("s_waitcnt lgkmcnt(0)":::"memory");SBAR();
    #define PK(k) (bf16x8){lo[k][0],lo[k][1],lo[k][2],lo[k][3],hi[k][0],hi[k][1],hi[k][2],hi[k][3]}
    o[d0]=__builtin_amdgcn_mfma_f32_32x32x16_bf16(pa0,PK(0),o[d0],0,0,0);
    o[d0]=__builtin_amdgcn_mfma_f32_32x32x16_bf16(pa1,PK(1),o[d0],0,0,0);
    o[d0]=__builtin_amdgcn_mfma_f32_32x32x16_bf16(pa2,PK(2),o[d0],0,0,0);
    o[d0]=__builtin_amdgcn_mfma_f32_32x32x16_bf16(pa3,PK(3),o[d0],0,0,0);
    #undef PK
  }
}

#ifndef ATTN_STORE16
#define ATTN_STORE16(p,v) (*(u32x4*)(p)=(v))
#endif
template<int THRL> __device__ __forceinline__ void attn_unit(int qb,const bf16*Q,const bf16*__restrict__ K,const bf16*__restrict__ V,bf16*O,char*shm){
  int tid_=threadIdx.x; asm volatile("":"+v"(tid_)); const int tid=tid_,lane=tid&63,r32=lane&31,hi=lane>>5; const int wid=__builtin_amdgcn_readfirstlane(tid>>6);
  const int q0=qb*QB;
  const unsigned lds0=(unsigned)(uintptr_t)shm;
  float*wsf=(float*)(shm+LDS_WS)+wid*WSF_STRIDE;
  const bf16*ksrc=K+(long)lane*DM+wid*8;
  const bf16*vsrc=V+(long)(16*(wid&3)+(lane>>2))*DM+(wid>>2)*32+(lane&3)*8;
  const unsigned kdst=lds0+LDS_K+wid*1024, vdst=lds0+LDS_V+wid*1024;
  #define DMA_K(t,s3) glds16(ksrc+(long)(t)*KVBLK*DM,(unsigned)__builtin_amdgcn_readfirstlane(kdst+(s3)*SLOTB))
  #define DMA_V(t,s3) do{ const unsigned vd_=(unsigned)__builtin_amdgcn_readfirstlane(vdst+(s3)*VSLOTB); glds16(vsrc+(long)(t)*KVBLK*DM,vd_); glds16(vsrc+(long)(t)*KVBLK*DM+64,(unsigned)__builtin_amdgcn_readfirstlane(vd_+8192)); }while(0)
  const lds_cptr shm3=(lds_cptr)shm;
  const int NT=(q0+QB)/KVBLK;
  DMA_K(0,0);DMA_V(0,0);DMA_K(1,1);DMA_V(1,1);
  int c0=0,c1=1,c2=2;
  #define ROT3() do{ const int x_=c0; c0=c1; c1=c2; c2=x_; }while(0)
  #define PKW(P,B) cvtpk_s(P[B],P[B+1])
  #define MX3(a,b,c) __builtin_fmaxf(__builtin_fmaxf((a),(b)),(c))
  const bf16*Qw=Q+(long)(q0+wid*QBLK)*DM;
  bf16x8 qr[4];
  #pragma unroll
  for(int d0=0;d0<4;++d0)qr[d0]=*reinterpret_cast<const bf16x8*>(&Qw[(long)r32*DM+d0*16+hi*8]);
  float mhat=0.f,l_reg=0.f; f32x16 negm=f32x16{};
  f32x16 o[4]; o[0]=f32x16{};o[1]=f32x16{};o[2]=f32x16{};o[3]=f32x16{};
  const int qrel=wid*QBLK+r32;
  const lds_cptr kp0=shm3+LDS_K+hi*1024+r32*16;
  const lds_cptr vp0=shm3+LDS_V+((lane>>4)&1)*32+(lane&3)*8+(4*hi+((lane&15)>>2))*64;
  WAIT_BAR(3);
  for(int t=0;t<NT;++t){
    if(t+2<NT){DMA_K(t+2,c2);DMA_V(t+2,c2);}
    bf16x8 kf[8]; kload8(kf,kp0+c0*SLOTB);
    SBAR();
    f32x16 C0,C1;
    {
      C0=__builtin_amdgcn_mfma_f32_32x32x16_bf16(kf[0],qr[0],negm,0,0,0); C1=__builtin_amdgcn_mfma_f32_32x32x16_bf16(kf[1],qr[0],negm,0,0,0);
      C0=__builtin_amdgcn_mfma_f32_32x32x16_bf16(kf[2],qr[1],C0,0,0,0);   C1=__builtin_amdgcn_mfma_f32_32x32x16_bf16(kf[3],qr[1],C1,0,0,0);
      C0=__builtin_amdgcn_mfma_f32_32x32x16_bf16(kf[4],qr[2],C0,0,0,0);   C1=__builtin_amdgcn_mfma_f32_32x32x16_bf16(kf[5],qr[2],C1,0,0,0);
      C0=__builtin_amdgcn_mfma_f32_32x32x16_bf16(kf[6],qr[3],C0,0,0,0);   C1=__builtin_amdgcn_mfma_f32_32x32x16_bf16(kf[7],qr[3],C1,0,0,0); }
    SBAR();
    const lds_cptr vp_=vp0+c0*VSLOTB; s16x4 vl_[8],vh_[8];
    #pragma unroll
    for(int k2=0;k2<2;++k2)
      #pragma unroll
      for(int d_=0;d_<4;++d_){ vl_[d_*2+k2]=vtr(vp_+(d_*4096+k2*1024)); vh_[d_*2+k2]=vtr(vp_+(d_*4096+k2*1024+512)); }
    SBAR();
    { const int jb_=t-(NT-4); if(jb_>=0)cmask(C0,C1,jb_,qrel,hi); }
    float a=MX3(C0[0],C0[1],C1[0]),b=MX3(C0[2],C0[3],C1[1]); a=MX3(a,C1[2],C1[3]);
    #pragma unroll
    for(int r=4;r<16;r+=4){a=MX3(a,C0[r],C0[r+1]);b=MX3(b,C0[r+2],C0[r+3]);a=MX3(a,C1[r],C1[r+1]);b=MX3(b,C1[r+2],C1[r+3]);}
    float rm=__builtin_fmaxf(a,b); { auto rr=__builtin_amdgcn_permlane32_swap(__float_as_uint(rm),__float_as_uint(rm),false,false); rm=__builtin_fmaxf(__uint_as_float(rr[0]),__uint_as_float(rr[1])); }
    if(t==0 || __any(rm>(float)THRL)){
      const float dl=(t==0)?rm:__builtin_fmaxf(rm,0.f); mhat+=dl;
      #pragma unroll
      for(int r=0;r<16;++r){C0[r]-=dl;C1[r]-=dl;}
      #pragma unroll
      for(int r=0;r<16;++r)negm[r]=-mhat;
      if(t!=0){ const float f=__builtin_amdgcn_exp2f(-dl); l_reg*=f; if(hi==0)wsf[r32]=f; asm volatile("s_waitcnt lgkmcnt(0)":::"memory");
        #pragma unroll
        for(int d_=0;d_<4;++d_)
          #pragma unroll
          for(int r=0;r<16;++r)o[d_][r]*=wsf[crow(r,hi)]; } }
    #pragma unroll
    for(int r=0;r<16;++r){C0[r]=__builtin_amdgcn_exp2f(C0[r]);C1[r]=__builtin_amdgcn_exp2f(C1[r]);}
    { float s0=C0[0]+C0[1],s1=C1[0]+C1[1];
      #pragma unroll
      for(int r=2;r<16;++r){s0+=C0[r];s1+=C1[r];}
      l_reg+=s0+s1; }
    const u32x4 pw0=(u32x4){PKW(C0,0),PKW(C0,2),PKW(C0,4),PKW(C0,6)},pw1=(u32x4){PKW(C0,8),PKW(C0,10),PKW(C0,12),PKW(C0,14)},pw2=(u32x4){PKW(C1,0),PKW(C1,2),PKW(C1,4),PKW(C1,6)},pw3=(u32x4){PKW(C1,8),PKW(C1,10),PKW(C1,12),PKW(C1,14)};
    SBAR();
    #define VFRAG(L_,H_,i_) (bf16x8){L_[i_][0],L_[i_][1],L_[i_][2],L_[i_][3],H_[i_][0],H_[i_][1],H_[i_][2],H_[i_][3]}
    s16x4 w2l_[4],w2h_[4],w3l_[4],w3h_[4];
    #pragma unroll
    for(int d_=0;d_<4;++d_){ w2l_[d_]=vtr(vp_+(d_*4096+2*1024)); w2h_[d_]=vtr(vp_+(d_*4096+2*1024+512)); }
    SBAR();
    #pragma unroll
    for(int d_=0;d_<4;++d_){ o[d_]=__builtin_amdgcn_mfma_f32_32x32x16_bf16(__builtin_bit_cast(bf16x8,pw0),VFRAG(vl_,vh_,d_*2),o[d_],0,0,0); }
    SBAR();
    #pragma unroll
    for(int d_=0;d_<4;++d_){ w3l_[d_]=vtr(vp_+(d_*4096+3*1024)); w3h_[d_]=vtr(vp_+(d_*4096+3*1024+512)); }
    SBAR();
    #pragma unroll
    for(int d_=0;d_<4;++d_){ o[d_]=__builtin_amdgcn_mfma_f32_32x32x16_bf16(__builtin_bit_cast(bf16x8,pw1),VFRAG(vl_,vh_,d_*2+1),o[d_],0,0,0); }
    #pragma unroll
    for(int d_=0;d_<4;++d_){ o[d_]=__builtin_amdgcn_mfma_f32_32x32x16_bf16(__builtin_bit_cast(bf16x8,pw2),VFRAG(w2l_,w2h_,d_),o[d_],0,0,0); }
    #pragma unroll
    for(int d_=0;d_<4;++d_){ o[d_]=__builtin_amdgcn_mfma_f32_32x32x16_bf16(__builtin_bit_cast(bf16x8,pw3),VFRAG(w3l_,w3h_,d_),o[d_],0,0,0); }
    SBAR();
    #undef VFRAG
    if(t+2<NT){WAIT_BAR(3);}else{WAIT_BAR(0);}
    ROT3();
  }
  { auto rr=__builtin_amdgcn_permlane32_swap(__float_as_uint(l_reg),__float_as_uint(l_reg),false,false); l_reg=__uint_as_float(rr[0])+__uint_as_float(rr[1]); }
  if(hi==0)wsf[32+r32]=l_reg; asm volatile("s_waitcnt lgkmcnt(0)":::"memory");
  bf16*Ow=O+(long)(q0+wid*QBLK)*DMO;
  { bf16*stg=(bf16*)(shm+LDS_P)+wid*4096;
    #pragma unroll
    for(int r=0;r<16;++r){const int orow=crow(r,hi); const float rl=__builtin_amdgcn_rcpf(wsf[32+orow]);
      #pragma unroll
      for(int d0=0;d0<4;++d0)stg[orow*128+d0*32+r32]=__float2bfloat16(o[d0][r]*rl);}
    asm volatile("s_waitcnt lgkmcnt(0)":::"memory");
    #pragma unroll
    for(int i=0;i<8;++i){const int row=i*4+(lane>>4),ch=lane&15; const u32x4 v=*(const u32x4*)(stg+row*128+ch*8); ATTN_STORE16(Ow+(long)row*DMO+ch*8,v);} }
  asm volatile("s_waitcnt lgkmcnt(0)\n\ts_barrier":::"memory");
  #undef DMA_K
  #undef DMA_V
  #undef ROT3
  #undef PKW
  #undef MX3
}
constexpr int ATTN_LDS_BYTES=LDS_BYTES;
struct AttnTensors { const bf16* Q; const bf16* K; const bf16* V; bf16* O; };
struct AttnUnit { int hc; int qb; };
struct StaticOrder {
  int vcu, G, bx;
  __device__ __forceinline__ StaticOrder(int grid,int block):vcu((grid%8==0)?(block%8)*(grid/8)+block/8:block),G(grid),bx(block){}
  __device__ __forceinline__ bool next(int i,AttnUnit&u)const{
    if(G==256){ if(i>=2)return false; const int s=vcu&31; u.hc=vcu>>5; u.qb=(i==0)?63-s:s; return true; }
    const int idx=i*G+bx; if(idx>=8*NQB)return false; u.hc=idx&7; u.qb=NQB-1-(idx>>3); return true; }
};
template<class Sched,int THRL=8> __device__ __forceinline__ void attn_phase(char*lds,const AttnTensors&T,const Sched&S){
  AttnUnit u;
  for(int i=0;S.next(i,u);++i){ const int h=u.hc>>1,c=u.hc&1;
    attn_unit<THRL>(u.qb,T.Q+h*128+c*64,T.K+h*128+c*64,T.V+h*128,T.O+u.hc*128,lds); }
}
#undef SBAR
#undef WAIT_BAR
}
constexpr int NWAVES = 8;
constexpr int M = 16384, D = 1024, FF = 2816, NGU = 2 * FF, NIN = 2048, DEPTH = 4;
constexpr size_t MiB = 1u << 20;
constexpr size_t WS_ROWSS = 1 * MiB;
constexpr size_t WS_ROPE = 2 * MiB;
constexpr size_t WS_XB = 8 * MiB;
constexpr size_t WS_H = 40 * MiB;
constexpr size_t WS_QKVU = 40 * MiB;
constexpr size_t WS_OBUF = 108 * MiB;
constexpr size_t WS_CAT = 140 * MiB;
constexpr size_t WS_W = 172 * MiB;
constexpr size_t OFF_GU1 = 0, OFF_DN1 = 11 * MiB, OFF_IN = 16 * MiB + 512 * 1024, OFF_OUT = 20 * MiB + 512 * 1024, OFF_GU2 = 22 * MiB + 512 * 1024, OFF_DN2 = 33 * MiB + 512 * 1024, W_LAYER = 39 * MiB;
constexpr size_t WS_XL = WS_W + DEPTH * W_LAYER;
constexpr size_t WS_END = WS_XL + (size_t)M * D;
static_assert(attn_body::ATTN_LDS_BYTES <= 147392 && (size_t)NGU * D * 2 == 11 * MiB && (size_t)D * FF * 2 == 5 * MiB + 512 * 1024 && WS_H + (size_t)M * FF * 2 <= WS_CAT && WS_ROWSS + 16 * (size_t)M * 4 <= WS_ROPE && WS_ROPE + (size_t)M * 64 * 4 <= WS_XB, "ws map");
constexpr int LDS_BYTES = 147456;

#define LAS __attribute__((address_space(3)))
typedef unsigned short bf16;
typedef unsigned v4u __attribute__((ext_vector_type(4)));
typedef unsigned v2u __attribute__((ext_vector_type(2)));
typedef float f32x4 __attribute__((ext_vector_type(4)));
#define LDS_WAIT() asm volatile("s_waitcnt lgkmcnt(0)" ::: "memory")
__device__ __forceinline__ unsigned f2bf(float f) { unsigned u = __builtin_bit_cast(unsigned, f); return (u + 0x7fffu + ((u >> 16) & 1u)) >> 16; }
__device__ __forceinline__ unsigned pk2(float lo, float hi) { return f2bf(lo) | (f2bf(hi) << 16); }
__device__ __forceinline__ float bflo(unsigned w) { return __builtin_bit_cast(float, w << 16); }
__device__ __forceinline__ float bfhi(unsigned w) { return __builtin_bit_cast(float, w & 0xffff0000u); }
__device__ __forceinline__ float wave_sum(float v) {
#pragma unroll
    for (int o = 1; o < 64; o <<= 1) v += __shfl_xor(v, o);
    return v;
}
struct TrDesc { const float* W; const float* gk; bf16* WT; int N, k0, n0, Kd, rbase, rstride; };
__device__ __forceinline__ void tr_load(const TrDesc& d, int lane, f32x4 (&v)[8]) {
    const int kblk = lane & 7, n4 = lane >> 3;
    const float* src = d.W + (size_t)(d.k0 + 8 * kblk) * d.N + d.n0 + 4 * n4;
#pragma unroll
    for (int i = 0; i < 8; ++i) v[i] = __builtin_nontemporal_load((const f32x4*)(src + (size_t)i * d.N));
}
__device__ __forceinline__ void tr_store(const TrDesc& d, int lane, f32x4 (&v)[8]) {
    const int kblk = lane & 7, n4 = lane >> 3;
    if (d.gk) { const f32x4 g0 = *(const f32x4*)(d.gk + d.k0 + 8 * kblk), g1 = *(const f32x4*)(d.gk + d.k0 + 8 * kblk + 4);
#pragma unroll
        for (int i = 0; i < 4; ++i) { v[i] = v[i] * g0[i]; v[4 + i] = v[4 + i] * g1[i]; } }
#pragma unroll
    for (int e = 0; e < 4; ++e) { v4u o; o.x = pk2(v[0][e], v[1][e]); o.y = pk2(v[2][e], v[3][e]); o.z = pk2(v[4][e], v[5][e]); o.w = pk2(v[6][e], v[7][e]);
        *(v4u*)(d.WT + (size_t)(d.rbase + (4 * n4 + e) * d.rstride) * d.Kd + d.k0 + 8 * kblk) = o; }
}

#define XB_TMO      128
#define XB_XCNT(j)  (256  + 64 * (j))
#define XB_XSUB(j)  (1280 + 64 * (j))
#define XB_XGEN(j)  (2304 + 64 * (j))
#define XB_TOP      3328
#define XB_TOPGEN   3392
#define XCD_BAR_WORDS 3456
#define XB_SPIN_CAP (1u << 18)

__device__ __forceinline__ unsigned xb_ld(unsigned* p)              { return __hip_atomic_load(p, __ATOMIC_RELAXED, __HIP_MEMORY_SCOPE_AGENT); }
__device__ __forceinline__ unsigned xb_add(unsigned* p, unsigned v) { return __hip_atomic_fetch_add(p, v, __ATOMIC_RELAXED, __HIP_MEMORY_SCOPE_AGENT); }
__device__ __forceinline__ unsigned xb_xcc_id() { return (unsigned)__builtin_amdgcn_s_getreg((3 << 11) | 20) & 0xFu; }
#define XB_SPIN(cond, bar) do { unsigned _sp = 0; while (cond) { __builtin_amdgcn_s_sleep(1); \
    if ((++_sp & 255u) == 0u) { if (xb_ld(&(bar)[XB_TMO])) break; if (_sp > XB_SPIN_CAP) { atomicAdd(&(bar)[XB_TMO], 1u); break; } } } } while (0)

struct XcdBarrier {
    unsigned* bar; unsigned x;
    volatile LAS unsigned* st;
};

__device__ __forceinline__ XcdBarrier xcd_barrier_post(unsigned* bar, volatile LAS unsigned* st) {
    XcdBarrier b; b.bar = bar; b.x = xb_xcc_id(); b.st = st;
    if (threadIdx.x == 0) (void)xb_add(&bar[XB_XCNT(b.x)], 1u);
    return b;
}
__device__ __forceinline__ void xcd_barrier_complete(unsigned* bar, unsigned x, unsigned& nloc, unsigned& nx) {
    const unsigned G = gridDim.x * gridDim.y * gridDim.z;
    unsigned sum, cnt, mine, sp = 0u;
    for (;;) {
        sum = 0u; cnt = 0u; mine = 0u;
#pragma unroll
        for (unsigned j = 0; j < 16; ++j) { const unsigned c = xb_ld(&bar[XB_XCNT(j)]); sum += c; cnt += (c > 0u) ? 1u : 0u; mine = (j == x) ? c : mine; }
        if (sum == G) break;
        __builtin_amdgcn_s_sleep(1);
        if ((++sp & 255u) == 0u) { if (xb_ld(&bar[XB_TMO])) break; if (sp > XB_SPIN_CAP) { atomicAdd(&bar[XB_TMO], 1u); break; } }
    }
    nloc = mine > 0u ? mine : 1u; nx = cnt > 0u ? cnt : 1u;
}

__device__ __forceinline__ void xcd_barrier(const XcdBarrier& b) {
    asm volatile("s_waitcnt vmcnt(0)" ::: "memory");
    __syncthreads();
    if (threadIdx.x == 0) {
        unsigned* bar = b.bar;
        __builtin_amdgcn_s_waitcnt(0);
        unsigned nloc = b.st[0], nx = b.st[1];
        if (nloc == 0u) { xcd_barrier_complete(bar, b.x, nloc, nx); b.st[0] = nloc; b.st[1] = nx; }
        const unsigned old = xb_add(&bar[XB_XSUB(b.x)], 1u);
        const unsigned gen = old / nloc;
        if (old + 1u == (gen + 1u) * nloc) {
            __builtin_amdgcn_fence(__ATOMIC_RELEASE, "agent");
            asm volatile("s_waitcnt vmcnt(0)" ::: "memory");
            const unsigned og = xb_add(&bar[XB_TOP], 1u);
            const unsigned tg = og / nx;
            if (og + 1u == (tg + 1u) * nx) xb_add(&bar[XB_TOPGEN], 1u);
            else XB_SPIN(xb_ld(&bar[XB_TOPGEN]) == tg, bar);
            __builtin_amdgcn_fence(__ATOMIC_ACQUIRE, "agent");
            xb_add(&bar[XB_XGEN(b.x)], 1u);
            asm volatile("s_waitcnt vmcnt(0)" ::: "memory");
        } else {
            XB_SPIN(xb_ld(&bar[XB_XGEN(b.x)]) == gen, bar);
            __builtin_amdgcn_fence(__ATOMIC_ACQUIRE, "agent");
            asm volatile("s_waitcnt vmcnt(0)" ::: "memory");
        }
    }
    __syncthreads();
}

struct Args { const float* in[20]; float* out; unsigned char* wsp; };
__device__ __forceinline__ int fresh_lane() { int l; asm volatile("v_mbcnt_lo_u32_b32 %0, -1, 0\n\tv_mbcnt_hi_u32_b32 %0, -1, %0" : "=v"(l)); return l; }
typedef __attribute__((address_space(1))) unsigned char* gptr_t;
__device__ __forceinline__ gptr_t fresh_ptr(unsigned char* p) { asm volatile("" : "+s"(p)); return (gptr_t)p; }

__global__ void __launch_bounds__(NWAVES * 64, 2) hymba_fwd(Args args) {
    extern __shared__ __attribute__((aligned(16))) unsigned char lds[];
    LAS unsigned char* L = (LAS unsigned char*)lds;
    const int tid = threadIdx.x, lane = tid & 63, wave = __builtin_amdgcn_readfirstlane(tid >> 6);
    const int G = gridDim.x, bx = blockIdx.x;
    const int gw = bx * NWAVES + wave, NGW = G * NWAVES;
    const int gtid = bx * (NWAVES * 64) + tid, NT = G * NWAVES * 64;
#define ws (fresh_ptr(args.wsp))
#define rowss ((float*)(unsigned char*)(ws + WS_ROWSS))
#define rope ((float*)(unsigned char*)(ws + WS_ROPE))
#define XB ((bf16*)(unsigned char*)(ws + WS_XB))
#define HB ((bf16*)(unsigned char*)(ws + WS_H))
#define QKVU ((bf16*)(unsigned char*)(ws + WS_QKVU))
#define OBUF ((bf16*)(unsigned char*)(ws + WS_OBUF))
#define CAT ((bf16*)(unsigned char*)(ws + WS_CAT))
#define xout ((float*)(unsigned char*)fresh_ptr((unsigned char*)args.out))
    { volatile LAS unsigned* st0 = (volatile LAS unsigned*)(L + 147392); if (tid < 2) st0[tid] = 0u; }
    __syncthreads();
    (void)xcd_barrier_post((unsigned*)args.wsp, (volatile LAS unsigned*)(L + 147392));

    {
        constexpr int IT_G = 16 * 88, IT_D = 44 * 32, IT_IN = 16 * 64, IT_OUT = 8 * 32, IT_LAYER = 4 * IT_G + 2 * IT_D + IT_IN + IT_OUT;
        static_assert(IT_G == IT_D, "item decode");
#define TR_DECODE(d_, it_) do { const int l = (it_) / IT_LAYER; int r = (it_) % IT_LAYER; unsigned char* wlc_ = (unsigned char*)(ws + WS_W + (size_t)l * W_LAYER); \
            if (r < 6 * IT_G) { \
                const int f = r / (3 * IT_G), q = r % (3 * IT_G), kind = q / IT_G, i = q % IT_G; \
                if (kind < 2) { const int kb = i / 88, nb = i % 88, n0 = 32 * nb; \
                    d_ = TrDesc{args.in[(f ? 16 : 2) + kind] + (size_t)l * D * FF, args.in[f ? 15 : 1] + l * D, (bf16*)(wlc_ + (f ? OFF_GU2 : OFF_GU1)), FF, 64 * kb, n0, D, (n0 >> 7) * 256 + kind * 128 + (n0 & 127), 1}; } \
                else { const int kb = i / 32, nb = i % 32; \
                    d_ = TrDesc{args.in[f ? 18 : 4] + (size_t)l * FF * D, nullptr, (bf16*)(wlc_ + (f ? OFF_DN2 : OFF_DN1)), D, 64 * kb, 32 * nb, FF, 32 * nb, 1}; } \
            } else { r -= 6 * IT_G; \
                if (r < IT_IN) { const int kb = r / 64, nb = r % 64, n0 = 32 * nb; int rbase = n0, rstride = 1; \
                    if (n0 < 1024) { const int d0 = n0 & 63; rbase = (n0 - d0) + (d0 ? 1 : 0); rstride = 2; } \
                    d_ = TrDesc{args.in[6] + (size_t)l * D * NIN, args.in[5] + l * D, (bf16*)(wlc_ + OFF_IN), NIN, 64 * kb, n0, D, rbase, rstride}; } \
                else { r -= IT_IN; const int kb = r / 32, nb = r % 32; \
                    d_ = TrDesc{args.in[14] + (size_t)l * D * D, nullptr, (bf16*)(wlc_ + OFF_OUT), D, 64 * kb, 32 * nb, D, 32 * nb, 1}; } \
            } } while (0)
        if (gw < DEPTH * IT_LAYER) { int it = gw; TrDesc d0; TR_DECODE(d0, it); f32x4 va[8]; tr_load(d0, lane, va);
            for (;;) { const int itn = it + NGW; const bool has = itn < DEPTH * IT_LAYER; TrDesc d1 = d0; f32x4 vb[8];
#pragma unroll
                for (int i = 0; i < 8; ++i) vb[i] = (f32x4){0.f, 0.f, 0.f, 0.f};
                if (has) { TR_DECODE(d1, itn); tr_load(d1, lane, vb); }
                tr_store(d0, lane, va); if (!has) break;
                d0 = d1; it = itn;
#pragma unroll
                for (int i = 0; i < 8; ++i) va[i] = vb[i]; } }
#undef TR_DECODE
        for (int it = gw; it < DEPTH * 1024; it += NGW) {
            const int l = it >> 10, r = it & 1023, g = r >> 8, cb = (r >> 4) & 15, nb = r & 15, c0 = cb * 8, n = nb * 64 + lane;
            const float* pw = args.in[12] + ((size_t)(l * 4 + g) * 128 + c0) * 128; const float* ps = args.in[13] + l * 512 + g * 128;
            const float* wo = args.in[14] + (size_t)l * D * D + (size_t)(512 + g * 128) * D + n;
            float a[8];
#pragma unroll
            for (int j = 0; j < 8; ++j) a[j] = 0.f;
#pragma unroll 16
            for (int e = 0; e < 128; ++e) { const float w = wo[(size_t)e * D] * ps[e];
#pragma unroll
                for (int j = 0; j < 8; ++j) a[j] += pw[j * 128 + e] * w; }
            v4u o; o.x = pk2(a[0], a[1]); o.y = pk2(a[2], a[3]); o.z = pk2(a[4], a[5]); o.w = pk2(a[6], a[7]);
            *(v4u*)((bf16*)(unsigned char*)(ws + WS_W + (size_t)l * W_LAYER + OFF_OUT) + (size_t)n * D + 512 + g * 128 + c0) = o;
        }
        for (int i = gtid; i < M * 32; i += NT) { const int s = i >> 5, j = i & 31; const float inv = (float)pow(10000.0, -(double)j / 32.0); const float ang = (float)s * inv;
            const double a = (double)ang; rope[2 * i] = (float)cos(a); rope[2 * i + 1] = (float)sin(a); }
        if (gw < M) { int m = gw; f32x4 v[4];
            { const f32x4* xr = (const f32x4*)(args.in[0] + (size_t)m * D) + lane;
#pragma unroll
              for (int j = 0; j < 4; ++j) v[j] = __builtin_nontemporal_load(xr + 64 * j); }
            for (;;) { const int mn = m + NGW; const bool has = mn < M; f32x4 vn[4];
#pragma unroll
                for (int j = 0; j < 4; ++j) vn[j] = (f32x4){0.f, 0.f, 0.f, 0.f};
                if (has) { const f32x4* xr = (const f32x4*)(args.in[0] + (size_t)mn * D) + lane;
#pragma unroll
                    for (int j = 0; j < 4; ++j) vn[j] = __builtin_nontemporal_load(xr + 64 * j); }
                float s = 0.f;
#pragma unroll
                for (int j = 0; j < 4; ++j) s += (v[j].x * v[j].x + v[j].y * v[j].y) + (v[j].z * v[j].z + v[j].w * v[j].w);
                s = wave_sum(s); if (lane < 16) rowss[(size_t)m * 16 + lane] = (lane == 0) ? s : 0.f;
                v2u* o8 = (v2u*)(XB + (size_t)m * D) + lane;
#pragma unroll
                for (int j = 0; j < 4; ++j) { v2u w; w.x = pk2(v[j].x, v[j].y); w.y = pk2(v[j].z, v[j].w); o8[64 * j] = w;
                    int e = __builtin_amdgcn_cvt_pk_bf8_f32(v[j].x - bflo(w.x), v[j].y - bfhi(w.x), 0, false); e = __builtin_amdgcn_cvt_pk_bf8_f32(v[j].z - bflo(w.y), v[j].w - bfhi(w.y), e, true);
                    ((unsigned*)(unsigned char*)(ws + WS_XL + (size_t)m * D))[lane + 64 * j] = (unsigned)e; }
                if (!has) break; m = mn;
#pragma unroll
                for (int j = 0; j < 4; ++j) v[j] = vn[j]; } }
    }
    cg::this_grid().sync();


    for (int step = 0; step < 3 * DEPTH; ++step) {
        const int l = step / 3, kind = step % 3;
#define wl ((unsigned char*)(ws + WS_W + (size_t)l * W_LAYER))
        if (kind != 1) {
            const int f = kind >> 1;
            { pg8::Gemm g{XB, (const bf16*)(wl + (f ? OFF_GU2 : OFF_GU1)), M, NGU, D}; pg8::StaticOrder S; S.init(M, NGU, G, bx);
              pg8::Unit u0; u0.pm = -1; u0.pn = 0; const bool any0 = S.next(0, u0);
              { int tt = threadIdx.x; asm volatile("" : "+v"(tt));
                if (any0 && tt < 256) ((LAS float*)(L + 131072))[tt] = pg8::rs_from_ss(rowss + (size_t)(u0.pm * 256 + tt) * 16); }
              __syncthreads();
              pg8::EpiGateUp E{HB, rowss, (const LAS float*)(L + 131072), any0 ? u0.pm : -1};
              pg8::gemm_phase<pg8::EpiGateUp, pg8::StaticOrder, PG8_ALIGN, PG8_SP2>(L, g, S, E); }
            xcd_barrier(XcdBarrier{(unsigned*)args.wsp, xb_xcc_id(), (volatile LAS unsigned*)(L + 147392)});
            { pg8::Gemm g{HB, (const bf16*)(wl + (f ? OFF_DN2 : OFF_DN1)), M, D, FF}; pg8::StaticOrder S; S.init(M, D, G, bx);
              pg8::EpiResidBf E{(__attribute__((address_space(1))) bf16*)(ws + WS_XB), (__attribute__((address_space(1))) unsigned char*)(ws + WS_XL), rowss, 0.5f};
              pg8::gemm_phase<pg8::EpiResidBf, pg8::StaticOrder, PG8_ALIGN, PG8_SP2>(L, g, S, E); }
            xcd_barrier(XcdBarrier{(unsigned*)args.wsp, xb_xcc_id(), (volatile LAS unsigned*)(L + 147392)});
        } else {
            { pg8::Gemm g{XB, (const bf16*)(wl + OFF_IN), M, NIN, D}; pg8::StaticOrder S; S.init(M, NIN, G, bx);
              pg8::Unit u0; u0.pm = -1; u0.pn = 0; const bool any0 = S.next(0, u0);
              { int tt = threadIdx.x; asm volatile("" : "+v"(tt));
                if (any0 && tt < 256) ((LAS float*)(L + 131072))[tt] = pg8::rs_from_ss(rowss + (size_t)(u0.pm * 256 + tt) * 16); }
              __syncthreads();
              pg8::EpiQKVU E{QKVU, rowss, rope, (const LAS float*)(L + 131072), any0 ? u0.pm : -1};
              pg8::gemm_phase<pg8::EpiQKVU, pg8::StaticOrder, PG8_ALIGN, PG8_SP2>(L, g, S, E); }
            xcd_barrier(XcdBarrier{(unsigned*)args.wsp, xb_xcc_id(), (volatile LAS unsigned*)(L + 147392)});
            { const attn_body::AttnTensors AT{(const attn_body::bf16*)QKVU, (const attn_body::bf16*)(QKVU + 512), (const attn_body::bf16*)(QKVU + 1024), (attn_body::bf16*)OBUF};
              const attn_body::StaticOrder S(G, bx);
              attn_body::attn_phase<attn_body::StaticOrder>((char*)lds, AT, S); }
            xcd_barrier(XcdBarrier{(unsigned*)args.wsp, xb_xcc_id(), (volatile LAS unsigned*)(L + 147392)});
            {
                const int lane = fresh_lane();
                const float li = 0.8f - 0.6f * expf(-0.3f * (float)l);
                const float s1 = wave_sum(args.in[7][l * 64 + lane] * args.in[8][l * 64 + lane]), s2 = wave_sum(args.in[9][l * 64 + lane] * args.in[10][l * 64 + lane]);
                const float lam = expf(s1) - expf(s2) + li;
                const int hd = lane >> 4, j0 = (lane & 15) * 8;
                float gn[8];
#pragma unroll
                for (int j = 0; j < 8; ++j) gn[j] = args.in[11][l * 128 + j0 + j] * (1.0f - li);
                const int win = 2 << hd;
                for (int mc = gw; mc < M / 8; mc += NGW) { float wsum[8];
                  for (int mr = 0; mr < 8; ++mr) { const int m = mc * 8 + mr;
                    const v4u a = *(const v4u*)(OBUF + (size_t)m * 1024 + hd * 256 + j0), b = *(const v4u*)(OBUF + (size_t)m * 1024 + hd * 256 + 128 + j0);
                    float o[8];
                    o[0] = bflo(a.x) - lam * bflo(b.x); o[1] = bfhi(a.x) - lam * bfhi(b.x); o[2] = bflo(a.y) - lam * bflo(b.y); o[3] = bfhi(a.y) - lam * bfhi(b.y);
                    o[4] = bflo(a.z) - lam * bflo(b.z); o[5] = bfhi(a.z) - lam * bfhi(b.z); o[6] = bflo(a.w) - lam * bflo(b.w); o[7] = bfhi(a.w) - lam * bfhi(b.w);
                    float ss = 0.f;
#pragma unroll
                    for (int j = 0; j < 8; ++j) ss += o[j] * o[j];
                    ss += __shfl_xor(ss, 1); ss += __shfl_xor(ss, 2); ss += __shfl_xor(ss, 4); ss += __shfl_xor(ss, 8);
                    const float rr = __builtin_amdgcn_rsqf(ss * (1.0f / 128.0f) + 1e-6f);
                    v4u w; w.x = pk2(o[0] * rr * gn[0], o[1] * rr * gn[1]); w.y = pk2(o[2] * rr * gn[2], o[3] * rr * gn[3]); w.z = pk2(o[4] * rr * gn[4], o[5] * rr * gn[5]); w.w = pk2(o[6] * rr * gn[6], o[7] * rr * gn[7]);
                    *(v4u*)(CAT + (size_t)m * 1024 + hd * 128 + j0) = w;
                    const bf16* up = QKVU + (size_t)m * 2112 + 1536 + hd * 128 + j0;
                    const v4u u0 = *(const v4u*)up;
                    const float us[8] = {bflo(u0.x), bfhi(u0.x), bflo(u0.y), bfhi(u0.y), bflo(u0.z), bfhi(u0.z), bflo(u0.w), bfhi(u0.w)};
                    float sm[8];
                    if (mr == 0) {
                        v4u ut[15]; float wt[15];
#pragma unroll
                        for (int j = 0; j < 8; ++j) sm[j] = us[j];
#pragma unroll
                        for (int t = 1; t < 16; ++t) { const bool ok = (t < win) && (m - t >= 0); ut[t - 1] = *(const v4u*)(up - (size_t)(ok ? t : 0) * 2112); wt[t - 1] = ok ? 1.0f : 0.0f; }
#pragma unroll
                        for (int t = 0; t < 15; ++t) { const float w = wt[t];
                            sm[0] += w * bflo(ut[t].x); sm[1] += w * bfhi(ut[t].x); sm[2] += w * bflo(ut[t].y); sm[3] += w * bfhi(ut[t].y); sm[4] += w * bflo(ut[t].z); sm[5] += w * bfhi(ut[t].z); sm[6] += w * bflo(ut[t].w); sm[7] += w * bfhi(ut[t].w); }
                    } else {
                        const bool dr = (m - win >= 0); const v4u ud = *(const v4u*)(up - (size_t)(dr ? win : 0) * 2112); const float wd = dr ? 1.0f : 0.0f;
                        sm[0] = wsum[0] + us[0] - wd * bflo(ud.x); sm[1] = wsum[1] + us[1] - wd * bfhi(ud.x); sm[2] = wsum[2] + us[2] - wd * bflo(ud.y); sm[3] = wsum[3] + us[3] - wd * bfhi(ud.y);
                        sm[4] = wsum[4] + us[4] - wd * bflo(ud.z); sm[5] = wsum[5] + us[5] - wd * bfhi(ud.z); sm[6] = wsum[6] + us[6] - wd * bflo(ud.w); sm[7] = wsum[7] + us[7] - wd * bfhi(ud.w);
                    }
#pragma unroll
                    for (int j = 0; j < 8; ++j) wsum[j] = sm[j];
                    const float ic = 1.0f / (float)((m + 1 < win) ? (m + 1) : win);
                    v4u d; d.x = pk2(sm[0] * ic - us[0], sm[1] * ic - us[1]); d.y = pk2(sm[2] * ic - us[2], sm[3] * ic - us[3]); d.z = pk2(sm[4] * ic - us[4], sm[5] * ic - us[5]); d.w = pk2(sm[6] * ic - us[6], sm[7] * ic - us[7]);
                    *(v4u*)(CAT + (size_t)m * 1024 + 512 + hd * 128 + j0) = d;
                  }
                }
            }
            xcd_barrier(XcdBarrier{(unsigned*)args.wsp, xb_xcc_id(), (volatile LAS unsigned*)(L + 147392)});
            { pg8::Gemm g{CAT, (const bf16*)(wl + OFF_OUT), M, D, D}; pg8::StaticOrder S; S.init(M, D, G, bx);
              pg8::EpiResidBf E{(__attribute__((address_space(1))) bf16*)(ws + WS_XB), (__attribute__((address_space(1))) unsigned char*)(ws + WS_XL), rowss, 1.0f};
              pg8::gemm_phase<pg8::EpiResidBf, pg8::StaticOrder, PG8_ALIGN, PG8_SP2>(L, g, S, E); }
            xcd_barrier(XcdBarrier{(unsigned*)args.wsp, xb_xcc_id(), (volatile LAS unsigned*)(L + 147392)});
        }
    }
    { const int lane = fresh_lane();
      if (gw < M) { int m = gw; v2u hw[4]; unsigned lw[4]; f32x4 pp[4]; f32x4 gg[4]; const f32x4* gr = (const f32x4*)args.in[19] + lane;
#pragma unroll
        for (int j = 0; j < 4; ++j) gg[j] = gr[64 * j];
#define FN_LD(mm, H_, L_, P_) do { const v2u* xr = (const v2u*)(XB + (size_t)(mm) * D) + lane; const unsigned* lr = (const unsigned*)(unsigned char*)(ws + WS_XL + (size_t)(mm) * D) + lane; const f32x4* pr = (const f32x4*)(rowss + (size_t)(mm) * 16); \
            _Pragma("unroll") for (int j = 0; j < 4; ++j) { H_[j] = xr[64 * j]; L_[j] = lr[64 * j]; P_[j] = pr[j]; } } while (0)
        FN_LD(m, hw, lw, pp);
        for (;;) { const int mn = m + NGW; const bool has = mn < M; v2u hn[4]; unsigned ln[4]; f32x4 pn[4];
#pragma unroll
            for (int j = 0; j < 4; ++j) { hn[j] = (v2u){0u, 0u}; ln[j] = 0u; pn[j] = (f32x4){0.f, 0.f, 0.f, 0.f}; }
            if (has) FN_LD(mn, hn, ln, pn);
            const float ss = (((pp[0][0] + pp[0][1]) + (pp[0][2] + pp[0][3])) + ((pp[1][0] + pp[1][1]) + (pp[1][2] + pp[1][3]))) + (((pp[2][0] + pp[2][1]) + (pp[2][2] + pp[2][3])) + ((pp[3][0] + pp[3][1]) + (pp[3][2] + pp[3][3])));
            const float r = __builtin_amdgcn_rsqf(ss * (1.0f / 1024.0f) + 1e-6f);
            f32x4* xo = (f32x4*)((float*)(unsigned char*)fresh_ptr((unsigned char*)args.out) + (size_t)m * D) + lane;
#pragma unroll
            for (int j = 0; j < 4; ++j) { const v2u w = hw[j]; const int e = (int)lw[j];
                const pg8::f32x2 la = __builtin_amdgcn_cvt_pk_f32_bf8(e, false), lb = __builtin_amdgcn_cvt_pk_f32_bf8(e, true);
                const f32x4 v = (f32x4){bflo(w.x) + la.x, bfhi(w.x) + la.y, bflo(w.y) + lb.x, bfhi(w.y) + lb.y}; xo[64 * j] = v * r * gg[j]; }
            if (!has) break; m = mn;
#pragma unroll
            for (int j = 0; j < 4; ++j) { hw[j] = hn[j]; lw[j] = ln[j]; pp[j] = pn[j]; } }
#undef FN_LD
      } }
}

#undef wl
#undef ws
#undef rowss
#undef rope
#undef XB
#undef HB
#undef QKVU
#undef OBUF
#undef CAT
#undef xout
extern "C" void kernel_launch(void* const* d_in, const int* in_sizes, int n_in, void* d_out, int out_size, void* d_ws, size_t ws_size, hipStream_t stream) {
    static int grid_blocks = 0;
    if (grid_blocks == 0) {
        if (n_in != 20 || out_size != M * D || ws_size < WS_END) { fprintf(stderr, "kernel_launch: unexpected shapes (n_in %d out %d ws %zu, need %zu)\n", n_in, out_size, ws_size, (size_t)WS_END); grid_blocks = -1; return; }
        int dev = 0, cus = 0, per_cu = 0;
        (void)hipGetDevice(&dev); (void)hipDeviceGetAttribute(&cus, hipDeviceAttributeMultiprocessorCount, dev);
        if (hipFuncSetAttribute((const void*)hymba_fwd, hipFuncAttributeMaxDynamicSharedMemorySize, LDS_BYTES) != hipSuccess) { fprintf(stderr, "kernel_launch: hipFuncSetAttribute failed\n"); grid_blocks = -1; return; }
        if (hipOccupancyMaxActiveBlocksPerMultiprocessor(&per_cu, (const void*)hymba_fwd, NWAVES * 64, LDS_BYTES) != hipSuccess || per_cu < 1) { fprintf(stderr, "kernel_launch: occupancy query says %d\n", per_cu); per_cu = 1; }
        (void)hipGetLastError();
        grid_blocks = cus * per_cu;
    }
    if (grid_blocks < 0) return;
    if (hipMemsetAsync(d_ws, 0, 65536, stream) != hipSuccess) { fprintf(stderr, "kernel_launch: memset failed\n"); return; }
    Args a{};
    for (int i = 0; i < 20; ++i) a.in[i] = (const float*)d_in[i];
    a.out = (float*)d_out; a.wsp = (unsigned char*)d_ws;
    void* kargs[] = {&a};
    hipError_t e = hipLaunchCooperativeKernel((const void*)hymba_fwd, dim3(grid_blocks), dim3(NWAVES * 64), kargs, LDS_BYTES, stream);
    if (e != hipSuccess) fprintf(stderr, "cooperative launch failed: %s (grid %d)\n", hipGetErrorString(e), grid_blocks);
}
```
